# Optimizing an MI355X kernel written in HIP

```python
import math
import jax, jax.numpy as jnp
from jax import lax
import numpy as np

D_MODEL = 1024
BATCH = 32
SEQ = 2048
DEPTH = 1

N_META = 16
EPS = 1e-6
BLOCK = 128
D_RNN = D_MODEL
RG_BLOCKS = 8
RG_BS = D_RNN // RG_BLOCKS
CONV_W = 4
RG_C = 8.0
MLA_HEADS = 16
Q_LORA = 384
KV_LORA = 256
QK_NOPE = 64
QK_ROPE = 32
V_DIM = 64
ROPE_BASE = 10000.0
PEER_HEADS = 8
PEER_NKEYS = 128
PEER_EXPERTS = PEER_NKEYS * PEER_NKEYS
PEER_QDIM = 256
PEER_TOPK = 16

IN_SIZES = (D_RNN, D_RNN, Q_LORA, KV_LORA, QK_ROPE, D_MODEL, D_MODEL)
IN_SPLITS = tuple(int(s) for s in np.cumsum(IN_SIZES)[:-1])
D_IN = int(sum(IN_SIZES))

kernel_name = 'hybrid_rglru_mla_peer_block'


def _rmsnorm(x, g):
    xf = x.astype(jnp.float32)
    xf = xf * lax.rsqrt(jnp.mean(xf * xf, axis=-1, keepdims=True) + EPS)
    return xf.astype(x.dtype) * g


def _rope(x, pos):
    half = QK_ROPE // 2
    inv = jnp.power(ROPE_BASE, -jnp.arange(half, dtype=jnp.float32) * (2.0 / QK_ROPE))
    ang = pos[:, None] * inv[None, :]
    cos = jnp.cos(ang)[None, :, None, :].astype(x.dtype)
    sin = jnp.sin(ang)[None, :, None, :].astype(x.dtype)
    x1, x2 = x[..., :half], x[..., half:]
    return jnp.concatenate([x1 * cos - x2 * sin, x1 * sin + x2 * cos], axis=-1)


def _causal_conv(x, w, b):
    T = x.shape[1]
    xp = jnp.pad(x, ((0, 0), (CONV_W - 1, 0), (0, 0)))
    y = xp[:, 0:T] * w[0] + b
    for k in range(1, CONV_W):
        y = y + xp[:, k:k + T] * w[k]
    return y


def _lin_combine(e1, e2):
    a1, b1 = e1
    a2, b2 = e2
    return (a1 * a2, a2 * b1 + b2)


def _rg_lru(x, w_a, b_a, w_x, b_x, lam):
    B, T, _ = x.shape
    xb = x.reshape(B, T, RG_BLOCKS, RG_BS)
    r = jax.nn.sigmoid(jnp.einsum('btnc,ncd->btnd', xb, w_a).reshape(B, T, D_RNN) + b_a)
    i = jax.nn.sigmoid(jnp.einsum('btnc,ncd->btnd', xb, w_x).reshape(B, T, D_RNN) + b_x)
    log_a = RG_C * r.astype(jnp.float32) * jax.nn.log_sigmoid(lam.astype(jnp.float32))
    a = jnp.exp(log_a)
    u = jnp.sqrt(-jnp.expm1(2.0 * log_a)) * (i * x).astype(jnp.float32)
    _, h = lax.associative_scan(_lin_combine, (a, u), axis=1)
    return h.astype(x.dtype)


def _mla_attention(q_nope, q_rope, k_nope, k_rope, v):
    B, T, H, _ = q_nope.shape
    nb = T // BLOCK
    scale = (QK_NOPE + QK_ROPE) ** -0.5
    key_pos = jnp.arange(T)

    def to_blocks(t):
        return jnp.swapaxes(t.reshape((B, nb, BLOCK) + t.shape[2:]), 0, 1)

    def one_block(args):
        qn, qr, bi = args
        q_pos = bi * BLOCK + jnp.arange(BLOCK)
        s = (jnp.einsum('bqhd,bkhd->bhqk', qn, k_nope)
             + jnp.einsum('bqhd,bkd->bhqk', qr, k_rope)).astype(jnp.float32) * scale
        s = jnp.where(key_pos[None, :] <= q_pos[:, None], s, -1e30)
        p = jax.nn.softmax(s, axis=-1).astype(v.dtype)
        return jnp.einsum('bhqk,bkhd->bqhd', p, v)

    o = lax.map(one_block, (to_blocks(q_nope), to_blocks(q_rope), jnp.arange(nb)))
    return jnp.swapaxes(o, 0, 1).reshape(B, T, H * V_DIM)


def _peer(x, w_q, keys1, keys2, u, v):
    B, T, D = x.shape
    half = PEER_QDIM // 2
    xc = x.reshape(B * T // BLOCK, BLOCK, D)

    def one_chunk(xt):
        q = (xt @ w_q).reshape(BLOCK, PEER_HEADS, PEER_QDIM)
        s1 = jnp.einsum('chd,nd->chn', q[..., :half], keys1).astype(jnp.float32)
        s2 = jnp.einsum('chd,nd->chn', q[..., half:], keys2).astype(jnp.float32)
        t1, i1 = lax.top_k(s1, PEER_TOPK)
        t2, i2 = lax.top_k(s2, PEER_TOPK)
        cand = (t1[..., :, None] + t2[..., None, :]).reshape(BLOCK, PEER_HEADS, PEER_TOPK * PEER_TOPK)
        cidx = (i1[..., :, None] * PEER_NKEYS + i2[..., None, :]).reshape(BLOCK, PEER_HEADS, PEER_TOPK * PEER_TOPK)
        ts, sel = lax.top_k(cand, PEER_TOPK)
        idx = jnp.take_along_axis(cidx, sel, axis=-1)
        g = jax.nn.softmax(ts, axis=-1)
        act = jax.nn.gelu(jnp.einsum('chkd,cd->chk', u[idx], xt))
        coef = (g * act.astype(jnp.float32)).astype(xt.dtype)
        return jnp.einsum('chk,chkd->cd', coef, v[idx])

    return lax.map(one_chunk, xc).reshape(B, T, D)


def setup_inputs(seed: int = 0) -> dict:
    key = jax.random.key(seed)
    ks = jax.random.split(key, 26)
    f32 = jnp.float32
    L = DEPTH

    def nrm(k, shape, scale):
        return jax.random.normal(k, shape, f32) * scale

    def gain(k, shape):
        return 1.0 + 0.01 * jax.random.normal(k, shape, f32)

    a_c = jax.random.uniform(ks[10], (L, D_RNN), f32, 0.9, 0.999)
    s = a_c ** (1.0 / RG_C)
    rg_lambda = jnp.log(s) - jnp.log1p(-s)
    return {
        'x': nrm(ks[0], (BATCH, SEQ, D_MODEL), 1.0),
        'meta_tokens': nrm(ks[1], (N_META, D_MODEL), 1.0),
        'norm1_g': gain(ks[2], (L, D_MODEL)),
        'w_in': nrm(ks[3], (L, D_MODEL, D_IN), D_MODEL ** -0.5),
        'conv_w': nrm(ks[4], (L, CONV_W, D_RNN), CONV_W ** -0.5),
        'conv_b': nrm(ks[5], (L, D_RNN), 0.01),
        'rg_wa': nrm(ks[6], (L, RG_BLOCKS, RG_BS, RG_BS), RG_BS ** -0.5),
        'rg_ba': nrm(ks[7], (L, D_RNN), 0.01),
        'rg_wx': nrm(ks[8], (L, RG_BLOCKS, RG_BS, RG_BS), RG_BS ** -0.5),
        'rg_bx': nrm(ks[9], (L, D_RNN), 0.01),
        'rg_lambda': rg_lambda,
        'w_rnn_out': nrm(ks[11], (L, D_RNN, D_MODEL), D_RNN ** -0.5),
        'q_norm_g': gain(ks[12], (L, Q_LORA)),
        'w_uq': nrm(ks[13], (L, Q_LORA, MLA_HEADS * (QK_NOPE + QK_ROPE)), Q_LORA ** -0.5),
        'kv_norm_g': gain(ks[14], (L, KV_LORA)),
        'w_ukv': nrm(ks[15], (L, KV_LORA, MLA_HEADS * (QK_NOPE + V_DIM)), KV_LORA ** -0.5),
        'w_attn_out': nrm(ks[16], (L, MLA_HEADS * V_DIM, D_MODEL), (MLA_HEADS * V_DIM) ** -0.5),
        'w_out': nrm(ks[17], (L, D_MODEL, D_MODEL), D_MODEL ** -0.5),
        'norm2_g': gain(ks[18], (L, D_MODEL)),
        'peer_wq': nrm(ks[19], (L, D_MODEL, PEER_HEADS * PEER_QDIM), D_MODEL ** -0.5),
        'peer_keys1': nrm(ks[20], (L, PEER_NKEYS, PEER_QDIM // 2), (PEER_QDIM // 2) ** -0.5),
        'peer_keys2': nrm(ks[21], (L, PEER_NKEYS, PEER_QDIM // 2), (PEER_QDIM // 2) ** -0.5),
        'peer_u': nrm(ks[22], (L, PEER_EXPERTS, D_MODEL), D_MODEL ** -0.5),
        'peer_v': nrm(ks[23], (L, PEER_EXPERTS, D_MODEL), PEER_HEADS ** -0.5),
        'final_g': gain(ks[24], (D_MODEL,)),
    }


def reference(x, meta_tokens, norm1_g, w_in, conv_w, conv_b, rg_wa, rg_ba, rg_wx, rg_bx, rg_lambda,
              w_rnn_out, q_norm_g, w_uq, kv_norm_g, w_ukv, w_attn_out, w_out, norm2_g,
              peer_wq, peer_keys1, peer_keys2, peer_u, peer_v, final_g):
    B, S, D = x.shape
    T = N_META + S
    Tp = -(-T // BLOCK) * BLOCK
    meta = jnp.broadcast_to(meta_tokens[None].astype(x.dtype), (B, N_META, D))
    h = jnp.concatenate([meta, x], axis=1)
    h = jnp.pad(h, ((0, 0), (0, Tp - T), (0, 0)))
    pos = jnp.arange(Tp, dtype=jnp.float32)
    for l in range(DEPTH):
        n1 = _rmsnorm(h, norm1_g[l])
        xr, gr, cq, ckv, kr, g_rnn, g_att = jnp.split(n1 @ w_in[l], IN_SPLITS, axis=-1)
        hr = _rg_lru(_causal_conv(xr, conv_w[l], conv_b[l]), rg_wa[l], rg_ba[l], rg_wx[l], rg_bx[l], rg_lambda[l])
        y_rnn = (hr * jax.nn.gelu(gr)) @ w_rnn_out[l]
        q = (_rmsnorm(cq, q_norm_g[l]) @ w_uq[l]).reshape(B, Tp, MLA_HEADS, QK_NOPE + QK_ROPE)
        kv = (_rmsnorm(ckv, kv_norm_g[l]) @ w_ukv[l]).reshape(B, Tp, MLA_HEADS, QK_NOPE + V_DIM)
        q_rope = _rope(q[..., QK_NOPE:], pos)
        k_rope = _rope(kr[:, :, None, :], pos)[:, :, 0, :]
        o = _mla_attention(q[..., :QK_NOPE], q_rope, kv[..., :QK_NOPE], k_rope, kv[..., QK_NOPE:])
        y_att = o @ w_attn_out[l]
        mixed = jax.nn.sigmoid(g_rnn) * y_rnn + jax.nn.sigmoid(g_att) * y_att
        h = h + mixed @ w_out[l]
        h = h + _peer(_rmsnorm(h, norm2_g[l]), peer_wq[l], peer_keys1[l], peer_keys2[l], peer_u[l], peer_v[l])
    h = _rmsnorm(h, final_g)
    return h[:, N_META:N_META + S]
```

```cpp
#include <hip/hip_runtime.h>
#include <cstdio>
#include <cstdint>

#ifndef ONE_LAUNCH
#define ONE_LAUNCH 1
#endif

#define LAS __attribute__((address_space(3)))
#define GAS __attribute__((address_space(1)))
typedef unsigned short bf16_t;
typedef short bf16x8 __attribute__((ext_vector_type(8)));
typedef float f32x4 __attribute__((ext_vector_type(4)));
typedef float f32x2 __attribute__((ext_vector_type(2)));
typedef float f32x16 __attribute__((ext_vector_type(16)));
typedef unsigned u32x4 __attribute__((ext_vector_type(4)));
typedef unsigned u32x2 __attribute__((ext_vector_type(2)));
typedef __bf16 bf16x2_t __attribute__((ext_vector_type(2)));
typedef short v4i16_t __attribute__((ext_vector_type(4)));

constexpr int DM = 1024, NB = 32, SEQ = 2048, NMETA = 16;
constexpr int M = NB * SEQ;
constexpr int METAROW = M;
constexpr int MTOT = M + 256;
constexpr int NPOS = SEQ + NMETA;
constexpr int DIN_P = 4864;
constexpr int CQKV_LD = 768, CQ_OFF = 384, KR_OFF = 256;
constexpr int QLD = 1536;
constexpr int NEXP = 16384;
constexpr float EPS = 1e-6f;
constexpr float LOG2E = 1.4426950408889634f;
constexpr float QSCALE = 0.10206207261596577f * 1.4426950408889634f;

constexpr size_t A1 = (size_t)MTOT * 1024 * 2;
constexpr size_t WS_CTL = 0, CTL_ZERO_BYTES = 65536;
constexpr size_t WS_WIN = 1u << 20;
constexpr size_t WS_WGATE = WS_WIN + (size_t)DIN_P * 1024 * 2;
constexpr size_t WS_WUQ = WS_WGATE + 2048 * 128 * 2;
constexpr size_t WS_WUKV = WS_WUQ + 1536 * 384 * 2;
constexpr size_t WS_WRNN = WS_WUKV + 2048 * 256 * 2;
constexpr size_t WS_WATT = WS_WRNN + 1024 * 1024 * 2;
constexpr size_t WS_WOUT = WS_WATT + 1024 * 1024 * 2;
constexpr size_t WS_WPQ = WS_WOUT + 1024 * 1024 * 2;
constexpr size_t WS_KEYS = WS_WPQ + 2048 * 1024 * 2;
constexpr size_t WS_PU = WS_KEYS + 256 * 256 * 2;
constexpr size_t WS_PV = WS_PU + (size_t)NEXP * 1024;
constexpr size_t WS_SU = WS_PV + (size_t)NEXP * 1024;
constexpr size_t WS_SV = WS_SU + (size_t)NEXP * 4;
constexpr size_t WS_CTAB = WS_SV + (size_t)NEXP * 4;
constexpr size_t WS_STAB = WS_CTAB + NPOS * 16 * 4;
constexpr size_t WS_CLAM = WS_STAB + NPOS * 16 * 4;
constexpr size_t WS_RSQ = WS_CLAM + 4096;
constexpr size_t WS_RSKV = WS_RSQ + (size_t)MTOT * 4;
constexpr size_t WS_KROPE = WS_RSKV + (size_t)MTOT * 4;
constexpr size_t WS_SCP = WS_KROPE + (size_t)MTOT * 32 * 2;
constexpr size_t WS_SCH = WS_SCP + 512 * 1024 * 4;
constexpr size_t WS_CARRY0 = WS_SCH + 512 * 1024 * 4;
constexpr size_t WS_SLOTS = ((WS_CARRY0 + 4096 + 4095) / 4096) * 4096;
constexpr size_t WS_END = WS_SLOTS + 7 * A1;
#define SLOT(i) (WS_SLOTS + (size_t)(i) * A1)

#define LDS_WAIT() asm volatile("s_waitcnt lgkmcnt(0)" ::: "memory")
#define VM_WAIT() asm volatile("s_waitcnt vmcnt(0)" ::: "memory")
__device__ __forceinline__ unsigned pk2(float lo, float hi) { f32x2 v = {lo, hi}; bf16x2_t b = __builtin_convertvector(v, bf16x2_t); return __builtin_bit_cast(unsigned, b); }
__device__ __forceinline__ float bf_lo(unsigned w) { return __uint_as_float(w << 16); }
__device__ __forceinline__ float bf_hi(unsigned w) { return __uint_as_float(w & 0xffff0000u); }
__device__ __forceinline__ float bf2f(bf16_t h) { return __uint_as_float((unsigned)h << 16); }
__device__ __forceinline__ float ex2(float x) { return __builtin_amdgcn_exp2f(x); }
__device__ __forceinline__ float rcpf_(float x) { return __builtin_amdgcn_rcpf(x); }
__device__ __forceinline__ float sigm(float v) { return rcpf_(1.f + ex2(-LOG2E * v)); }
__device__ __forceinline__ float gelu_t(float v) { const float y = v * (1.f + 0.044715f * v * v); return v * rcpf_(1.f + ex2(-2.302208198f * y)); }
__device__ __forceinline__ float wave_sum(float v) {
#pragma unroll
    for (int o = 1; o < 64; o <<= 1) v += __shfl_xor(v, o);
    return v;
}
__device__ __forceinline__ void unpack8(u32x4 w, float (&o)[8]) { o[0] = bf_lo(w.x); o[1] = bf_hi(w.x); o[2] = bf_lo(w.y); o[3] = bf_hi(w.y); o[4] = bf_lo(w.z); o[5] = bf_hi(w.z); o[6] = bf_lo(w.w); o[7] = bf_hi(w.w); }
__device__ __forceinline__ u32x4 pack8(const float (&o)[8]) { u32x4 w; w.x = pk2(o[0], o[1]); w.y = pk2(o[2], o[3]); w.z = pk2(o[4], o[5]); w.w = pk2(o[6], o[7]); return w; }
__device__ __forceinline__ float dot2bf(unsigned a, unsigned b, float acc) { return __builtin_amdgcn_fdot2_f32_bf16(__builtin_bit_cast(bf16x2_t, a), __builtin_bit_cast(bf16x2_t, b), acc, false); }

namespace pg8 {
constexpr int BM = 256, BK = 64, HALF = 128, HTB = HALF * BK * 2, STAGE_BYTES = 8 * HTB, NXCD = 8, WGM = 8;
__host__ __device__ __forceinline__ int lds_byte(int r, int c) { const int st = (r >> 4) * 2 + (c >> 5), rr = r & 15, cc = c & 31, ob = rr * 64 + cc * 2; return st * 1024 + (ob ^ (((ob >> 9) & 1) << 5)); }
__host__ __device__ __forceinline__ void stage_rc(int b, int& R, int& C) { const int st = b / 1024, sb = b % 1024, swz = sb ^ (((sb >> 9) & 1) << 5); R = (st >> 1) * 16 + swz / 64; C = (st & 1) * 32 + (swz % 64) / 2; }
__host__ __device__ __forceinline__ int perm32(int rho) { const int n = rho >> 4, i = rho & 15; return 8 * (i >> 2) + 4 * n + (i & 3); }

struct Unit { int pm, pn; };
struct Gemm { const bf16_t* A; const bf16_t* Bt; int lda, ldb, K, a_pn_off, b_pn_stride; };

struct Sched {
    int nM, nN, nwg, G, c, xpm, xn, xskip;
    __device__ __forceinline__ void init(int nM_, int nN_, int G_, int c_, int xpm_, int xn_, int xskip_) { nM = nM_; nN = nN_; nwg = nM_ * nN_; G = G_; c = c_; xpm = xpm_; xn = xn_; xskip = xskip_; }
    __device__ __forceinline__ bool next(int i, Unit& u) const {
        const int nmain = nwg > c ? (nwg - c - 1) / G + 1 : 0;
        if (i < nmain) {
            int wgid = i * G + c; { const int q = nwg / NXCD, r = nwg % NXCD, xcd = wgid % NXCD, off = wgid / NXCD; wgid = (xcd < r ? xcd * (q + 1) : r * (q + 1) + (xcd - r) * q) + off; }
            const int nig = WGM * nN, gid = wgid / nig, fm = gid * WGM, gsz = (nM - fm) < WGM ? (nM - fm) : WGM;
            u.pm = fm + ((wgid % nig) % gsz); u.pn = (wgid % nig) / gsz; return true;
        }
        const int e = G - 1 - c;
        if (i == nmain && e < xn) { u.pm = xpm; u.pn = e + (e >= 4 ? xskip : 0); return true; }
        return false;
    }
};

template <class F> struct Epi8 {
    static constexpr bool PERM = true;
    F f;
    __device__ __forceinline__ void operator()(const f32x4 (&acc)[2][2][4][2], const Unit& u, int wr, int wc, int fr, int fq) const {
        const int row0 = u.pm * BM + wr * 64 + fr, col0 = u.pn * BM + wc * 32 + 8 * fq;
#pragma unroll
        for (int ai = 0; ai < 2; ++ai) {
            typename F::Pre pre[4][2];
#pragma unroll
            for (int m = 0; m < 4; ++m)
#pragma unroll
                for (int bj = 0; bj < 2; ++bj) pre[m][bj] = f.load(u.pn, row0 + ai * HALF + m * 16, col0 + bj * HALF);
#pragma unroll
            for (int m = 0; m < 4; ++m)
#pragma unroll
                for (int bj = 0; bj < 2; ++bj) f.apply(pre[m][bj], u.pn, row0 + ai * HALF + m * 16, col0 + bj * HALF, acc[ai][bj][m][0], acc[ai][bj][m][1]);
        }
    }
};
template <class F> struct EpiPair {
    static constexpr bool PERM = true;
    F f;
    __device__ __forceinline__ void operator()(const f32x4 (&acc)[2][2][4][2], const Unit& u, int wr, int wc, int fr, int fq) const {
        const int row0 = u.pm * BM + wr * 64 + fr, col0 = wc * 32 + 8 * fq;
#pragma unroll
        for (int ai = 0; ai < 2; ++ai) {
            typename F::Pre pre[4];
#pragma unroll
            for (int m = 0; m < 4; ++m) pre[m] = f.load(u.pn, row0 + ai * HALF + m * 16, col0);
#pragma unroll
            for (int m = 0; m < 4; ++m) f.apply(pre[m], u.pn, row0 + ai * HALF + m * 16, col0, acc[ai][0][m][0], acc[ai][0][m][1], acc[ai][1][m][0], acc[ai][1][m][1]);
        }
    }
};

template <class Epi>
__device__ __forceinline__ void gemm_phase(LAS unsigned char* lds, const Gemm g, const Sched& S, const Epi& E) {
    int tid_ = threadIdx.x; asm volatile("" : "+v"(tid_));
    const int tid = tid_, wid = __builtin_amdgcn_readfirstlane(tid >> 6), lane = tid & 63, wr = wid >> 2, wc = wid & 3, fr = lane & 15, fq = lane >> 4;
    int nt_ = g.K / BK; asm volatile("" : "+s"(nt_));
    const int nt = nt_;
    unsigned voffA[2], voffB[2];
#pragma unroll
    for (int i = 0; i < 2; ++i) { int R, C; stage_rc(tid * 16 + i * 8192, R, C); const int Rb = Epi::PERM ? ((R & ~31) + perm32(R & 31)) : R;
        voffA[i] = (unsigned)(R * g.lda + C) * 2u; voffB[i] = (unsigned)(Rb * g.ldb + C) * 2u; }
    const size_t kstep = (size_t)(BK * 2);
    const size_t hA = (size_t)HALF * g.lda * 2, hB = (size_t)HALF * g.ldb * 2;
    const unsigned ldsw = (unsigned)wid * 1024u;
    const int aoff = lds_byte(wr * 64 + fr, fq * 8), boff = lds_byte(wc * 32 + fr, fq * 8);
#define PG8_SA(b, h) (((b) * 2 + (h)) * HTB)
#define PG8_SB(b, h) ((4 + (b) * 2 + (h)) * HTB)
#define PG8_STAGE(bufoff, gbase, voff) do { _Pragma("unroll") for (int _i = 0; _i < 2; ++_i) \
        __builtin_amdgcn_global_load_lds((const unsigned*)((const char*)(gbase) + (voff)[_i]), (LAS unsigned*)(lds + (bufoff) + ldsw + _i * 8192), 16, 0, 0); } while (0)
#define PG8_LDA(dst, b, h) do { _Pragma("unroll") for (int m = 0; m < 4; ++m) _Pragma("unroll") for (int k = 0; k < 2; ++k) dst[m][k] = *(const LAS bf16x8*)(lds + PG8_SA(b, h) + aoff + m * 2048 + k * 1024); } while (0)
#define PG8_LDB(dst, b, h) do { _Pragma("unroll") for (int n = 0; n < 2; ++n) _Pragma("unroll") for (int k = 0; k < 2; ++k) dst[n][k] = *(const LAS bf16x8*)(lds + PG8_SB(b, h) + boff + n * 2048 + k * 1024); } while (0)
#define PG8_MMA(ai, bj, At, Bt) do { __builtin_amdgcn_s_setprio(1); _Pragma("unroll") for (int m = 0; m < 4; ++m) _Pragma("unroll") for (int n = 0; n < 2; ++n) _Pragma("unroll") for (int k = 0; k < 2; ++k) \
        acc[ai][bj][m][n] = __builtin_amdgcn_mfma_f32_16x16x32_bf16(Bt[n][k], At[m][k], acc[ai][bj][m][n], 0, 0, 0); __builtin_amdgcn_s_setprio(0); } while (0)
#define PG8_WAIT_V(n) asm volatile("s_waitcnt vmcnt(" #n ")" ::: "memory")
#define PG8_WAIT_L(n) asm volatile("s_waitcnt lgkmcnt(" #n ")" ::: "memory")
#define PG8_BAR __builtin_amdgcn_s_barrier()
#define PG8_SCHED __builtin_amdgcn_sched_barrier(0)
#define PG8_ABASE(u) ((const char*)g.A + ((size_t)(u).pm * BM * g.lda + (size_t)(u).pn * g.a_pn_off) * 2)
#define PG8_BBASE(u) ((const char*)g.Bt + (size_t)(u).pn * g.b_pn_stride * 2)
    Unit cur, nxt; int ui = 0;
    if (!S.next(0, cur)) return;
    f32x4 acc[2][2][4][2];
#pragma unroll
    for (int a = 0; a < 2; ++a)
#pragma unroll
        for (int b = 0; b < 2; ++b)
#pragma unroll
            for (int m = 0; m < 4; ++m)
#pragma unroll
                for (int n = 0; n < 2; ++n) acc[a][b][m][n] = (f32x4){0.f, 0.f, 0.f, 0.f};
    bf16x8 At[4][2], B0[2][2], B1[2][2];
    const char* cA = PG8_ABASE(cur); const char* cB = PG8_BBASE(cur);
    PG8_STAGE(PG8_SB(0, 0), cB, voffB); PG8_STAGE(PG8_SB(0, 1), cB + hB, voffB); PG8_STAGE(PG8_SA(0, 0), cA, voffA); PG8_STAGE(PG8_SA(0, 1), cA + hA, voffA);
    if (wr == 1) PG8_BAR;
    PG8_WAIT_V(2); PG8_BAR;
    PG8_STAGE(PG8_SB(1, 0), cB + kstep, voffB); PG8_STAGE(PG8_SA(1, 0), cA + kstep, voffA); PG8_STAGE(PG8_SB(1, 1), cB + hB + kstep, voffB);
    PG8_WAIT_V(6); PG8_BAR;
    for (;;) {
        const bool has_next = S.next(ui + 1, nxt);
        const char* nA = has_next ? PG8_ABASE(nxt) : cA; const char* nB = has_next ? PG8_BBASE(nxt) : cB;
        asm volatile("" : "+s"(cA), "+s"(cB), "+s"(nA), "+s"(nB));
#pragma unroll 1
        for (int t = 0; t < nt; t += 2) {
            const bool last = (t == nt - 2);
            const char* a1 = cA + (size_t)(t + 1) * kstep;
            const char* a2 = last ? nA : cA + (size_t)(t + 2) * kstep; const char* b2 = last ? nB : cB + (size_t)(t + 2) * kstep;
            const char* a3 = a2 + kstep; const char* b3 = b2 + kstep;
            PG8_LDB(B0, 0, 0); PG8_LDB(B1, 0, 1); PG8_SCHED; PG8_LDA(At, 0, 0); PG8_STAGE(PG8_SA(1, 1), a1 + hA, voffA);
            PG8_WAIT_V(8); PG8_WAIT_L(0); PG8_BAR; PG8_MMA(0, 0, At, B0); PG8_MMA(0, 1, At, B1); PG8_BAR; PG8_SCHED;
            PG8_LDA(At, 0, 1); PG8_STAGE(PG8_SB(0, 0), b2, voffB); PG8_STAGE(PG8_SB(0, 1), b2 + hB, voffB); PG8_STAGE(PG8_SA(0, 0), a2, voffA);
            PG8_WAIT_V(8); PG8_WAIT_L(0); PG8_BAR; PG8_MMA(1, 0, At, B0); PG8_MMA(1, 1, At, B1); PG8_BAR; PG8_SCHED;
            PG8_LDB(B0, 1, 0); PG8_LDB(B1, 1, 1); PG8_SCHED; PG8_LDA(At, 1, 0); PG8_STAGE(PG8_SA(0, 1), a2 + hA, voffA);
            PG8_WAIT_V(8); PG8_WAIT_L(0); PG8_BAR; PG8_MMA(0, 0, At, B0); PG8_MMA(0, 1, At, B1); PG8_BAR; PG8_SCHED;
            PG8_LDA(At, 1, 1); PG8_STAGE(PG8_SB(1, 0), b3, voffB); PG8_STAGE(PG8_SB(1, 1), b3 + hB, voffB); PG8_STAGE(PG8_SA(1, 0), a3, voffA);
            PG8_WAIT_V(8); PG8_WAIT_L(0); PG8_BAR; PG8_MMA(1, 0, At, B0); PG8_MMA(1, 1, At, B1); PG8_BAR; PG8_SCHED;
        }
        if (wr == 0) PG8_BAR;
        E(acc, cur, wr, wc, fr, fq);
        if (!has_next) break;
#pragma unroll
        for (int a = 0; a < 2; ++a)
#pragma unroll
            for (int b = 0; b < 2; ++b)
#pragma unroll
                for (int m = 0; m < 4; ++m)
#pragma unroll
                    for (int n = 0; n < 2; ++n) acc[a][b][m][n] = (f32x4){0.f, 0.f, 0.f, 0.f};
        cur = nxt; cA = nA; cB = nB; ++ui;
        if (wr == 1) PG8_BAR;
    }
    PG8_WAIT_V(0);
    PG8_BAR;
#undef PG8_SA
#undef PG8_SB
#undef PG8_STAGE
#undef PG8_LDA
#undef PG8_LDB
#undef PG8_MMA
#undef PG8_WAIT_V
#undef PG8_WAIT_L
#undef PG8_BAR
#undef PG8_SCHED
#undef PG8_ABASE
#undef PG8_BBASE
}
}

#define XB_TMO      128
#define XB_XCNT(j)  (256  + 64 * (j))
#define XB_XSUB(j)  (1280 + 64 * (j))
#define XB_XGEN(j)  (2304 + 64 * (j))
#define XB_TOP      3328
#define XB_TOPGEN   3392
#define XCD_BAR_WORDS 3456
#define XB_SPIN_CAP (1u << 18)
__device__ __forceinline__ unsigned xb_ld(unsigned* p)              { return __hip_atomic_load(p, __ATOMIC_RELAXED, __HIP_MEMORY_SCOPE_AGENT); }
__device__ __forceinline__ unsigned xb_add(unsigned* p, unsigned v) { return __hip_atomic_fetch_add(p, v, __ATOMIC_RELAXED, __HIP_MEMORY_SCOPE_AGENT); }
__device__ __forceinline__ unsigned xb_xcc_id() { return (unsigned)__builtin_amdgcn_s_getreg((3 << 11) | 20) & 0xFu; }
#define XB_SPIN(cond, bar) do { unsigned _sp = 0; while (cond) { __builtin_amdgcn_s_sleep(1); \
    if ((++_sp & 255u) == 0u) { if (xb_ld(&(bar)[XB_TMO])) break; if (_sp > XB_SPIN_CAP) { atomicAdd(&(bar)[XB_TMO], 1u); break; } } } } while (0)
struct XcdBarrier { unsigned* bar; unsigned x; volatile LAS unsigned* st; };
__device__ __forceinline__ XcdBarrier xcd_barrier_post(unsigned* bar, volatile LAS unsigned* st) {
    XcdBarrier b; b.bar = bar; b.x = xb_xcc_id(); b.st = st;
    if (threadIdx.x == 0) (void)xb_add(&bar[XB_XCNT(b.x)], 1u);
    return b;
}
__device__ __forceinline__ void xcd_barrier_complete(unsigned* bar, unsigned x, unsigned& nloc, unsigned& nx) {
    const unsigned G = gridDim.x * gridDim.y * gridDim.z;
    unsigned sum, cnt, mine, sp = 0u;
    for (;;) {
        sum = 0u; cnt = 0u; mine = 0u;
#pragma unroll
        for (unsigned j = 0; j < 16; ++j) { const unsigned c = xb_ld(&bar[XB_XCNT(j)]); sum += c; cnt += (c > 0u) ? 1u : 0u; mine = (j == x) ? c : mine; }
        if (sum == G) break;
        __builtin_amdgcn_s_sleep(1);
        if ((++sp & 255u) == 0u) { if (xb_ld(&bar[XB_TMO])) break; if (sp > XB_SPIN_CAP) { atomicAdd(&bar[XB_TMO], 1u); break; } }
    }
    nloc = mine > 0u ? mine : 1u; nx = cnt > 0u ? cnt : 1u;
}
__device__ __forceinline__ void xcd_barrier(const XcdBarrier& b) {
    asm volatile("s_waitcnt vmcnt(0)" ::: "memory");
    __syncthreads();
    if (threadIdx.x == 0) {
        unsigned* bar = b.bar;
        __builtin_amdgcn_s_waitcnt(0);
        unsigned nloc = b.st[0], nx = b.st[1];
        if (nloc == 0u) { xcd_barrier_complete(bar, b.x, nloc, nx); b.st[0] = nloc; b.st[1] = nx; }
        const unsigned old = xb_add(&bar[XB_XSUB(b.x)], 1u);
        const unsigned gen = old / nloc;
        if (old + 1u == (gen + 1u) * nloc) {
            __builtin_amdgcn_fence(__ATOMIC_RELEASE, "agent");
            asm volatile("s_waitcnt vmcnt(0)" ::: "memory");
            const unsigned og = xb_add(&bar[XB_TOP], 1u);
            const unsigned tg = og / nx;
            if (og + 1u == (tg + 1u) * nx) xb_add(&bar[XB_TOPGEN], 1u);
            else XB_SPIN(xb_ld(&bar[XB_TOPGEN]) == tg, bar);
            __builtin_amdgcn_fence(__ATOMIC_ACQUIRE, "agent");
            xb_add(&bar[XB_XGEN(b.x)], 1u);
            asm volatile("s_waitcnt vmcnt(0)" ::: "memory");
        } else {
            XB_SPIN(xb_ld(&bar[XB_XGEN(b.x)]) == gen, bar);
            __builtin_amdgcn_fence(__ATOMIC_ACQUIRE, "agent");
            asm volatile("s_waitcnt vmcnt(0)" ::: "memory");
        }
    }
    __syncthreads();
}

constexpr int NWAVES = 8, NTHR = 512;
constexpr int RING_BYTES = 131072, MISC_OFF = RING_BYTES + 320, LDS_BYTES = 147456;
struct Args { const float* in[25]; float* out; unsigned char* ws; int ph_lo, ph_hi; };
static_assert(sizeof(Args) == 25 * 8 + 8 + 8 + 8, "Args has no padding");

struct Ctx {
    LAS unsigned char* lds; int tid, lane, wave, G, gw, NGW;
    unsigned char* ws; float* out; const float* const* in;
};

__device__ __forceinline__ void store8(bf16_t* p, f32x4 a, f32x4 b) { u32x4 w; w.x = pk2(a[0], a[1]); w.y = pk2(a[2], a[3]); w.z = pk2(b[0], b[1]); w.w = pk2(b[2], b[3]); *(u32x4*)p = w; }
struct NoPre {};
struct FInproj {
    typedef NoPre Pre;
    bf16_t *XR, *GR, *CQKV, *GRNN, *GATT;
    __device__ __forceinline__ Pre load(int, int, int) const { return Pre(); }
    __device__ __forceinline__ void apply(const Pre&, int pn, int row, int col, f32x4 a, f32x4 b) const {
        if (pn < 4) { store8(XR + (size_t)row * 1024 + col, a, b); }
        else if (pn < 8) {
#pragma unroll
            for (int i = 0; i < 4; ++i) { a[i] = gelu_t(a[i]); b[i] = gelu_t(b[i]); }
            store8(GR + (size_t)row * 1024 + (col - 1024), a, b); }
        else if (pn < 11) { store8(CQKV + (size_t)row * CQKV_LD + (col - 2048), a, b); }
        else {
#pragma unroll
            for (int i = 0; i < 4; ++i) { a[i] = sigm(a[i]); b[i] = sigm(b[i]); }
            if (pn < 15) store8(GRNN + (size_t)row * 1024 + (col - 2816), a, b); else store8(GATT + (size_t)row * 1024 + (col - 3840), a, b); }
    }
};
struct FGate {
    struct Pre { u32x4 xc; };
    const bf16_t* XC; const float *ba, *bx, *clam; bf16_t *LA, *UU;
    __device__ __forceinline__ Pre load(int pn, int row, int cl) const { Pre p; p.xc = *(const u32x4*)(XC + (size_t)row * 1024 + pn * 128 + cl); return p; }
    __device__ __forceinline__ void apply(const Pre& pr, int pn, int row, int cl, f32x4 a0, f32x4 a1, f32x4 x0, f32x4 x1) const {
        const int ch = pn * 128 + cl; const size_t off = (size_t)row * 1024 + ch;
        float xc[8]; unpack8(pr.xc, xc);
        const f32x4 ba0 = *(const f32x4*)(ba + ch), ba1 = *(const f32x4*)(ba + ch + 4), bx0 = *(const f32x4*)(bx + ch), bx1 = *(const f32x4*)(bx + ch + 4), cl0 = *(const f32x4*)(clam + ch), cl1 = *(const f32x4*)(clam + ch + 4);
        float la[8], uu[8];
#pragma unroll
        for (int i = 0; i < 8; ++i) {
            const float ga = (i < 4 ? a0[i & 3] + ba0[i & 3] : a1[i & 3] + ba1[i & 3]), gx = (i < 4 ? x0[i & 3] + bx0[i & 3] : x1[i & 3] + bx1[i & 3]), cc = (i < 4 ? cl0[i & 3] : cl1[i & 3]);
            const float r = sigm(ga), ig = sigm(gx), l = r * cc;
            la[i] = l; uu[i] = sqrtf(fmaxf(1.f - ex2(2.f * LOG2E * l), 0.f)) * (ig * xc[i]);
        }
        *(u32x4*)(LA + off) = pack8(la); *(u32x4*)(UU + off) = pack8(uu);
    }
};
struct FQ {
    struct Pre { float sc; };
    const float* rsq; bf16_t* Q;
    __device__ __forceinline__ Pre load(int, int row, int) const { Pre p; p.sc = rsq[row]; return p; }
    __device__ __forceinline__ void apply(const Pre& pr, int pn, int row, int col, f32x4 a, f32x4 b) const {
        const float sc = pr.sc * QSCALE; a = a * sc; b = b * sc;
        store8(Q + (size_t)row * QLD + col, a, b);
    }
};
struct FKV {
    struct Pre { float sc; };
    const float* rskv; bf16_t *KN, *V;
    __device__ __forceinline__ Pre load(int, int row, int) const { Pre p; p.sc = rskv[row]; return p; }
    __device__ __forceinline__ void apply(const Pre& pr, int pn, int row, int col, f32x4 a, f32x4 b) const {
        const float sc = pr.sc; a = a * sc; b = b * sc;
        if (pn < 4) store8(KN + (size_t)row * 1024 + col, a, b); else store8(V + (size_t)row * 1024 + (col - 1024), a, b);
    }
};
template <bool HAS_ADD> struct FMul {
    struct Pre { u32x4 g, ad; };
    const bf16_t* Gt; const bf16_t* ADD; bf16_t* O;
    __device__ __forceinline__ Pre load(int, int row, int col) const { const size_t off = (size_t)row * 1024 + col; Pre p; p.g = *(const u32x4*)(Gt + off); if (HAS_ADD) p.ad = *(const u32x4*)(ADD + off); else p.ad = (u32x4){0u, 0u, 0u, 0u}; return p; }
    __device__ __forceinline__ void apply(const Pre& pr, int pn, int row, int col, f32x4 a, f32x4 b) const {
        const size_t off = (size_t)row * 1024 + col; float gg[8]; unpack8(pr.g, gg);
        if (HAS_ADD) { float ad[8]; unpack8(pr.ad, ad);
#pragma unroll
            for (int i = 0; i < 4; ++i) { a[i] = ad[i] + gg[i] * a[i]; b[i] = ad[4 + i] + gg[4 + i] * b[i]; } }
        else {
#pragma unroll
            for (int i = 0; i < 4; ++i) { a[i] = gg[i] * a[i]; b[i] = gg[4 + i] * b[i]; } }
        store8(O + off, a, b);
    }
};
struct FRes {
    struct Pre { f32x4 x0, x1; };
    const float* X; bf16_t* H1B;
    __device__ __forceinline__ Pre load(int, int row, int col) const { const size_t off = (size_t)row * 1024 + col; Pre p; p.x0 = *(const f32x4*)(X + off); p.x1 = *(const f32x4*)(X + off + 4); return p; }
    __device__ __forceinline__ void apply(const Pre& pr, int pn, int row, int col, f32x4 a, f32x4 b) const {
        store8(H1B + (size_t)row * 1024 + col, a + pr.x0, b + pr.x1);
    }
};
typedef _Float16 f16x8 __attribute__((ext_vector_type(8)));
struct FF16 { typedef NoPre Pre; _Float16* O; int ldc;
    __device__ __forceinline__ Pre load(int, int, int) const { return Pre(); }
    __device__ __forceinline__ void apply(const Pre&, int pn, int row, int col, f32x4 a, f32x4 b) const {
        f16x8 h = {(_Float16)a[0], (_Float16)a[1], (_Float16)a[2], (_Float16)a[3], (_Float16)b[0], (_Float16)b[1], (_Float16)b[2], (_Float16)b[3]};
        *(f16x8*)(O + (size_t)row * ldc + col) = h; } };
struct FF32 { typedef NoPre Pre; float* O; int ldc;
    __device__ __forceinline__ Pre load(int, int, int) const { return Pre(); }
    __device__ __forceinline__ void apply(const Pre&, int pn, int row, int col, f32x4 a, f32x4 b) const { float* p = O + (size_t)row * ldc + col; *(f32x4*)p = a; *(f32x4*)(p + 4) = b; } };

struct MapId { __device__ __forceinline__ int operator()(int n) const { return n; } };
struct MapWin { __device__ __forceinline__ int operator()(int n) const {
    if (n < 2048) return n;
    if (n < 2816) { const int c = n - 2048; if (c < 256) return 2432 + c; if (c < 288) return 2688 + (c - 256); if (c < 384) return -1; return 2048 + (c - 384); }
    if (n < 3840) return 2720 + (n - 2816);
    return 3744 + (n - 3840); } };
struct MapUq { __device__ __forceinline__ int operator()(int n) const { const int h = n / 96, w = n % 96; if (w < 64) return n; const int t = w - 64; return h * 96 + 64 + (t >> 1) + 16 * (t & 1); } };
struct MapUkv { __device__ __forceinline__ int operator()(int n) const { if (n < 1024) return (n >> 6) * 128 + (n & 63); const int m = n - 1024; return (m >> 6) * 128 + 64 + (m & 63); } };

template <class Map> __device__ __forceinline__ void transpose_item(const float* W, int ldw, int Ndst, bf16_t* WT, int ldt, const float* kscale, LAS float* scr, int item, int lane, Map map) {
    const int nblk = Ndst / 32, kb = item / nblk, nb = item % nblk, k0 = 64 * kb, n0 = 32 * nb;
    const int src = map(n0 + (lane & 31));
#pragma unroll 8
    for (int i = 0; i < 32; ++i) { const int kk = 2 * i + (lane >> 5); float v = 0.f; if (src >= 0) { v = W[(size_t)(k0 + kk) * ldw + src]; if (kscale) v *= kscale[k0 + kk]; } scr[kk * 33 + (lane & 31)] = v; }
    LDS_WAIT(); asm volatile("" ::: "memory");
    const int c = lane & 7;
#pragma unroll
    for (int j = 0; j < 4; ++j) { const int n = (lane >> 3) + 8 * j; const LAS float* s = scr + (8 * c) * 33 + n;
        u32x4 o; o.x = pk2(s[0 * 33], s[1 * 33]); o.y = pk2(s[2 * 33], s[3 * 33]); o.z = pk2(s[4 * 33], s[5 * 33]); o.w = pk2(s[6 * 33], s[7 * 33]);
        *(u32x4*)(WT + (size_t)(n0 + n) * ldt + k0 + 8 * c) = o; }
    LDS_WAIT(); asm volatile("" ::: "memory");
}
__device__ __forceinline__ void rms_row_bf16(const float* xrow, const float* g, bf16_t* orow, int lane) {
    const f32x4* xr = (const f32x4*)xrow + lane; f32x4 v[4]; float s = 0.f;
#pragma unroll
    for (int j = 0; j < 4; ++j) { v[j] = xr[64 * j]; s += (v[j][0] * v[j][0] + v[j][1] * v[j][1]) + (v[j][2] * v[j][2] + v[j][3] * v[j][3]); }
    const float rstd = 1.f / sqrtf(wave_sum(s) * (1.f / 1024.f) + EPS);
    u32x2* o8 = (u32x2*)orow + lane;
#pragma unroll
    for (int j = 0; j < 4; ++j) { const f32x4 gg = ((const f32x4*)g)[lane + 64 * j]; u32x2 w; w.x = pk2(v[j][0] * rstd * gg[0], v[j][1] * rstd * gg[1]); w.y = pk2(v[j][2] * rstd * gg[2], v[j][3] * rstd * gg[3]); o8[64 * j] = w; }
}
__device__ __forceinline__ void rms_row_f32(const float* xrow, const float* g, float* orow, int lane) {
    const f32x4* xr = (const f32x4*)xrow + lane; f32x4 v[4]; float s = 0.f;
#pragma unroll
    for (int j = 0; j < 4; ++j) { v[j] = xr[64 * j]; s += (v[j][0] * v[j][0] + v[j][1] * v[j][1]) + (v[j][2] * v[j][2] + v[j][3] * v[j][3]); }
    const float rstd = 1.f / sqrtf(wave_sum(s) * (1.f / 1024.f) + EPS);
#pragma unroll
    for (int j = 0; j < 4; ++j) { const f32x4 gg = ((const f32x4*)g)[lane + 64 * j]; ((f32x4*)orow)[lane + 64 * j] = v[j] * rstd * gg; }
}

__device__ __forceinline__ void phase_prologue(const Ctx& C) {
    unsigned char* ws = C.ws; const float* const* in = C.in;
    LAS float* scr = (LAS float*)(C.lds + C.wave * 16384);
    const int gw = C.gw, NGW = C.NGW, lane = C.lane;
    constexpr int I_WIN = 16 * (DIN_P / 32), I_UQ = 6 * (1536 / 32), I_UKV = 4 * (2048 / 32), I_SQ = 16 * 32, I_G = 2 * 4;
    constexpr int NITEMS = I_WIN + I_UQ + I_UKV + 3 * I_SQ + 16 * I_G;
    for (int it = gw; it < NITEMS; it += NGW) {
        int r = it;
        if (r < I_WIN) { transpose_item(in[3], 4768, DIN_P, (bf16_t*)(ws + WS_WIN), 1024, nullptr, scr, r, lane, MapWin()); continue; } r -= I_WIN;
        if (r < I_UQ) { transpose_item(in[13], 1536, 1536, (bf16_t*)(ws + WS_WUQ), 384, in[12], scr, r, lane, MapUq()); continue; } r -= I_UQ;
        if (r < I_UKV) { transpose_item(in[15], 2048, 2048, (bf16_t*)(ws + WS_WUKV), 256, in[14], scr, r, lane, MapUkv()); continue; } r -= I_UKV;
        if (r < I_SQ) { transpose_item(in[11], 1024, 1024, (bf16_t*)(ws + WS_WRNN), 1024, nullptr, scr, r, lane, MapId()); continue; } r -= I_SQ;
        if (r < I_SQ) { transpose_item(in[16], 1024, 1024, (bf16_t*)(ws + WS_WATT), 1024, nullptr, scr, r, lane, MapId()); continue; } r -= I_SQ;
        if (r < I_SQ) { transpose_item(in[17], 1024, 1024, (bf16_t*)(ws + WS_WOUT), 1024, nullptr, scr, r, lane, MapId()); continue; } r -= I_SQ;
        { const int mat = r / I_G, sub = r % I_G, blk = mat >> 1, which = mat & 1;
          transpose_item((which ? in[8] : in[6]) + (size_t)blk * 16384, 128, 128, (bf16_t*)(ws + WS_WGATE) + (size_t)(blk * 256 + which * 128) * 128, 128, nullptr, scr, sub, lane, MapId()); }
    }
    const int gt = blockIdx.x * NTHR + C.tid, NT = C.G * NTHR;
    for (int it = blockIdx.x; it < 256; it += C.G) {
        const int hh = it >> 4, kc = it & 15, half = hh & 1, k = kc * 64 + lane, c0 = 16 * C.wave;
        const f32x4* keys = (const f32x4*)((half ? in[21] : in[20]) + (size_t)c0 * 128);
        LAS f32x4* ks = (LAS f32x4*)scr;
#pragma unroll
        for (int j = 0; j < 8; ++j) ks[j * 64 + lane] = keys[j * 64 + lane];
        const f32x4* wq = (const f32x4*)(in[19] + (size_t)k * 2048 + hh * 128); const float g2k = in[18][k];
        f32x4 a[32];
#pragma unroll
        for (int d4 = 0; d4 < 32; ++d4) a[d4] = wq[d4];
        LDS_WAIT(); asm volatile("" ::: "memory");
        bf16_t* o = (bf16_t*)(ws + WS_WPQ) + (size_t)(hh * 128 + c0) * 1024 + k;
#pragma unroll 4
        for (int c = 0; c < 16; ++c) { float s0 = 0.f, s1 = 0.f;
#pragma unroll
            for (int d4 = 0; d4 < 32; d4 += 2) { const f32x4 k0 = ks[c * 32 + d4], k1 = ks[c * 32 + d4 + 1]; s0 += (a[d4][0] * k0[0] + a[d4][1] * k0[1]) + (a[d4][2] * k0[2] + a[d4][3] * k0[3]); s1 += (a[d4 + 1][0] * k1[0] + a[d4 + 1][1] * k1[1]) + (a[d4 + 1][2] * k1[2] + a[d4 + 1][3] * k1[3]); }
            o[(size_t)c * 1024] = (bf16_t)(pk2((s0 + s1) * g2k, 0.f) & 0xffffu); }
        LDS_WAIT(); asm volatile("" ::: "memory");
    }
    for (int i = gt; i < NPOS * 16; i += NT) { const int pos = i >> 4, j = i & 15; const float inv = exp2f(-(float)j * (13.287712379549449f / 16.f)); const float ang = (float)pos * inv;
        float t = ang * 0.15915494309189535f; t = t - floorf(t);
        ((float*)(ws + WS_CTAB))[i] = __builtin_amdgcn_cosf(t); ((float*)(ws + WS_STAB))[i] = __builtin_amdgcn_sinf(t); }
    for (int i = gt; i < 1024; i += NT) { const float lam = in[10][i]; ((float*)(ws + WS_CLAM))[i] = -8.f * log1pf(expf(-lam)); }
    f32x4 tnv[4];
    if (gw < 2 * NEXP) { const int tb0 = gw >= NEXP, e0 = gw - tb0 * NEXP;
#pragma unroll
        for (int j = 0; j < 4; ++j) tnv[j] = ((const f32x4*)((tb0 ? in[23] : in[22]) + (size_t)e0 * 1024 + 16 * lane))[j]; }
    for (int row = gw; row < 2 * NEXP; row += NGW) {
        const int tbl = row >= NEXP, e = row - tbl * NEXP;
        f32x4 v[4]; float am = 0.f;
#pragma unroll
        for (int j = 0; j < 4; ++j) { v[j] = tnv[j]; am = fmaxf(am, fmaxf(fmaxf(fabsf(v[j][0]), fabsf(v[j][1])), fmaxf(fabsf(v[j][2]), fabsf(v[j][3])))); }
        if (row + NGW < 2 * NEXP) { const int tb1 = (row + NGW) >= NEXP, e1 = row + NGW - tb1 * NEXP;
#pragma unroll
            for (int j = 0; j < 4; ++j) tnv[j] = ((const f32x4*)((tb1 ? in[23] : in[22]) + (size_t)e1 * 1024 + 16 * lane))[j]; }
#pragma unroll
        for (int o = 1; o < 64; o <<= 1) am = fmaxf(am, __shfl_xor(am, o));
        const float scale = am > 0.f ? am * (1.f / 224.f) : 1.f, inv = 1.f / scale;
        u32x4 w;
#pragma unroll
        for (int j = 0; j < 4; ++j) { int p = __builtin_amdgcn_cvt_pk_fp8_f32(v[j][0] * inv, v[j][1] * inv, 0, false); p = __builtin_amdgcn_cvt_pk_fp8_f32(v[j][2] * inv, v[j][3] * inv, p, true); w[j] = (unsigned)p; }
        *(u32x4*)(ws + (tbl ? WS_PV : WS_PU) + (size_t)e * 1024 + 16 * lane) = w;
        if (lane == 0) ((float*)(ws + (tbl ? WS_SV : WS_SU)))[e] = scale;
    }
    bf16_t* N1 = (bf16_t*)(ws + SLOT(0));
    {
        f32x4 gg[4];
#pragma unroll
        for (int j = 0; j < 4; ++j) gg[j] = ((const f32x4*)in[2])[lane + 64 * j];
        int m = gw; f32x4 nv[4];
        if (m < M) {
#pragma unroll
            for (int j = 0; j < 4; ++j) nv[j] = ((const f32x4*)(in[0] + (size_t)m * 1024))[lane + 64 * j]; }
        for (; m < M; m += NGW) {
            f32x4 v[4]; float sq = 0.f;
#pragma unroll
            for (int j = 0; j < 4; ++j) { v[j] = nv[j]; sq += (v[j][0] * v[j][0] + v[j][1] * v[j][1]) + (v[j][2] * v[j][2] + v[j][3] * v[j][3]); }
            if (m + NGW < M) {
#pragma unroll
                for (int j = 0; j < 4; ++j) nv[j] = ((const f32x4*)(in[0] + (size_t)(m + NGW) * 1024))[lane + 64 * j]; }
            const float rstd = 1.f / sqrtf(wave_sum(sq) * (1.f / 1024.f) + EPS);
            u32x2* o8 = (u32x2*)(N1 + (size_t)m * 1024) + lane;
#pragma unroll
            for (int j = 0; j < 4; ++j) { u32x2 w; w.x = pk2(v[j][0] * rstd * gg[j][0], v[j][1] * rstd * gg[j][1]); w.y = pk2(v[j][2] * rstd * gg[j][2], v[j][3] * rstd * gg[j][3]); o8[64 * j] = w; }
        }
    }
    for (int m = gw; m < 256; m += NGW) {
        if (m < NMETA) rms_row_bf16(in[1] + (size_t)m * 1024, in[2], N1 + (size_t)(METAROW + m) * 1024, lane);
        else { u32x4* o = (u32x4*)(N1 + (size_t)(METAROW + m) * 1024); o[lane] = (u32x4){0u, 0u, 0u, 0u}; o[64 + lane] = (u32x4){0u, 0u, 0u, 0u}; }
    }
}

__device__ __forceinline__ int prev_row(int r, int j) {
    if (r < M) { const int s = r & (SEQ - 1); return s >= j ? r - j : METAROW + NMETA + (s - j); }
    const int p = r - METAROW; return p >= j ? r - j : -1;
}
struct ThinRow { u32x4 xa, xb, cq, ckv; unsigned k1, k2; };
__device__ __forceinline__ ThinRow thin_load(const bf16_t* XR, const bf16_t* CQKV, int r, int lane) {
    ThinRow d; const bf16_t* z = CQKV + (size_t)r * CQKV_LD;
    d.xa = *(const u32x4*)(XR + (size_t)r * 1024 + lane * 8); d.xb = *(const u32x4*)(XR + (size_t)r * 1024 + 512 + lane * 8);
    d.cq = *(const u32x4*)(z + CQ_OFF + (lane < 48 ? lane : 0) * 8); d.ckv = *(const u32x4*)(z + (lane & 31) * 8);
    d.k1 = z[KR_OFF + (lane & 15)]; d.k2 = z[KR_OFF + 16 + (lane & 15)];
    return d;
}
__device__ __forceinline__ void thin_row_stats(unsigned char* ws, const ThinRow& d, int r, int lane) {
    float* RSQ = (float*)(ws + WS_RSQ); float* RSKV = (float*)(ws + WS_RSKV); bf16_t* KROPE = (bf16_t*)(ws + WS_KROPE);
    float sq = 0.f, skv = 0.f;
    { float v[8]; unpack8(d.cq, v); float a = 0.f;
#pragma unroll
      for (int i = 0; i < 8; ++i) a += v[i] * v[i];
      sq = lane < 48 ? a : 0.f; }
    { float v[8]; unpack8(d.ckv, v); float a = 0.f;
#pragma unroll
      for (int i = 0; i < 8; ++i) a += v[i] * v[i];
      skv = lane < 32 ? a : 0.f; }
    sq = wave_sum(sq); skv = wave_sum(skv);
    if (lane == 0) { RSQ[r] = 1.f / sqrtf(sq * (1.f / 384.f) + EPS); RSKV[r] = 1.f / sqrtf(skv * (1.f / 256.f) + EPS); }
    if (lane < 16) { const int pos = r < M ? NMETA + (r & (SEQ - 1)) : r - METAROW; const float x1 = bf2f((bf16_t)d.k1), x2 = bf2f((bf16_t)d.k2);
        const float c = ((const float*)(ws + WS_CTAB))[pos * 16 + lane], s = ((const float*)(ws + WS_STAB))[pos * 16 + lane];
        ((unsigned*)(KROPE + (size_t)r * 32))[lane] = pk2(x1 * c - x2 * s, x1 * s + x2 * c); }
}
__device__ __forceinline__ void phase_thin(const Ctx& C) {
    unsigned char* ws = C.ws; const float* const* in = C.in; const int lane = C.lane;
    const bf16_t* XR = (const bf16_t*)(ws + SLOT(1)); const bf16_t* CQKV = (const bf16_t*)(ws + SLOT(3)); bf16_t* XC = (bf16_t*)(ws + SLOT(0));
    const float* cw = in[4]; const float* cb = in[5];
    float w[4][16], bias[16];
#pragma unroll
    for (int hh = 0; hh < 2; ++hh)
#pragma unroll
        for (int i = 0; i < 8; ++i) { const int ch = hh * 512 + lane * 8 + i; bias[hh * 8 + i] = cb[ch];
#pragma unroll
            for (int t = 0; t < 4; ++t) w[t][hh * 8 + i] = cw[t * 1024 + ch]; }
    for (int st = C.gw; st < M / 32 + 1; st += C.NGW) {
        const bool meta = st == M / 32; const int r0 = meta ? METAROW : st * 32, nrow = meta ? NMETA : 32;
        float x1[16], x2[16], x3[16];
        const bool first = meta || (r0 & (SEQ - 1)) == 0;
        ThinRow nx = thin_load(XR, CQKV, r0, lane);
#pragma unroll
        for (int j = 1; j <= 3; ++j) { const int pr = first ? (meta ? -1 : METAROW + NMETA - j) : r0 - j;
#pragma unroll
            for (int hh = 0; hh < 2; ++hh) { float v[8];
                if (pr >= 0) unpack8(*(const u32x4*)(XR + (size_t)pr * 1024 + hh * 512 + lane * 8), v); else {
#pragma unroll
                    for (int i = 0; i < 8; ++i) v[i] = 0.f; }
#pragma unroll
                for (int i = 0; i < 8; ++i) { if (j == 1) x1[hh * 8 + i] = v[i]; else if (j == 2) x2[hh * 8 + i] = v[i]; else x3[hh * 8 + i] = v[i]; } } }
        for (int t = 0; t < nrow; ++t) { const int r = r0 + t; float x0[16];
            const ThinRow d = nx;
            if (t + 1 < nrow) nx = thin_load(XR, CQKV, r + 1, lane);
            { float v[8]; unpack8(d.xa, v);
#pragma unroll
              for (int i = 0; i < 8; ++i) x0[i] = v[i];
              unpack8(d.xb, v);
#pragma unroll
              for (int i = 0; i < 8; ++i) x0[8 + i] = v[i]; }
#pragma unroll
            for (int hh = 0; hh < 2; ++hh) { float y[8];
#pragma unroll
                for (int i = 0; i < 8; ++i) { const int q = hh * 8 + i; y[i] = bias[q] + w[3][q] * x0[q] + w[2][q] * x1[q] + w[1][q] * x2[q] + w[0][q] * x3[q]; }
                *(u32x4*)(XC + (size_t)r * 1024 + hh * 512 + lane * 8) = pack8(y); }
#pragma unroll
            for (int q = 0; q < 16; ++q) { x3[q] = x2[q]; x2[q] = x1[q]; x1[q] = x0[q]; }
            thin_row_stats(ws, d, r, lane);
        }
    }
    float* RSQ = (float*)(ws + WS_RSQ); float* RSKV = (float*)(ws + WS_RSKV); bf16_t* KROPE = (bf16_t*)(ws + WS_KROPE);
    for (int r = M + NMETA + C.gw; r < MTOT; r += C.NGW) {
        u32x4* o = (u32x4*)(XC + (size_t)r * 1024); o[lane] = (u32x4){0u, 0u, 0u, 0u}; o[64 + lane] = (u32x4){0u, 0u, 0u, 0u};
        if (lane == 0) { RSQ[r] = 0.f; RSKV[r] = 0.f; }
        if (lane < 16) ((unsigned*)(KROPE + (size_t)r * 32))[lane] = 0u;
    }
}

__device__ __forceinline__ void phase_scan1(const Ctx& C) {
    unsigned char* ws = C.ws; const int lane = C.lane;
    const bf16_t* LA = (const bf16_t*)(ws + SLOT(1)); const bf16_t* UU = (const bf16_t*)(ws + SLOT(6));
    float* SCP = (float*)(ws + WS_SCP); float* SCH = (float*)(ws + WS_SCH); float* CARRY0 = (float*)(ws + WS_CARRY0);
    for (int it = C.gw; it < 2048 + 4; it += C.NGW) {
        const bool meta = it >= 2048; const int q = it & 3, bc = it >> 2, ch = q * 256 + lane * 4;
        const int row0 = meta ? METAROW : bc * 128, nrow = meta ? NMETA : 128;
        float P[4] = {1.f, 1.f, 1.f, 1.f}, H[4] = {0.f, 0.f, 0.f, 0.f};
#pragma unroll 8
        for (int t = 0; t < nrow; ++t) { const u32x2 l2 = *(const u32x2*)(LA + (size_t)(row0 + t) * 1024 + ch), u2 = *(const u32x2*)(UU + (size_t)(row0 + t) * 1024 + ch);
            const float a0 = ex2(LOG2E * bf_lo(l2.x)), a1 = ex2(LOG2E * bf_hi(l2.x)), a2 = ex2(LOG2E * bf_lo(l2.y)), a3 = ex2(LOG2E * bf_hi(l2.y));
            P[0] *= a0; P[1] *= a1; P[2] *= a2; P[3] *= a3;
            H[0] = a0 * H[0] + bf_lo(u2.x); H[1] = a1 * H[1] + bf_hi(u2.x); H[2] = a2 * H[2] + bf_lo(u2.y); H[3] = a3 * H[3] + bf_hi(u2.y); }
        if (meta) *(f32x4*)(CARRY0 + ch) = (f32x4){H[0], H[1], H[2], H[3]};
        else { *(f32x4*)(SCP + (size_t)bc * 1024 + ch) = (f32x4){P[0], P[1], P[2], P[3]}; *(f32x4*)(SCH + (size_t)bc * 1024 + ch) = (f32x4){H[0], H[1], H[2], H[3]}; }
    }
}
__device__ __forceinline__ void phase_scan2(const Ctx& C) {
    unsigned char* ws = C.ws; const int lane = C.lane;
    const bf16_t* LA = (const bf16_t*)(ws + SLOT(1)); const bf16_t* UU = (const bf16_t*)(ws + SLOT(6)); const bf16_t* GR = (const bf16_t*)(ws + SLOT(2)); bf16_t* HRG = (bf16_t*)(ws + SLOT(0));
    const float* SCP = (const float*)(ws + WS_SCP); const float* SCH = (const float*)(ws + WS_SCH); const float* CARRY0 = (const float*)(ws + WS_CARRY0);
    for (int it = C.gw; it < 2048; it += C.NGW) {
        const int q = it & 3, bc = it >> 2, b = bc >> 4, c = bc & 15, ch = q * 256 + lane * 4;
        f32x4 h = *(const f32x4*)(CARRY0 + ch);
        for (int cc = 0; cc < c; ++cc) { const f32x4 p = *(const f32x4*)(SCP + (size_t)(b * 16 + cc) * 1024 + ch), e = *(const f32x4*)(SCH + (size_t)(b * 16 + cc) * 1024 + ch); h = p * h + e; }
        float H[4] = {h[0], h[1], h[2], h[3]};
        const int row0 = bc * 128;
#pragma unroll 8
        for (int t = 0; t < 128; ++t) { const size_t off = (size_t)(row0 + t) * 1024 + ch; const u32x2 l2 = *(const u32x2*)(LA + off), u2 = *(const u32x2*)(UU + off), g2 = *(const u32x2*)(GR + off);
            H[0] = ex2(LOG2E * bf_lo(l2.x)) * H[0] + bf_lo(u2.x); H[1] = ex2(LOG2E * bf_hi(l2.x)) * H[1] + bf_hi(u2.x); H[2] = ex2(LOG2E * bf_lo(l2.y)) * H[2] + bf_lo(u2.y); H[3] = ex2(LOG2E * bf_hi(l2.y)) * H[3] + bf_hi(u2.y);
            u32x2 o; o.x = pk2(H[0] * bf_lo(g2.x), H[1] * bf_hi(g2.x)); o.y = pk2(H[2] * bf_lo(g2.y), H[3] * bf_hi(g2.y)); *(u32x2*)(HRG + off) = o; }
    }
}

constexpr int AT_KSLOT = 12 * 1024, AT_VSLOT = 8192;
#define AT_K(j) (((j) & 3) * AT_KSLOT)
#define AT_V(j) (4 * AT_KSLOT + ((j) & 7) * AT_VSLOT)
static_assert(4 * AT_KSLOT + 8 * AT_VSLOT <= 131072, "attention rings fit the phase scratch");
__device__ __forceinline__ void glds16(const void* gsrc, unsigned lds_dst) { unsigned keep;
    asm volatile("s_mov_b32 %0, m0\n\ts_mov_b32 m0, %2\n\ts_nop 0\n\tglobal_load_lds_dwordx4 %1, off\n\ts_mov_b32 m0, %0" : "=&s"(keep) : "v"(gsrc), "s"(lds_dst) : "memory"); }
#define AT_BAR(N) asm volatile("s_waitcnt vmcnt(" #N ") lgkmcnt(0)\n\ts_barrier" ::: "memory")
__device__ __forceinline__ int crow(int r, int hi) { return (r & 3) + 8 * (r >> 2) + 4 * hi; }
__device__ __forceinline__ void attn_q(LAS unsigned char* lds, int j, int s0, int q, int hi, const bf16x8 (&qf)[6], const f32x16& negm, f32x16& p0, f32x16& p1) {
    const int kb = AT_K(j);
    __builtin_amdgcn_s_setprio(1);
#pragma unroll
    for (int ks = 0; ks < 6; ++ks) {
        const bf16x8 a0 = *(const LAS bf16x8*)(lds + kb + (2 * ks + hi) * 1024 + q * 16);
        const bf16x8 a1 = *(const LAS bf16x8*)(lds + kb + (2 * ks + hi) * 1024 + (32 + q) * 16);
        if (ks == 0) { p0 = __builtin_amdgcn_mfma_f32_32x32x16_bf16(a0, qf[0], negm, 0, 0, 0); p1 = __builtin_amdgcn_mfma_f32_32x32x16_bf16(a1, qf[0], negm, 0, 0, 0); }
        else { p0 = __builtin_amdgcn_mfma_f32_32x32x16_bf16(a0, qf[ks], p0, 0, 0, 0); p1 = __builtin_amdgcn_mfma_f32_32x32x16_bf16(a1, qf[ks], p1, 0, 0, 0); }
    }
    __builtin_amdgcn_s_setprio(0);
    if (j == 0) {
#pragma unroll
        for (int r = 0; r < 16; ++r) { if (crow(r, hi) >= NMETA) p0[r] = -INFINITY; p1[r] = -INFINITY; }
    } else if ((j - 1) * 64 + 63 > s0) {
        const int qs = s0 + q, k0 = (j - 1) * 64;
#pragma unroll
        for (int r = 0; r < 16; ++r) { const int kk = k0 + crow(r, hi); if (kk > qs) p0[r] = -INFINITY; if (kk + 32 > qs) p1[r] = -INFINITY; }
    }
}
__device__ __forceinline__ void attn_pv(LAS unsigned char* lds, int vbase, const bf16x8 (&pb)[4], f32x16& o0, f32x16& o1) {
#pragma unroll
    for (int s = 0; s < 4; ++s)
#pragma unroll
        for (int db = 0; db < 2; ++db) {
            const v4i16_t lo = __builtin_amdgcn_ds_read_tr16_b64_v4i16((LAS v4i16_t*)(lds + vbase + db * 4096 + s * 1024));
            const v4i16_t hh = __builtin_amdgcn_ds_read_tr16_b64_v4i16((LAS v4i16_t*)(lds + vbase + db * 4096 + s * 1024 + 512));
            const bf16x8 va = {lo[0], lo[1], lo[2], lo[3], hh[0], hh[1], hh[2], hh[3]};
            if (db == 0) o0 = __builtin_amdgcn_mfma_f32_32x32x16_bf16(va, pb[s], o0, 0, 0, 0); else o1 = __builtin_amdgcn_mfma_f32_32x32x16_bf16(va, pb[s], o1, 0, 0, 0);
        }
}
#ifndef ATT_THR
#define ATT_THR 8.0f
#endif
template <bool DOPV, bool FIRST> __device__ __forceinline__ void attn_sp(LAS unsigned char* lds, int vbase, f32x16& p0, f32x16& p1, bf16x8 (&pb)[4], f32x16& o0, f32x16& o1, f32x16& negm, float& m_run, float& l_run) {
    float mx = fmaxf(p0[0], p1[0]);
#pragma unroll
    for (int r = 1; r < 16; ++r) mx = fmaxf(fmaxf(mx, p0[r]), p1[r]);
    mx = fmaxf(mx, __shfl_xor(mx, 32));
    if (DOPV) attn_pv(lds, vbase, pb, o0, o1);
    float rs = 0.f;
#pragma unroll
    for (int r = 0; r < 16; ++r) { p0[r] = ex2(p0[r]); p1[r] = ex2(p1[r]); rs += p0[r] + p1[r]; }
    if (FIRST || !__all(mx <= ATT_THR)) {
        const float d = FIRST ? mx : fmaxf(mx, 0.f), alpha = ex2(-d);
#pragma unroll
        for (int r = 0; r < 16; ++r) { p0[r] *= alpha; p1[r] *= alpha; o0[r] *= alpha; o1[r] *= alpha; }
        rs *= alpha; l_run *= alpha; m_run += d;
#pragma unroll
        for (int r = 0; r < 16; ++r) negm[r] = -m_run;
    }
    l_run += rs;
#pragma unroll
    for (int s = 0; s < 4; ++s) { unsigned w[4];
#pragma unroll
        for (int jj = 0; jj < 4; ++jj) w[jj] = (s < 2) ? pk2(p0[8 * (s & 1) + 2 * jj], p0[8 * (s & 1) + 2 * jj + 1]) : pk2(p1[8 * (s & 1) + 2 * jj], p1[8 * (s & 1) + 2 * jj + 1]);
        u32x4 ww = {w[0], w[1], w[2], w[3]}; pb[s] = __builtin_bit_cast(bf16x8, ww); }
}
__device__ __forceinline__ void attn_unit(const Ctx& C, int b, int h, int qb, const bf16_t* Q, const bf16_t* KN, const bf16_t* KR, const bf16_t* V, bf16_t* O) {
    const int tid = C.tid, lane = C.lane, wid = C.wave, q = lane & 31, hi = lane >> 5;
    LAS unsigned char* lds = C.lds;
    const int s0 = qb * 256 + wid * 32;
    const size_t qrow = (size_t)b * SEQ + s0 + q;
    bf16x8 qf[6];
#pragma unroll
    for (int ks = 0; ks < 6; ++ks) qf[ks] = *(const bf16x8*)(Q + qrow * QLD + h * 96 + ks * 16 + hi * 8);
    {
        const float* ctab = (const float*)(C.ws + WS_CTAB) + (NMETA + s0 + q) * 16; const float* stab = (const float*)(C.ws + WS_STAB) + (NMETA + s0 + q) * 16;
#pragma unroll
        for (int ks = 4; ks < 6; ++ks) { const f32x4 cc = *(const f32x4*)(ctab + 8 * (ks - 4) + 4 * hi), sn = *(const f32x4*)(stab + 8 * (ks - 4) + 4 * hi);
            const u32x4 w = __builtin_bit_cast(u32x4, qf[ks]); u32x4 r;
            { const float x1 = bf_lo(w.x), x2 = bf_hi(w.x); r.x = pk2(x1 * cc[0] - x2 * sn[0], x1 * sn[0] + x2 * cc[0]); }
            { const float x1 = bf_lo(w.y), x2 = bf_hi(w.y); r.y = pk2(x1 * cc[1] - x2 * sn[1], x1 * sn[1] + x2 * cc[1]); }
            { const float x1 = bf_lo(w.z), x2 = bf_hi(w.z); r.z = pk2(x1 * cc[2] - x2 * sn[2], x1 * sn[2] + x2 * cc[2]); }
            { const float x1 = bf_lo(w.w), x2 = bf_hi(w.w); r.w = pk2(x1 * cc[3] - x2 * sn[3], x1 * sn[3] + x2 * cc[3]); }
            qf[ks] = __builtin_bit_cast(bf16x8, r); }
    }
    f32x16 o0 = {}, o1 = {}, p0 = {}, p1 = {};
    bf16x8 pb[4] = {};
    float m_run = 0.f, l_run = 0.f; f32x16 negm = {};
    const int NJ = 4 * qb + 5;
    const unsigned lds0 = (unsigned)(size_t)lds;
    const bf16_t* ksrc = KN + (size_t)lane * 1024 + h * 64 + wid * 8;
    const bf16_t* rsrc = KR + (size_t)lane * 32 + (wid & 3) * 8;
    const bf16_t* vsrc = V + (size_t)(16 * (wid & 3) + (lane >> 2)) * 1024 + h * 64 + (wid >> 2) * 32 + (lane & 3) * 8;
#define AT_DMA(j) do { const size_t row_ = (j) == 0 ? (size_t)METAROW : (size_t)b * SEQ + (size_t)((j) - 1) * 64; \
        glds16(ksrc + row_ * 1024, (unsigned)__builtin_amdgcn_readfirstlane(lds0 + AT_K(j) + wid * 1024)); \
        if (wid < 4) glds16(rsrc + row_ * 32, (unsigned)__builtin_amdgcn_readfirstlane(lds0 + AT_K(j) + (8 + wid) * 1024)); \
        glds16(vsrc + row_ * 1024, (unsigned)__builtin_amdgcn_readfirstlane(lds0 + AT_V(j) + wid * 1024)); } while (0)
#define AT_STEP(n) do { if ((n) + 2 < NJ) { if (wid < 4) AT_BAR(6); else AT_BAR(4); } else if ((n) + 1 < NJ) { if (wid < 4) AT_BAR(3); else AT_BAR(2); } else AT_BAR(0); if ((n) + 3 < NJ) AT_DMA((n) + 3); } while (0)
    AT_BAR(0);
    AT_DMA(0); AT_DMA(1); AT_DMA(2);
    const int g16 = lane >> 4, qq = (lane & 15) >> 2, pp = lane & 3;
    const int vtr_off = (4 * hi + qq) * 64 + (16 * (g16 & 1) + 4 * pp) * 2;
    {
        AT_STEP(0);
        attn_q(lds, 0, s0, q, hi, qf, negm, p0, p1);
        attn_sp<false, true>(lds, 0, p0, p1, pb, o0, o1, negm, m_run, l_run);
    }
    const int jend = (s0 + 31) / 64 + 2 < NJ ? (s0 + 31) / 64 + 2 : NJ;
    for (int j = 1; j < jend; ++j) {
        AT_STEP(j);
        attn_q(lds, j, s0, q, hi, qf, negm, p0, p1);
        attn_sp<true, false>(lds, AT_V(j - 1) + vtr_off, p0, p1, pb, o0, o1, negm, m_run, l_run);
    }
    attn_pv(lds, AT_V(jend - 1) + vtr_off, pb, o0, o1);
    for (int j = jend; j < NJ; ++j) AT_STEP(j);
#undef AT_DMA
#undef AT_STEP
    const float inv = 1.f / (l_run + __shfl_xor(l_run, 32));
    bf16_t* orow = O + qrow * 1024 + h * 64;
#pragma unroll
    for (int db = 0; db < 2; ++db)
#pragma unroll
        for (int gp = 0; gp < 2; ++gp) {
            const f32x16& o = db ? o1 : o0; const int r0 = 8 * gp;
            const unsigned x0 = pk2(o[r0] * inv, o[r0 + 1] * inv), x1 = pk2(o[r0 + 2] * inv, o[r0 + 3] * inv);
            const unsigned y0 = pk2(o[r0 + 4] * inv, o[r0 + 5] * inv), y1 = pk2(o[r0 + 6] * inv, o[r0 + 7] * inv);
            auto s0 = __builtin_amdgcn_permlane32_swap(x0, y0, false, false); auto s1 = __builtin_amdgcn_permlane32_swap(x1, y1, false, false);
            const u32x4 w = {s0[0], s1[0], s0[1], s1[1]};
            *(u32x4*)(orow + 32 * db + 16 * gp + 8 * hi) = w;
        }
}
__device__ __forceinline__ void phase_attn(const Ctx& C) {
    unsigned char* ws = C.ws;
    const bf16_t* Q = (const bf16_t*)(ws + SLOT(0)); const bf16_t* KN = (const bf16_t*)(ws + SLOT(4)); const bf16_t* V = (const bf16_t*)(ws + SLOT(6)); const bf16_t* KR = (const bf16_t*)(ws + WS_KROPE);
    bf16_t* O = (bf16_t*)(ws + SLOT(3));
    const int G = C.G, c = blockIdx.x; const int vcu = (G % 8 == 0) ? (c % 8) * (G / 8) + c / 8 : c;
    for (int bh = vcu; bh < NB * 16; bh += G)
        for (int i = 0; i < 8; ++i) { const int qb = (i & 1) ? 7 - (i >> 1) : (i >> 1); attn_unit(C, bh >> 4, bh & 15, qb, Q, KN, KR, V, O); }
    __syncthreads();
}

__device__ __forceinline__ int tk_enc(float f) { const int x = __float_as_int(f); return x ^ ((x >> 31) & 0x7fffffff); }
__device__ __forceinline__ float tk_dec(int k) { return __int_as_float(k ^ ((k >> 31) & 0x7fffffff)); }
#define TK_CE(a, b) do { const int hi_ = max((a), (b)), lo_ = min((a), (b)); (a) = hi_; (b) = lo_; } while (0)
__device__ __forceinline__ void tk_sort16(int (&v)[16]) {
#pragma unroll
    for (int k = 2; k <= 16; k <<= 1)
#pragma unroll
        for (int j = k >> 1; j > 0; j >>= 1)
#pragma unroll
            for (int i = 0; i < 16; ++i) { const int l = i ^ j; if (l > i) { if ((i & k) == 0) TK_CE(v[i], v[l]); else TK_CE(v[l], v[i]); } }
}
__device__ __forceinline__ void tk_merge16(int (&a)[16], const int (&b)[16]) {
#pragma unroll
    for (int i = 0; i < 16; ++i) a[i] = max(a[i], b[15 - i]);
#pragma unroll
    for (int j = 8; j > 0; j >>= 1)
#pragma unroll
        for (int i = 0; i < 16; ++i) { const int l = i ^ j; if (l > i) TK_CE(a[i], a[l]); }
}
__host__ __device__ constexpr int tk_pos(int i) { int n = 0; for (int a = 0; a < i; ++a) n += 16 / (a + 1); return n; }
__device__ __forceinline__ int tk_lookup(const int (&w)[4], int i) {
    const unsigned long long lo = ((unsigned long long)(unsigned)w[1] << 32) | (unsigned long long)(unsigned)w[0], hi = ((unsigned long long)(unsigned)w[3] << 32) | (unsigned long long)(unsigned)w[2];
    const unsigned long long a = (i & 8) ? hi : lo;
    return (int)(a >> (8 * (i & 7))) & 127;
}
__device__ __forceinline__ void phase_topk(const Ctx& C) {
    unsigned char* ws = C.ws;
    const _Float16* SC = (const _Float16*)(ws + SLOT(0)); int* TIDX = (int*)(ws + SLOT(5)); float* TVAL = (float*)(ws + SLOT(5) + (size_t)M * 128 * 4);
    const int gt = blockIdx.x * NTHR + C.tid, NT = C.G * NTHR;
    for (int it = gt; it < M * 8 * 4; it += NT) {
        const int p = it >> 2, q = it & 3;
        const f16x8* s = (const f16x8*)(SC + (size_t)p * 256 + 64 * q);
        f16x8 raw[8];
#pragma unroll
        for (int c = 0; c < 8; ++c) raw[c] = s[c];
        const int ibase = 127 - 64 * (q & 1);
        int ch[4][16];
#pragma unroll
        for (int c = 0; c < 4; ++c)
#pragma unroll
            for (int e = 0; e < 16; ++e) ch[c][e] = (tk_enc((float)raw[2 * c + (e >> 3)][e & 7]) & ~127) | (ibase - (16 * c + e));
        tk_sort16(ch[0]); tk_sort16(ch[1]); tk_sort16(ch[2]); tk_sort16(ch[3]);
        tk_merge16(ch[0], ch[1]); tk_merge16(ch[2], ch[3]); tk_merge16(ch[0], ch[2]);
        int oth[16];
#pragma unroll
        for (int i = 0; i < 16; ++i) oth[i] = __builtin_amdgcn_mov_dpp(ch[0][i], 0xB1, 0xF, 0xF, true);
        tk_merge16(ch[0], oth);
#pragma unroll
        for (int i = 0; i < 16; ++i) oth[i] = __builtin_amdgcn_mov_dpp(ch[0][i], 0x4E, 0xF, 0xF, true);
        int t1[16], t2[16];
#pragma unroll
        for (int i = 0; i < 16; ++i) { t1[i] = (q < 2) ? ch[0][i] : oth[i]; t2[i] = (q < 2) ? oth[i] : ch[0][i]; }
        float f1[16], f2[16];
#pragma unroll
        for (int i = 0; i < 16; ++i) { f1[i] = tk_dec(t1[i]); f2[i] = tk_dec(t2[i]); }
        int cd[4][16];
#pragma unroll
        for (int i = 0; i < 16; ++i)
#pragma unroll
            for (int j = 0; j < 16; ++j) if ((i + 1) * (j + 1) <= 16) { constexpr int dummy = 0; (void)dummy; const int n = tk_pos(i) + j; cd[n >> 4][n & 15] = (tk_enc(f1[i] + f2[j]) & ~255) | (255 - (16 * i + j)); }
#pragma unroll
        for (int n = 50; n < 64; ++n) cd[n >> 4][n & 15] = (int)0x80000000;
        tk_sort16(cd[0]); tk_sort16(cd[1]); tk_sort16(cd[2]); tk_sort16(cd[3]);
        tk_merge16(cd[0], cd[1]); tk_merge16(cd[2], cd[3]); tk_merge16(cd[0], cd[2]);
        int w1[4], w2[4];
#pragma unroll
        for (int m = 0; m < 4; ++m) { w1[m] = (t1[4 * m] & 127) | ((t1[4 * m + 1] & 127) << 8) | ((t1[4 * m + 2] & 127) << 16) | ((t1[4 * m + 3] & 127) << 24);
                                      w2[m] = (t2[4 * m] & 127) | ((t2[4 * m + 1] & 127) << 8) | ((t2[4 * m + 2] & 127) << 16) | ((t2[4 * m + 3] & 127) << 24); }
        if (q == 0) {
            int id[16];
#pragma unroll
            for (int k = 0; k < 16; ++k) { const int c = 255 - (cd[0][k] & 255); id[k] = (127 - tk_lookup(w1, c >> 4)) * 128 + (127 - tk_lookup(w2, c & 15)); }
            int* oi = TIDX + (size_t)p * 16;
#pragma unroll
            for (int k = 0; k < 16; k += 4) *(int4*)(oi + k) = make_int4(id[k], id[k + 1], id[k + 2], id[k + 3]);
        } else if (q == 1) {
            float* ov = TVAL + (size_t)p * 16;
#pragma unroll
            for (int k = 0; k < 16; k += 4) *(f32x4*)(ov + k) = (f32x4){tk_dec(cd[0][k]), tk_dec(cd[0][k + 1]), tk_dec(cd[0][k + 2]), tk_dec(cd[0][k + 3])};
        }
    }
}

__device__ __forceinline__ f32x2 fp8lo(unsigned w) { return __builtin_amdgcn_cvt_pk_f32_fp8((int)w, false); }
__device__ __forceinline__ f32x2 fp8hi(unsigned w) { return __builtin_amdgcn_cvt_pk_f32_fp8((int)w, true); }
__device__ __forceinline__ float dpp_ror8(float v) { return __uint_as_float(__builtin_amdgcn_update_dpp(0, __float_as_uint(v), 0x128, 0xF, 0xF, true)); }
__device__ __forceinline__ float dpp_hmir(float v) { return __uint_as_float(__builtin_amdgcn_update_dpp(0, __float_as_uint(v), 0x141, 0xF, 0xF, true)); }
__device__ __forceinline__ float dpp_x2(float v) { return __uint_as_float(__builtin_amdgcn_mov_dpp(__float_as_uint(v), 0x4E, 0xF, 0xF, true)); }
__device__ __forceinline__ float dpp_x1(float v) { return __uint_as_float(__builtin_amdgcn_mov_dpp(__float_as_uint(v), 0xB1, 0xF, 0xF, true)); }
__device__ __forceinline__ float fp8dot16(const u32x4 w, const f32x2 (&x2)[8]) {
    f32x2 a = fp8lo(w.x) * x2[0]; a += fp8hi(w.x) * x2[1]; a += fp8lo(w.y) * x2[2]; a += fp8hi(w.y) * x2[3];
    a += fp8lo(w.z) * x2[4]; a += fp8hi(w.z) * x2[5]; a += fp8lo(w.w) * x2[6]; a += fp8hi(w.w) * x2[7];
    return a.x + a.y;
}
__device__ __forceinline__ void load_x2(const bf16_t* H1B, const float* g2, int tok, int lane, f32x2 (&x2)[8], f32x4 (&e)[4], float& ss) {
    const u32x4 xa = *(const u32x4*)(H1B + (size_t)tok * 1024 + 16 * lane), xb = *(const u32x4*)(H1B + (size_t)tok * 1024 + 16 * lane + 8);
    float hv[16]; { float t8[8]; unpack8(xa, t8);
#pragma unroll
        for (int i = 0; i < 8; ++i) hv[i] = t8[i];
        unpack8(xb, t8);
#pragma unroll
        for (int i = 0; i < 8; ++i) hv[8 + i] = t8[i]; }
    const f32x4* gp = (const f32x4*)(g2 + 16 * lane); ss = 0.f;
#pragma unroll
    for (int j = 0; j < 4; ++j) { const f32x4 gv = gp[j]; e[j] = (f32x4){hv[4 * j], hv[4 * j + 1], hv[4 * j + 2], hv[4 * j + 3]};
        ss += (e[j][0] * e[j][0] + e[j][1] * e[j][1]) + (e[j][2] * e[j][2] + e[j][3] * e[j][3]);
        x2[2 * j] = (f32x2){e[j][0] * gv[0], e[j][1] * gv[1]}; x2[2 * j + 1] = (f32x2){e[j][2] * gv[2], e[j][3] * gv[3]}; }
}
__device__ __forceinline__ void u_process(unsigned c, int n, int sub, int tok, const f32x2 (&x2)[8], const unsigned char* PU, float* ACT, int lane, bool b3) {
    for (int base = 0; base < n; base += 24) {
        int id[24];
#pragma unroll
        for (int k = 0; k < 24; ++k) { const int v = (int)(__builtin_amdgcn_readlane(c, (base + k) & 63) & 0xffffu); id[k] = (base + k < n) ? v : (sub << 11); }
        u32x4 w[24];
#pragma unroll
        for (int g = 0; g < 3; ++g) if (base + 8 * g < n) {
#pragma unroll
            for (int k = 0; k < 8; ++k) w[8 * g + k] = *(const u32x4*)(PU + (size_t)id[8 * g + k] * 1024 + 16 * lane); }
        __builtin_amdgcn_sched_barrier(0);
#pragma unroll
        for (int g = 0; g < 3; ++g) if (base + 8 * g < n) {
            float p[8];
#pragma unroll
            for (int k = 0; k < 8; ++k) p[k] = fp8dot16(w[8 * g + k], x2);
            float q4[4], q2[2];
#pragma unroll
            for (int i = 0; i < 4; ++i) { auto rr = __builtin_amdgcn_permlane32_swap(__float_as_uint(p[i]), __float_as_uint(p[4 + i]), false, false); q4[i] = __uint_as_float(rr[0]) + __uint_as_float(rr[1]); }
#pragma unroll
            for (int i = 0; i < 2; ++i) { auto rr = __builtin_amdgcn_permlane16_swap(__float_as_uint(q4[i]), __float_as_uint(q4[2 + i]), false, false); q2[i] = __uint_as_float(rr[0]) + __uint_as_float(rr[1]); }
            float t; { const float keep = b3 ? q2[1] : q2[0], send = b3 ? q2[0] : q2[1]; t = keep + dpp_ror8(send); }
            t += dpp_hmir(t); t += dpp_x2(t); t += dpp_x1(t);
            const int slot = base + 8 * g + (lane >> 3);
            const unsigned mine = (unsigned)__builtin_amdgcn_ds_bpermute((slot & 63) * 4, (int)c);
            if ((lane & 7) == 0 && slot < n) ACT[(size_t)tok * 128 + (mine >> 16)] = t;
        }
    }
}
__device__ __forceinline__ void phase_upart(const Ctx& C, int xcc, int rank) {
    unsigned char* ws = C.ws; const int lane = C.lane;
    const bf16_t* H1B = (const bf16_t*)(ws + SLOT(4)); const int* TIDX = (const int*)(ws + SLOT(5)); float* ACT = (float*)(ws + SLOT(0));
    const unsigned char* PU = ws + WS_PU;
    int nloc, xi, nx;
    if ((C.G & 7) == 0) { nx = 8; xi = xcc; nloc = C.G >> 3; } else { nx = 1; xi = 0; nloc = C.G; rank = blockIdx.x; }
    const bool b3 = (lane & 8) != 0;
    f32x4 gv[4];
#pragma unroll
    for (int j = 0; j < 4; ++j) gv[j] = ((const f32x4*)(C.in[18] + 16 * lane))[j];
    const int tstep = nloc * NWAVES;
    for (int sub = xi; sub < 8; sub += nx) {
        int tok = rank * NWAVES + C.wave;
        u32x4 ra = {0u, 0u, 0u, 0u}, rb = {0u, 0u, 0u, 0u}; int ia = 0, ib = 0;
        if (tok < M) { ra = *(const u32x4*)(H1B + (size_t)tok * 1024 + 16 * lane); rb = *(const u32x4*)(H1B + (size_t)tok * 1024 + 16 * lane + 8); ia = TIDX[(size_t)tok * 128 + lane]; ib = TIDX[(size_t)tok * 128 + 64 + lane]; }
        for (; tok < M; tok += tstep) {
            f32x2 x2[8];
            { float hv[16]; { float t8[8]; unpack8(ra, t8);
#pragma unroll
                for (int i = 0; i < 8; ++i) hv[i] = t8[i];
                unpack8(rb, t8);
#pragma unroll
                for (int i = 0; i < 8; ++i) hv[8 + i] = t8[i]; }
#pragma unroll
              for (int j = 0; j < 4; ++j) { x2[2 * j] = (f32x2){hv[4 * j] * gv[j][0], hv[4 * j + 1] * gv[j][1]}; x2[2 * j + 1] = (f32x2){hv[4 * j + 2] * gv[j][2], hv[4 * j + 3] * gv[j][3]}; } }
            const int ca = ia, cb = ib;
            const int nt = tok + tstep;
            if (nt < M) { ra = *(const u32x4*)(H1B + (size_t)nt * 1024 + 16 * lane); rb = *(const u32x4*)(H1B + (size_t)nt * 1024 + 16 * lane + 8); ia = TIDX[(size_t)nt * 128 + lane]; ib = TIDX[(size_t)nt * 128 + 64 + lane]; }
            const bool fa = (ca >> 11) == sub, fb = (cb >> 11) == sub;
            const unsigned long long ma = __ballot(fa), mb = __ballot(fb);
            const int npa = __builtin_popcountll(ma), npb = __builtin_popcountll(mb);
            const int ra_ = (int)__builtin_amdgcn_mbcnt_hi((unsigned)(ma >> 32), __builtin_amdgcn_mbcnt_lo((unsigned)ma, 0u));
            const int rb_ = (int)__builtin_amdgcn_mbcnt_hi((unsigned)(mb >> 32), __builtin_amdgcn_mbcnt_lo((unsigned)mb, 0u));
            const int da = fa ? ra_ : npa + (lane - ra_), db = fb ? rb_ : npb + (lane - rb_);
            const unsigned cA = (unsigned)__builtin_amdgcn_ds_permute(da * 4, ca | (lane << 16));
            const unsigned cB = (unsigned)__builtin_amdgcn_ds_permute(db * 4, cb | ((64 + lane) << 16));
            if (npa + npb <= 64) {
                const unsigned pulled = (unsigned)__builtin_amdgcn_ds_bpermute(((lane - npa) & 63) * 4, (int)cB);
                u_process(lane < npa ? cA : pulled, npa + npb, sub, tok, x2, PU, ACT, lane, b3);
            } else { u_process(cA, npa, sub, tok, x2, PU, ACT, lane, b3); u_process(cB, npb, sub, tok, x2, PU, ACT, lane, b3); }
        }
    }
}
__device__ __forceinline__ void phase_gather(const Ctx& C, float* DST) {
    unsigned char* ws = C.ws; const int lane = C.lane;
    const bf16_t* H1B = (const bf16_t*)(ws + SLOT(4)); const int* TIDX = (const int*)(ws + SLOT(5)); const float* TVAL = (const float*)(ws + SLOT(5) + (size_t)M * 128 * 4);
    const float* ACT = (const float*)(ws + SLOT(0));
    const unsigned char* PV = ws + WS_PV; const float* SU = (const float*)(ws + WS_SU); const float* SV = (const float*)(ws + WS_SV);
    const float* fg = C.in[24]; const f32x4* gp = (const f32x4*)(C.in[18] + 16 * lane);
    const int l4 = lane >> 2;
    int tok = C.gw;
    u32x4 ra = {0u, 0u, 0u, 0u}, rb = {0u, 0u, 0u, 0u};
    if (tok < M) { ra = *(const u32x4*)(H1B + (size_t)tok * 1024 + 16 * lane); rb = *(const u32x4*)(H1B + (size_t)tok * 1024 + 16 * lane + 8); }
    for (; tok < M; tok += C.NGW) {
        f32x4 e[4]; float ss = 0.f;
        { float hv[16]; { float t8[8]; unpack8(ra, t8);
#pragma unroll
            for (int i = 0; i < 8; ++i) hv[i] = t8[i];
            unpack8(rb, t8);
#pragma unroll
            for (int i = 0; i < 8; ++i) hv[8 + i] = t8[i]; }
#pragma unroll
          for (int j = 0; j < 4; ++j) { e[j] = (f32x4){hv[4 * j], hv[4 * j + 1], hv[4 * j + 2], hv[4 * j + 3]}; ss += (e[j][0] * e[j][0] + e[j][1] * e[j][1]) + (e[j][2] * e[j][2] + e[j][3] * e[j][3]); } }
        { const int nt = tok + C.NGW; if (nt < M) { ra = *(const u32x4*)(H1B + (size_t)nt * 1024 + 16 * lane); rb = *(const u32x4*)(H1B + (size_t)nt * 1024 + 16 * lane + 8); } }
        f32x4* dp = (f32x4*)(DST + (size_t)tok * 1024 + 16 * lane);
        const float rstd = 1.f / sqrtf(wave_sum(ss) * (1.f / 1024.f) + EPS);
        f32x2 acc[8];
#pragma unroll
        for (int i = 0; i < 8; ++i) acc[i] = (f32x2){0.f, 0.f};
        int idxn0 = TIDX[(size_t)tok * 128 + l4], idxn1 = TIDX[(size_t)tok * 128 + 16 + l4];
        float tsn0 = TVAL[(size_t)tok * 128 + l4], tsn1 = TVAL[(size_t)tok * 128 + 16 + l4], dtn0 = ACT[(size_t)tok * 128 + l4], dtn1 = ACT[(size_t)tok * 128 + 16 + l4];
        for (int hp = 0; hp < 8; hp += 2) {
            const int idx0 = idxn0, idx1 = idxn1; const float ts0 = tsn0 * rstd, ts1 = tsn1 * rstd, dot0 = dtn0, dot1 = dtn1;
            u32x4 wv[32];
#pragma unroll
            for (int k = 0; k < 16; ++k) wv[k] = *(const u32x4*)(PV + (size_t)__builtin_amdgcn_readlane(idx0, 4 * k) * 1024 + 16 * lane);
#pragma unroll
            for (int k = 0; k < 16; ++k) wv[16 + k] = *(const u32x4*)(PV + (size_t)__builtin_amdgcn_readlane(idx1, 4 * k) * 1024 + 16 * lane);
            __builtin_amdgcn_sched_barrier(0);
            const float su0 = SU[idx0], sv0 = SV[idx0], su1 = SU[idx1], sv1 = SV[idx1];
            if (hp < 6) { const size_t nb = (size_t)tok * 128 + (hp + 2) * 16 + l4; idxn0 = TIDX[nb]; idxn1 = TIDX[nb + 16]; tsn0 = TVAL[nb]; tsn1 = TVAL[nb + 16]; dtn0 = ACT[nb]; dtn1 = ACT[nb + 16]; }
            __builtin_amdgcn_sched_barrier(0);
            float mx0 = ts0, mx1 = ts1;
#pragma unroll
            for (int o = 4; o < 64; o <<= 1) { mx0 = fmaxf(mx0, __shfl_xor(mx0, o)); mx1 = fmaxf(mx1, __shfl_xor(mx1, o)); }
            const float ee0 = ex2((ts0 - mx0) * LOG2E), ee1 = ex2((ts1 - mx1) * LOG2E); float sm0 = ee0, sm1 = ee1;
#pragma unroll
            for (int o = 4; o < 64; o <<= 1) { sm0 += __shfl_xor(sm0, o); sm1 += __shfl_xor(sm1, o); }
            const float coef0 = (ee0 / sm0) * gelu_t(dot0 * su0 * rstd) * sv0, coef1 = (ee1 / sm1) * gelu_t(dot1 * su1 * rstd) * sv1;
#pragma unroll
            for (int k = 0; k < 32; ++k) {
                const float ck = __uint_as_float(__builtin_amdgcn_readlane(__float_as_uint(k < 16 ? coef0 : coef1), 4 * (k & 15))); const f32x2 c2 = {ck, ck};
                const u32x4 w = wv[k];
                acc[0] += c2 * fp8lo(w.x); acc[1] += c2 * fp8hi(w.x); acc[2] += c2 * fp8lo(w.y); acc[3] += c2 * fp8hi(w.y);
                acc[4] += c2 * fp8lo(w.z); acc[5] += c2 * fp8hi(w.z); acc[6] += c2 * fp8lo(w.w); acc[7] += c2 * fp8hi(w.w);
            }
        }
        float s2 = 0.f;
#pragma unroll
        for (int j = 0; j < 4; ++j) { e[j] = e[j] + (f32x4){acc[2 * j].x, acc[2 * j].y, acc[2 * j + 1].x, acc[2 * j + 1].y}; s2 += (e[j][0] * e[j][0] + e[j][1] * e[j][1]) + (e[j][2] * e[j][2] + e[j][3] * e[j][3]); }
        const float r2 = 1.f / sqrtf(wave_sum(s2) * (1.f / 1024.f) + EPS);
        const f32x4* fp = (const f32x4*)(fg + 16 * lane);
#pragma unroll
        for (int j = 0; j < 4; ++j) dp[j] = e[j] * r2 * fp[j];
        (void)gp;
    }
}

constexpr int NPHASE = 16;
__global__ void __launch_bounds__(NTHR, 2) hybrid_fwd(Args args) {
    extern __shared__ __attribute__((aligned(16))) unsigned char lds_raw[];
    Ctx C;
    C.lds = (LAS unsigned char*)lds_raw; C.tid = threadIdx.x; C.lane = C.tid & 63; C.wave = __builtin_amdgcn_readfirstlane(C.tid >> 6);
    C.G = gridDim.x; C.gw = blockIdx.x * NWAVES + C.wave; C.NGW = C.G * NWAVES; C.ws = args.ws; C.out = args.out; C.in = args.in;
    unsigned char* ws = args.ws;
    volatile LAS unsigned* MISC = (volatile LAS unsigned*)(C.lds + MISC_OFF);
    for (int u = C.tid; u < (LDS_BYTES - RING_BYTES) / 4; u += NTHR) ((LAS unsigned*)(C.lds + RING_BYTES))[u] = 0u;
    __syncthreads();
    XcdBarrier bar; bar.bar = (unsigned*)(ws + WS_CTL) + 1024; bar.x = 0; bar.st = nullptr;
    if (ONE_LAUNCH) bar = xcd_barrier_post((unsigned*)(ws + WS_CTL) + 1024, MISC + 8);
    const int lo = args.ph_lo, hi = args.ph_hi;
#ifndef PHMASK
#define PHMASK 0xffff
#endif
#define IN(k) (((PHMASK >> (k)) & 1) && lo <= (k) && (k) < hi)
#ifndef PROBE_PHASE
#define PROBE_PHASE -1
#endif
#define REPS(k) for (int rep_ = 0; rep_ < ((k) == PROBE_PHASE ? 2 : 1); ++rep_)
#define SEAM(k) do { if (IN(k) && IN((k) + 1)) xcd_barrier(bar); } while (0)
    const int G = C.G, cb = blockIdx.x;
    LAS unsigned char* ring = C.lds;

    if (IN(0)) REPS(0) { phase_prologue(C); }
    SEAM(0);
    if (IN(1)) REPS(1) {
        pg8::Gemm g{(const bf16_t*)(ws + SLOT(0)), (const bf16_t*)(ws + WS_WIN), 1024, 1024, 1024, 0, 256 * 1024};
        pg8::Sched S; S.init(256, 19, G, cb, 256, 6, 4);
        pg8::Epi8<FInproj> E{{(bf16_t*)(ws + SLOT(1)), (bf16_t*)(ws + SLOT(2)), (bf16_t*)(ws + SLOT(3)), (bf16_t*)(ws + SLOT(4)), (bf16_t*)(ws + SLOT(5))}};
        pg8::gemm_phase(ring, g, S, E);
    }
    SEAM(1);
    if (IN(2)) REPS(2) { phase_thin(C); }
    SEAM(2);
    if (IN(3)) REPS(3) {
        pg8::Gemm g{(const bf16_t*)(ws + SLOT(0)), (const bf16_t*)(ws + WS_WGATE), 1024, 128, 128, 128, 256 * 128};
        pg8::Sched S; S.init(256, 8, G, cb, 256, 8, 0);
        pg8::EpiPair<FGate> E{{(const bf16_t*)(ws + SLOT(0)), args.in[7], args.in[9], (const float*)(ws + WS_CLAM), (bf16_t*)(ws + SLOT(1)), (bf16_t*)(ws + SLOT(6))}};
        pg8::gemm_phase(ring, g, S, E);
    }
    SEAM(3);
    if (IN(4)) REPS(4) { phase_scan1(C); }
    SEAM(4);
    if (IN(5)) REPS(5) { phase_scan2(C); }
    SEAM(5);
    if (IN(6)) REPS(6) {
        pg8::Gemm g{(const bf16_t*)(ws + SLOT(0)), (const bf16_t*)(ws + WS_WRNN), 1024, 1024, 1024, 0, 256 * 1024};
        pg8::Sched S; S.init(256, 4, G, cb, 0, 0, 0);
        pg8::Epi8<FMul<false>> E{{(const bf16_t*)(ws + SLOT(4)), nullptr, (bf16_t*)(ws + SLOT(2))}};
        pg8::gemm_phase(ring, g, S, E);
    }
    SEAM(6);
    if (IN(7)) REPS(7) {
        { pg8::Gemm g{(const bf16_t*)(ws + SLOT(3)) + CQ_OFF, (const bf16_t*)(ws + WS_WUQ), CQKV_LD, 384, 384, 0, 256 * 384};
          pg8::Sched S; S.init(256, 6, G, cb, 0, 0, 0);
          pg8::Epi8<FQ> E{{(const float*)(ws + WS_RSQ), (bf16_t*)(ws + SLOT(0))}};
          pg8::gemm_phase(ring, g, S, E); }
        { pg8::Gemm g{(const bf16_t*)(ws + SLOT(3)), (const bf16_t*)(ws + WS_WUKV), CQKV_LD, 256, 256, 0, 256 * 256};
          pg8::Sched S; S.init(256, 8, G, cb, 256, 8, 0);
          pg8::Epi8<FKV> E{{(const float*)(ws + WS_RSKV), (bf16_t*)(ws + SLOT(4)), (bf16_t*)(ws + SLOT(6))}};
          pg8::gemm_phase(ring, g, S, E); }
    }
    SEAM(7);
    if (IN(8)) REPS(8) { phase_attn(C); }
    SEAM(8);
    if (IN(9)) REPS(9) {
        pg8::Gemm g{(const bf16_t*)(ws + SLOT(3)), (const bf16_t*)(ws + WS_WATT), 1024, 1024, 1024, 0, 256 * 1024};
        pg8::Sched S; S.init(256, 4, G, cb, 0, 0, 0);
        pg8::Epi8<FMul<true>> E{{(const bf16_t*)(ws + SLOT(5)), (const bf16_t*)(ws + SLOT(2)), (bf16_t*)(ws + SLOT(0))}};
        pg8::gemm_phase(ring, g, S, E);
    }
    SEAM(9);
    if (IN(10)) REPS(10) {
        pg8::Gemm g{(const bf16_t*)(ws + SLOT(0)), (const bf16_t*)(ws + WS_WOUT), 1024, 1024, 1024, 0, 256 * 1024};
        pg8::Sched S; S.init(256, 4, G, cb, 0, 0, 0);
        pg8::Epi8<FRes> E{{args.in[0], (bf16_t*)(ws + SLOT(4))}};
        pg8::gemm_phase(ring, g, S, E);
    }
    SEAM(10);
    if (IN(11)) REPS(11) {
        pg8::Gemm g{(const bf16_t*)(ws + SLOT(4)), (const bf16_t*)(ws + WS_WPQ), 1024, 1024, 1024, 0, 256 * 1024};
        pg8::Sched S; S.init(256, 8, G, cb, 0, 0, 0);
        pg8::Epi8<FF16> E{{(_Float16*)(ws + SLOT(0)), 2048}};
        pg8::gemm_phase(ring, g, S, E);
    }
    SEAM(11);
    if (IN(13)) REPS(13) { phase_topk(C); }
    SEAM(13);
    if (IN(14)) REPS(14) { phase_upart(C, (int)(blockIdx.x & 7), (int)(blockIdx.x >> 3)); }
    SEAM(14);
    if (IN(15)) REPS(15) { phase_gather(C, C.out); }
#undef IN
#undef SEAM
}

extern "C" void kernel_launch(void* const* d_in, const int* in_sizes, int n_in, void* d_out, int out_size, void* d_ws, size_t ws_size, hipStream_t stream) {
    static int grid = 0;
    if (grid == 0) {
        if (n_in != 25 || in_sizes[0] != M * DM || out_size != M * DM || ws_size < WS_END) { fprintf(stderr, "kernel_launch: unexpected shapes (n_in %d in0 %d out %d ws %zu need %zu); nothing launched\n", n_in, n_in > 0 ? in_sizes[0] : -1, out_size, ws_size, (size_t)WS_END); grid = -1; return; }
        int dev = 0, cus = 0, per_cu = 0;
        if (hipGetDevice(&dev) != hipSuccess || hipDeviceGetAttribute(&cus, hipDeviceAttributeMultiprocessorCount, dev) != hipSuccess) { grid = -1; return; }
        if (hipFuncSetAttribute((const void*)hybrid_fwd, hipFuncAttributeMaxDynamicSharedMemorySize, LDS_BYTES) != hipSuccess) { fprintf(stderr, "kernel_launch: hipFuncSetAttribute failed\n"); grid = -1; return; }
        if (hipOccupancyMaxActiveBlocksPerMultiprocessor(&per_cu, (const void*)hybrid_fwd, NTHR, LDS_BYTES) != hipSuccess || per_cu < 1) fprintf(stderr, "kernel_launch: occupancy query reports %d\n", per_cu);
        (void)hipGetLastError();
        grid = cus;
    }
    if (grid < 0) return;
    if (hipMemsetAsync((char*)d_ws + WS_CTL, 0, CTL_ZERO_BYTES, stream) != hipSuccess) return;
    Args a{};
    for (int i = 0; i < 25; ++i) a.in[i] = (const float*)d_in[i];
    a.out = (float*)d_out; a.ws = (unsigned char*)d_ws;
#if ONE_LAUNCH
    a.ph_lo = 0; a.ph_hi = NPHASE;
    hipLaunchKernelGGL(hybrid_fwd, dim3(grid), dim3(NTHR), LDS_BYTES, stream, a);
#else
    for (int p = 0; p < NPHASE; ++p) { a.ph_lo = p; a.ph_hi = p + 1; hipLaunchKernelGGL(hybrid_fwd, dim3(grid), dim3(NTHR), LDS_BYTES, stream, a); }
#endif
}
```

```cpp
#include <hip/hip_runtime.h>
#include <cstdio>
#include <cstdint>

#ifndef ONE_LAUNCH
#define ONE_LAUNCH 1
#endif

#define LAS __attribute__((address_space(3)))
#define GAS __attribute__((address_space(1)))
typedef unsigned short bf16_t;
typedef short bf16x8 __attribute__((ext_vector_type(8)));
typedef float f32x4 __attribute__((ext_vector_type(4)));
typedef float f32x2 __attribute__((ext_vector_type(2)));
typedef float f32x16 __attribute__((ext_vector_type(16)));
typedef unsigned u32x4 __attribute__((ext_vector_type(4)));
typedef unsigned u32x2 __attribute__((ext_vector_type(2)));
typedef __bf16 bf16x2_t __attribute__((ext_vector_type(2)));
typedef short v4i16_t __attribute__((ext_vector_type(4)));

constexpr int DM = 1024, NB = 32, SEQ = 2048, NMETA = 16;
constexpr int M = NB * SEQ;
constexpr int METAROW = M;
constexpr int MTOT = M + 256;
constexpr int NPOS = SEQ + NMETA;
constexpr int DIN_P = 4864;
constexpr int CQKV_LD = 768, CQ_OFF = 384, KR_OFF = 256;
constexpr int QLD = 1536;
constexpr int NEXP = 16384;
constexpr float EPS = 1e-6f;
constexpr float LOG2E = 1.4426950408889634f;
constexpr float QSCALE = 0.10206207261596577f * 1.4426950408889634f;

constexpr size_t A1 = (size_t)MTOT * 1024 * 2;
constexpr size_t WS_CTL = 0, CTL_ZERO_BYTES = 65536;
constexpr size_t WS_WIN = 1u << 20;
constexpr size_t WS_WGATE = WS_WIN + (size_t)DIN_P * 1024 * 2;
constexpr size_t WS_WUQ = WS_WGATE + 2048 * 128 * 2;
constexpr size_t WS_WUKV = WS_WUQ + 1536 * 384 * 2;
constexpr size_t WS_WRNN = WS_WUKV + 2048 * 256 * 2;
constexpr size_t WS_WATT = WS_WRNN + 1024 * 1024 * 2;
constexpr size_t WS_WOUT = WS_WATT + 1024 * 1024 * 2;
constexpr size_t WS_WPQ = WS_WOUT + 1024 * 1024 * 2;
constexpr size_t WS_KEYS = WS_WPQ + 2048 * 1024 * 2;
constexpr size_t WS_PU = WS_KEYS + 256 * 256 * 2;
constexpr size_t WS_PV = WS_PU + (size_t)NEXP * 1024;
constexpr size_t WS_SU = WS_PV + (size_t)NEXP * 1024;
constexpr size_t WS_SV = WS_SU + (size_t)NEXP * 4;
constexpr size_t WS_CTAB = WS_SV + (size_t)NEXP * 4;
constexpr size_t WS_STAB = WS_CTAB + NPOS * 16 * 4;
constexpr size_t WS_CLAM = WS_STAB + NPOS * 16 * 4;
constexpr size_t WS_RSQ = WS_CLAM + 4096;
constexpr size_t WS_RSKV = WS_RSQ + (size_t)MTOT * 4;
constexpr size_t WS_KROPE = WS_RSKV + (size_t)MTOT * 4;
constexpr size_t WS_SCP = WS_KROPE + (size_t)MTOT * 32 * 2;
constexpr size_t WS_SCH = WS_SCP + 512 * 1024 * 4;
constexpr size_t WS_CARRY0 = WS_SCH + 512 * 1024 * 4;
constexpr size_t WS_SLOTS = ((WS_CARRY0 + 4096 + 4095) / 4096) * 4096;
constexpr size_t WS_END = WS_SLOTS + 7 * A1;
#define SLOT(i) (WS_SLOTS + (size_t)(i) * A1)

#define LDS_WAIT() asm volatile("s_waitcnt lgkmcnt(0)" ::: "memory")
#define VM_WAIT() asm volatile("s_waitcnt vmcnt(0)" ::: "memory")
__device__ __forceinline__ unsigned pk2(float lo, float hi) { f32x2 v = {lo, hi}; bf16x2_t b = __builtin_convertvector(v, bf16x2_t); return __builtin_bit_cast(unsigned, b); }
__device__ __forceinline__ float bf_lo(unsigned w) { return __uint_as_float(w << 16); }
__device__ __forceinline__ float bf_hi(unsigned w) { return __uint_as_float(w & 0xffff0000u); }
__device__ __forceinline__ float bf2f(bf16_t h) { return __uint_as_float((unsigned)h << 16); }
__device__ __forceinline__ float ex2(float x) { return __builtin_amdgcn_exp2f(x); }
__device__ __forceinline__ float rcpf_(float x) { return __builtin_amdgcn_rcpf(x); }
__device__ __forceinline__ float sigm(float v) { return rcpf_(1.f + ex2(-LOG2E * v)); }
__device__ __forceinline__ float gelu_t(float v) { const float y = v * (1.f + 0.044715f * v * v); return v * rcpf_(1.f + ex2(-2.302208198f * y)); }
__device__ __forceinline__ float wave_sum(float v) {
#pragma unroll
    for (int o = 1; o < 64; o <<= 1) v += __shfl_xor(v, o);
    return v;
}
__device__ __forceinline__ void unpack8(u32x4 w, float (&o)[8]) { o[0] = bf_lo(w.x); o[1] = bf_hi(w.x); o[2] = bf_lo(w.y); o[3] = bf_hi(w.y); o[4] = bf_lo(w.z); o[5] = bf_hi(w.z); o[6] = bf_lo(w.w); o[7] = bf_hi(w.w); }
__device__ __forceinline__ u32x4 pack8(const float (&o)[8]) { u32x4 w; w.x = pk2(o[0], o[1]); w.y = pk2(o[2], o[3]); w.z = pk2(o[4], o[5]); w.w = pk2(o[6], o[7]); return w; }
__device__ __forceinline__ float dot2bf(unsigned a, unsigned b, float acc) { return __builtin_amdgcn_fdot2_f32_bf16(__builtin_bit_cast(bf16x2_t, a), __builtin_bit_cast(bf16x2_t, b), acc, false); }

typedef float f32x32 __attribute__((ext_vector_type(32)));
typedef unsigned u32x6 __attribute__((ext_vector_type(6)));
__device__ __forceinline__ float fp6_probe_val(int i) { return i < 8 ? 0.125f * i : i < 16 ? 1.f + 0.125f * (i - 8) : i < 24 ? 2.f + 0.25f * (i - 16) : 4.f + 0.5f * (i - 24); }
__device__ __forceinline__ void fp6_sigma(int (&sig)[32]) {
    f32x16 lo, hi;
#pragma unroll
    for (int i = 0; i < 16; ++i) { lo[i] = fp6_probe_val(i); hi[i] = fp6_probe_val(16 + i); }
    asm volatile("" : "+v"(lo), "+v"(hi));
    const u32x6 p = __builtin_amdgcn_cvt_scalef32_2xpk16_fp6_f32(lo, hi, 1.0f);
    const f32x32 r = __builtin_amdgcn_cvt_scalef32_pk32_f32_fp6(p, 1.0f);
#pragma unroll
    for (int j = 0; j < 32; ++j) { const float v = r[j]; const float idx = v < 1.f ? v * 8.f : v < 2.f ? 8.f + (v - 1.f) * 8.f : v < 4.f ? 16.f + (v - 2.f) * 4.f : 24.f + (v - 4.f) * 2.f;
        sig[j] = __builtin_amdgcn_readfirstlane((int)(idx + 0.5f)) & 31; }
}

namespace pg8 {
constexpr int BM = 256, BK = 64, HALF = 128, HTB = HALF * BK * 2, STAGE_BYTES = 8 * HTB, NXCD = 8, WGM = 8;
__host__ __device__ __forceinline__ int lds_byte(int r, int c) { const int st = (r >> 4) * 2 + (c >> 5), rr = r & 15, cc = c & 31, ob = rr * 64 + cc * 2; return st * 1024 + (ob ^ (((ob >> 9) & 1) << 5)); }
__host__ __device__ __forceinline__ void stage_rc(int b, int& R, int& C) { const int st = b / 1024, sb = b % 1024, swz = sb ^ (((sb >> 9) & 1) << 5); R = (st >> 1) * 16 + swz / 64; C = (st & 1) * 32 + (swz % 64) / 2; }
__host__ __device__ __forceinline__ int perm32(int rho) { const int n = rho >> 4, i = rho & 15; return 8 * (i >> 2) + 4 * n + (i & 3); }

struct Unit { int pm, pn; };
struct Gemm { const bf16_t* A; const bf16_t* Bt; int lda, ldb, K, a_pn_off, b_pn_stride; };

struct Sched {
    int nM, nN, nwg, G, c, xpm, xn, xskip;
    __device__ __forceinline__ void init(int nM_, int nN_, int G_, int c_, int xpm_, int xn_, int xskip_) { nM = nM_; nN = nN_; nwg = nM_ * nN_; G = G_; c = c_; xpm = xpm_; xn = xn_; xskip = xskip_; }
    __device__ __forceinline__ bool next(int i, Unit& u) const {
        const int nmain = nwg > c ? (nwg - c - 1) / G + 1 : 0;
        if (i < nmain) {
            int wgid = i * G + c; { const int q = nwg / NXCD, r = nwg % NXCD, xcd = wgid % NXCD, off = wgid / NXCD; wgid = (xcd < r ? xcd * (q + 1) : r * (q + 1) + (xcd - r) * q) + off; }
            const int nig = WGM * nN, gid = wgid / nig, fm = gid * WGM, gsz = (nM - fm) < WGM ? (nM - fm) : WGM;
            u.pm = fm + ((wgid % nig) % gsz); u.pn = (wgid % nig) / gsz; return true;
        }
        const int e = G - 1 - c;
        if (i == nmain && e < xn) { u.pm = xpm; u.pn = e + (e >= 4 ? xskip : 0); return true; }
        return false;
    }
};

template <class F> struct Epi8 {
    static constexpr bool PERM = true;
    F f;
    __device__ __forceinline__ void operator()(const f32x4 (&acc)[2][2][4][2], const Unit& u, int wr, int wc, int fr, int fq) const {
        const int row0 = u.pm * BM + wr * 64 + fr, col0 = u.pn * BM + wc * 32 + 8 * fq;
#pragma unroll
        for (int ai = 0; ai < 2; ++ai) {
            typename F::Pre pre[4][2];
#pragma unroll
            for (int m = 0; m < 4; ++m)
#pragma unroll
                for (int bj = 0; bj < 2; ++bj) pre[m][bj] = f.load(u.pn, row0 + ai * HALF + m * 16, col0 + bj * HALF);
#pragma unroll
            for (int m = 0; m < 4; ++m)
#pragma unroll
                for (int bj = 0; bj < 2; ++bj) f.apply(pre[m][bj], u.pn, row0 + ai * HALF + m * 16, col0 + bj * HALF, acc[ai][bj][m][0], acc[ai][bj][m][1]);
        }
    }
};
template <class F> struct EpiPair {
    static constexpr bool PERM = true;
    F f;
    __device__ __forceinline__ void operator()(const f32x4 (&acc)[2][2][4][2], const Unit& u, int wr, int wc, int fr, int fq) const {
        const int row0 = u.pm * BM + wr * 64 + fr, col0 = wc * 32 + 8 * fq;
#pragma unroll
        for (int ai = 0; ai < 2; ++ai) {
            typename F::Pre pre[4];
#pragma unroll
            for (int m = 0; m < 4; ++m) pre[m] = f.load(u.pn, row0 + ai * HALF + m * 16, col0);
#pragma unroll
            for (int m = 0; m < 4; ++m) f.apply(pre[m], u.pn, row0 + ai * HALF + m * 16, col0, acc[ai][0][m][0], acc[ai][0][m][1], acc[ai][1][m][0], acc[ai][1][m][1]);
        }
    }
};

template <class Epi>
__device__ __forceinline__ void gemm_phase(LAS unsigned char* lds, const Gemm g, const Sched& S, const Epi& E) {
    int tid_ = threadIdx.x; asm volatile("" : "+v"(tid_));
    const int tid = tid_, wid = __builtin_amdgcn_readfirstlane(tid >> 6), lane = tid & 63, wr = wid >> 2, wc = wid & 3, fr = lane & 15, fq = lane >> 4;
    int nt_ = g.K / BK; asm volatile("" : "+s"(nt_));
    const int nt = nt_;
    unsigned voffA[2], voffB[2];
#pragma unroll
    for (int i = 0; i < 2; ++i) { int R, C; stage_rc(tid * 16 + i * 8192, R, C); const int Rb = Epi::PERM ? ((R & ~31) + perm32(R & 31)) : R;
        voffA[i] = (unsigned)(R * g.lda + C) * 2u; voffB[i] = (unsigned)(Rb * g.ldb + C) * 2u; }
    const size_t kstep = (size_t)(BK * 2);
    const size_t hA = (size_t)HALF * g.lda * 2, hB = (size_t)HALF * g.ldb * 2;
    const unsigned ldsw = (unsigned)wid * 1024u;
    const int aoff = lds_byte(wr * 64 + fr, fq * 8), boff = lds_byte(wc * 32 + fr, fq * 8);
#define PG8_SA(b, h) (((b) * 2 + (h)) * HTB)
#define PG8_SB(b, h) ((4 + (b) * 2 + (h)) * HTB)
#define PG8_STAGE(bufoff, gbase, voff) do { _Pragma("unroll") for (int _i = 0; _i < 2; ++_i) \
        __builtin_amdgcn_global_load_lds((const unsigned*)((const char*)(gbase) + (voff)[_i]), (LAS unsigned*)(lds + (bufoff) + ldsw + _i * 8192), 16, 0, 0); } while (0)
#define PG8_LDA(dst, b, h) do { _Pragma("unroll") for (int m = 0; m < 4; ++m) _Pragma("unroll") for (int k = 0; k < 2; ++k) dst[m][k] = *(const LAS bf16x8*)(lds + PG8_SA(b, h) + aoff + m * 2048 + k * 1024); } while (0)
#define PG8_LDB(dst, b, h) do { _Pragma("unroll") for (int n = 0; n < 2; ++n) _Pragma("unroll") for (int k = 0; k < 2; ++k) dst[n][k] = *(const LAS bf16x8*)(lds + PG8_SB(b, h) + boff + n * 2048 + k * 1024); } while (0)
#define PG8_MMA(ai, bj, At, Bt) do { __builtin_amdgcn_s_setprio(1); _Pragma("unroll") for (int m = 0; m < 4; ++m) _Pragma("unroll") for (int n = 0; n < 2; ++n) _Pragma("unroll") for (int k = 0; k < 2; ++k) \
        acc[ai][bj][m][n] = __builtin_amdgcn_mfma_f32_16x16x32_bf16(Bt[n][k], At[m][k], acc[ai][bj][m][n], 0, 0, 0); __builtin_amdgcn_s_setprio(0); } while (0)
#define PG8_WAIT_V(n) asm volatile("s_waitcnt vmcnt(" #n ")" ::: "memory")
#define PG8_WAIT_L(n) asm volatile("s_waitcnt lgkmcnt(" #n ")" ::: "memory")
#define PG8_BAR __builtin_amdgcn_s_barrier()
#define PG8_SCHED __builtin_amdgcn_sched_barrier(0)
#define PG8_ABASE(u) ((const char*)g.A + ((size_t)(u).pm * BM * g.lda + (size_t)(u).pn * g.a_pn_off) * 2)
#define PG8_BBASE(u) ((const char*)g.Bt + (size_t)(u).pn * g.b_pn_stride * 2)
    Unit cur, nxt; int ui = 0;
    if (!S.next(0, cur)) return;
    f32x4 acc[2][2][4][2];
#pragma unroll
    for (int a = 0; a < 2; ++a)
#pragma unroll
        for (int b = 0; b < 2; ++b)
#pragma unroll
            for (int m = 0; m < 4; ++m)
#pragma unroll
                for (int n = 0; n < 2; ++n) acc[a][b][m][n] = (f32x4){0.f, 0.f, 0.f, 0.f};
    bf16x8 At[4][2], B0[2][2], B1[2][2];
    const char* cA = PG8_ABASE(cur); const char* cB = PG8_BBASE(cur);
    PG8_STAGE(PG8_SB(0, 0), cB, voffB); PG8_STAGE(PG8_SB(0, 1), cB + hB, voffB); PG8_STAGE(PG8_SA(0, 0), cA, voffA); PG8_STAGE(PG8_SA(0, 1), cA + hA, voffA);
    if (wr == 1) PG8_BAR;
    PG8_WAIT_V(2); PG8_BAR;
    PG8_STAGE(PG8_SB(1, 0), cB + kstep, voffB); PG8_STAGE(PG8_SA(1, 0), cA + kstep, voffA); PG8_STAGE(PG8_SB(1, 1), cB + hB + kstep, voffB);
    PG8_WAIT_V(6); PG8_BAR;
    for (;;) {
        const bool has_next = S.next(ui + 1, nxt);
        const char* nA = has_next ? PG8_ABASE(nxt) : cA; const char* nB = has_next ? PG8_BBASE(nxt) : cB;
        asm volatile("" : "+s"(cA), "+s"(cB), "+s"(nA), "+s"(nB));
#pragma unroll 1
        for (int t = 0; t < nt; t += 2) {
            const bool last = (t == nt - 2);
            const char* a1 = cA + (size_t)(t + 1) * kstep;
            const char* a2 = last ? nA : cA + (size_t)(t + 2) * kstep; const char* b2 = last ? nB : cB + (size_t)(t + 2) * kstep;
            const char* a3 = a2 + kstep; const char* b3 = b2 + kstep;
            PG8_LDB(B0, 0, 0); PG8_LDB(B1, 0, 1); PG8_SCHED; PG8_LDA(At, 0, 0); PG8_STAGE(PG8_SA(1, 1), a1 + hA, voffA);
            PG8_WAIT_V(8); PG8_WAIT_L(0); PG8_BAR; PG8_MMA(0, 0, At, B0); PG8_MMA(0, 1, At, B1); PG8_BAR; PG8_SCHED;
            PG8_LDA(At, 0, 1); PG8_STAGE(PG8_SB(0, 0), b2, voffB); PG8_STAGE(PG8_SB(0, 1), b2 + hB, voffB); PG8_STAGE(PG8_SA(0, 0), a2, voffA);
            PG8_WAIT_V(8); PG8_WAIT_L(0); PG8_BAR; PG8_MMA(1, 0, At, B0); PG8_MMA(1, 1, At, B1); PG8_BAR; PG8_SCHED;
            PG8_LDB(B0, 1, 0); PG8_LDB(B1, 1, 1); PG8_SCHED; PG8_LDA(At, 1, 0); PG8_STAGE(PG8_SA(0, 1), a2 + hA, voffA);
            PG8_WAIT_V(8); PG8_WAIT_L(0); PG8_BAR; PG8_MMA(0, 0, At, B0); PG8_MMA(0, 1, At, B1); PG8_BAR; PG8_SCHED;
            PG8_LDA(At, 1, 1); PG8_STAGE(PG8_SB(1, 0), b3, voffB); PG8_STAGE(PG8_SB(1, 1), b3 + hB, voffB); PG8_STAGE(PG8_SA(1, 0), a3, voffA);
            PG8_WAIT_V(8); PG8_WAIT_L(0); PG8_BAR; PG8_MMA(1, 0, At, B0); PG8_MMA(1, 1, At, B1); PG8_BAR; PG8_SCHED;
        }
        if (wr == 0) PG8_BAR;
        E(acc, cur, wr, wc, fr, fq);
        if (!has_next) break;
#pragma unroll
        for (int a = 0; a < 2; ++a)
#pragma unroll
            for (int b = 0; b < 2; ++b)
#pragma unroll
                for (int m = 0; m < 4; ++m)
#pragma unroll
                    for (int n = 0; n < 2; ++n) acc[a][b][m][n] = (f32x4){0.f, 0.f, 0.f, 0.f};
        cur = nxt; cA = nA; cB = nB; ++ui;
        if (wr == 1) PG8_BAR;
    }
    PG8_WAIT_V(0);
    PG8_BAR;
#undef PG8_SA
#undef PG8_SB
#undef PG8_STAGE
#undef PG8_LDA
#undef PG8_LDB
#undef PG8_MMA
#undef PG8_WAIT_V
#undef PG8_WAIT_L
#undef PG8_BAR
#undef PG8_SCHED
#undef PG8_ABASE
#undef PG8_BBASE
}
}

#define XB_TMO      128
#define XB_XCNT(j)  (256  + 64 * (j))
#define XB_XSUB(j)  (1280 + 64 * (j))
#define XB_XGEN(j)  (2304 + 64 * (j))
#define XB_TOP      3328
#define XB_TOPGEN   3392
#define XCD_BAR_WORDS 3456
#define XB_SPIN_CAP (1u << 18)
__device__ __forceinline__ unsigned xb_ld(unsigned* p)              { return __hip_atomic_load(p, __ATOMIC_RELAXED, __HIP_MEMORY_SCOPE_AGENT); }
__device__ __forceinline__ unsigned xb_add(unsigned* p, unsigned v) { return __hip_atomic_fetch_add(p, v, __ATOMIC_RELAXED, __HIP_MEMORY_SCOPE_AGENT); }
__device__ __forceinline__ unsigned xb_xcc_id() { return (unsigned)__builtin_amdgcn_s_getreg((3 << 11) | 20) & 0xFu; }
#define XB_SPIN(cond, bar) do { unsigned _sp = 0; while (cond) { __builtin_amdgcn_s_sleep(1); \
    if ((++_sp & 255u) == 0u) { if (xb_ld(&(bar)[XB_TMO])) break; if (_sp > XB_SPIN_CAP) { atomicAdd(&(bar)[XB_TMO], 1u); break; } } } } while (0)
struct XcdBarrier { unsigned* bar; unsigned x; volatile LAS unsigned* st; };
__device__ __forceinline__ XcdBarrier xcd_barrier_post(unsigned* bar, volatile LAS unsigned* st) {
    XcdBarrier b; b.bar = bar; b.x = xb_xcc_id(); b.st = st;
    if (threadIdx.x == 0) (void)xb_add(&bar[XB_XCNT(b.x)], 1u);
    return b;
}
__device__ __forceinline__ void xcd_barrier_complete(unsigned* bar, unsigned x, unsigned& nloc, unsigned& nx) {
    const unsigned G = gridDim.x * gridDim.y * gridDim.z;
    unsigned sum, cnt, mine, sp = 0u;
    for (;;) {
        sum = 0u; cnt = 0u; mine = 0u;
#pragma unroll
        for (unsigned j = 0; j < 16; ++j) { const unsigned c = xb_ld(&bar[XB_XCNT(j)]); sum += c; cnt += (c > 0u) ? 1u : 0u; mine = (j == x) ? c : mine; }
        if (sum == G) break;
        __builtin_amdgcn_s_sleep(1);
        if ((++sp & 255u) == 0u) { if (xb_ld(&bar[XB_TMO])) break; if (sp > XB_SPIN_CAP) { atomicAdd(&bar[XB_TMO], 1u); break; } }
    }
    nloc = mine > 0u ? mine : 1u; nx = cnt > 0u ? cnt : 1u;
}
__device__ __forceinline__ void xcd_barrier(const XcdBarrier& b) {
    asm volatile("s_waitcnt vmcnt(0)" ::: "memory");
    __syncthreads();
    if (threadIdx.x == 0) {
        unsigned* bar = b.bar;
        __builtin_amdgcn_s_waitcnt(0);
        unsigned nloc = b.st[0], nx = b.st[1];
        if (nloc == 0u) { xcd_barrier_complete(bar, b.x, nloc, nx); b.st[0] = nloc; b.st[1] = nx; }
        const unsigned old = xb_add(&bar[XB_XSUB(b.x)], 1u);
        const unsigned gen = old / nloc;
        if (old + 1u == (gen + 1u) * nloc) {
            __builtin_amdgcn_fence(__ATOMIC_RELEASE, "agent");
            asm volatile("s_waitcnt vmcnt(0)" ::: "memory");
            const unsigned og = xb_add(&bar[XB_TOP], 1u);
            const unsigned tg = og / nx;
            if (og + 1u == (tg + 1u) * nx) xb_add(&bar[XB_TOPGEN], 1u);
            else XB_SPIN(xb_ld(&bar[XB_TOPGEN]) == tg, bar);
            __builtin_amdgcn_fence(__ATOMIC_ACQUIRE, "agent");
            xb_add(&bar[XB_XGEN(b.x)], 1u);
            asm volatile("s_waitcnt vmcnt(0)" ::: "memory");
        } else {
            XB_SPIN(xb_ld(&bar[XB_XGEN(b.x)]) == gen, bar);
            __builtin_amdgcn_fence(__ATOMIC_ACQUIRE, "agent");
            asm volatile("s_waitcnt vmcnt(0)" ::: "memory");
        }
    }
    __syncthreads();
}

constexpr int NWAVES = 8, NTHR = 512;
constexpr int RING_BYTES = 131072, MISC_OFF = RING_BYTES + 320, LDS_BYTES = 147456;
struct Args { const float* in[25]; float* out; unsigned char* ws; int ph_lo, ph_hi; };
static_assert(sizeof(Args) == 25 * 8 + 8 + 8 + 8, "Args has no padding");

struct Ctx {
    LAS unsigned char* lds; int tid, lane, wave, G, gw, NGW;
    unsigned char* ws; float* out; const float* const* in;
};

__device__ __forceinline__ void store8(bf16_t* p, f32x4 a, f32x4 b) { u32x4 w; w.x = pk2(a[0], a[1]); w.y = pk2(a[2], a[3]); w.z = pk2(b[0], b[1]); w.w = pk2(b[2], b[3]); *(u32x4*)p = w; }
struct NoPre {};
struct FInproj {
    typedef NoPre Pre;
    bf16_t *XR, *GR, *CQKV, *GRNN, *GATT;
    __device__ __forceinline__ Pre load(int, int, int) const { return Pre(); }
    __device__ __forceinline__ void apply(const Pre&, int pn, int row, int col, f32x4 a, f32x4 b) const {
        if (pn < 4) { store8(XR + (size_t)row * 1024 + col, a, b); }
        else if (pn < 8) {
#pragma unroll
            for (int i = 0; i < 4; ++i) { a[i] = gelu_t(a[i]); b[i] = gelu_t(b[i]); }
            store8(GR + (size_t)row * 1024 + (col - 1024), a, b); }
        else if (pn < 11) { store8(CQKV + (size_t)row * CQKV_LD + (col - 2048), a, b); }
        else {
#pragma unroll
            for (int i = 0; i < 4; ++i) { a[i] = sigm(a[i]); b[i] = sigm(b[i]); }
            if (pn < 15) store8(GRNN + (size_t)row * 1024 + (col - 2816), a, b); else store8(GATT + (size_t)row * 1024 + (col - 3840), a, b); }
    }
};
struct FGate {
    struct Pre { u32x4 xc; };
    const bf16_t* XC; const float *ba, *bx, *clam; bf16_t *LA, *UU;
    __device__ __forceinline__ Pre load(int pn, int row, int cl) const { Pre p; p.xc = *(const u32x4*)(XC + (size_t)row * 1024 + pn * 128 + cl); return p; }
    __device__ __forceinline__ void apply(const Pre& pr, int pn, int row, int cl, f32x4 a0, f32x4 a1, f32x4 x0, f32x4 x1) const {
        const int ch = pn * 128 + cl; const size_t off = (size_t)row * 1024 + ch;
        float xc[8]; unpack8(pr.xc, xc);
        const f32x4 ba0 = *(const f32x4*)(ba + ch), ba1 = *(const f32x4*)(ba + ch + 4), bx0 = *(const f32x4*)(bx + ch), bx1 = *(const f32x4*)(bx + ch + 4), cl0 = *(const f32x4*)(clam + ch), cl1 = *(const f32x4*)(clam + ch + 4);
        float la[8], uu[8];
#pragma unroll
        for (int i = 0; i < 8; ++i) {
            const float ga = (i < 4 ? a0[i & 3] + ba0[i & 3] : a1[i & 3] + ba1[i & 3]), gx = (i < 4 ? x0[i & 3] + bx0[i & 3] : x1[i & 3] + bx1[i & 3]), cc = (i < 4 ? cl0[i & 3] : cl1[i & 3]);
            const float r = sigm(ga), ig = sigm(gx), l = r * cc;
            la[i] = l; uu[i] = sqrtf(fmaxf(1.f - ex2(2.f * LOG2E * l), 0.f)) * (ig * xc[i]);
        }
        *(u32x4*)(LA + off) = pack8(la); *(u32x4*)(UU + off) = pack8(uu);
    }
};
struct FQ {
    struct Pre { float sc; };
    const float* rsq; bf16_t* Q;
    __device__ __forceinline__ Pre load(int, int row, int) const { Pre p; p.sc = rsq[row]; return p; }
    __device__ __forceinline__ void apply(const Pre& pr, int pn, int row, int col, f32x4 a, f32x4 b) const {
        const float sc = pr.sc * QSCALE; a = a * sc; b = b * sc;
        store8(Q + (size_t)row * QLD + col, a, b);
    }
};
struct FKV {
    struct Pre { float sc; };
    const float* rskv; bf16_t *KN, *V;
    __device__ __forceinline__ Pre load(int, int row, int) const { Pre p; p.sc = rskv[row]; return p; }
    __device__ __forceinline__ void apply(const Pre& pr, int pn, int row, int col, f32x4 a, f32x4 b) const {
        const float sc = pr.sc; a = a * sc; b = b * sc;
        if (pn < 4) store8(KN + (size_t)row * 1024 + col, a, b); else store8(V + (size_t)row * 1024 + (col - 1024), a, b);
    }
};
template <bool HAS_ADD> struct FMul {
    struct Pre { u32x4 g, ad; };
    const bf16_t* Gt; const bf16_t* ADD; bf16_t* O;
    __device__ __forceinline__ Pre load(int, int row, int col) const { const size_t off = (size_t)row * 1024 + col; Pre p; p.g = *(const u32x4*)(Gt + off); if (HAS_ADD) p.ad = *(const u32x4*)(ADD + off); else p.ad = (u32x4){0u, 0u, 0u, 0u}; return p; }
    __device__ __forceinline__ void apply(const Pre& pr, int pn, int row, int col, f32x4 a, f32x4 b) const {
        const size_t off = (size_t)row * 1024 + col; float gg[8]; unpack8(pr.g, gg);
        if (HAS_ADD) { float ad[8]; unpack8(pr.ad, ad);
#pragma unroll
            for (int i = 0; i < 4; ++i) { a[i] = ad[i] + gg[i] * a[i]; b[i] = ad[4 + i] + gg[4 + i] * b[i]; } }
        else {
#pragma unroll
            for (int i = 0; i < 4; ++i) { a[i] = gg[i] * a[i]; b[i] = gg[4 + i] * b[i]; } }
        store8(O + off, a, b);
    }
};
struct FRes {
    struct Pre { f32x4 x0, x1; };
    const float* X; bf16_t* H1B;
    __device__ __forceinline__ Pre load(int, int row, int col) const { const size_t off = (size_t)row * 1024 + col; Pre p; p.x0 = *(const f32x4*)(X + off); p.x1 = *(const f32x4*)(X + off + 4); return p; }
    __device__ __forceinline__ void apply(const Pre& pr, int pn, int row, int col, f32x4 a, f32x4 b) const {
        store8(H1B + (size_t)row * 1024 + col, a + pr.x0, b + pr.x1);
    }
};
typedef _Float16 f16x8 __attribute__((ext_vector_type(8)));
struct FF16 { typedef NoPre Pre; _Float16* O; int ldc;
    __device__ __forceinline__ Pre load(int, int, int) const { return Pre(); }
    __device__ __forceinline__ void apply(const Pre&, int pn, int row, int col, f32x4 a, f32x4 b) const {
        f16x8 h = {(_Float16)a[0], (_Float16)a[1], (_Float16)a[2], (_Float16)a[3], (_Float16)b[0], (_Float16)b[1], (_Float16)b[2], (_Float16)b[3]};
        *(f16x8*)(O + (size_t)row * ldc + col) = h; } };
struct FF32 { typedef NoPre Pre; float* O; int ldc;
    __device__ __forceinline__ Pre load(int, int, int) const { return Pre(); }
    __device__ __forceinline__ void apply(const Pre&, int pn, int row, int col, f32x4 a, f32x4 b) const { float* p = O + (size_t)row * ldc + col; *(f32x4*)p = a; *(f32x4*)(p + 4) = b; } };

struct MapId { __device__ __forceinline__ int operator()(int n) const { return n; } };
struct MapWin { __device__ __forceinline__ int operator()(int n) const {
    if (n < 2048) return n;
    if (n < 2816) { const int c = n - 2048; if (c < 256) return 2432 + c; if (c < 288) return 2688 + (c - 256); if (c < 384) return -1; return 2048 + (c - 384); }
    if (n < 3840) return 2720 + (n - 2816);
    return 3744 + (n - 3840); } };
struct MapUq { __device__ __forceinline__ int operator()(int n) const { const int h = n / 96, w = n % 96; if (w < 64) return n; const int t = w - 64; return h * 96 + 64 + (t >> 1) + 16 * (t & 1); } };
struct MapUkv { __device__ __forceinline__ int operator()(int n) const { if (n < 1024) return (n >> 6) * 128 + (n & 63); const int m = n - 1024; return (m >> 6) * 128 + 64 + (m & 63); } };

template <class Map> __device__ __forceinline__ void transpose_item(const float* W, int ldw, int Ndst, bf16_t* WT, int ldt, const float* kscale, LAS float* scr, int item, int lane, Map map) {
    const int nblk = Ndst / 32, kb = item / nblk, nb = item % nblk, k0 = 64 * kb, n0 = 32 * nb;
    const int src = map(n0 + (lane & 31));
#pragma unroll 8
    for (int i = 0; i < 32; ++i) { const int kk = 2 * i + (lane >> 5); float v = 0.f; if (src >= 0) { v = W[(size_t)(k0 + kk) * ldw + src]; if (kscale) v *= kscale[k0 + kk]; } scr[kk * 33 + (lane & 31)] = v; }
    LDS_WAIT(); asm volatile("" ::: "memory");
    const int c = lane & 7;
#pragma unroll
    for (int j = 0; j < 4; ++j) { const int n = (lane >> 3) + 8 * j; const LAS float* s = scr + (8 * c) * 33 + n;
        u32x4 o; o.x = pk2(s[0 * 33], s[1 * 33]); o.y = pk2(s[2 * 33], s[3 * 33]); o.z = pk2(s[4 * 33], s[5 * 33]); o.w = pk2(s[6 * 33], s[7 * 33]);
        *(u32x4*)(WT + (size_t)(n0 + n) * ldt + k0 + 8 * c) = o; }
    LDS_WAIT(); asm volatile("" ::: "memory");
}
__device__ __forceinline__ void rms_row_bf16(const float* xrow, const float* g, bf16_t* orow, int lane) {
    const f32x4* xr = (const f32x4*)xrow + lane; f32x4 v[4]; float s = 0.f;
#pragma unroll
    for (int j = 0; j < 4; ++j) { v[j] = xr[64 * j]; s += (v[j][0] * v[j][0] + v[j][1] * v[j][1]) + (v[j][2] * v[j][2] + v[j][3] * v[j][3]); }
    const float rstd = 1.f / sqrtf(wave_sum(s) * (1.f / 1024.f) + EPS);
    u32x2* o8 = (u32x2*)orow + lane;
#pragma unroll
    for (int j = 0; j < 4; ++j) { const f32x4 gg = ((const f32x4*)g)[lane + 64 * j]; u32x2 w; w.x = pk2(v[j][0] * rstd * gg[0], v[j][1] * rstd * gg[1]); w.y = pk2(v[j][2] * rstd * gg[2], v[j][3] * rstd * gg[3]); o8[64 * j] = w; }
}
__device__ __forceinline__ void rms_row_f32(const float* xrow, const float* g, float* orow, int lane) {
    const f32x4* xr = (const f32x4*)xrow + lane; f32x4 v[4]; float s = 0.f;
#pragma unroll
    for (int j = 0; j < 4; ++j) { v[j] = xr[64 * j]; s += (v[j][0] * v[j][0] + v[j][1] * v[j][1]) + (v[j][2] * v[j][2] + v[j][3] * v[j][3]); }
    const float rstd = 1.f / sqrtf(wave_sum(s) * (1.f / 1024.f) + EPS);
#pragma unroll
    for (int j = 0; j < 4; ++j) { const f32x4 gg = ((const f32x4*)g)[lane + 64 * j]; ((f32x4*)orow)[lane + 64 * j] = v[j] * rstd * gg; }
}

__device__ __forceinline__ void phase_prologue(const Ctx& C) {
    unsigned char* ws = C.ws; const float* const* in = C.in;
    LAS float* scr = (LAS float*)(C.lds + C.wave * 16384);
    const int gw = C.gw, NGW = C.NGW, lane = C.lane;
    constexpr int I_WIN = 16 * (DIN_P / 32), I_UQ = 6 * (1536 / 32), I_UKV = 4 * (2048 / 32), I_SQ = 16 * 32, I_G = 2 * 4;
    constexpr int NITEMS = I_WIN + I_UQ + I_UKV + 3 * I_SQ + 16 * I_G;
    for (int it = gw; it < NITEMS; it += NGW) {
        int r = it;
        if (r < I_WIN) { transpose_item(in[3], 4768, DIN_P, (bf16_t*)(ws + WS_WIN), 1024, nullptr, scr, r, lane, MapWin()); continue; } r -= I_WIN;
        if (r < I_UQ) { transpose_item(in[13], 1536, 1536, (bf16_t*)(ws + WS_WUQ), 384, in[12], scr, r, lane, MapUq()); continue; } r -= I_UQ;
        if (r < I_UKV) { transpose_item(in[15], 2048, 2048, (bf16_t*)(ws + WS_WUKV), 256, in[14], scr, r, lane, MapUkv()); continue; } r -= I_UKV;
        if (r < I_SQ) { transpose_item(in[11], 1024, 1024, (bf16_t*)(ws + WS_WRNN), 1024, nullptr, scr, r, lane, MapId()); continue; } r -= I_SQ;
        if (r < I_SQ) { transpose_item(in[16], 1024, 1024, (bf16_t*)(ws + WS_WATT), 1024, nullptr, scr, r, lane, MapId()); continue; } r -= I_SQ;
        if (r < I_SQ) { transpose_item(in[17], 1024, 1024, (bf16_t*)(ws + WS_WOUT), 1024, nullptr, scr, r, lane, MapId()); continue; } r -= I_SQ;
        { const int mat = r / I_G, sub = r % I_G, blk = mat >> 1, which = mat & 1;
          transpose_item((which ? in[8] : in[6]) + (size_t)blk * 16384, 128, 128, (bf16_t*)(ws + WS_WGATE) + (size_t)(blk * 256 + which * 128) * 128, 128, nullptr, scr, sub, lane, MapId()); }
    }
    const int gt = blockIdx.x * NTHR + C.tid, NT = C.G * NTHR;
    for (int it = blockIdx.x; it < 256; it += C.G) {
        const int hh = it >> 4, kc = it & 15, half = hh & 1, k = kc * 64 + lane, c0 = 16 * C.wave;
        const f32x4* keys = (const f32x4*)((half ? in[21] : in[20]) + (size_t)c0 * 128);
        LAS f32x4* ks = (LAS f32x4*)scr;
#pragma unroll
        for (int j = 0; j < 8; ++j) ks[j * 64 + lane] = keys[j * 64 + lane];
        const f32x4* wq = (const f32x4*)(in[19] + (size_t)k * 2048 + hh * 128); const float g2k = in[18][k];
        f32x4 a[32];
#pragma unroll
        for (int d4 = 0; d4 < 32; ++d4) a[d4] = wq[d4];
        LDS_WAIT(); asm volatile("" ::: "memory");
        bf16_t* o = (bf16_t*)(ws + WS_WPQ) + (size_t)(hh * 128 + c0) * 1024 + k;
#pragma unroll 4
        for (int c = 0; c < 16; ++c) { float s0 = 0.f, s1 = 0.f;
#pragma unroll
            for (int d4 = 0; d4 < 32; d4 += 2) { const f32x4 k0 = ks[c * 32 + d4], k1 = ks[c * 32 + d4 + 1]; s0 += (a[d4][0] * k0[0] + a[d4][1] * k0[1]) + (a[d4][2] * k0[2] + a[d4][3] * k0[3]); s1 += (a[d4 + 1][0] * k1[0] + a[d4 + 1][1] * k1[1]) + (a[d4 + 1][2] * k1[2] + a[d4 + 1][3] * k1[3]); }
            o[(size_t)c * 1024] = (bf16_t)(pk2((s0 + s1) * g2k, 0.f) & 0xffffu); }
        LDS_WAIT(); asm volatile("" ::: "memory");
    }
    for (int i = gt; i < NPOS * 16; i += NT) { const int pos = i >> 4, j = i & 15; const float inv = exp2f(-(float)j * (13.287712379549449f / 16.f)); const float ang = (float)pos * inv;
        float t = ang * 0.15915494309189535f; t = t - floorf(t);
        ((float*)(ws + WS_CTAB))[i] = __builtin_amdgcn_cosf(t); ((float*)(ws + WS_STAB))[i] = __builtin_amdgcn_sinf(t); }
    for (int i = gt; i < 1024; i += NT) { const float lam = in[10][i]; ((float*)(ws + WS_CLAM))[i] = -8.f * log1pf(expf(-lam)); }
    f32x4 tnv[4];
    if (gw < NEXP) { const int tb0 = 0, e0 = gw;
#pragma unroll
        for (int j = 0; j < 4; ++j) tnv[j] = ((const f32x4*)((tb0 ? in[23] : in[22]) + (size_t)e0 * 1024 + 16 * lane))[j]; }
    for (int row = gw; row < NEXP; row += NGW) {
        const int tbl = 0, e = row;
        f32x4 v[4]; float am = 0.f;
#pragma unroll
        for (int j = 0; j < 4; ++j) { v[j] = tnv[j]; am = fmaxf(am, fmaxf(fmaxf(fabsf(v[j][0]), fabsf(v[j][1])), fmaxf(fabsf(v[j][2]), fabsf(v[j][3])))); }
        if (row + NGW < NEXP) { const int tb1 = 0, e1 = row + NGW;
#pragma unroll
            for (int j = 0; j < 4; ++j) tnv[j] = ((const f32x4*)((tb1 ? in[23] : in[22]) + (size_t)e1 * 1024 + 16 * lane))[j]; }
#pragma unroll
        for (int o = 1; o < 64; o <<= 1) am = fmaxf(am, __shfl_xor(am, o));
        const float scale = am > 0.f ? am * (1.f / 224.f) : 1.f, inv = 1.f / scale;
        u32x4 w;
#pragma unroll
        for (int j = 0; j < 4; ++j) { int p = __builtin_amdgcn_cvt_pk_fp8_f32(v[j][0] * inv, v[j][1] * inv, 0, false); p = __builtin_amdgcn_cvt_pk_fp8_f32(v[j][2] * inv, v[j][3] * inv, p, true); w[j] = (unsigned)p; }
        *(u32x4*)(ws + (tbl ? WS_PV : WS_PU) + (size_t)e * 1024 + 16 * lane) = w;
        if (lane == 0) ((float*)(ws + (tbl ? WS_SV : WS_SU)))[e] = scale;
    }
    for (int pr = gw; pr < NEXP / 2; pr += NGW) {
        const int e = 2 * pr + (lane >> 5), ll = lane & 31;
        const f32x4* src = (const f32x4*)(in[23] + (size_t)e * 1024 + 32 * ll);
        f32x4 v[8]; float am = 0.f;
#pragma unroll
        for (int j = 0; j < 8; ++j) { v[j] = src[j]; am = fmaxf(am, fmaxf(fmaxf(fabsf(v[j][0]), fabsf(v[j][1])), fmaxf(fabsf(v[j][2]), fabsf(v[j][3])))); }
#pragma unroll
        for (int o = 1; o < 32; o <<= 1) am = fmaxf(am, __shfl_xor(am, o));
        const float scale = am > 0.f ? am * (1.f / 7.5f) : 1.f, inv = 1.f / scale;
        f32x16 lo, hi;
#pragma unroll
        for (int i = 0; i < 16; ++i) { lo[i] = v[i >> 2][i & 3] * inv; hi[i] = v[4 + (i >> 2)][i & 3] * inv; }
        const u32x6 p = __builtin_amdgcn_cvt_scalef32_2xpk16_fp6_f32(lo, hi, 1.0f);
        unsigned char* rp = ws + WS_PV + (size_t)e * 768;
        *(u32x4*)(rp + 16 * ll) = (u32x4){p[0], p[1], p[2], p[3]}; *(u32x2*)(rp + 512 + 8 * ll) = (u32x2){p[4], p[5]};
        if (ll == 0) ((float*)(ws + WS_SV))[e] = scale;
    }
    bf16_t* N1 = (bf16_t*)(ws + SLOT(0));
    {
        f32x4 gg[4];
#pragma unroll
        for (int j = 0; j < 4; ++j) gg[j] = ((const f32x4*)in[2])[lane + 64 * j];
        int m = gw; f32x4 nv[4];
        if (m < M) {
#pragma unroll
            for (int j = 0; j < 4; ++j) nv[j] = ((const f32x4*)(in[0] + (size_t)m * 1024))[lane + 64 * j]; }
        for (; m < M; m += NGW) {
            f32x4 v[4]; float sq = 0.f;
#pragma unroll
            for (int j = 0; j < 4; ++j) { v[j] = nv[j]; sq += (v[j][0] * v[j][0] + v[j][1] * v[j][1]) + (v[j][2] * v[j][2] + v[j][3] * v[j][3]); }
            if (m + NGW < M) {
#pragma unroll
                for (int j = 0; j < 4; ++j) nv[j] = ((const f32x4*)(in[0] + (size_t)(m + NGW) * 1024))[lane + 64 * j]; }
            const float rstd = 1.f / sqrtf(wave_sum(sq) * (1.f / 1024.f) + EPS);
            u32x2* o8 = (u32x2*)(N1 + (size_t)m * 1024) + lane;
#pragma unroll
            for (int j = 0; j < 4; ++j) { u32x2 w; w.x = pk2(v[j][0] * rstd * gg[j][0], v[j][1] * rstd * gg[j][1]); w.y = pk2(v[j][2] * rstd * gg[j][2], v[j][3] * rstd * gg[j][3]); o8[64 * j] = w; }
        }
    }
    for (int m = gw; m < 256; m += NGW) {
        if (m < NMETA) rms_row_bf16(in[1] + (size_t)m * 1024, in[2], N1 + (size_t)(METAROW + m) * 1024, lane);
        else { u32x4* o = (u32x4*)(N1 + (size_t)(METAROW + m) * 1024); o[lane] = (u32x4){0u, 0u, 0u, 0u}; o[64 + lane] = (u32x4){0u, 0u, 0u, 0u}; }
    }
}

__device__ __forceinline__ int prev_row(int r, int j) {
    if (r < M) { const int s = r & (SEQ - 1); return s >= j ? r - j : METAROW + NMETA + (s - j); }
    const int p = r - METAROW; return p >= j ? r - j : -1;
}
struct ThinRow { u32x4 xa, xb, cq, ckv; unsigned k1, k2; };
__device__ __forceinline__ ThinRow thin_load(const bf16_t* XR, const bf16_t* CQKV, int r, int lane) {
    ThinRow d; const bf16_t* z = CQKV + (size_t)r * CQKV_LD;
    d.xa = *(const u32x4*)(XR + (size_t)r * 1024 + lane * 8); d.xb = *(const u32x4*)(XR + (size_t)r * 1024 + 512 + lane * 8);
    d.cq = *(const u32x4*)(z + CQ_OFF + (lane < 48 ? lane : 0) * 8); d.ckv = *(const u32x4*)(z + (lane & 31) * 8);
    d.k1 = z[KR_OFF + (lane & 15)]; d.k2 = z[KR_OFF + 16 + (lane & 15)];
    return d;
}
__device__ __forceinline__ void thin_row_stats(unsigned char* ws, const ThinRow& d, int r, int lane) {
    float* RSQ = (float*)(ws + WS_RSQ); float* RSKV = (float*)(ws + WS_RSKV); bf16_t* KROPE = (bf16_t*)(ws + WS_KROPE);
    float sq = 0.f, skv = 0.f;
    { float v[8]; unpack8(d.cq, v); float a = 0.f;
#pragma unroll
      for (int i = 0; i < 8; ++i) a += v[i] * v[i];
      sq = lane < 48 ? a : 0.f; }
    { float v[8]; unpack8(d.ckv, v); float a = 0.f;
#pragma unroll
      for (int i = 0; i < 8; ++i) a += v[i] * v[i];
      skv = lane < 32 ? a : 0.f; }
    sq = wave_sum(sq); skv = wave_sum(skv);
    if (lane == 0) { RSQ[r] = 1.f / sqrtf(sq * (1.f / 384.f) + EPS); RSKV[r] = 1.f / sqrtf(skv * (1.f / 256.f) + EPS); }
    if (lane < 16) { const int pos = r < M ? NMETA + (r & (SEQ - 1)) : r - METAROW; const float x1 = bf2f((bf16_t)d.k1), x2 = bf2f((bf16_t)d.k2);
        const float c = ((const float*)(ws + WS_CTAB))[pos * 16 + lane], s = ((const float*)(ws + WS_STAB))[pos * 16 + lane];
        ((unsigned*)(KROPE + (size_t)r * 32))[lane] = pk2(x1 * c - x2 * s, x1 * s + x2 * c); }
}
__device__ __forceinline__ void phase_thin(const Ctx& C) {
    unsigned char* ws = C.ws; const float* const* in = C.in; const int lane = C.lane;
    const bf16_t* XR = (const bf16_t*)(ws + SLOT(1)); const bf16_t* CQKV = (const bf16_t*)(ws + SLOT(3)); bf16_t* XC = (bf16_t*)(ws + SLOT(0));
    const float* cw = in[4]; const float* cb = in[5];
    float w[4][16], bias[16];
#pragma unroll
    for (int hh = 0; hh < 2; ++hh)
#pragma unroll
        for (int i = 0; i < 8; ++i) { const int ch = hh * 512 + lane * 8 + i; bias[hh * 8 + i] = cb[ch];
#pragma unroll
            for (int t = 0; t < 4; ++t) w[t][hh * 8 + i] = cw[t * 1024 + ch]; }
    for (int st = C.gw; st < M / 32 + 1; st += C.NGW) {
        const bool meta = st == M / 32; const int r0 = meta ? METAROW : st * 32, nrow = meta ? NMETA : 32;
        float x1[16], x2[16], x3[16];
        const bool first = meta || (r0 & (SEQ - 1)) == 0;
        ThinRow nx = thin_load(XR, CQKV, r0, lane);
#pragma unroll
        for (int j = 1; j <= 3; ++j) { const int pr = first ? (meta ? -1 : METAROW + NMETA - j) : r0 - j;
#pragma unroll
            for (int hh = 0; hh < 2; ++hh) { float v[8];
                if (pr >= 0) unpack8(*(const u32x4*)(XR + (size_t)pr * 1024 + hh * 512 + lane * 8), v); else {
#pragma unroll
                    for (int i = 0; i < 8; ++i) v[i] = 0.f; }
#pragma unroll
                for (int i = 0; i < 8; ++i) { if (j == 1) x1[hh * 8 + i] = v[i]; else if (j == 2) x2[hh * 8 + i] = v[i]; else x3[hh * 8 + i] = v[i]; } } }
        for (int t = 0; t < nrow; ++t) { const int r = r0 + t; float x0[16];
            const ThinRow d = nx;
            if (t + 1 < nrow) nx = thin_load(XR, CQKV, r + 1, lane);
            { float v[8]; unpack8(d.xa, v);
#pragma unroll
              for (int i = 0; i < 8; ++i) x0[i] = v[i];
              unpack8(d.xb, v);
#pragma unroll
              for (int i = 0; i < 8; ++i) x0[8 + i] = v[i]; }
#pragma unroll
            for (int hh = 0; hh < 2; ++hh) { float y[8];
#pragma unroll
                for (int i = 0; i < 8; ++i) { const int q = hh * 8 + i; y[i] = bias[q] + w[3][q] * x0[q] + w[2][q] * x1[q] + w[1][q] * x2[q] + w[0][q] * x3[q]; }
                *(u32x4*)(XC + (size_t)r * 1024 + hh * 512 + lane * 8) = pack8(y); }
#pragma unroll
            for (int q = 0; q < 16; ++q) { x3[q] = x2[q]; x2[q] = x1[q]; x1[q] = x0[q]; }
            thin_row_stats(ws, d, r, lane);
        }
    }
    float* RSQ = (float*)(ws + WS_RSQ); float* RSKV = (float*)(ws + WS_RSKV); bf16_t* KROPE = (bf16_t*)(ws + WS_KROPE);
    for (int r = M + NMETA + C.gw; r < MTOT; r += C.NGW) {
        u32x4* o = (u32x4*)(XC + (size_t)r * 1024); o[lane] = (u32x4){0u, 0u, 0u, 0u}; o[64 + lane] = (u32x4){0u, 0u, 0u, 0u};
        if (lane == 0) { RSQ[r] = 0.f; RSKV[r] = 0.f; }
        if (lane < 16) ((unsigned*)(KROPE + (size_t)r * 32))[lane] = 0u;
    }
}

__device__ __forceinline__ void phase_scan1(const Ctx& C) {
    unsigned char* ws = C.ws; const int lane = C.lane;
    const bf16_t* LA = (const bf16_t*)(ws + SLOT(1)); const bf16_t* UU = (const bf16_t*)(ws + SLOT(6));
    float* SCP = (float*)(ws + WS_SCP); float* SCH = (float*)(ws + WS_SCH); float* CARRY0 = (float*)(ws + WS_CARRY0);
    for (int it = C.gw; it < 2048 + 4; it += C.NGW) {
        const bool meta = it >= 2048; const int q = it & 3, bc = it >> 2, ch = q * 256 + lane * 4;
        const int row0 = meta ? METAROW : bc * 128, nrow = meta ? NMETA : 128;
        float P[4] = {1.f, 1.f, 1.f, 1.f}, H[4] = {0.f, 0.f, 0.f, 0.f};
#pragma unroll 8
        for (int t = 0; t < nrow; ++t) { const u32x2 l2 = *(const u32x2*)(LA + (size_t)(row0 + t) * 1024 + ch), u2 = *(const u32x2*)(UU + (size_t)(row0 + t) * 1024 + ch);
            const float a0 = ex2(LOG2E * bf_lo(l2.x)), a1 = ex2(LOG2E * bf_hi(l2.x)), a2 = ex2(LOG2E * bf_lo(l2.y)), a3 = ex2(LOG2E * bf_hi(l2.y));
            P[0] *= a0; P[1] *= a1; P[2] *= a2; P[3] *= a3;
            H[0] = a0 * H[0] + bf_lo(u2.x); H[1] = a1 * H[1] + bf_hi(u2.x); H[2] = a2 * H[2] + bf_lo(u2.y); H[3] = a3 * H[3] + bf_hi(u2.y); }
        if (meta) *(f32x4*)(CARRY0 + ch) = (f32x4){H[0], H[1], H[2], H[3]};
        else { *(f32x4*)(SCP + (size_t)bc * 1024 + ch) = (f32x4){P[0], P[1], P[2], P[3]}; *(f32x4*)(SCH + (size_t)bc * 1024 + ch) = (f32x4){H[0], H[1], H[2], H[3]}; }
    }
}
__device__ __forceinline__ void phase_scan2(const Ctx& C) {
    unsigned char* ws = C.ws; const int lane = C.lane;
    const bf16_t* LA = (const bf16_t*)(ws + SLOT(1)); const bf16_t* UU = (const bf16_t*)(ws + SLOT(6)); const bf16_t* GR = (const bf16_t*)(ws + SLOT(2)); bf16_t* HRG = (bf16_t*)(ws + SLOT(0));
    const float* SCP = (const float*)(ws + WS_SCP); const float* SCH = (const float*)(ws + WS_SCH); const float* CARRY0 = (const float*)(ws + WS_CARRY0);
    for (int it = C.gw; it < 2048; it += C.NGW) {
        const int q = it & 3, bc = it >> 2, b = bc >> 4, c = bc & 15, ch = q * 256 + lane * 4;
        f32x4 h = *(const f32x4*)(CARRY0 + ch);
        for (int cc = 0; cc < c; ++cc) { const f32x4 p = *(const f32x4*)(SCP + (size_t)(b * 16 + cc) * 1024 + ch), e = *(const f32x4*)(SCH + (size_t)(b * 16 + cc) * 1024 + ch); h = p * h + e; }
        float H[4] = {h[0], h[1], h[2], h[3]};
        const int row0 = bc * 128;
#pragma unroll 8
        for (int t = 0; t < 128; ++t) { const size_t off = (size_t)(row0 + t) * 1024 + ch; const u32x2 l2 = *(const u32x2*)(LA + off), u2 = *(const u32x2*)(UU + off), g2 = *(const u32x2*)(GR + off);
            H[0] = ex2(LOG2E * bf_lo(l2.x)) * H[0] + bf_lo(u2.x); H[1] = ex2(LOG2E * bf_hi(l2.x)) * H[1] + bf_hi(u2.x); H[2] = ex2(LOG2E * bf_lo(l2.y)) * H[2] + bf_lo(u2.y); H[3] = ex2(LOG2E * bf_hi(l2.y)) * H[3] + bf_hi(u2.y);
            u32x2 o; o.x = pk2(H[0] * bf_lo(g2.x), H[1] * bf_hi(g2.x)); o.y = pk2(H[2] * bf_lo(g2.y), H[3] * bf_hi(g2.y)); *(u32x2*)(HRG + off) = o; }
    }
}

constexpr int AT_KSLOT = 12 * 1024, AT_VSLOT = 8192;
#define AT_K(j) (((j) & 3) * AT_KSLOT)
#define AT_V(j) (4 * AT_KSLOT + ((j) & 7) * AT_VSLOT)
static_assert(4 * AT_KSLOT + 8 * AT_VSLOT <= 131072, "attention rings fit the phase scratch");
__device__ __forceinline__ void glds16(const void* gsrc, unsigned lds_dst) { unsigned keep;
    asm volatile("s_mov_b32 %0, m0\n\ts_mov_b32 m0, %2\n\ts_nop 0\n\tglobal_load_lds_dwordx4 %1, off\n\ts_mov_b32 m0, %0" : "=&s"(keep) : "v"(gsrc), "s"(lds_dst) : "memory"); }
#define AT_BAR(N) asm volatile("s_waitcnt vmcnt(" #N ") lgkmcnt(0)\n\ts_barrier" ::: "memory")
__device__ __forceinline__ int crow(int r, int hi) { return (r & 3) + 8 * (r >> 2) + 4 * hi; }
__device__ __forceinline__ void attn_q(LAS unsigned char* lds, int j, int s0, int q, int hi, const bf16x8 (&qf)[6], const f32x16& negm, f32x16& p0, f32x16& p1) {
    const int kb = AT_K(j);
    __builtin_amdgcn_s_setprio(1);
#pragma unroll
    for (int ks = 0; ks < 6; ++ks) {
        const bf16x8 a0 = *(const LAS bf16x8*)(lds + kb + (2 * ks + hi) * 1024 + q * 16);
        const bf16x8 a1 = *(const LAS bf16x8*)(lds + kb + (2 * ks + hi) * 1024 + (32 + q) * 16);
        if (ks == 0) { p0 = __builtin_amdgcn_mfma_f32_32x32x16_bf16(a0, qf[0], negm, 0, 0, 0); p1 = __builtin_amdgcn_mfma_f32_32x32x16_bf16(a1, qf[0], negm, 0, 0, 0); }
        else { p0 = __builtin_amdgcn_mfma_f32_32x32x16_bf16(a0, qf[ks], p0, 0, 0, 0); p1 = __builtin_amdgcn_mfma_f32_32x32x16_bf16(a1, qf[ks], p1, 0, 0, 0); }
    }
    __builtin_amdgcn_s_setprio(0);
    if (j == 0) {
#pragma unroll
        for (int r = 0; r < 16; ++r) { if (crow(r, hi) >= NMETA) p0[r] = -INFINITY; p1[r] = -INFINITY; }
    } else if ((j - 1) * 64 + 63 > s0) {
        const int qs = s0 + q, k0 = (j - 1) * 64;
#pragma unroll
        for (int r = 0; r < 16; ++r) { const int kk = k0 + crow(r, hi); if (kk > qs) p0[r] = -INFINITY; if (kk + 32 > qs) p1[r] = -INFINITY; }
    }
}
__device__ __forceinline__ void attn_pv(LAS unsigned char* lds, int vbase, const bf16x8 (&pb)[4], f32x16& o0, f32x16& o1) {
#pragma unroll
    for (int s = 0; s < 4; ++s)
#pragma unroll
        for (int db = 0; db < 2; ++db) {
            const v4i16_t lo = __builtin_amdgcn_ds_read_tr16_b64_v4i16((LAS v4i16_t*)(lds + vbase + db * 4096 + s * 1024));
            const v4i16_t hh = __builtin_amdgcn_ds_read_tr16_b64_v4i16((LAS v4i16_t*)(lds + vbase + db * 4096 + s * 1024 + 512));
            const bf16x8 va = {lo[0], lo[1], lo[2], lo[3], hh[0], hh[1], hh[2], hh[3]};
            if (db == 0) o0 = __builtin_amdgcn_mfma_f32_32x32x16_bf16(va, pb[s], o0, 0, 0, 0); else o1 = __builtin_amdgcn_mfma_f32_32x32x16_bf16(va, pb[s], o1, 0, 0, 0);
        }
}
#ifndef ATT_THR
#define ATT_THR 8.0f
#endif
template <bool DOPV, bool FIRST> __device__ __forceinline__ void attn_sp(LAS unsigned char* lds, int vbase, f32x16& p0, f32x16& p1, bf16x8 (&pb)[4], f32x16& o0, f32x16& o1, f32x16& negm, float& m_run, float& l_run) {
    float mx = fmaxf(p0[0], p1[0]);
#pragma unroll
    for (int r = 1; r < 16; ++r) mx = fmaxf(fmaxf(mx, p0[r]), p1[r]);
    mx = fmaxf(mx, __shfl_xor(mx, 32));
    if (DOPV) attn_pv(lds, vbase, pb, o0, o1);
    float rs = 0.f;
#pragma unroll
    for (int r = 0; r < 16; ++r) { p0[r] = ex2(p0[r]); p1[r] = ex2(p1[r]); rs += p0[r] + p1[r]; }
    if (FIRST || !__all(mx <= ATT_THR)) {
        const float d = FIRST ? mx : fmaxf(mx, 0.f), alpha = ex2(-d);
#pragma unroll
        for (int r = 0; r < 16; ++r) { p0[r] *= alpha; p1[r] *= alpha; o0[r] *= alpha; o1[r] *= alpha; }
        rs *= alpha; l_run *= alpha; m_run += d;
#pragma unroll
        for (int r = 0; r < 16; ++r) negm[r] = -m_run;
    }
    l_run += rs;
#pragma unroll
    for (int s = 0; s < 4; ++s) { unsigned w[4];
#pragma unroll
        for (int jj = 0; jj < 4; ++jj) w[jj] = (s < 2) ? pk2(p0[8 * (s & 1) + 2 * jj], p0[8 * (s & 1) + 2 * jj + 1]) : pk2(p1[8 * (s & 1) + 2 * jj], p1[8 * (s & 1) + 2 * jj + 1]);
        u32x4 ww = {w[0], w[1], w[2], w[3]}; pb[s] = __builtin_bit_cast(bf16x8, ww); }
}
__device__ __forceinline__ void attn_unit(const Ctx& C, int b, int h, int qb, const bf16_t* Q, const bf16_t* KN, const bf16_t* KR, const bf16_t* V, bf16_t* O) {
    const int tid = C.tid, lane = C.lane, wid = C.wave, q = lane & 31, hi = lane >> 5;
    LAS unsigned char* lds = C.lds;
    const int s0 = qb * 256 + wid * 32;
    const size_t qrow = (size_t)b * SEQ + s0 + q;
    bf16x8 qf[6];
#pragma unroll
    for (int ks = 0; ks < 6; ++ks) qf[ks] = *(const bf16x8*)(Q + qrow * QLD + h * 96 + ks * 16 + hi * 8);
    {
        const float* ctab = (const float*)(C.ws + WS_CTAB) + (NMETA + s0 + q) * 16; const float* stab = (const float*)(C.ws + WS_STAB) + (NMETA + s0 + q) * 16;
#pragma unroll
        for (int ks = 4; ks < 6; ++ks) { const f32x4 cc = *(const f32x4*)(ctab + 8 * (ks - 4) + 4 * hi), sn = *(const f32x4*)(stab + 8 * (ks - 4) + 4 * hi);
            const u32x4 w = __builtin_bit_cast(u32x4, qf[ks]); u32x4 r;
            { const float x1 = bf_lo(w.x), x2 = bf_hi(w.x); r.x = pk2(x1 * cc[0] - x2 * sn[0], x1 * sn[0] + x2 * cc[0]); }
            { const float x1 = bf_lo(w.y), x2 = bf_hi(w.y); r.y = pk2(x1 * cc[1] - x2 * sn[1], x1 * sn[1] + x2 * cc[1]); }
            { const float x1 = bf_lo(w.z), x2 = bf_hi(w.z); r.z = pk2(x1 * cc[2] - x2 * sn[2], x1 * sn[2] + x2 * cc[2]); }
            { const float x1 = bf_lo(w.w), x2 = bf_hi(w.w); r.w = pk2(x1 * cc[3] - x2 * sn[3], x1 * sn[3] + x2 * cc[3]); }
            qf[ks] = __builtin_bit_cast(bf16x8, r); }
    }
    f32x16 o0 = {}, o1 = {}, p0 = {}, p1 = {};
    bf16x8 pb[4] = {};
    float m_run = 0.f, l_run = 0.f; f32x16 negm = {};
    const int NJ = 4 * qb + 5;
    const unsigned lds0 = (unsigned)(size_t)lds;
    const bf16_t* ksrc = KN + (size_t)lane * 1024 + h * 64 + wid * 8;
    const bf16_t* rsrc = KR + (size_t)lane * 32 + (wid & 3) * 8;
    const bf16_t* vsrc = V + (size_t)(16 * (wid & 3) + (lane >> 2)) * 1024 + h * 64 + (wid >> 2) * 32 + (lane & 3) * 8;
#define AT_DMA(j) do { const size_t row_ = (j) == 0 ? (size_t)METAROW : (size_t)b * SEQ + (size_t)((j) - 1) * 64; \
        glds16(ksrc + row_ * 1024, (unsigned)__builtin_amdgcn_readfirstlane(lds0 + AT_K(j) + wid * 1024)); \
        if (wid < 4) glds16(rsrc + row_ * 32, (unsigned)__builtin_amdgcn_readfirstlane(lds0 + AT_K(j) + (8 + wid) * 1024)); \
        glds16(vsrc + row_ * 1024, (unsigned)__builtin_amdgcn_readfirstlane(lds0 + AT_V(j) + wid * 1024)); } while (0)
#define AT_STEP(n) do { if ((n) + 2 < NJ) { if (wid < 4) AT_BAR(6); else AT_BAR(4); } else if ((n) + 1 < NJ) { if (wid < 4) AT_BAR(3); else AT_BAR(2); } else AT_BAR(0); if ((n) + 3 < NJ) AT_DMA((n) + 3); } while (0)
    AT_BAR(0);
    AT_DMA(0); AT_DMA(1); AT_DMA(2);
    const int g16 = lane >> 4, qq = (lane & 15) >> 2, pp = lane & 3;
    const int vtr_off = (4 * hi + qq) * 64 + (16 * (g16 & 1) + 4 * pp) * 2;
    {
        AT_STEP(0);
        attn_q(lds, 0, s0, q, hi, qf, negm, p0, p1);
        attn_sp<false, true>(lds, 0, p0, p1, pb, o0, o1, negm, m_run, l_run);
    }
    const int jend = (s0 + 31) / 64 + 2 < NJ ? (s0 + 31) / 64 + 2 : NJ;
    for (int j = 1; j < jend; ++j) {
        AT_STEP(j);
        attn_q(lds, j, s0, q, hi, qf, negm, p0, p1);
        attn_sp<true, false>(lds, AT_V(j - 1) + vtr_off, p0, p1, pb, o0, o1, negm, m_run, l_run);
    }
    attn_pv(lds, AT_V(jend - 1) + vtr_off, pb, o0, o1);
    for (int j = jend; j < NJ; ++j) AT_STEP(j);
#undef AT_DMA
#undef AT_STEP
    const float inv = 1.f / (l_run + __shfl_xor(l_run, 32));
    bf16_t* orow = O + qrow * 1024 + h * 64;
#pragma unroll
    for (int g4 = 0; g4 < 4; ++g4) {
        u32x2 w0, w1; w0.x = pk2(o0[4 * g4] * inv, o0[4 * g4 + 1] * inv); w0.y = pk2(o0[4 * g4 + 2] * inv, o0[4 * g4 + 3] * inv);
        w1.x = pk2(o1[4 * g4] * inv, o1[4 * g4 + 1] * inv); w1.y = pk2(o1[4 * g4 + 2] * inv, o1[4 * g4 + 3] * inv);
        *(u32x2*)(orow + 8 * g4 + 4 * hi) = w0; *(u32x2*)(orow + 32 + 8 * g4 + 4 * hi) = w1;
    }
}
__device__ __forceinline__ void phase_attn(const Ctx& C) {
    unsigned char* ws = C.ws;
    const bf16_t* Q = (const bf16_t*)(ws + SLOT(0)); const bf16_t* KN = (const bf16_t*)(ws + SLOT(4)); const bf16_t* V = (const bf16_t*)(ws + SLOT(6)); const bf16_t* KR = (const bf16_t*)(ws + WS_KROPE);
    bf16_t* O = (bf16_t*)(ws + SLOT(3));
    const int G = C.G, c = blockIdx.x; const int vcu = (G % 8 == 0) ? (c % 8) * (G / 8) + c / 8 : c;
    for (int bh = vcu; bh < NB * 16; bh += G)
        for (int i = 0; i < 8; ++i) { const int qb = (i & 1) ? 7 - (i >> 1) : (i >> 1); attn_unit(C, bh >> 4, bh & 15, qb, Q, KN, KR, V, O); }
    __syncthreads();
}

__device__ __forceinline__ int tk_enc(float f) { const int x = __float_as_int(f); return x ^ ((x >> 31) & 0x7fffffff); }
__device__ __forceinline__ float tk_dec(int k) { return __int_as_float(k ^ ((k >> 31) & 0x7fffffff)); }
#define TK_CE(a, b) do { const int hi_ = max((a), (b)), lo_ = min((a), (b)); (a) = hi_; (b) = lo_; } while (0)
__device__ __forceinline__ void tk_sort16(int (&v)[16]) {
#pragma unroll
    for (int k = 2; k <= 16; k <<= 1)
#pragma unroll
        for (int j = k >> 1; j > 0; j >>= 1)
#pragma unroll
            for (int i = 0; i < 16; ++i) { const int l = i ^ j; if (l > i) { if ((i & k) == 0) TK_CE(v[i], v[l]); else TK_CE(v[l], v[i]); } }
}
__device__ __forceinline__ void tk_merge16(int (&a)[16], const int (&b)[16]) {
#pragma unroll
    for (int i = 0; i < 16; ++i) a[i] = max(a[i], b[15 - i]);
#pragma unroll
    for (int j = 8; j > 0; j >>= 1)
#pragma unroll
        for (int i = 0; i < 16; ++i) { const int l = i ^ j; if (l > i) TK_CE(a[i], a[l]); }
}
__host__ __device__ constexpr int tk_pos(int i) { int n = 0; for (int a = 0; a < i; ++a) n += 16 / (a + 1); return n; }
__device__ __forceinline__ int tk_lookup(const int (&w)[4], int i) {
    const unsigned long long lo = ((unsigned long long)(unsigned)w[1] << 32) | (unsigned long long)(unsigned)w[0], hi = ((unsigned long long)(unsigned)w[3] << 32) | (unsigned long long)(unsigned)w[2];
    const unsigned long long a = (i & 8) ? hi : lo;
    return (int)(a >> (8 * (i & 7))) & 127;
}
__device__ __forceinline__ void phase_topk(const Ctx& C) {
    unsigned char* ws = C.ws;
    const _Float16* SC = (const _Float16*)(ws + SLOT(0)); int* TIDX = (int*)(ws + SLOT(5)); float* TVAL = (float*)(ws + SLOT(5) + (size_t)M * 128 * 4);
    const int gt = blockIdx.x * NTHR + C.tid, NT = C.G * NTHR;
    for (int it = gt; it < M * 8 * 4; it += NT) {
        const int p = it >> 2, q = it & 3;
        const f16x8* s = (const f16x8*)(SC + (size_t)p * 256 + 64 * q);
        f16x8 raw[8];
#pragma unroll
        for (int c = 0; c < 8; ++c) raw[c] = s[c];
        const int ibase = 127 - 64 * (q & 1);
        int ch[4][16];
#pragma unroll
        for (int c = 0; c < 4; ++c)
#pragma unroll
            for (int e = 0; e < 16; ++e) ch[c][e] = (tk_enc((float)raw[2 * c + (e >> 3)][e & 7]) & ~127) | (ibase - (16 * c + e));
        tk_sort16(ch[0]); tk_sort16(ch[1]); tk_sort16(ch[2]); tk_sort16(ch[3]);
        tk_merge16(ch[0], ch[1]); tk_merge16(ch[2], ch[3]); tk_merge16(ch[0], ch[2]);
        int oth[16];
#pragma unroll
        for (int i = 0; i < 16; ++i) oth[i] = __builtin_amdgcn_mov_dpp(ch[0][i], 0xB1, 0xF, 0xF, true);
        tk_merge16(ch[0], oth);
#pragma unroll
        for (int i = 0; i < 16; ++i) oth[i] = __builtin_amdgcn_mov_dpp(ch[0][i], 0x4E, 0xF, 0xF, true);
        int t1[16], t2[16];
#pragma unroll
        for (int i = 0; i < 16; ++i) { t1[i] = (q < 2) ? ch[0][i] : oth[i]; t2[i] = (q < 2) ? oth[i] : ch[0][i]; }
        float f1[16], f2[16];
#pragma unroll
        for (int i = 0; i < 16; ++i) { f1[i] = tk_dec(t1[i]); f2[i] = tk_dec(t2[i]); }
        int cd[4][16];
#pragma unroll
        for (int i = 0; i < 16; ++i)
#pragma unroll
            for (int j = 0; j < 16; ++j) if ((i + 1) * (j + 1) <= 16) { constexpr int dummy = 0; (void)dummy; const int n = tk_pos(i) + j; cd[n >> 4][n & 15] = (tk_enc(f1[i] + f2[j]) & ~255) | (255 - (16 * i + j)); }
#pragma unroll
        for (int n = 50; n < 64; ++n) cd[n >> 4][n & 15] = (int)0x80000000;
        tk_sort16(cd[0]); tk_sort16(cd[1]); tk_sort16(cd[2]); tk_sort16(cd[3]);
        tk_merge16(cd[0], cd[1]); tk_merge16(cd[2], cd[3]); tk_merge16(cd[0], cd[2]);
        int w1[4], w2[4];
#pragma unroll
        for (int m = 0; m < 4; ++m) { w1[m] = (t1[4 * m] & 127) | ((t1[4 * m + 1] & 127) << 8) | ((t1[4 * m + 2] & 127) << 16) | ((t1[4 * m + 3] & 127) << 24);
                                      w2[m] = (t2[4 * m] & 127) | ((t2[4 * m + 1] & 127) << 8) | ((t2[4 * m + 2] & 127) << 16) | ((t2[4 * m + 3] & 127) << 24); }
        if (q == 0) {
            int id[16];
#pragma unroll
            for (int k = 0; k < 16; ++k) { const int c = 255 - (cd[0][k] & 255); id[k] = (127 - tk_lookup(w1, c >> 4)) * 128 + (127 - tk_lookup(w2, c & 15)); }
            int* oi = TIDX + (size_t)p * 16;
#pragma unroll
            for (int k = 0; k < 16; k += 4) *(int4*)(oi + k) = make_int4(id[k], id[k + 1], id[k + 2], id[k + 3]);
        } else if (q == 1) {
            float* ov = TVAL + (size_t)p * 16;
#pragma unroll
            for (int k = 0; k < 16; k += 4) *(f32x4*)(ov + k) = (f32x4){tk_dec(cd[0][k]), tk_dec(cd[0][k + 1]), tk_dec(cd[0][k + 2]), tk_dec(cd[0][k + 3])};
        }
    }
}

__device__ __forceinline__ f32x2 fp8lo(unsigned w) { return __builtin_amdgcn_cvt_pk_f32_fp8((int)w, false); }
__device__ __forceinline__ f32x2 fp8hi(unsigned w) { return __builtin_amdgcn_cvt_pk_f32_fp8((int)w, true); }
__device__ __forceinline__ float dpp_ror8(float v) { return __uint_as_float(__builtin_amdgcn_update_dpp(0, __float_as_uint(v), 0x128, 0xF, 0xF, true)); }
__device__ __forceinline__ float dpp_hmir(float v) { return __uint_as_float(__builtin_amdgcn_update_dpp(0, __float_as_uint(v), 0x141, 0xF, 0xF, true)); }
__device__ __forceinline__ float dpp_x2(float v) { return __uint_as_float(__builtin_amdgcn_mov_dpp(__float_as_uint(v), 0x4E, 0xF, 0xF, true)); }
__device__ __forceinline__ float dpp_x1(float v) { return __uint_as_float(__builtin_amdgcn_mov_dpp(__float_as_uint(v), 0xB1, 0xF, 0xF, true)); }
__device__ __forceinline__ float fp8dot16(const u32x4 w, const f32x2 (&x2)[8]) {
    f32x2 a = fp8lo(w.x) * x2[0]; a += fp8hi(w.x) * x2[1]; a += fp8lo(w.y) * x2[2]; a += fp8hi(w.y) * x2[3];
    a += fp8lo(w.z) * x2[4]; a += fp8hi(w.z) * x2[5]; a += fp8lo(w.w) * x2[6]; a += fp8hi(w.w) * x2[7];
    return a.x + a.y;
}
__device__ __forceinline__ void load_x2(const bf16_t* H1B, const float* g2, int tok, int lane, f32x2 (&x2)[8], f32x4 (&e)[4], float& ss) {
    const u32x4 xa = *(const u32x4*)(H1B + (size_t)tok * 1024 + 16 * lane), xb = *(const u32x4*)(H1B + (size_t)tok * 1024 + 16 * lane + 8);
    float hv[16]; { float t8[8]; unpack8(xa, t8);
#pragma unroll
        for (int i = 0; i < 8; ++i) hv[i] = t8[i];
        unpack8(xb, t8);
#pragma unroll
        for (int i = 0; i < 8; ++i) hv[8 + i] = t8[i]; }
    const f32x4* gp = (const f32x4*)(g2 + 16 * lane); ss = 0.f;
#pragma unroll
    for (int j = 0; j < 4; ++j) { const f32x4 gv = gp[j]; e[j] = (f32x4){hv[4 * j], hv[4 * j + 1], hv[4 * j + 2], hv[4 * j + 3]};
        ss += (e[j][0] * e[j][0] + e[j][1] * e[j][1]) + (e[j][2] * e[j][2] + e[j][3] * e[j][3]);
        x2[2 * j] = (f32x2){e[j][0] * gv[0], e[j][1] * gv[1]}; x2[2 * j + 1] = (f32x2){e[j][2] * gv[2], e[j][3] * gv[3]}; }
}
__device__ __forceinline__ void u_process(unsigned c, int n, int sub, int tok, const f32x2 (&x2)[8], const unsigned char* PU, float* ACT, int lane, bool b3) {
    for (int base = 0; base < n; base += 24) {
        int id[24];
#pragma unroll
        for (int k = 0; k < 24; ++k) { const int v = (int)(__builtin_amdgcn_readlane(c, (base + k) & 63) & 0xffffu); id[k] = (base + k < n) ? v : (sub << 11); }
        u32x4 w[24];
#pragma unroll
        for (int g = 0; g < 3; ++g) if (base + 8 * g < n) {
#pragma unroll
            for (int k = 0; k < 8; ++k) w[8 * g + k] = *(const u32x4*)(PU + (size_t)id[8 * g + k] * 1024 + 16 * lane); }
        __builtin_amdgcn_sched_barrier(0);
#pragma unroll
        for (int g = 0; g < 3; ++g) if (base + 8 * g < n) {
            float p[8];
#pragma unroll
            for (int k = 0; k < 8; ++k) p[k] = fp8dot16(w[8 * g + k], x2);
            float q4[4], q2[2];
#pragma unroll
            for (int i = 0; i < 4; ++i) { auto rr = __builtin_amdgcn_permlane32_swap(__float_as_uint(p[i]), __float_as_uint(p[4 + i]), false, false); q4[i] = __uint_as_float(rr[0]) + __uint_as_float(rr[1]); }
#pragma unroll
            for (int i = 0; i < 2; ++i) { auto rr = __builtin_amdgcn_permlane16_swap(__float_as_uint(q4[i]), __float_as_uint(q4[2 + i]), false, false); q2[i] = __uint_as_float(rr[0]) + __uint_as_float(rr[1]); }
            float t; { const float keep = b3 ? q2[1] : q2[0], send = b3 ? q2[0] : q2[1]; t = keep + dpp_ror8(send); }
            t += dpp_hmir(t); t += dpp_x2(t); t += dpp_x1(t);
            const int slot = base + 8 * g + (lane >> 3);
            const unsigned mine = (unsigned)__builtin_amdgcn_ds_bpermute((slot & 63) * 4, (int)c);
            if ((lane & 7) == 0 && slot < n) ACT[(size_t)tok * 128 + (mine >> 16)] = t;
        }
    }
}
__device__ __forceinline__ void phase_upart(const Ctx& C, int xcc, int rank) {
    unsigned char* ws = C.ws; const int lane = C.lane;
    const bf16_t* H1B = (const bf16_t*)(ws + SLOT(4)); const int* TIDX = (const int*)(ws + SLOT(5)); float* ACT = (float*)(ws + SLOT(0));
    const unsigned char* PU = ws + WS_PU;
    int nloc, xi, nx;
    if ((C.G & 7) == 0) { nx = 8; xi = xcc; nloc = C.G >> 3; } else { nx = 1; xi = 0; nloc = C.G; rank = blockIdx.x; }
    const bool b3 = (lane & 8) != 0;
    f32x4 gv[4];
#pragma unroll
    for (int j = 0; j < 4; ++j) gv[j] = ((const f32x4*)(C.in[18] + 16 * lane))[j];
    const int tstep = nloc * NWAVES;
    for (int sub = xi; sub < 8; sub += nx) {
        int tok = rank * NWAVES + C.wave;
        u32x4 ra = {0u, 0u, 0u, 0u}, rb = {0u, 0u, 0u, 0u}; int ia = 0, ib = 0;
        if (tok < M) { ra = *(const u32x4*)(H1B + (size_t)tok * 1024 + 16 * lane); rb = *(const u32x4*)(H1B + (size_t)tok * 1024 + 16 * lane + 8); ia = TIDX[(size_t)tok * 128 + lane]; ib = TIDX[(size_t)tok * 128 + 64 + lane]; }
        for (; tok < M; tok += tstep) {
            f32x2 x2[8];
            { float hv[16]; { float t8[8]; unpack8(ra, t8);
#pragma unroll
                for (int i = 0; i < 8; ++i) hv[i] = t8[i];
                unpack8(rb, t8);
#pragma unroll
                for (int i = 0; i < 8; ++i) hv[8 + i] = t8[i]; }
#pragma unroll
              for (int j = 0; j < 4; ++j) { x2[2 * j] = (f32x2){hv[4 * j] * gv[j][0], hv[4 * j + 1] * gv[j][1]}; x2[2 * j + 1] = (f32x2){hv[4 * j + 2] * gv[j][2], hv[4 * j + 3] * gv[j][3]}; } }
            const int ca = ia, cb = ib;
            const int nt = tok + tstep;
            if (nt < M) { ra = *(const u32x4*)(H1B + (size_t)nt * 1024 + 16 * lane); rb = *(const u32x4*)(H1B + (size_t)nt * 1024 + 16 * lane + 8); ia = TIDX[(size_t)nt * 128 + lane]; ib = TIDX[(size_t)nt * 128 + 64 + lane]; }
            const bool fa = (ca >> 11) == sub, fb = (cb >> 11) == sub;
            const unsigned long long ma = __ballot(fa), mb = __ballot(fb);
            const int npa = __builtin_popcountll(ma), npb = __builtin_popcountll(mb);
            const int ra_ = (int)__builtin_amdgcn_mbcnt_hi((unsigned)(ma >> 32), __builtin_amdgcn_mbcnt_lo((unsigned)ma, 0u));
            const int rb_ = (int)__builtin_amdgcn_mbcnt_hi((unsigned)(mb >> 32), __builtin_amdgcn_mbcnt_lo((unsigned)mb, 0u));
            const int da = fa ? ra_ : npa + (lane - ra_), db = fb ? rb_ : npb + (lane - rb_);
            const unsigned cA = (unsigned)__builtin_amdgcn_ds_permute(da * 4, ca | (lane << 16));
            const unsigned cB = (unsigned)__builtin_amdgcn_ds_permute(db * 4, cb | ((64 + lane) << 16));
            if (npa + npb <= 64) {
                const unsigned pulled = (unsigned)__builtin_amdgcn_ds_bpermute(((lane - npa) & 63) * 4, (int)cB);
                u_process(lane < npa ? cA : pulled, npa + npb, sub, tok, x2, PU, ACT, lane, b3);
            } else { u_process(cA, npa, sub, tok, x2, PU, ACT, lane, b3); u_process(cB, npb, sub, tok, x2, PU, ACT, lane, b3); }
        }
    }
}
__device__ __forceinline__ void phase_gather(const Ctx& C, float* DST) {
    unsigned char* ws = C.ws; const int lane = C.lane;
    const bf16_t* H1B = (const bf16_t*)(ws + SLOT(4)); const int* TIDX = (const int*)(ws + SLOT(5)); const float* TVAL = (const float*)(ws + SLOT(5) + (size_t)M * 128 * 4);
    const float* ACT = (const float*)(ws + SLOT(0));
    const unsigned char* PV = ws + WS_PV; const float* SU = (const float*)(ws + WS_SU); const float* SV = (const float*)(ws + WS_SV);
    const float* fg = C.in[24];
    const int l4 = lane >> 2, ll = lane & 31; const bool hb = lane >= 32;
    int sig[32]; fp6_sigma(sig);
    LAS float* vs = (LAS float*)(C.lds + C.wave * 8448);
    int tok = C.gw;
    u32x4 ra = {0u, 0u, 0u, 0u}, rb = {0u, 0u, 0u, 0u};
    if (tok < M) { ra = *(const u32x4*)(H1B + (size_t)tok * 1024 + 16 * lane); rb = *(const u32x4*)(H1B + (size_t)tok * 1024 + 16 * lane + 8); }
    for (; tok < M; tok += C.NGW) {
        f32x4 e[4]; float ss = 0.f;
        { float hv[16]; { float t8[8]; unpack8(ra, t8);
#pragma unroll
            for (int i = 0; i < 8; ++i) hv[i] = t8[i];
            unpack8(rb, t8);
#pragma unroll
            for (int i = 0; i < 8; ++i) hv[8 + i] = t8[i]; }
#pragma unroll
          for (int j = 0; j < 4; ++j) { e[j] = (f32x4){hv[4 * j], hv[4 * j + 1], hv[4 * j + 2], hv[4 * j + 3]}; ss += (e[j][0] * e[j][0] + e[j][1] * e[j][1]) + (e[j][2] * e[j][2] + e[j][3] * e[j][3]); } }
        { const int nt = tok + C.NGW; if (nt < M) { ra = *(const u32x4*)(H1B + (size_t)nt * 1024 + 16 * lane); rb = *(const u32x4*)(H1B + (size_t)nt * 1024 + 16 * lane + 8); } }
        f32x4* dp = (f32x4*)(DST + (size_t)tok * 1024 + 16 * lane);
        const float rstd = 1.f / sqrtf(wave_sum(ss) * (1.f / 1024.f) + EPS);
        f32x2 acc[16];
#pragma unroll
        for (int i = 0; i < 16; ++i) acc[i] = (f32x2){0.f, 0.f};
        int idxn0 = TIDX[(size_t)tok * 128 + l4], idxn1 = TIDX[(size_t)tok * 128 + 16 + l4];
        float tsn0 = TVAL[(size_t)tok * 128 + l4], tsn1 = TVAL[(size_t)tok * 128 + 16 + l4], dtn0 = ACT[(size_t)tok * 128 + l4], dtn1 = ACT[(size_t)tok * 128 + 16 + l4];
        for (int hp = 0; hp < 8; hp += 2) {
            const int idx0 = idxn0, idx1 = idxn1; const float ts0 = tsn0 * rstd, ts1 = tsn1 * rstd, dot0 = dtn0, dot1 = dtn1;
            u32x4 pa[16]; u32x2 pb[16];
#pragma unroll
            for (int m = 0; m < 16; ++m) { const int src = m < 8 ? idx0 : idx1; const int ida = __builtin_amdgcn_readlane(src, 4 * ((2 * m) & 15)), idb = __builtin_amdgcn_readlane(src, 4 * ((2 * m + 1) & 15));
                const unsigned char* rp = PV + (size_t)(hb ? idb : ida) * 768; pa[m] = *(const u32x4*)(rp + 16 * ll); pb[m] = *(const u32x2*)(rp + 512 + 8 * ll); }
            __builtin_amdgcn_sched_barrier(0);
            const float su0 = SU[idx0], sv0 = SV[idx0], su1 = SU[idx1], sv1 = SV[idx1];
            if (hp < 6) { const size_t nb = (size_t)tok * 128 + (hp + 2) * 16 + l4; idxn0 = TIDX[nb]; idxn1 = TIDX[nb + 16]; tsn0 = TVAL[nb]; tsn1 = TVAL[nb + 16]; dtn0 = ACT[nb]; dtn1 = ACT[nb + 16]; }
            __builtin_amdgcn_sched_barrier(0);
            float mx0 = ts0, mx1 = ts1;
#pragma unroll
            for (int o = 4; o < 64; o <<= 1) { mx0 = fmaxf(mx0, __shfl_xor(mx0, o)); mx1 = fmaxf(mx1, __shfl_xor(mx1, o)); }
            const float ee0 = ex2((ts0 - mx0) * LOG2E), ee1 = ex2((ts1 - mx1) * LOG2E); float sm0 = ee0, sm1 = ee1;
#pragma unroll
            for (int o = 4; o < 64; o <<= 1) { sm0 += __shfl_xor(sm0, o); sm1 += __shfl_xor(sm1, o); }
            const float coef0 = (ee0 / sm0) * gelu_t(dot0 * su0 * rstd) * sv0, coef1 = (ee1 / sm1) * gelu_t(dot1 * su1 * rstd) * sv1;
#pragma unroll
            for (int m = 0; m < 16; ++m) {
                const unsigned cs = __float_as_uint(m < 8 ? coef0 : coef1);
                const float ca = __uint_as_float(__builtin_amdgcn_readlane(cs, 4 * ((2 * m) & 15))), cb = __uint_as_float(__builtin_amdgcn_readlane(cs, 4 * ((2 * m + 1) & 15)));
                const float ck = hb ? cb : ca;
                const f32x32 r = __builtin_amdgcn_cvt_scalef32_pk32_f32_fp6((u32x6){pa[m].x, pa[m].y, pa[m].z, pa[m].w, pb[m].x, pb[m].y}, 1.0f);
#pragma unroll
                for (int j = 0; j < 16; ++j) acc[j] = __builtin_elementwise_fma((f32x2){r[2 * j], r[2 * j + 1]}, (f32x2){ck, ck}, acc[j]);
                __builtin_amdgcn_sched_barrier(0);
            }
        }
#pragma unroll
        for (int j = 0; j < 32; ++j) vs[(hb ? 1056 : 0) + 33 * ll + sig[j]] = acc[j >> 1][j & 1];
        asm volatile("s_waitcnt lgkmcnt(0)" ::: "memory");
        float s2 = 0.f;
        { const int pos = 33 * (lane >> 1) + 16 * (lane & 1);
#pragma unroll
          for (int j = 0; j < 4; ++j) {
#pragma unroll
              for (int i = 0; i < 4; ++i) e[j][i] += vs[pos + 4 * j + i] + vs[1056 + pos + 4 * j + i];
              s2 += (e[j][0] * e[j][0] + e[j][1] * e[j][1]) + (e[j][2] * e[j][2] + e[j][3] * e[j][3]); } }
        asm volatile("s_waitcnt lgkmcnt(0)" ::: "memory");
        const float r2 = 1.f / sqrtf(wave_sum(s2) * (1.f / 1024.f) + EPS);
        const f32x4* fp = (const f32x4*)(fg + 16 * lane);
#pragma unroll
        for (int j = 0; j < 4; ++j) dp[j] = e[j] * r2 * fp[j];
    }
}

constexpr int NPHASE = 16;
__global__ void __launch_bounds__(NTHR, 2) hybrid_fwd(Args args) {
    extern __shared__ __attribute__((aligned(16))) unsigned char lds_raw[];
    Ctx C;
    C.lds = (LAS unsigned char*)lds_raw; C.tid = threadIdx.x; C.lane = C.tid & 63; C.wave = __builtin_amdgcn_readfirstlane(C.tid >> 6);
    C.G = gridDim.x; C.gw = blockIdx.x * NWAVES + C.wave; C.NGW = C.G * NWAVES; C.ws = args.ws; C.out = args.out; C.in = args.in;
    unsigned char* ws = args.ws;
    volatile LAS unsigned* MISC = (volatile LAS unsigned*)(C.lds + MISC_OFF);
    for (int u = C.tid; u < (LDS_BYTES - RING_BYTES) / 4; u += NTHR) ((LAS unsigned*)(C.lds + RING_BYTES))[u] = 0u;
    __syncthreads();
    XcdBarrier bar; bar.bar = (unsigned*)(ws + WS_CTL) + 1024; bar.x = 0; bar.st = nullptr;
    if (ONE_LAUNCH) bar = xcd_barrier_post((unsigned*)(ws + WS_CTL) + 1024, MISC + 8);
    const int lo = args.ph_lo, hi = args.ph_hi;
#ifndef PHMASK
#define PHMASK 0xffff
#endif
#define IN(k) (((PHMASK >> (k)) & 1) && lo <= (k) && (k) < hi)
#ifndef PROBE_PHASE
#define PROBE_PHASE -1
#endif
#define REPS(k) for (int rep_ = 0; rep_ < ((k) == PROBE_PHASE ? 2 : 1); ++rep_)
#define SEAM(k) do { if (IN(k) && IN((k) + 1)) xcd_barrier(bar); } while (0)
    const int G = C.G, cb = blockIdx.x;
    LAS unsigned char* ring = C.lds;

    if (IN(0)) REPS(0) { phase_prologue(C); }
    SEAM(0);
    if (IN(1)) REPS(1) {
        pg8::Gemm g{(const bf16_t*)(ws + SLOT(0)), (const bf16_t*)(ws + WS_WIN), 1024, 1024, 1024, 0, 256 * 1024};
        pg8::Sched S; S.init(256, 19, G, cb, 256, 6, 4);
        pg8::Epi8<FInproj> E{{(bf16_t*)(ws + SLOT(1)), (bf16_t*)(ws + SLOT(2)), (bf16_t*)(ws + SLOT(3)), (bf16_t*)(ws + SLOT(4)), (bf16_t*)(ws + SLOT(5))}};
        pg8::gemm_phase(ring, g, S, E);
    }
    SEAM(1);
    if (IN(2)) REPS(2) { phase_thin(C); }
    SEAM(2);
    if (IN(3)) REPS(3) {
        pg8::Gemm g{(const bf16_t*)(ws + SLOT(0)), (const bf16_t*)(ws + WS_WGATE), 1024, 128, 128, 128, 256 * 128};
        pg8::Sched S; S.init(256, 8, G, cb, 256, 8, 0);
        pg8::EpiPair<FGate> E{{(const bf16_t*)(ws + SLOT(0)), args.in[7], args.in[9], (const float*)(ws + WS_CLAM), (bf16_t*)(ws + SLOT(1)), (bf16_t*)(ws + SLOT(6))}};
        pg8::gemm_phase(ring, g, S, E);
    }
    SEAM(3);
    if (IN(4)) REPS(4) { phase_scan1(C); }
    SEAM(4);
    if (IN(5)) REPS(5) { phase_scan2(C); }
    SEAM(5);
    if (IN(6)) REPS(6) {
        pg8::Gemm g{(const bf16_t*)(ws + SLOT(0)), (const bf16_t*)(ws + WS_WRNN), 1024, 1024, 1024, 0, 256 * 1024};
        pg8::Sched S; S.init(256, 4, G, cb, 0, 0, 0);
        pg8::Epi8<FMul<false>> E{{(const bf16_t*)(ws + SLOT(4)), nullptr, (bf16_t*)(ws + SLOT(2))}};
        pg8::gemm_phase(ring, g, S, E);
    }
    SEAM(6);
    if (IN(7)) REPS(7) {
        { pg8::Gemm g{(const bf16_t*)(ws + SLOT(3)) + CQ_OFF, (const bf16_t*)(ws + WS_WUQ), CQKV_LD, 384, 384, 0, 256 * 384};
          pg8::Sched S; S.init(256, 6, G, cb, 0, 0, 0);
          pg8::Epi8<FQ> E{{(const float*)(ws + WS_RSQ), (bf16_t*)(ws + SLOT(0))}};
          pg8::gemm_phase(ring, g, S, E); }
        { pg8::Gemm g{(const bf16_t*)(ws + SLOT(3)), (const bf16_t*)(ws + WS_WUKV), CQKV_LD, 256, 256, 0, 256 * 256};
          pg8::Sched S; S.init(256, 8, G, cb, 256, 8, 0);
          pg8::Epi8<FKV> E{{(const float*)(ws + WS_RSKV), (bf16_t*)(ws + SLOT(4)), (bf16_t*)(ws + SLOT(6))}};
          pg8::gemm_phase(ring, g, S, E); }
    }
    SEAM(7);
    if (IN(8)) REPS(8) { phase_attn(C); }
    SEAM(8);
    if (IN(9)) REPS(9) {
        pg8::Gemm g{(const bf16_t*)(ws + SLOT(3)), (const bf16_t*)(ws + WS_WATT), 1024, 1024, 1024, 0, 256 * 1024};
        pg8::Sched S; S.init(256, 4, G, cb, 0, 0, 0);
        pg8::Epi8<FMul<true>> E{{(const bf16_t*)(ws + SLOT(5)), (const bf16_t*)(ws + SLOT(2)), (bf16_t*)(ws + SLOT(0))}};
        pg8::gemm_phase(ring, g, S, E);
    }
    SEAM(9);
    if (IN(10)) REPS(10) {
        pg8::Gemm g{(const bf16_t*)(ws + SLOT(0)), (const bf16_t*)(ws + WS_WOUT), 1024, 1024, 1024, 0, 256 * 1024};
        pg8::Sched S; S.init(256, 4, G, cb, 0, 0, 0);
        pg8::Epi8<FRes> E{{args.in[0], (bf16_t*)(ws + SLOT(4))}};
        pg8::gemm_phase(ring, g, S, E);
    }
    SEAM(10);
    if (IN(11)) REPS(11) {
        pg8::Gemm g{(const bf16_t*)(ws + SLOT(4)), (const bf16_t*)(ws + WS_WPQ), 1024, 1024, 1024, 0, 256 * 1024};
        pg8::Sched S; S.init(256, 8, G, cb, 0, 0, 0);
        pg8::Epi8<FF16> E{{(_Float16*)(ws + SLOT(0)), 2048}};
        pg8::gemm_phase(ring, g, S, E);
    }
    SEAM(11);
    if (IN(13)) REPS(13) { phase_topk(C); }
    SEAM(13);
    if (IN(14)) REPS(14) { phase_upart(C, (int)(blockIdx.x & 7), (int)(blockIdx.x >> 3)); }
    SEAM(14);
    if (IN(15)) REPS(15) { phase_gather(C, C.out); }
#undef IN
#undef SEAM
}

extern "C" void kernel_launch(void* const* d_in, const int* in_sizes, int n_in, void* d_out, int out_size, void* d_ws, size_t ws_size, hipStream_t stream) {
    static int grid = 0;
    if (grid == 0) {
        if (n_in != 25 || in_sizes[0] != M * DM || out_size != M * DM || ws_size < WS_END) { fprintf(stderr, "kernel_launch: unexpected shapes (n_in %d in0 %d out %d ws %zu need %zu); nothing launched\n", n_in, n_in > 0 ? in_sizes[0] : -1, out_size, ws_size, (size_t)WS_END); grid = -1; return; }
        int dev = 0, cus = 0, per_cu = 0;
        if (hipGetDevice(&dev) != hipSuccess || hipDeviceGetAttribute(&cus, hipDeviceAttributeMultiprocessorCount, dev) != hipSuccess) { grid = -1; return; }
        if (hipFuncSetAttribute((const void*)hybrid_fwd, hipFuncAttributeMaxDynamicSharedMemorySize, LDS_BYTES) != hipSuccess) { fprintf(stderr, "kernel_launch: hipFuncSetAttribute failed\n"); grid = -1; return; }
        if (hipOccupancyMaxActiveBlocksPerMultiprocessor(&per_cu, (const void*)hybrid_fwd, NTHR, LDS_BYTES) != hipSuccess || per_cu < 1) fprintf(stderr, "kernel_launch: occupancy query reports %d\n", per_cu);
        (void)hipGetLastError();
        grid = cus;
    }
    if (grid < 0) return;
    if (hipMemsetAsync((char*)d_ws + WS_CTL, 0, CTL_ZERO_BYTES, stream) != hipSuccess) return;
    Args a{};
    for (int i = 0; i < 25; ++i) a.in[i] = (const float*)d_in[i];
    a.out = (float*)d_out; a.ws = (unsigned char*)d_ws;
#if ONE_LAUNCH
    a.ph_lo = 0; a.ph_hi = NPHASE;
    hipLaunchKernelGGL(hybrid_fwd, dim3(grid), dim3(NTHR), LDS_BYTES, stream, a);
#else
    for (int p = 0; p < NPHASE; ++p) { a.ph_lo = p; a.ph_hi = p + 1; hipLaunchKernelGGL(hybrid_fwd, dim3(grid), dim3(NTHR), LDS_BYTES, stream, a); }
#endif
}
```

```cpp
#include <hip/hip_runtime.h>
#include <cstdio>
#include <cstdint>

#ifndef ONE_LAUNCH
#define ONE_LAUNCH 1
#endif

#define LAS __attribute__((address_space(3)))
#define GAS __attribute__((address_space(1)))
typedef unsigned short bf16_t;
typedef short bf16x8 __attribute__((ext_vector_type(8)));
typedef float f32x4 __attribute__((ext_vector_type(4)));
typedef float f32x2 __attribute__((ext_vector_type(2)));
typedef float f32x16 __attribute__((ext_vector_type(16)));
typedef unsigned u32x4 __attribute__((ext_vector_type(4)));
typedef unsigned u32x2 __attribute__((ext_vector_type(2)));
typedef __bf16 bf16x2_t __attribute__((ext_vector_type(2)));
typedef short v4i16_t __attribute__((ext_vector_type(4)));

constexpr int DM = 1024, NB = 32, SEQ = 2048, NMETA = 16;
constexpr int M = NB * SEQ;
constexpr int METAROW = M;
constexpr int MTOT = M + 256;
constexpr int NPOS = SEQ + NMETA;
constexpr int DIN_P = 4864;
constexpr int CQKV_LD = 768, CQ_OFF = 384, KR_OFF = 256;
constexpr int QLD = 1536;
constexpr int NEXP = 16384;
constexpr float EPS = 1e-6f;
constexpr float LOG2E = 1.4426950408889634f;
constexpr float QSCALE = 0.10206207261596577f * 1.4426950408889634f;

constexpr size_t A1 = (size_t)MTOT * 1024 * 2;
constexpr size_t WS_CTL = 0, CTL_ZERO_BYTES = 65536;
constexpr size_t WS_WIN = 1u << 20;
constexpr size_t WS_WGATE = WS_WIN + (size_t)DIN_P * 1024 * 2;
constexpr size_t WS_WUQ = WS_WGATE + 2048 * 128 * 2;
constexpr size_t WS_WUKV = WS_WUQ + 1536 * 384 * 2;
constexpr size_t WS_WRNN = WS_WUKV + 2048 * 256 * 2;
constexpr size_t WS_WATT = WS_WRNN + 1024 * 1024 * 2;
constexpr size_t WS_WOUT = WS_WATT + 1024 * 1024 * 2;
constexpr size_t WS_WPQ = WS_WOUT + 1024 * 1024 * 2;
constexpr size_t WS_KEYS = WS_WPQ + 2048 * 1024 * 2;
constexpr size_t WS_PU = WS_KEYS + 256 * 256 * 2;
constexpr size_t WS_PV = WS_PU + (size_t)NEXP * 1024;
constexpr size_t WS_SU = WS_PV + (size_t)NEXP * 1024;
constexpr size_t WS_SV = WS_SU + (size_t)NEXP * 4;
constexpr size_t WS_CTAB = WS_SV + (size_t)NEXP * 4;
constexpr size_t WS_STAB = WS_CTAB + NPOS * 16 * 4;
constexpr size_t WS_CLAM = WS_STAB + NPOS * 16 * 4;
constexpr size_t WS_RSQ = WS_CLAM + 4096;
constexpr size_t WS_RSKV = WS_RSQ + (size_t)MTOT * 4;
constexpr size_t WS_KROPE = WS_RSKV + (size_t)MTOT * 4;
constexpr size_t WS_SCP = WS_KROPE + (size_t)MTOT * 32 * 2;
constexpr size_t WS_SCH = WS_SCP + 512 * 1024 * 4;
constexpr size_t WS_CARRY0 = WS_SCH + 512 * 1024 * 4;
constexpr size_t WS_SLOTS = ((WS_CARRY0 + 4096 + 4095) / 4096) * 4096;
constexpr size_t WS_END = WS_SLOTS + 7 * A1;
#define SLOT(i) (WS_SLOTS + (size_t)(i) * A1)

#define LDS_WAIT() asm volatile("s_waitcnt lgkmcnt(0)" ::: "memory")
#define VM_WAIT() asm volatile("s_waitcnt vmcnt(0)" ::: "memory")
__device__ __forceinline__ unsigned pk2(float lo, float hi) { f32x2 v = {lo, hi}; bf16x2_t b = __builtin_convertvector(v, bf16x2_t); return __builtin_bit_cast(unsigned, b); }
__device__ __forceinline__ float bf_lo(unsigned w) { return __uint_as_float(w << 16); }
__device__ __forceinline__ float bf_hi(unsigned w) { return __uint_as_float(w & 0xffff0000u); }
__device__ __forceinline__ float bf2f(bf16_t h) { return __uint_as_float((unsigned)h << 16); }
__device__ __forceinline__ float ex2(float x) { return __builtin_amdgcn_exp2f(x); }
__device__ __forceinline__ float rcpf_(float x) { return __builtin_amdgcn_rcpf(x); }
__device__ __forceinline__ float sigm(float v) { return rcpf_(1.f + ex2(-LOG2E * v)); }
__device__ __forceinline__ float gelu_t(float v) { const float y = v * (1.f + 0.044715f * v * v); return v * rcpf_(1.f + ex2(-2.302208198f * y)); }
__device__ __forceinline__ float wave_sum(float v) {
#pragma unroll
    for (int o = 1; o < 64; o <<= 1) v += __shfl_xor(v, o);
    return v;
}
__device__ __forceinline__ void unpack8(u32x4 w, float (&o)[8]) { o[0] = bf_lo(w.x); o[1] = bf_hi(w.x); o[2] = bf_lo(w.y); o[3] = bf_hi(w.y); o[4] = bf_lo(w.z); o[5] = bf_hi(w.z); o[6] = bf_lo(w.w); o[7] = bf_hi(w.w); }
__device__ __forceinline__ u32x4 pack8(const float (&o)[8]) { u32x4 w; w.x = pk2(o[0], o[1]); w.y = pk2(o[2], o[3]); w.z = pk2(o[4], o[5]); w.w = pk2(o[6], o[7]); return w; }
__device__ __forceinline__ float dot2bf(unsigned a, unsigned b, float acc) { return __builtin_amdgcn_fdot2_f32_bf16(__builtin_bit_cast(bf16x2_t, a), __builtin_bit_cast(bf16x2_t, b), acc, false); }

typedef float f32x32 __attribute__((ext_vector_type(32)));
typedef unsigned u32x6 __attribute__((ext_vector_type(6)));
typedef __bf16 bf16x32 __attribute__((ext_vector_type(32)));
__device__ __forceinline__ float fp6_probe_val(int i) { return i < 8 ? 0.125f * i : i < 16 ? 1.f + 0.125f * (i - 8) : i < 24 ? 2.f + 0.25f * (i - 16) : 4.f + 0.5f * (i - 24); }
__device__ __forceinline__ int fp6_code(float v) { return v < 1.f ? (int)(v * 8.f + 0.5f) : (int)(__float_as_uint(v) >> 20) - 1016 + 8; }
template <bool BF> __device__ __forceinline__ void fp6_sigma(int (&sig)[32]) {
    f32x16 lo, hi;
#pragma unroll
    for (int i = 0; i < 16; ++i) { lo[i] = fp6_probe_val(i); hi[i] = fp6_probe_val(16 + i); }
    asm volatile("" : "+v"(lo), "+v"(hi));
    const u32x6 p = __builtin_amdgcn_cvt_scalef32_2xpk16_fp6_f32(lo, hi, 1.0f);
    if (BF) { const bf16x32 r = __builtin_amdgcn_cvt_scalef32_pk32_bf16_fp6(p, 1.0f);
#pragma unroll
        for (int j = 0; j < 32; ++j) sig[j] = __builtin_amdgcn_readfirstlane(fp6_code((float)r[j])) & 31;
    } else { const f32x32 r = __builtin_amdgcn_cvt_scalef32_pk32_f32_fp6(p, 1.0f);
#pragma unroll
        for (int j = 0; j < 32; ++j) sig[j] = __builtin_amdgcn_readfirstlane(fp6_code(r[j])) & 31; }
}

namespace pg8 {
constexpr int BM = 256, BK = 64, HALF = 128, HTB = HALF * BK * 2, STAGE_BYTES = 8 * HTB, NXCD = 8, WGM = 8;
__host__ __device__ __forceinline__ int lds_byte(int r, int c) { const int st = (r >> 4) * 2 + (c >> 5), rr = r & 15, cc = c & 31, ob = rr * 64 + cc * 2; return st * 1024 + (ob ^ (((ob >> 9) & 1) << 5)); }
__host__ __device__ __forceinline__ void stage_rc(int b, int& R, int& C) { const int st = b / 1024, sb = b % 1024, swz = sb ^ (((sb >> 9) & 1) << 5); R = (st >> 1) * 16 + swz / 64; C = (st & 1) * 32 + (swz % 64) / 2; }
__host__ __device__ __forceinline__ int perm32(int rho) { const int n = rho >> 4, i = rho & 15; return 8 * (i >> 2) + 4 * n + (i & 3); }

struct Unit { int pm, pn; };
struct Gemm { const bf16_t* A; const bf16_t* Bt; int lda, ldb, K, a_pn_off, b_pn_stride; };

struct Sched {
    int nM, nN, nwg, G, c, xpm, xn, xskip;
    __device__ __forceinline__ void init(int nM_, int nN_, int G_, int c_, int xpm_, int xn_, int xskip_) { nM = nM_; nN = nN_; nwg = nM_ * nN_; G = G_; c = c_; xpm = xpm_; xn = xn_; xskip = xskip_; }
    __device__ __forceinline__ bool next(int i, Unit& u) const {
        const int nmain = nwg > c ? (nwg - c - 1) / G + 1 : 0;
        if (i < nmain) {
            int wgid = i * G + c; { const int q = nwg / NXCD, r = nwg % NXCD, xcd = wgid % NXCD, off = wgid / NXCD; wgid = (xcd < r ? xcd * (q + 1) : r * (q + 1) + (xcd - r) * q) + off; }
            const int nig = WGM * nN, gid = wgid / nig, fm = gid * WGM, gsz = (nM - fm) < WGM ? (nM - fm) : WGM;
            u.pm = fm + ((wgid % nig) % gsz); u.pn = (wgid % nig) / gsz; return true;
        }
        const int e = G - 1 - c;
        if (i == nmain && e < xn) { u.pm = xpm; u.pn = e + (e >= 4 ? xskip : 0); return true; }
        return false;
    }
};

template <class F> struct Epi8 {
    static constexpr bool PERM = true;
    F f;
    __device__ __forceinline__ void operator()(const f32x4 (&acc)[2][2][4][2], const Unit& u, int wr, int wc, int fr, int fq) const {
        const int row0 = u.pm * BM + wr * 64 + fr, col0 = u.pn * BM + wc * 32 + 8 * fq;
#pragma unroll
        for (int ai = 0; ai < 2; ++ai) {
            typename F::Pre pre[4][2];
#pragma unroll
            for (int m = 0; m < 4; ++m)
#pragma unroll
                for (int bj = 0; bj < 2; ++bj) pre[m][bj] = f.load(u.pn, row0 + ai * HALF + m * 16, col0 + bj * HALF);
#pragma unroll
            for (int m = 0; m < 4; ++m)
#pragma unroll
                for (int bj = 0; bj < 2; ++bj) f.apply(pre[m][bj], u.pn, row0 + ai * HALF + m * 16, col0 + bj * HALF, acc[ai][bj][m][0], acc[ai][bj][m][1]);
        }
    }
};
template <class F> struct EpiPair {
    static constexpr bool PERM = true;
    F f;
    __device__ __forceinline__ void operator()(const f32x4 (&acc)[2][2][4][2], const Unit& u, int wr, int wc, int fr, int fq) const {
        const int row0 = u.pm * BM + wr * 64 + fr, col0 = wc * 32 + 8 * fq;
#pragma unroll
        for (int ai = 0; ai < 2; ++ai) {
            typename F::Pre pre[4];
#pragma unroll
            for (int m = 0; m < 4; ++m) pre[m] = f.load(u.pn, row0 + ai * HALF + m * 16, col0);
#pragma unroll
            for (int m = 0; m < 4; ++m) f.apply(pre[m], u.pn, row0 + ai * HALF + m * 16, col0, acc[ai][0][m][0], acc[ai][0][m][1], acc[ai][1][m][0], acc[ai][1][m][1]);
        }
    }
};

template <class Epi>
__device__ __forceinline__ void gemm_phase(LAS unsigned char* lds, const Gemm g, const Sched& S, const Epi& E) {
    int tid_ = threadIdx.x; asm volatile("" : "+v"(tid_));
    const int tid = tid_, wid = __builtin_amdgcn_readfirstlane(tid >> 6), lane = tid & 63, wr = wid >> 2, wc = wid & 3, fr = lane & 15, fq = lane >> 4;
    int nt_ = g.K / BK; asm volatile("" : "+s"(nt_));
    const int nt = nt_;
    unsigned voffA[2], voffB[2];
#pragma unroll
    for (int i = 0; i < 2; ++i) { int R, C; stage_rc(tid * 16 + i * 8192, R, C); const int Rb = Epi::PERM ? ((R & ~31) + perm32(R & 31)) : R;
        voffA[i] = (unsigned)(R * g.lda + C) * 2u; voffB[i] = (unsigned)(Rb * g.ldb + C) * 2u; }
    const size_t kstep = (size_t)(BK * 2);
    const size_t hA = (size_t)HALF * g.lda * 2, hB = (size_t)HALF * g.ldb * 2;
    const unsigned ldsw = (unsigned)wid * 1024u;
    const int aoff = lds_byte(wr * 64 + fr, fq * 8), boff = lds_byte(wc * 32 + fr, fq * 8);
#define PG8_SA(b, h) (((b) * 2 + (h)) * HTB)
#define PG8_SB(b, h) ((4 + (b) * 2 + (h)) * HTB)
#define PG8_STAGE(bufoff, gbase, voff) do { _Pragma("unroll") for (int _i = 0; _i < 2; ++_i) \
        __builtin_amdgcn_global_load_lds((const unsigned*)((const char*)(gbase) + (voff)[_i]), (LAS unsigned*)(lds + (bufoff) + ldsw + _i * 8192), 16, 0, 0); } while (0)
#define PG8_LDA(dst, b, h) do { _Pragma("unroll") for (int m = 0; m < 4; ++m) _Pragma("unroll") for (int k = 0; k < 2; ++k) dst[m][k] = *(const LAS bf16x8*)(lds + PG8_SA(b, h) + aoff + m * 2048 + k * 1024); } while (0)
#define PG8_LDB(dst, b, h) do { _Pragma("unroll") for (int n = 0; n < 2; ++n) _Pragma("unroll") for (int k = 0; k < 2; ++k) dst[n][k] = *(const LAS bf16x8*)(lds + PG8_SB(b, h) + boff + n * 2048 + k * 1024); } while (0)
#define PG8_MMA(ai, bj, At, Bt) do { __builtin_amdgcn_s_setprio(1); _Pragma("unroll") for (int m = 0; m < 4; ++m) _Pragma("unroll") for (int n = 0; n < 2; ++n) _Pragma("unroll") for (int k = 0; k < 2; ++k) \
        acc[ai][bj][m][n] = __builtin_amdgcn_mfma_f32_16x16x32_bf16(Bt[n][k], At[m][k], acc[ai][bj][m][n], 0, 0, 0); __builtin_amdgcn_s_setprio(0); } while (0)
#define PG8_WAIT_V(n) asm volatile("s_waitcnt vmcnt(" #n ")" ::: "memory")
#define PG8_WAIT_L(n) asm volatile("s_waitcnt lgkmcnt(" #n ")" ::: "memory")
#define PG8_BAR __builtin_amdgcn_s_barrier()
#define PG8_SCHED __builtin_amdgcn_sched_barrier(0)
#define PG8_ABASE(u) ((const char*)g.A + ((size_t)(u).pm * BM * g.lda + (size_t)(u).pn * g.a_pn_off) * 2)
#define PG8_BBASE(u) ((const char*)g.Bt + (size_t)(u).pn * g.b_pn_stride * 2)
    Unit cur, nxt; int ui = 0;
    if (!S.next(0, cur)) return;
    f32x4 acc[2][2][4][2];
#pragma unroll
    for (int a = 0; a < 2; ++a)
#pragma unroll
        for (int b = 0; b < 2; ++b)
#pragma unroll
            for (int m = 0; m < 4; ++m)
#pragma unroll
                for (int n = 0; n < 2; ++n) acc[a][b][m][n] = (f32x4){0.f, 0.f, 0.f, 0.f};
    bf16x8 At[4][2], B0[2][2], B1[2][2];
    const char* cA = PG8_ABASE(cur); const char* cB = PG8_BBASE(cur);
    PG8_STAGE(PG8_SB(0, 0), cB, voffB); PG8_STAGE(PG8_SB(0, 1), cB + hB, voffB); PG8_STAGE(PG8_SA(0, 0), cA, voffA); PG8_STAGE(PG8_SA(0, 1), cA + hA, voffA);
    if (wr == 1) PG8_BAR;
    PG8_WAIT_V(2); PG8_BAR;
    PG8_STAGE(PG8_SB(1, 0), cB + kstep, voffB); PG8_STAGE(PG8_SA(1, 0), cA + kstep, voffA); PG8_STAGE(PG8_SB(1, 1), cB + hB + kstep, voffB);
    PG8_WAIT_V(6); PG8_BAR;
    for (;;) {
        const bool has_next = S.next(ui + 1, nxt);
        const char* nA = has_next ? PG8_ABASE(nxt) : cA; const char* nB = has_next ? PG8_BBASE(nxt) : cB;
        asm volatile("" : "+s"(cA), "+s"(cB), "+s"(nA), "+s"(nB));
#pragma unroll 1
        for (int t = 0; t < nt; t += 2) {
            const bool last = (t == nt - 2);
            const char* a1 = cA + (size_t)(t + 1) * kstep;
            const char* a2 = last ? nA : cA + (size_t)(t + 2) * kstep; const char* b2 = last ? nB : cB + (size_t)(t + 2) * kstep;
            const char* a3 = a2 + kstep; const char* b3 = b2 + kstep;
            PG8_LDB(B0, 0, 0); PG8_LDB(B1, 0, 1); PG8_SCHED; PG8_LDA(At, 0, 0); PG8_STAGE(PG8_SA(1, 1), a1 + hA, voffA);
            PG8_WAIT_V(8); PG8_WAIT_L(0); PG8_BAR; PG8_MMA(0, 0, At, B0); PG8_MMA(0, 1, At, B1); PG8_BAR; PG8_SCHED;
            PG8_LDA(At, 0, 1); PG8_STAGE(PG8_SB(0, 0), b2, voffB); PG8_STAGE(PG8_SB(0, 1), b2 + hB, voffB); PG8_STAGE(PG8_SA(0, 0), a2, voffA);
            PG8_WAIT_V(8); PG8_WAIT_L(0); PG8_BAR; PG8_MMA(1, 0, At, B0); PG8_MMA(1, 1, At, B1); PG8_BAR; PG8_SCHED;
            PG8_LDB(B0, 1, 0); PG8_LDB(B1, 1, 1); PG8_SCHED; PG8_LDA(At, 1, 0); PG8_STAGE(PG8_SA(0, 1), a2 + hA, voffA);
            PG8_WAIT_V(8); PG8_WAIT_L(0); PG8_BAR; PG8_MMA(0, 0, At, B0); PG8_MMA(0, 1, At, B1); PG8_BAR; PG8_SCHED;
            PG8_LDA(At, 1, 1); PG8_STAGE(PG8_SB(1, 0), b3, voffB); PG8_STAGE(PG8_SB(1, 1), b3 + hB, voffB); PG8_STAGE(PG8_SA(1, 0), a3, voffA);
            PG8_WAIT_V(8); PG8_WAIT_L(0); PG8_BAR; PG8_MMA(1, 0, At, B0); PG8_MMA(1, 1, At, B1); PG8_BAR; PG8_SCHED;
        }
        if (wr == 0) PG8_BAR;
        E(acc, cur, wr, wc, fr, fq);
        if (!has_next) break;
#pragma unroll
        for (int a = 0; a < 2; ++a)
#pragma unroll
            for (int b = 0; b < 2; ++b)
#pragma unroll
                for (int m = 0; m < 4; ++m)
#pragma unroll
                    for (int n = 0; n < 2; ++n) acc[a][b][m][n] = (f32x4){0.f, 0.f, 0.f, 0.f};
        cur = nxt; cA = nA; cB = nB; ++ui;
        if (wr == 1) PG8_BAR;
    }
    PG8_WAIT_V(0);
    PG8_BAR;
#undef PG8_SA
#undef PG8_SB
#undef PG8_STAGE
#undef PG8_LDA
#undef PG8_LDB
#undef PG8_MMA
#undef PG8_WAIT_V
#undef PG8_WAIT_L
#undef PG8_BAR
#undef PG8_SCHED
#undef PG8_ABASE
#undef PG8_BBASE
}
}

#define XB_TMO      128
#define XB_XCNT(j)  (256  + 64 * (j))
#define XB_XSUB(j)  (1280 + 64 * (j))
#define XB_XGEN(j)  (2304 + 64 * (j))
#define XB_TOP      3328
#define XB_TOPGEN   3392
#define XCD_BAR_WORDS 3456
#define XB_SPIN_CAP (1u << 18)
__device__ __forceinline__ unsigned xb_ld(unsigned* p)              { return __hip_atomic_load(p, __ATOMIC_RELAXED, __HIP_MEMORY_SCOPE_AGENT); }
__device__ __forceinline__ unsigned xb_add(unsigned* p, unsigned v) { return __hip_atomic_fetch_add(p, v, __ATOMIC_RELAXED, __HIP_MEMORY_SCOPE_AGENT); }
__device__ __forceinline__ unsigned xb_xcc_id() { return (unsigned)__builtin_amdgcn_s_getreg((3 << 11) | 20) & 0xFu; }
#define XB_SPIN(cond, bar) do { unsigned _sp = 0; while (cond) { __builtin_amdgcn_s_sleep(1); \
    if ((++_sp & 255u) == 0u) { if (xb_ld(&(bar)[XB_TMO])) break; if (_sp > XB_SPIN_CAP) { atomicAdd(&(bar)[XB_TMO], 1u); break; } } } } while (0)
struct XcdBarrier { unsigned* bar; unsigned x; volatile LAS unsigned* st; };
__device__ __forceinline__ XcdBarrier xcd_barrier_post(unsigned* bar, volatile LAS unsigned* st) {
    XcdBarrier b; b.bar = bar; b.x = xb_xcc_id(); b.st = st;
    if (threadIdx.x == 0) (void)xb_add(&bar[XB_XCNT(b.x)], 1u);
    return b;
}
__device__ __forceinline__ void xcd_barrier_complete(unsigned* bar, unsigned x, unsigned& nloc, unsigned& nx) {
    const unsigned G = gridDim.x * gridDim.y * gridDim.z;
    unsigned sum, cnt, mine, sp = 0u;
    for (;;) {
        sum = 0u; cnt = 0u; mine = 0u;
#pragma unroll
        for (unsigned j = 0; j < 16; ++j) { const unsigned c = xb_ld(&bar[XB_XCNT(j)]); sum += c; cnt += (c > 0u) ? 1u : 0u; mine = (j == x) ? c : mine; }
        if (sum == G) break;
        __builtin_amdgcn_s_sleep(1);
        if ((++sp & 255u) == 0u) { if (xb_ld(&bar[XB_TMO])) break; if (sp > XB_SPIN_CAP) { atomicAdd(&bar[XB_TMO], 1u); break; } }
    }
    nloc = mine > 0u ? mine : 1u; nx = cnt > 0u ? cnt : 1u;
}
__device__ __forceinline__ void xcd_barrier(const XcdBarrier& b) {
    asm volatile("s_waitcnt vmcnt(0)" ::: "memory");
    __syncthreads();
    if (threadIdx.x == 0) {
        unsigned* bar = b.bar;
        __builtin_amdgcn_s_waitcnt(0);
        unsigned nloc = b.st[0], nx = b.st[1];
        if (nloc == 0u) { xcd_barrier_complete(bar, b.x, nloc, nx); b.st[0] = nloc; b.st[1] = nx; }
        const unsigned old = xb_add(&bar[XB_XSUB(b.x)], 1u);
        const unsigned gen = old / nloc;
        if (old + 1u == (gen + 1u) * nloc) {
            __builtin_amdgcn_fence(__ATOMIC_RELEASE, "agent");
            asm volatile("s_waitcnt vmcnt(0)" ::: "memory");
            const unsigned og = xb_add(&bar[XB_TOP], 1u);
            const unsigned tg = og / nx;
            if (og + 1u == (tg + 1u) * nx) xb_add(&bar[XB_TOPGEN], 1u);
            else XB_SPIN(xb_ld(&bar[XB_TOPGEN]) == tg, bar);
            __builtin_amdgcn_fence(__ATOMIC_ACQUIRE, "agent");
            xb_add(&bar[XB_XGEN(b.x)], 1u);
            asm volatile("s_waitcnt vmcnt(0)" ::: "memory");
        } else {
            XB_SPIN(xb_ld(&bar[XB_XGEN(b.x)]) == gen, bar);
            __builtin_amdgcn_fence(__ATOMIC_ACQUIRE, "agent");
            asm volatile("s_waitcnt vmcnt(0)" ::: "memory");
        }
    }
    __syncthreads();
}

constexpr int NWAVES = 8, NTHR = 512;
constexpr int RING_BYTES = 131072, MISC_OFF = RING_BYTES + 320, LDS_BYTES = 147456;
struct Args { const float* in[25]; float* out; unsigned char* ws; int ph_lo, ph_hi; };
static_assert(sizeof(Args) == 25 * 8 + 8 + 8 + 8, "Args has no padding");

struct Ctx {
    LAS unsigned char* lds; int tid, lane, wave, G, gw, NGW;
    unsigned char* ws; float* out; const float* const* in;
};

__device__ __forceinline__ void store8(bf16_t* p, f32x4 a, f32x4 b) { u32x4 w; w.x = pk2(a[0], a[1]); w.y = pk2(a[2], a[3]); w.z = pk2(b[0], b[1]); w.w = pk2(b[2], b[3]); *(u32x4*)p = w; }
struct NoPre {};
struct FInproj {
    typedef NoPre Pre;
    bf16_t *XR, *GR, *CQKV, *GRNN, *GATT;
    __device__ __forceinline__ Pre load(int, int, int) const { return Pre(); }
    __device__ __forceinline__ void apply(const Pre&, int pn, int row, int col, f32x4 a, f32x4 b) const {
        if (pn < 4) { store8(XR + (size_t)row * 1024 + col, a, b); }
        else if (pn < 8) {
#pragma unroll
            for (int i = 0; i < 4; ++i) { a[i] = gelu_t(a[i]); b[i] = gelu_t(b[i]); }
            store8(GR + (size_t)row * 1024 + (col - 1024), a, b); }
        else if (pn < 11) { store8(CQKV + (size_t)row * CQKV_LD + (col - 2048), a, b); }
        else {
#pragma unroll
            for (int i = 0; i < 4; ++i) { a[i] = sigm(a[i]); b[i] = sigm(b[i]); }
            if (pn < 15) store8(GRNN + (size_t)row * 1024 + (col - 2816), a, b); else store8(GATT + (size_t)row * 1024 + (col - 3840), a, b); }
    }
};
struct FGate {
    struct Pre { u32x4 xc; };
    const bf16_t* XC; const float *ba, *bx, *clam; bf16_t *LA, *UU;
    __device__ __forceinline__ Pre load(int pn, int row, int cl) const { Pre p; p.xc = *(const u32x4*)(XC + (size_t)row * 1024 + pn * 128 + cl); return p; }
    __device__ __forceinline__ void apply(const Pre& pr, int pn, int row, int cl, f32x4 a0, f32x4 a1, f32x4 x0, f32x4 x1) const {
        const int ch = pn * 128 + cl; const size_t off = (size_t)row * 1024 + ch;
        float xc[8]; unpack8(pr.xc, xc);
        const f32x4 ba0 = *(const f32x4*)(ba + ch), ba1 = *(const f32x4*)(ba + ch + 4), bx0 = *(const f32x4*)(bx + ch), bx1 = *(const f32x4*)(bx + ch + 4), cl0 = *(const f32x4*)(clam + ch), cl1 = *(const f32x4*)(clam + ch + 4);
        float la[8], uu[8];
#pragma unroll
        for (int i = 0; i < 8; ++i) {
            const float ga = (i < 4 ? a0[i & 3] + ba0[i & 3] : a1[i & 3] + ba1[i & 3]), gx = (i < 4 ? x0[i & 3] + bx0[i & 3] : x1[i & 3] + bx1[i & 3]), cc = (i < 4 ? cl0[i & 3] : cl1[i & 3]);
            const float r = sigm(ga), ig = sigm(gx), l = r * cc;
            la[i] = l; uu[i] = sqrtf(fmaxf(1.f - ex2(2.f * LOG2E * l), 0.f)) * (ig * xc[i]);
        }
        *(u32x4*)(LA + off) = pack8(la); *(u32x4*)(UU + off) = pack8(uu);
    }
};
struct FQ {
    struct Pre { float sc; };
    const float* rsq; bf16_t* Q;
    __device__ __forceinline__ Pre load(int, int row, int) const { Pre p; p.sc = rsq[row]; return p; }
    __device__ __forceinline__ void apply(const Pre& pr, int pn, int row, int col, f32x4 a, f32x4 b) const {
        const float sc = pr.sc * QSCALE; a = a * sc; b = b * sc;
        store8(Q + (size_t)row * QLD + col, a, b);
    }
};
struct FKV {
    struct Pre { float sc; };
    const float* rskv; bf16_t *KN, *V;
    __device__ __forceinline__ Pre load(int, int row, int) const { Pre p; p.sc = rskv[row]; return p; }
    __device__ __forceinline__ void apply(const Pre& pr, int pn, int row, int col, f32x4 a, f32x4 b) const {
        const float sc = pr.sc; a = a * sc; b = b * sc;
        if (pn < 4) store8(KN + (size_t)row * 1024 + col, a, b); else store8(V + (size_t)row * 1024 + (col - 1024), a, b);
    }
};
template <bool HAS_ADD> struct FMul {
    struct Pre { u32x4 g, ad; };
    const bf16_t* Gt; const bf16_t* ADD; bf16_t* O;
    __device__ __forceinline__ Pre load(int, int row, int col) const { const size_t off = (size_t)row * 1024 + col; Pre p; p.g = *(const u32x4*)(Gt + off); if (HAS_ADD) p.ad = *(const u32x4*)(ADD + off); else p.ad = (u32x4){0u, 0u, 0u, 0u}; return p; }
    __device__ __forceinline__ void apply(const Pre& pr, int pn, int row, int col, f32x4 a, f32x4 b) const {
        const size_t off = (size_t)row * 1024 + col; float gg[8]; unpack8(pr.g, gg);
        if (HAS_ADD) { float ad[8]; unpack8(pr.ad, ad);
#pragma unroll
            for (int i = 0; i < 4; ++i) { a[i] = ad[i] + gg[i] * a[i]; b[i] = ad[4 + i] + gg[4 + i] * b[i]; } }
        else {
#pragma unroll
            for (int i = 0; i < 4; ++i) { a[i] = gg[i] * a[i]; b[i] = gg[4 + i] * b[i]; } }
        store8(O + off, a, b);
    }
};
struct FRes {
    struct Pre { f32x4 x0, x1; };
    const float* X; bf16_t* H1B;
    __device__ __forceinline__ Pre load(int, int row, int col) const { const size_t off = (size_t)row * 1024 + col; Pre p; p.x0 = *(const f32x4*)(X + off); p.x1 = *(const f32x4*)(X + off + 4); return p; }
    __device__ __forceinline__ void apply(const Pre& pr, int pn, int row, int col, f32x4 a, f32x4 b) const {
        store8(H1B + (size_t)row * 1024 + col, a + pr.x0, b + pr.x1);
    }
};
typedef _Float16 f16x8 __attribute__((ext_vector_type(8)));
struct FF16 { typedef NoPre Pre; _Float16* O; int ldc;
    __device__ __forceinline__ Pre load(int, int, int) const { return Pre(); }
    __device__ __forceinline__ void apply(const Pre&, int pn, int row, int col, f32x4 a, f32x4 b) const {
        f16x8 h = {(_Float16)a[0], (_Float16)a[1], (_Float16)a[2], (_Float16)a[3], (_Float16)b[0], (_Float16)b[1], (_Float16)b[2], (_Float16)b[3]};
        *(f16x8*)(O + (size_t)row * ldc + col) = h; } };
struct FF32 { typedef NoPre Pre; float* O; int ldc;
    __device__ __forceinline__ Pre load(int, int, int) const { return Pre(); }
    __device__ __forceinline__ void apply(const Pre&, int pn, int row, int col, f32x4 a, f32x4 b) const { float* p = O + (size_t)row * ldc + col; *(f32x4*)p = a; *(f32x4*)(p + 4) = b; } };

struct MapId { __device__ __forceinline__ int operator()(int n) const { return n; } };
struct MapWin { __device__ __forceinline__ int operator()(int n) const {
    if (n < 2048) return n;
    if (n < 2816) { const int c = n - 2048; if (c < 256) return 2432 + c; if (c < 288) return 2688 + (c - 256); if (c < 384) return -1; return 2048 + (c - 384); }
    if (n < 3840) return 2720 + (n - 2816);
    return 3744 + (n - 3840); } };
struct MapUq { __device__ __forceinline__ int operator()(int n) const { const int h = n / 96, w = n % 96; if (w < 64) return n; const int t = w - 64; return h * 96 + 64 + (t >> 1) + 16 * (t & 1); } };
struct MapUkv { __device__ __forceinline__ int operator()(int n) const { if (n < 1024) return (n >> 6) * 128 + (n & 63); const int m = n - 1024; return (m >> 6) * 128 + 64 + (m & 63); } };

template <class Map> __device__ __forceinline__ void transpose_item(const float* W, int ldw, int Ndst, bf16_t* WT, int ldt, const float* kscale, LAS float* scr, int item, int lane, Map map) {
    const int nblk = Ndst / 32, kb = item / nblk, nb = item % nblk, k0 = 64 * kb, n0 = 32 * nb;
    const int src = map(n0 + (lane & 31));
#pragma unroll 8
    for (int i = 0; i < 32; ++i) { const int kk = 2 * i + (lane >> 5); float v = 0.f; if (src >= 0) { v = W[(size_t)(k0 + kk) * ldw + src]; if (kscale) v *= kscale[k0 + kk]; } scr[kk * 33 + (lane & 31)] = v; }
    LDS_WAIT(); asm volatile("" ::: "memory");
    const int c = lane & 7;
#pragma unroll
    for (int j = 0; j < 4; ++j) { const int n = (lane >> 3) + 8 * j; const LAS float* s = scr + (8 * c) * 33 + n;
        u32x4 o; o.x = pk2(s[0 * 33], s[1 * 33]); o.y = pk2(s[2 * 33], s[3 * 33]); o.z = pk2(s[4 * 33], s[5 * 33]); o.w = pk2(s[6 * 33], s[7 * 33]);
        *(u32x4*)(WT + (size_t)(n0 + n) * ldt + k0 + 8 * c) = o; }
    LDS_WAIT(); asm volatile("" ::: "memory");
}
__device__ __forceinline__ void rms_row_bf16(const float* xrow, const float* g, bf16_t* orow, int lane) {
    const f32x4* xr = (const f32x4*)xrow + lane; f32x4 v[4]; float s = 0.f;
#pragma unroll
    for (int j = 0; j < 4; ++j) { v[j] = xr[64 * j]; s += (v[j][0] * v[j][0] + v[j][1] * v[j][1]) + (v[j][2] * v[j][2] + v[j][3] * v[j][3]); }
    const float rstd = 1.f / sqrtf(wave_sum(s) * (1.f / 1024.f) + EPS);
    u32x2* o8 = (u32x2*)orow + lane;
#pragma unroll
    for (int j = 0; j < 4; ++j) { const f32x4 gg = ((const f32x4*)g)[lane + 64 * j]; u32x2 w; w.x = pk2(v[j][0] * rstd * gg[0], v[j][1] * rstd * gg[1]); w.y = pk2(v[j][2] * rstd * gg[2], v[j][3] * rstd * gg[3]); o8[64 * j] = w; }
}
__device__ __forceinline__ void rms_row_f32(const float* xrow, const float* g, float* orow, int lane) {
    const f32x4* xr = (const f32x4*)xrow + lane; f32x4 v[4]; float s = 0.f;
#pragma unroll
    for (int j = 0; j < 4; ++j) { v[j] = xr[64 * j]; s += (v[j][0] * v[j][0] + v[j][1] * v[j][1]) + (v[j][2] * v[j][2] + v[j][3] * v[j][3]); }
    const float rstd = 1.f / sqrtf(wave_sum(s) * (1.f / 1024.f) + EPS);
#pragma unroll
    for (int j = 0; j < 4; ++j) { const f32x4 gg = ((const f32x4*)g)[lane + 64 * j]; ((f32x4*)orow)[lane + 64 * j] = v[j] * rstd * gg; }
}

__device__ __forceinline__ void phase_prologue(const Ctx& C) {
    unsigned char* ws = C.ws; const float* const* in = C.in;
    LAS float* scr = (LAS float*)(C.lds + C.wave * 16384);
    const int gw = C.gw, NGW = C.NGW, lane = C.lane;
    constexpr int I_WIN = 16 * (DIN_P / 32), I_UQ = 6 * (1536 / 32), I_UKV = 4 * (2048 / 32), I_SQ = 16 * 32, I_G = 2 * 4;
    constexpr int NITEMS = I_WIN + I_UQ + I_UKV + 3 * I_SQ + 16 * I_G;
    for (int it = gw; it < NITEMS; it += NGW) {
        int r = it;
        if (r < I_WIN) { transpose_item(in[3], 4768, DIN_P, (bf16_t*)(ws + WS_WIN), 1024, nullptr, scr, r, lane, MapWin()); continue; } r -= I_WIN;
        if (r < I_UQ) { transpose_item(in[13], 1536, 1536, (bf16_t*)(ws + WS_WUQ), 384, in[12], scr, r, lane, MapUq()); continue; } r -= I_UQ;
        if (r < I_UKV) { transpose_item(in[15], 2048, 2048, (bf16_t*)(ws + WS_WUKV), 256, in[14], scr, r, lane, MapUkv()); continue; } r -= I_UKV;
        if (r < I_SQ) { transpose_item(in[11], 1024, 1024, (bf16_t*)(ws + WS_WRNN), 1024, nullptr, scr, r, lane, MapId()); continue; } r -= I_SQ;
        if (r < I_SQ) { transpose_item(in[16], 1024, 1024, (bf16_t*)(ws + WS_WATT), 1024, nullptr, scr, r, lane, MapId()); continue; } r -= I_SQ;
        if (r < I_SQ) { transpose_item(in[17], 1024, 1024, (bf16_t*)(ws + WS_WOUT), 1024, nullptr, scr, r, lane, MapId()); continue; } r -= I_SQ;
        { const int mat = r / I_G, sub = r % I_G, blk = mat >> 1, which = mat & 1;
          transpose_item((which ? in[8] : in[6]) + (size_t)blk * 16384, 128, 128, (bf16_t*)(ws + WS_WGATE) + (size_t)(blk * 256 + which * 128) * 128, 128, nullptr, scr, sub, lane, MapId()); }
    }
    const int gt = blockIdx.x * NTHR + C.tid, NT = C.G * NTHR;
    for (int it = blockIdx.x; it < 256; it += C.G) {
        const int hh = it >> 4, kc = it & 15, half = hh & 1, k = kc * 64 + lane, c0 = 16 * C.wave;
        const f32x4* keys = (const f32x4*)((half ? in[21] : in[20]) + (size_t)c0 * 128);
        LAS f32x4* ks = (LAS f32x4*)scr;
#pragma unroll
        for (int j = 0; j < 8; ++j) ks[j * 64 + lane] = keys[j * 64 + lane];
        const f32x4* wq = (const f32x4*)(in[19] + (size_t)k * 2048 + hh * 128); const float g2k = in[18][k];
        f32x4 a[32];
#pragma unroll
        for (int d4 = 0; d4 < 32; ++d4) a[d4] = wq[d4];
        LDS_WAIT(); asm volatile("" ::: "memory");
        bf16_t* o = (bf16_t*)(ws + WS_WPQ) + (size_t)(hh * 128 + c0) * 1024 + k;
#pragma unroll 4
        for (int c = 0; c < 16; ++c) { float s0 = 0.f, s1 = 0.f;
#pragma unroll
            for (int d4 = 0; d4 < 32; d4 += 2) { const f32x4 k0 = ks[c * 32 + d4], k1 = ks[c * 32 + d4 + 1]; s0 += (a[d4][0] * k0[0] + a[d4][1] * k0[1]) + (a[d4][2] * k0[2] + a[d4][3] * k0[3]); s1 += (a[d4 + 1][0] * k1[0] + a[d4 + 1][1] * k1[1]) + (a[d4 + 1][2] * k1[2] + a[d4 + 1][3] * k1[3]); }
            o[(size_t)c * 1024] = (bf16_t)(pk2((s0 + s1) * g2k, 0.f) & 0xffffu); }
        LDS_WAIT(); asm volatile("" ::: "memory");
    }
    for (int i = gt; i < NPOS * 16; i += NT) { const int pos = i >> 4, j = i & 15; const float inv = exp2f(-(float)j * (13.287712379549449f / 16.f)); const float ang = (float)pos * inv;
        float t = ang * 0.15915494309189535f; t = t - floorf(t);
        ((float*)(ws + WS_CTAB))[i] = __builtin_amdgcn_cosf(t); ((float*)(ws + WS_STAB))[i] = __builtin_amdgcn_sinf(t); }
    for (int i = gt; i < 1024; i += NT) { const float lam = in[10][i]; ((float*)(ws + WS_CLAM))[i] = -8.f * log1pf(expf(-lam)); }
    {
        int sgu[32], sgv[32]; fp6_sigma<true>(sgu); fp6_sigma<false>(sgv);
        const int ll = lane & 31;
        f32x4 g2h[8];
#pragma unroll
        for (int j = 0; j < 8; ++j) g2h[j] = ((const f32x4*)(in[18] + 32 * ll))[j];
        for (int pr = gw; pr < NEXP; pr += NGW) {
            const int tbl = pr >= NEXP / 2, e = 2 * (pr - tbl * (NEXP / 2)) + (lane >> 5);
            const f32x4* src = (const f32x4*)((tbl ? in[23] : in[22]) + (size_t)e * 1024 + 32 * ll);
            f32x4 v[8]; float am = 0.f;
#pragma unroll
            for (int j = 0; j < 8; ++j) { v[j] = src[j]; if (!tbl) v[j] *= g2h[j]; am = fmaxf(am, fmaxf(fmaxf(fabsf(v[j][0]), fabsf(v[j][1])), fmaxf(fabsf(v[j][2]), fabsf(v[j][3])))); }
#pragma unroll
            for (int o = 1; o < 32; o <<= 1) am = fmaxf(am, __shfl_xor(am, o));
            const float scale = am > 0.f ? am * (1.f / 7.5f) : 1.f, inv = 1.f / scale;
            if (tbl) {
#pragma unroll
                for (int j = 0; j < 32; ++j) scr[33 * lane + sgv[j]] = v[j >> 2][j & 3] * inv;
            } else {
#pragma unroll
                for (int j = 0; j < 32; ++j) scr[33 * lane + sgu[j]] = v[j >> 2][j & 3] * inv;
            }
            LDS_WAIT(); asm volatile("" ::: "memory");
            f32x16 lo, hi;
#pragma unroll
            for (int i = 0; i < 16; ++i) { lo[i] = scr[33 * lane + i]; hi[i] = scr[33 * lane + 16 + i]; }
            LDS_WAIT(); asm volatile("" ::: "memory");
            const u32x6 p = __builtin_amdgcn_cvt_scalef32_2xpk16_fp6_f32(lo, hi, 1.0f);
            unsigned char* rp = ws + (tbl ? WS_PV : WS_PU) + (size_t)e * 768;
            *(u32x4*)(rp + 16 * ll) = (u32x4){p[0], p[1], p[2], p[3]}; *(u32x2*)(rp + 512 + 8 * ll) = (u32x2){p[4], p[5]};
            if (ll == 0) ((float*)(ws + (tbl ? WS_SV : WS_SU)))[e] = scale;
        }
    }
    bf16_t* N1 = (bf16_t*)(ws + SLOT(0));
    {
        f32x4 gg[4];
#pragma unroll
        for (int j = 0; j < 4; ++j) gg[j] = ((const f32x4*)in[2])[lane + 64 * j];
        int m = gw; f32x4 nv[4];
        if (m < M) {
#pragma unroll
            for (int j = 0; j < 4; ++j) nv[j] = ((const f32x4*)(in[0] + (size_t)m * 1024))[lane + 64 * j]; }
        for (; m < M; m += NGW) {
            f32x4 v[4]; float sq = 0.f;
#pragma unroll
            for (int j = 0; j < 4; ++j) { v[j] = nv[j]; sq += (v[j][0] * v[j][0] + v[j][1] * v[j][1]) + (v[j][2] * v[j][2] + v[j][3] * v[j][3]); }
            if (m + NGW < M) {
#pragma unroll
                for (int j = 0; j < 4; ++j) nv[j] = ((const f32x4*)(in[0] + (size_t)(m + NGW) * 1024))[lane + 64 * j]; }
            const float rstd = 1.f / sqrtf(wave_sum(sq) * (1.f / 1024.f) + EPS);
            u32x2* o8 = (u32x2*)(N1 + (size_t)m * 1024) + lane;
#pragma unroll
            for (int j = 0; j < 4; ++j) { u32x2 w; w.x = pk2(v[j][0] * rstd * gg[j][0], v[j][1] * rstd * gg[j][1]); w.y = pk2(v[j][2] * rstd * gg[j][2], v[j][3] * rstd * gg[j][3]); o8[64 * j] = w; }
        }
    }
    for (int m = gw; m < 256; m += NGW) {
        if (m < NMETA) rms_row_bf16(in[1] + (size_t)m * 1024, in[2], N1 + (size_t)(METAROW + m) * 1024, lane);
        else { u32x4* o = (u32x4*)(N1 + (size_t)(METAROW + m) * 1024); o[lane] = (u32x4){0u, 0u, 0u, 0u}; o[64 + lane] = (u32x4){0u, 0u, 0u, 0u}; }
    }
}

__device__ __forceinline__ int prev_row(int r, int j) {
    if (r < M) { const int s = r & (SEQ - 1); return s >= j ? r - j : METAROW + NMETA + (s - j); }
    const int p = r - METAROW; return p >= j ? r - j : -1;
}
struct ThinRow { u32x4 xa, xb, cq, ckv; unsigned k1, k2; };
__device__ __forceinline__ ThinRow thin_load(const bf16_t* XR, const bf16_t* CQKV, int r, int lane) {
    ThinRow d; const bf16_t* z = CQKV + (size_t)r * CQKV_LD;
    d.xa = *(const u32x4*)(XR + (size_t)r * 1024 + lane * 8); d.xb = *(const u32x4*)(XR + (size_t)r * 1024 + 512 + lane * 8);
    d.cq = *(const u32x4*)(z + CQ_OFF + (lane < 48 ? lane : 0) * 8); d.ckv = *(const u32x4*)(z + (lane & 31) * 8);
    d.k1 = z[KR_OFF + (lane & 15)]; d.k2 = z[KR_OFF + 16 + (lane & 15)];
    return d;
}
__device__ __forceinline__ void thin_row_stats(unsigned char* ws, const ThinRow& d, int r, int lane) {
    float* RSQ = (float*)(ws + WS_RSQ); float* RSKV = (float*)(ws + WS_RSKV); bf16_t* KROPE = (bf16_t*)(ws + WS_KROPE);
    float sq = 0.f, skv = 0.f;
    { float v[8]; unpack8(d.cq, v); float a = 0.f;
#pragma unroll
      for (int i = 0; i < 8; ++i) a += v[i] * v[i];
      sq = lane < 48 ? a : 0.f; }
    { float v[8]; unpack8(d.ckv, v); float a = 0.f;
#pragma unroll
      for (int i = 0; i < 8; ++i) a += v[i] * v[i];
      skv = lane < 32 ? a : 0.f; }
    sq = wave_sum(sq); skv = wave_sum(skv);
    if (lane == 0) { RSQ[r] = 1.f / sqrtf(sq * (1.f / 384.f) + EPS); RSKV[r] = 1.f / sqrtf(skv * (1.f / 256.f) + EPS); }
    if (lane < 16) { const int pos = r < M ? NMETA + (r & (SEQ - 1)) : r - METAROW; const float x1 = bf2f((bf16_t)d.k1), x2 = bf2f((bf16_t)d.k2);
        const float c = ((const float*)(ws + WS_CTAB))[pos * 16 + lane], s = ((const float*)(ws + WS_STAB))[pos * 16 + lane];
        ((unsigned*)(KROPE + (size_t)r * 32))[lane] = pk2(x1 * c - x2 * s, x1 * s + x2 * c); }
}
__device__ __forceinline__ void phase_thin(const Ctx& C) {
    unsigned char* ws = C.ws; const float* const* in = C.in; const int lane = C.lane;
    const bf16_t* XR = (const bf16_t*)(ws + SLOT(1)); const bf16_t* CQKV = (const bf16_t*)(ws + SLOT(3)); bf16_t* XC = (bf16_t*)(ws + SLOT(0));
    const float* cw = in[4]; const float* cb = in[5];
    float w[4][16], bias[16];
#pragma unroll
    for (int hh = 0; hh < 2; ++hh)
#pragma unroll
        for (int i = 0; i < 8; ++i) { const int ch = hh * 512 + lane * 8 + i; bias[hh * 8 + i] = cb[ch];
#pragma unroll
            for (int t = 0; t < 4; ++t) w[t][hh * 8 + i] = cw[t * 1024 + ch]; }
    for (int st = C.gw; st < M / 32 + 1; st += C.NGW) {
        const bool meta = st == M / 32; const int r0 = meta ? METAROW : st * 32, nrow = meta ? NMETA : 32;
        float x1[16], x2[16], x3[16];
        const bool first = meta || (r0 & (SEQ - 1)) == 0;
        ThinRow nx = thin_load(XR, CQKV, r0, lane);
#pragma unroll
        for (int j = 1; j <= 3; ++j) { const int pr = first ? (meta ? -1 : METAROW + NMETA - j) : r0 - j;
#pragma unroll
            for (int hh = 0; hh < 2; ++hh) { float v[8];
                if (pr >= 0) unpack8(*(const u32x4*)(XR + (size_t)pr * 1024 + hh * 512 + lane * 8), v); else {
#pragma unroll
                    for (int i = 0; i < 8; ++i) v[i] = 0.f; }
#pragma unroll
                for (int i = 0; i < 8; ++i) { if (j == 1) x1[hh * 8 + i] = v[i]; else if (j == 2) x2[hh * 8 + i] = v[i]; else x3[hh * 8 + i] = v[i]; } } }
        for (int t = 0; t < nrow; ++t) { const int r = r0 + t; float x0[16];
            const ThinRow d = nx;
            if (t + 1 < nrow) nx = thin_load(XR, CQKV, r + 1, lane);
            { float v[8]; unpack8(d.xa, v);
#pragma unroll
              for (int i = 0; i < 8; ++i) x0[i] = v[i];
              unpack8(d.xb, v);
#pragma unroll
              for (int i = 0; i < 8; ++i) x0[8 + i] = v[i]; }
#pragma unroll
            for (int hh = 0; hh < 2; ++hh) { float y[8];
#pragma unroll
                for (int i = 0; i < 8; ++i) { const int q = hh * 8 + i; y[i] = bias[q] + w[3][q] * x0[q] + w[2][q] * x1[q] + w[1][q] * x2[q] + w[0][q] * x3[q]; }
                *(u32x4*)(XC + (size_t)r * 1024 + hh * 512 + lane * 8) = pack8(y); }
#pragma unroll
            for (int q = 0; q < 16; ++q) { x3[q] = x2[q]; x2[q] = x1[q]; x1[q] = x0[q]; }
            thin_row_stats(ws, d, r, lane);
        }
    }
    float* RSQ = (float*)(ws + WS_RSQ); float* RSKV = (float*)(ws + WS_RSKV); bf16_t* KROPE = (bf16_t*)(ws + WS_KROPE);
    for (int r = M + NMETA + C.gw; r < MTOT; r += C.NGW) {
        u32x4* o = (u32x4*)(XC + (size_t)r * 1024); o[lane] = (u32x4){0u, 0u, 0u, 0u}; o[64 + lane] = (u32x4){0u, 0u, 0u, 0u};
        if (lane == 0) { RSQ[r] = 0.f; RSKV[r] = 0.f; }
        if (lane < 16) ((unsigned*)(KROPE + (size_t)r * 32))[lane] = 0u;
    }
}

__device__ __forceinline__ void phase_scan1(const Ctx& C) {
    unsigned char* ws = C.ws; const int lane = C.lane;
    const bf16_t* LA = (const bf16_t*)(ws + SLOT(1)); const bf16_t* UU = (const bf16_t*)(ws + SLOT(6));
    float* SCP = (float*)(ws + WS_SCP); float* SCH = (float*)(ws + WS_SCH); float* CARRY0 = (float*)(ws + WS_CARRY0);
    for (int it = C.gw; it < 2048 + 4; it += C.NGW) {
        const bool meta = it >= 2048; const int q = it & 3, bc = it >> 2, ch = q * 256 + lane * 4;
        const int row0 = meta ? METAROW : bc * 128, nrow = meta ? NMETA : 128;
        float P[4] = {1.f, 1.f, 1.f, 1.f}, H[4] = {0.f, 0.f, 0.f, 0.f};
#pragma unroll 8
        for (int t = 0; t < nrow; ++t) { const u32x2 l2 = *(const u32x2*)(LA + (size_t)(row0 + t) * 1024 + ch), u2 = *(const u32x2*)(UU + (size_t)(row0 + t) * 1024 + ch);
            const float a0 = ex2(LOG2E * bf_lo(l2.x)), a1 = ex2(LOG2E * bf_hi(l2.x)), a2 = ex2(LOG2E * bf_lo(l2.y)), a3 = ex2(LOG2E * bf_hi(l2.y));
            P[0] *= a0; P[1] *= a1; P[2] *= a2; P[3] *= a3;
            H[0] = a0 * H[0] + bf_lo(u2.x); H[1] = a1 * H[1] + bf_hi(u2.x); H[2] = a2 * H[2] + bf_lo(u2.y); H[3] = a3 * H[3] + bf_hi(u2.y); }
        if (meta) *(f32x4*)(CARRY0 + ch) = (f32x4){H[0], H[1], H[2], H[3]};
        else { *(f32x4*)(SCP + (size_t)bc * 1024 + ch) = (f32x4){P[0], P[1], P[2], P[3]}; *(f32x4*)(SCH + (size_t)bc * 1024 + ch) = (f32x4){H[0], H[1], H[2], H[3]}; }
    }
}
__device__ __forceinline__ void phase_scan2(const Ctx& C) {
    unsigned char* ws = C.ws; const int lane = C.lane;
    const bf16_t* LA = (const bf16_t*)(ws + SLOT(1)); const bf16_t* UU = (const bf16_t*)(ws + SLOT(6)); const bf16_t* GR = (const bf16_t*)(ws + SLOT(2)); bf16_t* HRG = (bf16_t*)(ws + SLOT(0));
    const float* SCP = (const float*)(ws + WS_SCP); const float* SCH = (const float*)(ws + WS_SCH); const float* CARRY0 = (const float*)(ws + WS_CARRY0);
    for (int it = C.gw; it < 2048; it += C.NGW) {
        const int q = it & 3, bc = it >> 2, b = bc >> 4, c = bc & 15, ch = q * 256 + lane * 4;
        f32x4 h = *(const f32x4*)(CARRY0 + ch);
        for (int cc = 0; cc < c; ++cc) { const f32x4 p = *(const f32x4*)(SCP + (size_t)(b * 16 + cc) * 1024 + ch), e = *(const f32x4*)(SCH + (size_t)(b * 16 + cc) * 1024 + ch); h = p * h + e; }
        float H[4] = {h[0], h[1], h[2], h[3]};
        const int row0 = bc * 128;
#pragma unroll 8
        for (int t = 0; t < 128; ++t) { const size_t off = (size_t)(row0 + t) * 1024 + ch; const u32x2 l2 = *(const u32x2*)(LA + off), u2 = *(const u32x2*)(UU + off), g2 = *(const u32x2*)(GR + off);
            H[0] = ex2(LOG2E * bf_lo(l2.x)) * H[0] + bf_lo(u2.x); H[1] = ex2(LOG2E * bf_hi(l2.x)) * H[1] + bf_hi(u2.x); H[2] = ex2(LOG2E * bf_lo(l2.y)) * H[2] + bf_lo(u2.y); H[3] = ex2(LOG2E * bf_hi(l2.y)) * H[3] + bf_hi(u2.y);
            u32x2 o; o.x = pk2(H[0] * bf_lo(g2.x), H[1] * bf_hi(g2.x)); o.y = pk2(H[2] * bf_lo(g2.y), H[3] * bf_hi(g2.y)); *(u32x2*)(HRG + off) = o; }
    }
}

constexpr int AT_KSLOT = 12 * 1024, AT_VSLOT = 8192;
#define AT_K(j) (((j) & 3) * AT_KSLOT)
#define AT_V(j) (4 * AT_KSLOT + ((j) & 7) * AT_VSLOT)
static_assert(4 * AT_KSLOT + 8 * AT_VSLOT <= 131072, "attention rings fit the phase scratch");
__device__ __forceinline__ void glds16(const void* gsrc, unsigned lds_dst) { unsigned keep;
    asm volatile("s_mov_b32 %0, m0\n\ts_mov_b32 m0, %2\n\ts_nop 0\n\tglobal_load_lds_dwordx4 %1, off\n\ts_mov_b32 m0, %0" : "=&s"(keep) : "v"(gsrc), "s"(lds_dst) : "memory"); }
#define AT_BAR(N) asm volatile("s_waitcnt vmcnt(" #N ") lgkmcnt(0)\n\ts_barrier" ::: "memory")
__device__ __forceinline__ int crow(int r, int hi) { return (r & 3) + 8 * (r >> 2) + 4 * hi; }
__device__ __forceinline__ void attn_q(LAS unsigned char* lds, int j, int s0, int q, int hi, const bf16x8 (&qf)[6], const f32x16& negm, f32x16& p0, f32x16& p1) {
    const int kb = AT_K(j);
    __builtin_amdgcn_s_setprio(1);
#pragma unroll
    for (int ks = 0; ks < 6; ++ks) {
        const bf16x8 a0 = *(const LAS bf16x8*)(lds + kb + (2 * ks + hi) * 1024 + q * 16);
        const bf16x8 a1 = *(const LAS bf16x8*)(lds + kb + (2 * ks + hi) * 1024 + (32 + q) * 16);
        if (ks == 0) { p0 = __builtin_amdgcn_mfma_f32_32x32x16_bf16(a0, qf[0], negm, 0, 0, 0); p1 = __builtin_amdgcn_mfma_f32_32x32x16_bf16(a1, qf[0], negm, 0, 0, 0); }
        else { p0 = __builtin_amdgcn_mfma_f32_32x32x16_bf16(a0, qf[ks], p0, 0, 0, 0); p1 = __builtin_amdgcn_mfma_f32_32x32x16_bf16(a1, qf[ks], p1, 0, 0, 0); }
    }
    __builtin_amdgcn_s_setprio(0);
    if (j == 0) {
#pragma unroll
        for (int r = 0; r < 16; ++r) { if (crow(r, hi) >= NMETA) p0[r] = -INFINITY; p1[r] = -INFINITY; }
    } else if ((j - 1) * 64 + 63 > s0) {
        const int qs = s0 + q, k0 = (j - 1) * 64;
#pragma unroll
        for (int r = 0; r < 16; ++r) { const int kk = k0 + crow(r, hi); if (kk > qs) p0[r] = -INFINITY; if (kk + 32 > qs) p1[r] = -INFINITY; }
    }
}
__device__ __forceinline__ void attn_pv(LAS unsigned char* lds, int vbase, const bf16x8 (&pb)[4], f32x16& o0, f32x16& o1) {
#pragma unroll
    for (int s = 0; s < 4; ++s)
#pragma unroll
        for (int db = 0; db < 2; ++db) {
            const v4i16_t lo = __builtin_amdgcn_ds_read_tr16_b64_v4i16((LAS v4i16_t*)(lds + vbase + db * 4096 + s * 1024));
            const v4i16_t hh = __builtin_amdgcn_ds_read_tr16_b64_v4i16((LAS v4i16_t*)(lds + vbase + db * 4096 + s * 1024 + 512));
            const bf16x8 va = {lo[0], lo[1], lo[2], lo[3], hh[0], hh[1], hh[2], hh[3]};
            if (db == 0) o0 = __builtin_amdgcn_mfma_f32_32x32x16_bf16(va, pb[s], o0, 0, 0, 0); else o1 = __builtin_amdgcn_mfma_f32_32x32x16_bf16(va, pb[s], o1, 0, 0, 0);
        }
}
#ifndef ATT_THR
#define ATT_THR 8.0f
#endif
template <bool DOPV, bool FIRST> __device__ __forceinline__ void attn_sp(LAS unsigned char* lds, int vbase, f32x16& p0, f32x16& p1, bf16x8 (&pb)[4], f32x16& o0, f32x16& o1, f32x16& negm, float& m_run, float& l_run) {
    float mx = fmaxf(p0[0], p1[0]);
#pragma unroll
    for (int r = 1; r < 16; ++r) mx = fmaxf(fmaxf(mx, p0[r]), p1[r]);
    mx = fmaxf(mx, __shfl_xor(mx, 32));
    if (DOPV) attn_pv(lds, vbase, pb, o0, o1);
    float rs = 0.f;
#pragma unroll
    for (int r = 0; r < 16; ++r) { p0[r] = ex2(p0[r]); p1[r] = ex2(p1[r]); rs += p0[r] + p1[r]; }
    if (FIRST || !__all(mx <= ATT_THR)) {
        const float d = FIRST ? mx : fmaxf(mx, 0.f), alpha = ex2(-d);
#pragma unroll
        for (int r = 0; r < 16; ++r) { p0[r] *= alpha; p1[r] *= alpha; o0[r] *= alpha; o1[r] *= alpha; }
        rs *= alpha; l_run *= alpha; m_run += d;
#pragma unroll
        for (int r = 0; r < 16; ++r) negm[r] = -m_run;
    }
    l_run += rs;
#pragma unroll
    for (int s = 0; s < 4; ++s) { unsigned w[4];
#pragma unroll
        for (int jj = 0; jj < 4; ++jj) w[jj] = (s < 2) ? pk2(p0[8 * (s & 1) + 2 * jj], p0[8 * (s & 1) + 2 * jj + 1]) : pk2(p1[8 * (s & 1) + 2 * jj], p1[8 * (s & 1) + 2 * jj + 1]);
        u32x4 ww = {w[0], w[1], w[2], w[3]}; pb[s] = __builtin_bit_cast(bf16x8, ww); }
}
__device__ __forceinline__ void attn_unit(const Ctx& C, int b, int h, int qb, const bf16_t* Q, const bf16_t* KN, const bf16_t* KR, const bf16_t* V, bf16_t* O) {
    const int tid = C.tid, lane = C.lane, wid = C.wave, q = lane & 31, hi = lane >> 5;
    LAS unsigned char* lds = C.lds;
    const int s0 = qb * 256 + wid * 32;
    const size_t qrow = (size_t)b * SEQ + s0 + q;
    bf16x8 qf[6];
#pragma unroll
    for (int ks = 0; ks < 6; ++ks) qf[ks] = *(const bf16x8*)(Q + qrow * QLD + h * 96 + ks * 16 + hi * 8);
    {
        const float* ctab = (const float*)(C.ws + WS_CTAB) + (NMETA + s0 + q) * 16; const float* stab = (const float*)(C.ws + WS_STAB) + (NMETA + s0 + q) * 16;
#pragma unroll
        for (int ks = 4; ks < 6; ++ks) { const f32x4 cc = *(const f32x4*)(ctab + 8 * (ks - 4) + 4 * hi), sn = *(const f32x4*)(stab + 8 * (ks - 4) + 4 * hi);
            const u32x4 w = __builtin_bit_cast(u32x4, qf[ks]); u32x4 r;
            { const float x1 = bf_lo(w.x), x2 = bf_hi(w.x); r.x = pk2(x1 * cc[0] - x2 * sn[0], x1 * sn[0] + x2 * cc[0]); }
            { const float x1 = bf_lo(w.y), x2 = bf_hi(w.y); r.y = pk2(x1 * cc[1] - x2 * sn[1], x1 * sn[1] + x2 * cc[1]); }
            { const float x1 = bf_lo(w.z), x2 = bf_hi(w.z); r.z = pk2(x1 * cc[2] - x2 * sn[2], x1 * sn[2] + x2 * cc[2]); }
            { const float x1 = bf_lo(w.w), x2 = bf_hi(w.w); r.w = pk2(x1 * cc[3] - x2 * sn[3], x1 * sn[3] + x2 * cc[3]); }
            qf[ks] = __builtin_bit_cast(bf16x8, r); }
    }
    f32x16 o0 = {}, o1 = {}, p0 = {}, p1 = {};
    bf16x8 pb[4] = {};
    float m_run = 0.f, l_run = 0.f; f32x16 negm = {};
    const int NJ = 4 * qb + 5;
    const unsigned lds0 = (unsigned)(size_t)lds;
    const bf16_t* ksrc = KN + (size_t)lane * 1024 + h * 64 + wid * 8;
    const bf16_t* rsrc = KR + (size_t)lane * 32 + (wid & 3) * 8;
    const bf16_t* vsrc = V + (size_t)(16 * (wid & 3) + (lane >> 2)) * 1024 + h * 64 + (wid >> 2) * 32 + (lane & 3) * 8;
#define AT_DMA(j) do { const size_t row_ = (j) == 0 ? (size_t)METAROW : (size_t)b * SEQ + (size_t)((j) - 1) * 64; \
        glds16(ksrc + row_ * 1024, (unsigned)__builtin_amdgcn_readfirstlane(lds0 + AT_K(j) + wid * 1024)); \
        if (wid < 4) glds16(rsrc + row_ * 32, (unsigned)__builtin_amdgcn_readfirstlane(lds0 + AT_K(j) + (8 + wid) * 1024)); \
        glds16(vsrc + row_ * 1024, (unsigned)__builtin_amdgcn_readfirstlane(lds0 + AT_V(j) + wid * 1024)); } while (0)
#define AT_STEP(n) do { if ((n) + 2 < NJ) { if (wid < 4) AT_BAR(6); else AT_BAR(4); } else if ((n) + 1 < NJ) { if (wid < 4) AT_BAR(3); else AT_BAR(2); } else AT_BAR(0); if ((n) + 3 < NJ) AT_DMA((n) + 3); } while (0)
    AT_BAR(0);
    AT_DMA(0); AT_DMA(1); AT_DMA(2);
    const int g16 = lane >> 4, qq = (lane & 15) >> 2, pp = lane & 3;
    const int vtr_off = (4 * hi + qq) * 64 + (16 * (g16 & 1) + 4 * pp) * 2;
    {
        AT_STEP(0);
        attn_q(lds, 0, s0, q, hi, qf, negm, p0, p1);
        attn_sp<false, true>(lds, 0, p0, p1, pb, o0, o1, negm, m_run, l_run);
    }
    const int jend = (s0 + 31) / 64 + 2 < NJ ? (s0 + 31) / 64 + 2 : NJ;
    for (int j = 1; j < jend; ++j) {
        AT_STEP(j);
        attn_q(lds, j, s0, q, hi, qf, negm, p0, p1);
        attn_sp<true, false>(lds, AT_V(j - 1) + vtr_off, p0, p1, pb, o0, o1, negm, m_run, l_run);
    }
    attn_pv(lds, AT_V(jend - 1) + vtr_off, pb, o0, o1);
    for (int j = jend; j < NJ; ++j) AT_STEP(j);
#undef AT_DMA
#undef AT_STEP
    const float inv = 1.f / (l_run + __shfl_xor(l_run, 32));
    bf16_t* orow = O + qrow * 1024 + h * 64;
#pragma unroll
    for (int g4 = 0; g4 < 4; ++g4) {
        u32x2 w0, w1; w0.x = pk2(o0[4 * g4] * inv, o0[4 * g4 + 1] * inv); w0.y = pk2(o0[4 * g4 + 2] * inv, o0[4 * g4 + 3] * inv);
        w1.x = pk2(o1[4 * g4] * inv, o1[4 * g4 + 1] * inv); w1.y = pk2(o1[4 * g4 + 2] * inv, o1[4 * g4 + 3] * inv);
        *(u32x2*)(orow + 8 * g4 + 4 * hi) = w0; *(u32x2*)(orow + 32 + 8 * g4 + 4 * hi) = w1;
    }
}
__device__ __forceinline__ void phase_attn(const Ctx& C) {
    unsigned char* ws = C.ws;
    const bf16_t* Q = (const bf16_t*)(ws + SLOT(0)); const bf16_t* KN = (const bf16_t*)(ws + SLOT(4)); const bf16_t* V = (const bf16_t*)(ws + SLOT(6)); const bf16_t* KR = (const bf16_t*)(ws + WS_KROPE);
    bf16_t* O = (bf16_t*)(ws + SLOT(3));
    const int G = C.G, c = blockIdx.x; const int vcu = (G % 8 == 0) ? (c % 8) * (G / 8) + c / 8 : c;
    for (int bh = vcu; bh < NB * 16; bh += G)
        for (int i = 0; i < 8; ++i) { const int qb = (i & 1) ? 7 - (i >> 1) : (i >> 1); attn_unit(C, bh >> 4, bh & 15, qb, Q, KN, KR, V, O); }
    __syncthreads();
}

__device__ __forceinline__ int tk_enc(float f) { const int x = __float_as_int(f); return x ^ ((x >> 31) & 0x7fffffff); }
__device__ __forceinline__ float tk_dec(int k) { return __int_as_float(k ^ ((k >> 31) & 0x7fffffff)); }
#define TK_CE(a, b) do { const int hi_ = max((a), (b)), lo_ = min((a), (b)); (a) = hi_; (b) = lo_; } while (0)
__device__ __forceinline__ void tk_sort16(int (&v)[16]) {
#pragma unroll
    for (int k = 2; k <= 16; k <<= 1)
#pragma unroll
        for (int j = k >> 1; j > 0; j >>= 1)
#pragma unroll
            for (int i = 0; i < 16; ++i) { const int l = i ^ j; if (l > i) { if ((i & k) == 0) TK_CE(v[i], v[l]); else TK_CE(v[l], v[i]); } }
}
__device__ __forceinline__ void tk_merge16(int (&a)[16], const int (&b)[16]) {
#pragma unroll
    for (int i = 0; i < 16; ++i) a[i] = max(a[i], b[15 - i]);
#pragma unroll
    for (int j = 8; j > 0; j >>= 1)
#pragma unroll
        for (int i = 0; i < 16; ++i) { const int l = i ^ j; if (l > i) TK_CE(a[i], a[l]); }
}
__host__ __device__ constexpr int tk_pos(int i) { int n = 0; for (int a = 0; a < i; ++a) n += 16 / (a + 1); return n; }
__device__ __forceinline__ int tk_lookup(const int (&w)[4], int i) {
    const unsigned long long lo = ((unsigned long long)(unsigned)w[1] << 32) | (unsigned long long)(unsigned)w[0], hi = ((unsigned long long)(unsigned)w[3] << 32) | (unsigned long long)(unsigned)w[2];
    const unsigned long long a = (i & 8) ? hi : lo;
    return (int)(a >> (8 * (i & 7))) & 127;
}
__device__ __forceinline__ void phase_topk(const Ctx& C) {
    unsigned char* ws = C.ws;
    const _Float16* SC = (const _Float16*)(ws + SLOT(0)); int* TIDX = (int*)(ws + SLOT(5)); float* TVAL = (float*)(ws + SLOT(5) + (size_t)M * 128 * 4);
    const int gt = blockIdx.x * NTHR + C.tid, NT = C.G * NTHR;
    for (int it = gt; it < M * 8 * 4; it += NT) {
        const int p = it >> 2, q = it & 3;
        const f16x8* s = (const f16x8*)(SC + (size_t)p * 256 + 64 * q);
        f16x8 raw[8];
#pragma unroll
        for (int c = 0; c < 8; ++c) raw[c] = s[c];
        const int ibase = 127 - 64 * (q & 1);
        int ch[4][16];
#pragma unroll
        for (int c = 0; c < 4; ++c)
#pragma unroll
            for (int e = 0; e < 16; ++e) ch[c][e] = (tk_enc((float)raw[2 * c + (e >> 3)][e & 7]) & ~127) | (ibase - (16 * c + e));
        tk_sort16(ch[0]); tk_sort16(ch[1]); tk_sort16(ch[2]); tk_sort16(ch[3]);
        tk_merge16(ch[0], ch[1]); tk_merge16(ch[2], ch[3]); tk_merge16(ch[0], ch[2]);
        int oth[16];
#pragma unroll
        for (int i = 0; i < 16; ++i) oth[i] = __builtin_amdgcn_mov_dpp(ch[0][i], 0xB1, 0xF, 0xF, true);
        tk_merge16(ch[0], oth);
#pragma unroll
        for (int i = 0; i < 16; ++i) oth[i] = __builtin_amdgcn_mov_dpp(ch[0][i], 0x4E, 0xF, 0xF, true);
        int t1[16], t2[16];
#pragma unroll
        for (int i = 0; i < 16; ++i) { t1[i] = (q < 2) ? ch[0][i] : oth[i]; t2[i] = (q < 2) ? oth[i] : ch[0][i]; }
        float f1[16], f2[16];
#pragma unroll
        for (int i = 0; i < 16; ++i) { f1[i] = tk_dec(t1[i]); f2[i] = tk_dec(t2[i]); }
        int cd[4][16];
#pragma unroll
        for (int i = 0; i < 16; ++i)
#pragma unroll
            for (int j = 0; j < 16; ++j) if ((i + 1) * (j + 1) <= 16) { constexpr int dummy = 0; (void)dummy; const int n = tk_pos(i) + j; cd[n >> 4][n & 15] = (tk_enc(f1[i] + f2[j]) & ~255) | (255 - (16 * i + j)); }
#pragma unroll
        for (int n = 50; n < 64; ++n) cd[n >> 4][n & 15] = (int)0x80000000;
        tk_sort16(cd[0]); tk_sort16(cd[1]); tk_sort16(cd[2]); tk_sort16(cd[3]);
        tk_merge16(cd[0], cd[1]); tk_merge16(cd[2], cd[3]); tk_merge16(cd[0], cd[2]);
        int w1[4], w2[4];
#pragma unroll
        for (int m = 0; m < 4; ++m) { w1[m] = (t1[4 * m] & 127) | ((t1[4 * m + 1] & 127) << 8) | ((t1[4 * m + 2] & 127) << 16) | ((t1[4 * m + 3] & 127) << 24);
                                      w2[m] = (t2[4 * m] & 127) | ((t2[4 * m + 1] & 127) << 8) | ((t2[4 * m + 2] & 127) << 16) | ((t2[4 * m + 3] & 127) << 24); }
        if (q == 0) {
            int id[16];
#pragma unroll
            for (int k = 0; k < 16; ++k) { const int c = 255 - (cd[0][k] & 255); id[k] = (127 - tk_lookup(w1, c >> 4)) * 128 + (127 - tk_lookup(w2, c & 15)); }
            int* oi = TIDX + (size_t)p * 16;
#pragma unroll
            for (int k = 0; k < 16; k += 4) *(int4*)(oi + k) = make_int4(id[k], id[k + 1], id[k + 2], id[k + 3]);
        } else if (q == 1) {
            float* ov = TVAL + (size_t)p * 16;
#pragma unroll
            for (int k = 0; k < 16; k += 4) *(f32x4*)(ov + k) = (f32x4){tk_dec(cd[0][k]), tk_dec(cd[0][k + 1]), tk_dec(cd[0][k + 2]), tk_dec(cd[0][k + 3])};
        }
    }
}

__device__ __forceinline__ float dpp_ror8(float v) { return __uint_as_float(__builtin_amdgcn_update_dpp(0, __float_as_uint(v), 0x128, 0xF, 0xF, true)); }
__device__ __forceinline__ float dpp_hmir(float v) { return __uint_as_float(__builtin_amdgcn_update_dpp(0, __float_as_uint(v), 0x141, 0xF, 0xF, true)); }
__device__ __forceinline__ float dpp_x2(float v) { return __uint_as_float(__builtin_amdgcn_mov_dpp(__float_as_uint(v), 0x4E, 0xF, 0xF, true)); }
__device__ __forceinline__ float dpp_x1(float v) { return __uint_as_float(__builtin_amdgcn_mov_dpp(__float_as_uint(v), 0xB1, 0xF, 0xF, true)); }
__device__ __forceinline__ float fp6dot32(const u32x4 wa, const u32x2 wb, const unsigned (&x)[16]) {
    const bf16x32 r = __builtin_amdgcn_cvt_scalef32_pk32_bf16_fp6((u32x6){wa.x, wa.y, wa.z, wa.w, wb.x, wb.y}, 1.0f);
    float a = 0.f;
#pragma unroll
    for (int i = 0; i < 16; ++i) { const bf16x2_t rp = {r[2 * i], r[2 * i + 1]}; a = __builtin_amdgcn_fdot2_f32_bf16(rp, __builtin_bit_cast(bf16x2_t, x[i]), a, false); }
    return a;
}
__device__ __forceinline__ void u_process(unsigned c, int n, int sub, int tok, const unsigned (&x)[16], const unsigned char* PU, float* ACT, int lane, int ll, bool hb, bool b3) {
    for (int base = 0; base < n; base += 32) {
        u32x4 wa[16]; u32x2 wb[16];
#pragma unroll
        for (int g = 0; g < 4; ++g) if (base + 8 * g < n) {
#pragma unroll
            for (int k = 0; k < 4; ++k) { const int s0 = base + 8 * g + 2 * k;
                int ida = (int)(__builtin_amdgcn_readlane(c, s0 & 63) & 0xffffu), idb = (int)(__builtin_amdgcn_readlane(c, (s0 + 1) & 63) & 0xffffu);
                ida = s0 < n ? ida : (sub << 11); idb = s0 + 1 < n ? idb : (sub << 11);
                const unsigned char* rp = PU + (size_t)(hb ? idb : ida) * 768;
                wa[4 * g + k] = *(const u32x4*)(rp + 16 * ll); wb[4 * g + k] = *(const u32x2*)(rp + 512 + 8 * ll); } }
        __builtin_amdgcn_sched_barrier(0);
#pragma unroll
        for (int g = 0; g < 4; ++g) if (base + 8 * g < n) {
            float p[4];
#pragma unroll
            for (int k = 0; k < 4; ++k) p[k] = fp6dot32(wa[4 * g + k], wb[4 * g + k], x);
            float q2[2];
#pragma unroll
            for (int i = 0; i < 2; ++i) { auto rr = __builtin_amdgcn_permlane16_swap(__float_as_uint(p[i]), __float_as_uint(p[2 + i]), false, false); q2[i] = __uint_as_float(rr[0]) + __uint_as_float(rr[1]); }
            float t; { const float keep = b3 ? q2[1] : q2[0], send = b3 ? q2[0] : q2[1]; t = keep + dpp_ror8(send); }
            t += dpp_hmir(t); t += dpp_x2(t); t += dpp_x1(t);
            const int slot = base + 8 * g + ((lane >> 4) & 1) * 4 + ((lane >> 3) & 1) * 2 + (lane >> 5);
            const unsigned mine = (unsigned)__builtin_amdgcn_ds_bpermute((slot & 63) * 4, (int)c);
            if ((lane & 7) == 0 && slot < n) ACT[(size_t)tok * 128 + (mine >> 16)] = t;
        }
    }
}
__device__ __forceinline__ void phase_upart(const Ctx& C, int xcc, int rank) {
    unsigned char* ws = C.ws; const int lane = C.lane;
    const bf16_t* H1B = (const bf16_t*)(ws + SLOT(4)); const int* TIDX = (const int*)(ws + SLOT(5)); float* ACT = (float*)(ws + SLOT(0));
    const unsigned char* PU = ws + WS_PU;
    int nloc, xi, nx;
    if ((C.G & 7) == 0) { nx = 8; xi = xcc; nloc = C.G >> 3; } else { nx = 1; xi = 0; nloc = C.G; rank = blockIdx.x; }
    const bool b3 = (lane & 8) != 0, hb = lane >= 32; const int ll = lane & 31;
    const int tstep = nloc * NWAVES;
    for (int sub = xi; sub < 8; sub += nx) {
        int tok = rank * NWAVES + C.wave;
        u32x4 xn[4]; int ia = 0, ib = 0;
#pragma unroll
        for (int j = 0; j < 4; ++j) xn[j] = (u32x4){0u, 0u, 0u, 0u};
        if (tok < M) {
#pragma unroll
            for (int j = 0; j < 4; ++j) xn[j] = *(const u32x4*)(H1B + (size_t)tok * 1024 + 32 * ll + 8 * j);
            ia = TIDX[(size_t)tok * 128 + lane]; ib = TIDX[(size_t)tok * 128 + 64 + lane]; }
        for (; tok < M; tok += tstep) {
            unsigned x[16];
#pragma unroll
            for (int i = 0; i < 16; ++i) { x[i] = xn[i >> 2][i & 3]; asm volatile("" : "+v"(x[i])); }
            const int ca = ia, cb = ib;
            const int nt = tok + tstep;
            if (nt < M) {
#pragma unroll
                for (int j = 0; j < 4; ++j) xn[j] = *(const u32x4*)(H1B + (size_t)nt * 1024 + 32 * ll + 8 * j);
                ia = TIDX[(size_t)nt * 128 + lane]; ib = TIDX[(size_t)nt * 128 + 64 + lane]; }
            const bool fa = (ca >> 11) == sub, fb = (cb >> 11) == sub;
            const unsigned long long ma = __ballot(fa), mb = __ballot(fb);
            const int npa = __builtin_popcountll(ma), npb = __builtin_popcountll(mb);
            const int ra_ = (int)__builtin_amdgcn_mbcnt_hi((unsigned)(ma >> 32), __builtin_amdgcn_mbcnt_lo((unsigned)ma, 0u));
            const int rb_ = (int)__builtin_amdgcn_mbcnt_hi((unsigned)(mb >> 32), __builtin_amdgcn_mbcnt_lo((unsigned)mb, 0u));
            const int da = fa ? ra_ : npa + (lane - ra_), db = fb ? rb_ : npb + (lane - rb_);
            const unsigned cA = (unsigned)__builtin_amdgcn_ds_permute(da * 4, ca | (lane << 16));
            const unsigned cB = (unsigned)__builtin_amdgcn_ds_permute(db * 4, cb | ((64 + lane) << 16));
            if (npa + npb <= 64) {
                const unsigned pulled = (unsigned)__builtin_amdgcn_ds_bpermute(((lane - npa) & 63) * 4, (int)cB);
                u_process(lane < npa ? cA : pulled, npa + npb, sub, tok, x, PU, ACT, lane, ll, hb, b3);
            } else { u_process(cA, npa, sub, tok, x, PU, ACT, lane, ll, hb, b3); u_process(cB, npb, sub, tok, x, PU, ACT, lane, ll, hb, b3); }
        }
    }
}
__device__ __forceinline__ void phase_gather(const Ctx& C, float* DST) {
    unsigned char* ws = C.ws; const int lane = C.lane;
    const bf16_t* H1B = (const bf16_t*)(ws + SLOT(4)); const int* TIDX = (const int*)(ws + SLOT(5)); const float* TVAL = (const float*)(ws + SLOT(5) + (size_t)M * 128 * 4);
    const float* ACT = (const float*)(ws + SLOT(0));
    const unsigned char* PV = ws + WS_PV; const float* SU = (const float*)(ws + WS_SU); const float* SV = (const float*)(ws + WS_SV);
    const float* fg = C.in[24];
    const int l4 = lane >> 2, ll = lane & 31; const bool hb = lane >= 32;
    const int ln = 2 * ll + (lane >> 5);
    int tok = C.gw;
    u32x4 ra = {0u, 0u, 0u, 0u}, rb = {0u, 0u, 0u, 0u};
    if (tok < M) { ra = *(const u32x4*)(H1B + (size_t)tok * 1024 + 16 * ln); rb = *(const u32x4*)(H1B + (size_t)tok * 1024 + 16 * ln + 8); }
    for (; tok < M; tok += C.NGW) {
        f32x4 e[4]; float ss = 0.f;
        { float hv[16]; { float t8[8]; unpack8(ra, t8);
#pragma unroll
            for (int i = 0; i < 8; ++i) hv[i] = t8[i];
            unpack8(rb, t8);
#pragma unroll
            for (int i = 0; i < 8; ++i) hv[8 + i] = t8[i]; }
#pragma unroll
          for (int j = 0; j < 4; ++j) { e[j] = (f32x4){hv[4 * j], hv[4 * j + 1], hv[4 * j + 2], hv[4 * j + 3]}; ss += (e[j][0] * e[j][0] + e[j][1] * e[j][1]) + (e[j][2] * e[j][2] + e[j][3] * e[j][3]); } }
        { const int nt = tok + C.NGW; if (nt < M) { ra = *(const u32x4*)(H1B + (size_t)nt * 1024 + 16 * ln); rb = *(const u32x4*)(H1B + (size_t)nt * 1024 + 16 * ln + 8); } }
        f32x4* dp = (f32x4*)(DST + (size_t)tok * 1024 + 16 * ln);
        const float rstd = 1.f / sqrtf(wave_sum(ss) * (1.f / 1024.f) + EPS);
        f32x2 acc[16];
#pragma unroll
        for (int i = 0; i < 16; ++i) acc[i] = (f32x2){0.f, 0.f};
        int idxn0 = TIDX[(size_t)tok * 128 + l4], idxn1 = TIDX[(size_t)tok * 128 + 16 + l4];
        float tsn0 = TVAL[(size_t)tok * 128 + l4], tsn1 = TVAL[(size_t)tok * 128 + 16 + l4], dtn0 = ACT[(size_t)tok * 128 + l4], dtn1 = ACT[(size_t)tok * 128 + 16 + l4];
        for (int hp = 0; hp < 8; hp += 2) {
            const int idx0 = idxn0, idx1 = idxn1; const float ts0 = tsn0 * rstd, ts1 = tsn1 * rstd, dot0 = dtn0, dot1 = dtn1;
            u32x4 pa[16]; u32x2 pb[16];
#pragma unroll
            for (int m = 0; m < 16; ++m) { const int src = m < 8 ? idx0 : idx1; const int ida = __builtin_amdgcn_readlane(src, 4 * ((2 * m) & 15)), idb = __builtin_amdgcn_readlane(src, 4 * ((2 * m + 1) & 15));
                const unsigned char* rp = PV + (size_t)(hb ? idb : ida) * 768; pa[m] = *(const u32x4*)(rp + 16 * ll); pb[m] = *(const u32x2*)(rp + 512 + 8 * ll); }
            __builtin_amdgcn_sched_barrier(0);
            const float su0 = SU[idx0], sv0 = SV[idx0], su1 = SU[idx1], sv1 = SV[idx1];
            if (hp < 6) { const size_t nb = (size_t)tok * 128 + (hp + 2) * 16 + l4; idxn0 = TIDX[nb]; idxn1 = TIDX[nb + 16]; tsn0 = TVAL[nb]; tsn1 = TVAL[nb + 16]; dtn0 = ACT[nb]; dtn1 = ACT[nb + 16]; }
            __builtin_amdgcn_sched_barrier(0);
            float mx0 = ts0, mx1 = ts1;
#pragma unroll
            for (int o = 4; o < 64; o <<= 1) { mx0 = fmaxf(mx0, __shfl_xor(mx0, o)); mx1 = fmaxf(mx1, __shfl_xor(mx1, o)); }
            const float ee0 = ex2((ts0 - mx0) * LOG2E), ee1 = ex2((ts1 - mx1) * LOG2E); float sm0 = ee0, sm1 = ee1;
#pragma unroll
            for (int o = 4; o < 64; o <<= 1) { sm0 += __shfl_xor(sm0, o); sm1 += __shfl_xor(sm1, o); }
            const float coef0 = (ee0 / sm0) * gelu_t(dot0 * su0 * rstd) * sv0, coef1 = (ee1 / sm1) * gelu_t(dot1 * su1 * rstd) * sv1;
#pragma unroll
            for (int m = 0; m < 16; ++m) {
                const unsigned cs = __float_as_uint(m < 8 ? coef0 : coef1);
                const float ca = __uint_as_float(__builtin_amdgcn_readlane(cs, 4 * ((2 * m) & 15))), cb = __uint_as_float(__builtin_amdgcn_readlane(cs, 4 * ((2 * m + 1) & 15)));
                const float ck = hb ? cb : ca;
                const f32x32 r = __builtin_amdgcn_cvt_scalef32_pk32_f32_fp6((u32x6){pa[m].x, pa[m].y, pa[m].z, pa[m].w, pb[m].x, pb[m].y}, 1.0f);
#pragma unroll
                for (int j = 0; j < 16; ++j) acc[j] = __builtin_elementwise_fma((f32x2){r[2 * j], r[2 * j + 1]}, (f32x2){ck, ck}, acc[j]);
                __builtin_amdgcn_sched_barrier(0);
            }
        }
        float s2 = 0.f;
#pragma unroll
        for (int j = 0; j < 4; ++j) {
#pragma unroll
            for (int i = 0; i < 4; ++i) { const int q = 4 * j + i; auto rr = __builtin_amdgcn_permlane32_swap(__float_as_uint(acc[q >> 1][q & 1]), __float_as_uint(acc[8 + (q >> 1)][q & 1]), false, false);
                e[j][i] += __uint_as_float(rr[0]) + __uint_as_float(rr[1]); }
            s2 += (e[j][0] * e[j][0] + e[j][1] * e[j][1]) + (e[j][2] * e[j][2] + e[j][3] * e[j][3]); }
        const float r2 = 1.f / sqrtf(wave_sum(s2) * (1.f / 1024.f) + EPS);
        const f32x4* fp = (const f32x4*)(fg + 16 * ln);
#pragma unroll
        for (int j = 0; j < 4; ++j) dp[j] = e[j] * r2 * fp[j];
    }
}

constexpr int NPHASE = 16;
__global__ void __launch_bounds__(NTHR, 2) hybrid_fwd(Args args) {
    extern __shared__ __attribute__((aligned(16))) unsigned char lds_raw[];
    Ctx C;
    C.lds = (LAS unsigned char*)lds_raw; C.tid = threadIdx.x; C.lane = C.tid & 63; C.wave = __builtin_amdgcn_readfirstlane(C.tid >> 6);
    C.G = gridDim.x; C.gw = blockIdx.x * NWAVES + C.wave; C.NGW = C.G * NWAVES; C.ws = args.ws; C.out = args.out; C.in = args.in;
    unsigned char* ws = args.ws;
    volatile LAS unsigned* MISC = (volatile LAS unsigned*)(C.lds + MISC_OFF);
    for (int u = C.tid; u < (LDS_BYTES - RING_BYTES) / 4; u += NTHR) ((LAS unsigned*)(C.lds + RING_BYTES))[u] = 0u;
    __syncthreads();
    XcdBarrier bar; bar.bar = (unsigned*)(ws + WS_CTL) + 1024; bar.x = 0; bar.st = nullptr;
    if (ONE_LAUNCH) bar = xcd_barrier_post((unsigned*)(ws + WS_CTL) + 1024, MISC + 8);
    const int lo = args.ph_lo, hi = args.ph_hi;
#ifndef PHMASK
#define PHMASK 0xffff
#endif
#define IN(k) (((PHMASK >> (k)) & 1) && lo <= (k) && (k) < hi)
#ifndef PROBE_PHASE
#define PROBE_PHASE -1
#endif
#define REPS(k) for (int rep_ = 0; rep_ < ((k) == PROBE_PHASE ? 2 : 1); ++rep_)
#define SEAM(k) do { if (IN(k) && IN((k) + 1)) xcd_barrier(bar); } while (0)
    const int G = C.G, cb = blockIdx.x;
    LAS unsigned char* ring = C.lds;

    if (IN(0)) REPS(0) { phase_prologue(C); }
    SEAM(0);
    if (IN(1)) REPS(1) {
        pg8::Gemm g{(const bf16_t*)(ws + SLOT(0)), (const bf16_t*)(ws + WS_WIN), 1024, 1024, 1024, 0, 256 * 1024};
        pg8::Sched S; S.init(256, 19, G, cb, 256, 6, 4);
        pg8::Epi8<FInproj> E{{(bf16_t*)(ws + SLOT(1)), (bf16_t*)(ws + SLOT(2)), (bf16_t*)(ws + SLOT(3)), (bf16_t*)(ws + SLOT(4)), (bf16_t*)(ws + SLOT(5))}};
        pg8::gemm_phase(ring, g, S, E);
    }
    SEAM(1);
    if (IN(2)) REPS(2) { phase_thin(C); }
    SEAM(2);
    if (IN(3)) REPS(3) {
        pg8::Gemm g{(const bf16_t*)(ws + SLOT(0)), (const bf16_t*)(ws + WS_WGATE), 1024, 128, 128, 128, 256 * 128};
        pg8::Sched S; S.init(256, 8, G, cb, 256, 8, 0);
        pg8::EpiPair<FGate> E{{(const bf16_t*)(ws + SLOT(0)), args.in[7], args.in[9], (const float*)(ws + WS_CLAM), (bf16_t*)(ws + SLOT(1)), (bf16_t*)(ws + SLOT(6))}};
        pg8::gemm_phase(ring, g, S, E);
    }
    SEAM(3);
    if (IN(4)) REPS(4) { phase_scan1(C); }
    SEAM(4);
    if (IN(5)) REPS(5) { phase_scan2(C); }
    SEAM(5);
    if (IN(6)) REPS(6) {
        pg8::Gemm g{(const bf16_t*)(ws + SLOT(0)), (const bf16_t*)(ws + WS_WRNN), 1024, 1024, 1024, 0, 256 * 1024};
        pg8::Sched S; S.init(256, 4, G, cb, 0, 0, 0);
        pg8::Epi8<FMul<false>> E{{(const bf16_t*)(ws + SLOT(4)), nullptr, (bf16_t*)(ws + SLOT(2))}};
        pg8::gemm_phase(ring, g, S, E);
    }
    SEAM(6);
    if (IN(7)) REPS(7) {
        { pg8::Gemm g{(const bf16_t*)(ws + SLOT(3)) + CQ_OFF, (const bf16_t*)(ws + WS_WUQ), CQKV_LD, 384, 384, 0, 256 * 384};
          pg8::Sched S; S.init(256, 6, G, cb, 0, 0, 0);
          pg8::Epi8<FQ> E{{(const float*)(ws + WS_RSQ), (bf16_t*)(ws + SLOT(0))}};
          pg8::gemm_phase(ring, g, S, E); }
        { pg8::Gemm g{(const bf16_t*)(ws + SLOT(3)), (const bf16_t*)(ws + WS_WUKV), CQKV_LD, 256, 256, 0, 256 * 256};
          pg8::Sched S; S.init(256, 8, G, cb, 256, 8, 0);
          pg8::Epi8<FKV> E{{(const float*)(ws + WS_RSKV), (bf16_t*)(ws + SLOT(4)), (bf16_t*)(ws + SLOT(6))}};
          pg8::gemm_phase(ring, g, S, E); }
    }
    SEAM(7);
    if (IN(8)) REPS(8) { phase_attn(C); }
    SEAM(8);
    if (IN(9)) REPS(9) {
        pg8::Gemm g{(const bf16_t*)(ws + SLOT(3)), (const bf16_t*)(ws + WS_WATT), 1024, 1024, 1024, 0, 256 * 1024};
        pg8::Sched S; S.init(256, 4, G, cb, 0, 0, 0);
        pg8::Epi8<FMul<true>> E{{(const bf16_t*)(ws + SLOT(5)), (const bf16_t*)(ws + SLOT(2)), (bf16_t*)(ws + SLOT(0))}};
        pg8::gemm_phase(ring, g, S, E);
    }
    SEAM(9);
    if (IN(10)) REPS(10) {
        pg8::Gemm g{(const bf16_t*)(ws + SLOT(0)), (const bf16_t*)(ws + WS_WOUT), 1024, 1024, 1024, 0, 256 * 1024};
        pg8::Sched S; S.init(256, 4, G, cb, 0, 0, 0);
        pg8::Epi8<FRes> E{{args.in[0], (bf16_t*)(ws + SLOT(4))}};
        pg8::gemm_phase(ring, g, S, E);
    }
    SEAM(10);
    if (IN(11)) REPS(11) {
        pg8::Gemm g{(const bf16_t*)(ws + SLOT(4)), (const bf16_t*)(ws + WS_WPQ), 1024, 1024, 1024, 0, 256 * 1024};
        pg8::Sched S; S.init(256, 8, G, cb, 0, 0, 0);
        pg8::Epi8<FF16> E{{(_Float16*)(ws + SLOT(0)), 2048}};
        pg8::gemm_phase(ring, g, S, E);
    }
    SEAM(11);
    if (IN(13)) REPS(13) { phase_topk(C); }
    SEAM(13);
    if (IN(14)) REPS(14) { phase_upart(C, (int)(blockIdx.x & 7), (int)(blockIdx.x >> 3)); }
    SEAM(14);
    if (IN(15)) REPS(15) { phase_gather(C, C.out); }
#undef IN
#undef SEAM
}

extern "C" void kernel_launch(void* const* d_in, const int* in_sizes, int n_in, void* d_out, int out_size, void* d_ws, size_t ws_size, hipStream_t stream) {
    static int grid = 0;
    if (grid == 0) {
        if (n_in != 25 || in_sizes[0] != M * DM || out_size != M * DM || ws_size < WS_END) { fprintf(stderr, "kernel_launch: unexpected shapes (n_in %d in0 %d out %d ws %zu need %zu); nothing launched\n", n_in, n_in > 0 ? in_sizes[0] : -1, out_size, ws_size, (size_t)WS_END); grid = -1; return; }
        int dev = 0, cus = 0, per_cu = 0;
        if (hipGetDevice(&dev) != hipSuccess || hipDeviceGetAttribute(&cus, hipDeviceAttributeMultiprocessorCount, dev) != hipSuccess) { grid = -1; return; }
        if (hipFuncSetAttribute((const void*)hybrid_fwd, hipFuncAttributeMaxDynamicSharedMemorySize, LDS_BYTES) != hipSuccess) { fprintf(stderr, "kernel_launch: hipFuncSetAttribute failed\n"); grid = -1; return; }
        if (hipOccupancyMaxActiveBlocksPerMultiprocessor(&per_cu, (const void*)hybrid_fwd, NTHR, LDS_BYTES) != hipSuccess || per_cu < 1) fprintf(stderr, "kernel_launch: occupancy query reports %d\n", per_cu);
        (void)hipGetLastError();
        grid = cus;
    }
    if (grid < 0) return;
    if (hipMemsetAsync((char*)d_ws + WS_CTL, 0, CTL_ZERO_BYTES, stream) != hipSuccess) return;
    Args a{};
    for (int i = 0; i < 25; ++i) a.in[i] = (const float*)d_in[i];
    a.out = (float*)d_out; a.ws = (unsigned char*)d_ws;
#if ONE_LAUNCH
    a.ph_lo = 0; a.ph_hi = NPHASE;
    hipLaunchKernelGGL(hybrid_fwd, dim3(grid), dim3(NTHR), LDS_BYTES, stream, a);
#else
    for (int p = 0; p < NPHASE; ++p) { a.ph_lo = p; a.ph_hi = p + 1; hipLaunchKernelGGL(hybrid_fwd, dim3(grid), dim3(NTHR), LDS_BYTES, stream, a); }
#endif
}
```

```cpp
#include <hip/hip_runtime.h>
#include <cstdio>
#include <cstdint>

#ifndef ONE_LAUNCH
#define ONE_LAUNCH 1
#endif

#define LAS __attribute__((address_space(3)))
#define GAS __attribute__((address_space(1)))
typedef unsigned short bf16_t;
typedef short bf16x8 __attribute__((ext_vector_type(8)));
typedef float f32x4 __attribute__((ext_vector_type(4)));
typedef float f32x2 __attribute__((ext_vector_type(2)));
typedef float f32x16 __attribute__((ext_vector_type(16)));
typedef unsigned u32x4 __attribute__((ext_vector_type(4)));
typedef unsigned u32x2 __attribute__((ext_vector_type(2)));
typedef __bf16 bf16x2_t __attribute__((ext_vector_type(2)));
typedef short v4i16_t __attribute__((ext_vector_type(4)));

constexpr int DM = 1024, NB = 32, SEQ = 2048, NMETA = 16;
constexpr int M = NB * SEQ;
constexpr int METAROW = M;
constexpr int MTOT = M + 256;
constexpr int NPOS = SEQ + NMETA;
constexpr int DIN_P = 4864;
constexpr int CQKV_LD = 768, CQ_OFF = 384, KR_OFF = 256;
constexpr int QLD = 1536;
constexpr int NEXP = 16384;
constexpr float EPS = 1e-6f;
constexpr float LOG2E = 1.4426950408889634f;
constexpr float QSCALE = 0.10206207261596577f * 1.4426950408889634f;

constexpr size_t A1 = (size_t)MTOT * 1024 * 2;
constexpr size_t WS_CTL = 0, CTL_ZERO_BYTES = 65536;
constexpr size_t WS_WIN = 1u << 20;
constexpr size_t WS_WGATE = WS_WIN + (size_t)DIN_P * 1024 * 2;
constexpr size_t WS_WUQ = WS_WGATE + 2048 * 128 * 2;
constexpr size_t WS_WUKV = WS_WUQ + 1536 * 384 * 2;
constexpr size_t WS_WRNN = WS_WUKV + 2048 * 256 * 2;
constexpr size_t WS_WATT = WS_WRNN + 1024 * 1024 * 2;
constexpr size_t WS_WOUT = WS_WATT + 1024 * 1024 * 2;
constexpr size_t WS_WPQ = WS_WOUT + 1024 * 1024 * 2;
constexpr size_t WS_KEYS = WS_WPQ + 2048 * 1024 * 2;
constexpr size_t WS_PU = WS_KEYS + 256 * 256 * 2;
constexpr size_t WS_PV = WS_PU + (size_t)NEXP * 1024;
constexpr size_t WS_SU = WS_PV + (size_t)NEXP * 1024;
constexpr size_t WS_SV = WS_SU + (size_t)NEXP * 4;
constexpr size_t WS_CTAB = WS_SV + (size_t)NEXP * 4;
constexpr size_t WS_STAB = WS_CTAB + NPOS * 16 * 4;
constexpr size_t WS_CLAM = WS_STAB + NPOS * 16 * 4;
constexpr size_t WS_RSQ = WS_CLAM + 4096;
constexpr size_t WS_RSKV = WS_RSQ + (size_t)MTOT * 4;
constexpr size_t WS_KROPE = WS_RSKV + (size_t)MTOT * 4;
constexpr size_t WS_SCP = WS_KROPE + (size_t)MTOT * 32 * 2;
constexpr size_t WS_SCH = WS_SCP + 512 * 1024 * 4;
constexpr size_t WS_CARRY0 = WS_SCH + 512 * 1024 * 4;
constexpr size_t WS_SLOTS = ((WS_CARRY0 + 4096 + 4095) / 4096) * 4096;
constexpr size_t WS_END = WS_SLOTS + 7 * A1;
#define SLOT(i) (WS_SLOTS + (size_t)(i) * A1)

#define LDS_WAIT() asm volatile("s_waitcnt lgkmcnt(0)" ::: "memory")
#define VM_WAIT() asm volatile("s_waitcnt vmcnt(0)" ::: "memory")
__device__ __forceinline__ unsigned pk2(float lo, float hi) { f32x2 v = {lo, hi}; bf16x2_t b = __builtin_convertvector(v, bf16x2_t); return __builtin_bit_cast(unsigned, b); }
__device__ __forceinline__ float bf_lo(unsigned w) { return __uint_as_float(w << 16); }
__device__ __forceinline__ float bf_hi(unsigned w) { return __uint_as_float(w & 0xffff0000u); }
__device__ __forceinline__ float bf2f(bf16_t h) { return __uint_as_float((unsigned)h << 16); }
__device__ __forceinline__ float ex2(float x) { return __builtin_amdgcn_exp2f(x); }
__device__ __forceinline__ float rcpf_(float x) { return __builtin_amdgcn_rcpf(x); }
__device__ __forceinline__ float sigm(float v) { return rcpf_(1.f + ex2(-LOG2E * v)); }
__device__ __forceinline__ float gelu_t(float v) { const float y = v * (1.f + 0.044715f * v * v); return v * rcpf_(1.f + ex2(-2.302208198f * y)); }
__device__ __forceinline__ float wave_sum(float v) {
#pragma unroll
    for (int o = 1; o < 64; o <<= 1) v += __shfl_xor(v, o);
    return v;
}
__device__ __forceinline__ void unpack8(u32x4 w, float (&o)[8]) { o[0] = bf_lo(w.x); o[1] = bf_hi(w.x); o[2] = bf_lo(w.y); o[3] = bf_hi(w.y); o[4] = bf_lo(w.z); o[5] = bf_hi(w.z); o[6] = bf_lo(w.w); o[7] = bf_hi(w.w); }
__device__ __forceinline__ u32x4 pack8(const float (&o)[8]) { u32x4 w; w.x = pk2(o[0], o[1]); w.y = pk2(o[2], o[3]); w.z = pk2(o[4], o[5]); w.w = pk2(o[6], o[7]); return w; }
__device__ __forceinline__ float dot2bf(unsigned a, unsigned b, float acc) { return __builtin_amdgcn_fdot2_f32_bf16(__builtin_bit_cast(bf16x2_t, a), __builtin_bit_cast(bf16x2_t, b), acc, false); }

typedef float f32x32 __attribute__((ext_vector_type(32)));
typedef unsigned u32x6 __attribute__((ext_vector_type(6)));
typedef __bf16 bf16x32 __attribute__((ext_vector_type(32)));
__device__ __forceinline__ float fp6_probe_val(int i) { return i < 8 ? 0.125f * i : i < 16 ? 1.f + 0.125f * (i - 8) : i < 24 ? 2.f + 0.25f * (i - 16) : 4.f + 0.5f * (i - 24); }
__device__ __forceinline__ int fp6_code(float v) { return v < 1.f ? (int)(v * 8.f + 0.5f) : (int)(__float_as_uint(v) >> 20) - 1016 + 8; }
template <bool BF> __device__ __forceinline__ void fp6_sigma(int (&sig)[32]) {
    f32x16 lo, hi;
#pragma unroll
    for (int i = 0; i < 16; ++i) { lo[i] = fp6_probe_val(i); hi[i] = fp6_probe_val(16 + i); }
    asm volatile("" : "+v"(lo), "+v"(hi));
    const u32x6 p = __builtin_amdgcn_cvt_scalef32_2xpk16_fp6_f32(lo, hi, 1.0f);
    if (BF) { const bf16x32 r = __builtin_amdgcn_cvt_scalef32_pk32_bf16_fp6(p, 1.0f);
#pragma unroll
        for (int j = 0; j < 32; ++j) sig[j] = __builtin_amdgcn_readfirstlane(fp6_code((float)r[j])) & 31;
    } else { const f32x32 r = __builtin_amdgcn_cvt_scalef32_pk32_f32_fp6(p, 1.0f);
#pragma unroll
        for (int j = 0; j < 32; ++j) sig[j] = __builtin_amdgcn_readfirstlane(fp6_code(r[j])) & 31; }
}

namespace pg8 {
constexpr int BM = 256, BK = 64, HALF = 128, HTB = HALF * BK * 2, STAGE_BYTES = 8 * HTB, NXCD = 8, WGM = 8;
__host__ __device__ __forceinline__ int lds_byte(int r, int c) { const int st = (r >> 4) * 2 + (c >> 5), rr = r & 15, cc = c & 31, ob = rr * 64 + cc * 2; return st * 1024 + (ob ^ (((ob >> 9) & 1) << 5)); }
__host__ __device__ __forceinline__ void stage_rc(int b, int& R, int& C) { const int st = b / 1024, sb = b % 1024, swz = sb ^ (((sb >> 9) & 1) << 5); R = (st >> 1) * 16 + swz / 64; C = (st & 1) * 32 + (swz % 64) / 2; }
__host__ __device__ __forceinline__ int perm32(int rho) { const int n = rho >> 4, i = rho & 15; return 8 * (i >> 2) + 4 * n + (i & 3); }

struct Unit { int pm, pn; };
struct Gemm { const bf16_t* A; const bf16_t* Bt; int lda, ldb, K, a_pn_off, b_pn_stride; };

struct Sched {
    int nM, nN, nwg, G, c, xpm, xn, xskip;
    __device__ __forceinline__ void init(int nM_, int nN_, int G_, int c_, int xpm_, int xn_, int xskip_) { nM = nM_; nN = nN_; nwg = nM_ * nN_; G = G_; c = c_; xpm = xpm_; xn = xn_; xskip = xskip_; }
    __device__ __forceinline__ bool next(int i, Unit& u) const {
        const int nmain = nwg > c ? (nwg - c - 1) / G + 1 : 0;
        if (i < nmain) {
            int wgid = i * G + c; { const int q = nwg / NXCD, r = nwg % NXCD, xcd = wgid % NXCD, off = wgid / NXCD; wgid = (xcd < r ? xcd * (q + 1) : r * (q + 1) + (xcd - r) * q) + off; }
            const int nig = WGM * nN, gid = wgid / nig, fm = gid * WGM, gsz = (nM - fm) < WGM ? (nM - fm) : WGM;
            u.pm = fm + ((wgid % nig) % gsz); u.pn = (wgid % nig) / gsz; return true;
        }
        const int e = G - 1 - c;
        if (i == nmain && e < xn) { u.pm = xpm; u.pn = e + (e >= 4 ? xskip : 0); return true; }
        return false;
    }
};

template <class F> struct Epi8 {
    static constexpr bool PERM = true;
    F f;
    __device__ __forceinline__ void operator()(const f32x4 (&acc)[2][2][4][2], const Unit& u, int wr, int wc, int fr, int fq) const {
        const int row0 = u.pm * BM + wr * 64 + fr, col0 = u.pn * BM + wc * 32 + 8 * fq;
#pragma unroll
        for (int ai = 0; ai < 2; ++ai) {
            typename F::Pre pre[4][2];
#pragma unroll
            for (int m = 0; m < 4; ++m)
#pragma unroll
                for (int bj = 0; bj < 2; ++bj) pre[m][bj] = f.load(u.pn, row0 + ai * HALF + m * 16, col0 + bj * HALF);
#pragma unroll
            for (int m = 0; m < 4; ++m)
#pragma unroll
                for (int bj = 0; bj < 2; ++bj) f.apply(pre[m][bj], u.pn, row0 + ai * HALF + m * 16, col0 + bj * HALF, acc[ai][bj][m][0], acc[ai][bj][m][1]);
        }
    }
};
template <class F> struct EpiPair {
    static constexpr bool PERM = true;
    F f;
    __device__ __forceinline__ void operator()(const f32x4 (&acc)[2][2][4][2], const Unit& u, int wr, int wc, int fr, int fq) const {
        const int row0 = u.pm * BM + wr * 64 + fr, col0 = wc * 32 + 8 * fq;
#pragma unroll
        for (int ai = 0; ai < 2; ++ai) {
            typename F::Pre pre[4];
#pragma unroll
            for (int m = 0; m < 4; ++m) pre[m] = f.load(u.pn, row0 + ai * HALF + m * 16, col0);
#pragma unroll
            for (int m = 0; m < 4; ++m) f.apply(pre[m], u.pn, row0 + ai * HALF + m * 16, col0, acc[ai][0][m][0], acc[ai][0][m][1], acc[ai][1][m][0], acc[ai][1][m][1]);
        }
    }
};

template <class Epi>
__device__ __forceinline__ void gemm_phase(LAS unsigned char* lds, const Gemm g, const Sched& S, const Epi& E) {
    int tid_ = threadIdx.x; asm volatile("" : "+v"(tid_));
    const int tid = tid_, wid = __builtin_amdgcn_readfirstlane(tid >> 6), lane = tid & 63, wr = wid >> 2, wc = wid & 3, fr = lane & 15, fq = lane >> 4;
    int nt_ = g.K / BK; asm volatile("" : "+s"(nt_));
    const int nt = nt_;
    unsigned voffA[2], voffB[2];
#pragma unroll
    for (int i = 0; i < 2; ++i) { int R, C; stage_rc(tid * 16 + i * 8192, R, C); const int Rb = Epi::PERM ? ((R & ~31) + perm32(R & 31)) : R;
        voffA[i] = (unsigned)(R * g.lda + C) * 2u; voffB[i] = (unsigned)(Rb * g.ldb + C) * 2u; }
    const size_t kstep = (size_t)(BK * 2);
    const size_t hA = (size_t)HALF * g.lda * 2, hB = (size_t)HALF * g.ldb * 2;
    const unsigned ldsw = (unsigned)wid * 1024u;
    const int aoff = lds_byte(wr * 64 + fr, fq * 8), boff = lds_byte(wc * 32 + fr, fq * 8);
#define PG8_SA(b, h) (((b) * 2 + (h)) * HTB)
#define PG8_SB(b, h) ((4 + (b) * 2 + (h)) * HTB)
#define PG8_STAGE(bufoff, gbase, voff) do { _Pragma("unroll") for (int _i = 0; _i < 2; ++_i) \
        __builtin_amdgcn_global_load_lds((const unsigned*)((const char*)(gbase) + (voff)[_i]), (LAS unsigned*)(lds + (bufoff) + ldsw + _i * 8192), 16, 0, 0); } while (0)
#define PG8_LDA(dst, b, h) do { _Pragma("unroll") for (int m = 0; m < 4; ++m) _Pragma("unroll") for (int k = 0; k < 2; ++k) dst[m][k] = *(const LAS bf16x8*)(lds + PG8_SA(b, h) + aoff + m * 2048 + k * 1024); } while (0)
#define PG8_LDB(dst, b, h) do { _Pragma("unroll") for (int n = 0; n < 2; ++n) _Pragma("unroll") for (int k = 0; k < 2; ++k) dst[n][k] = *(const LAS bf16x8*)(lds + PG8_SB(b, h) + boff + n * 2048 + k * 1024); } while (0)
#define PG8_MMA(ai, bj, At, Bt) do { __builtin_amdgcn_s_setprio(1); _Pragma("unroll") for (int m = 0; m < 4; ++m) _Pragma("unroll") for (int n = 0; n < 2; ++n) _Pragma("unroll") for (int k = 0; k < 2; ++k) \
        acc[ai][bj][m][n] = __builtin_amdgcn_mfma_f32_16x16x32_bf16(Bt[n][k], At[m][k], acc[ai][bj][m][n], 0, 0, 0); __builtin_amdgcn_s_setprio(0); } while (0)
#define PG8_WAIT_V(n) asm volatile("s_waitcnt vmcnt(" #n ")" ::: "memory")
#define PG8_WAIT_L(n) asm volatile("s_waitcnt lgkmcnt(" #n ")" ::: "memory")
#define PG8_BAR __builtin_amdgcn_s_barrier()
#define PG8_SCHED __builtin_amdgcn_sched_barrier(0)
#define PG8_ABASE(u) ((const char*)g.A + ((size_t)(u).pm * BM * g.lda + (size_t)(u).pn * g.a_pn_off) * 2)
#define PG8_BBASE(u) ((const char*)g.Bt + (size_t)(u).pn * g.b_pn_stride * 2)
    Unit cur, nxt; int ui = 0;
    if (!S.next(0, cur)) return;
    f32x4 acc[2][2][4][2];
#pragma unroll
    for (int a = 0; a < 2; ++a)
#pragma unroll
        for (int b = 0; b < 2; ++b)
#pragma unroll
            for (int m = 0; m < 4; ++m)
#pragma unroll
                for (int n = 0; n < 2; ++n) acc[a][b][m][n] = (f32x4){0.f, 0.f, 0.f, 0.f};
    bf16x8 At[4][2], B0[2][2], B1[2][2];
    const char* cA = PG8_ABASE(cur); const char* cB = PG8_BBASE(cur);
    PG8_STAGE(PG8_SB(0, 0), cB, voffB); PG8_STAGE(PG8_SB(0, 1), cB + hB, voffB); PG8_STAGE(PG8_SA(0, 0), cA, voffA); PG8_STAGE(PG8_SA(0, 1), cA + hA, voffA);
    if (wr == 1) PG8_BAR;
    PG8_WAIT_V(2); PG8_BAR;
    PG8_STAGE(PG8_SB(1, 0), cB + kstep, voffB); PG8_STAGE(PG8_SA(1, 0), cA + kstep, voffA); PG8_STAGE(PG8_SB(1, 1), cB + hB + kstep, voffB);
    PG8_WAIT_V(6); PG8_BAR;
    for (;;) {
        const bool has_next = S.next(ui + 1, nxt);
        const char* nA = has_next ? PG8_ABASE(nxt) : cA; const char* nB = has_next ? PG8_BBASE(nxt) : cB;
        asm volatile("" : "+s"(cA), "+s"(cB), "+s"(nA), "+s"(nB));
#pragma unroll 1
        for (int t = 0; t < nt; t += 2) {
            const bool last = (t == nt - 2);
            const char* a1 = cA + (size_t)(t + 1) * kstep;
            const char* a2 = last ? nA : cA + (size_t)(t + 2) * kstep; const char* b2 = last ? nB : cB + (size_t)(t + 2) * kstep;
            const char* a3 = a2 + kstep; const char* b3 = b2 + kstep;
            PG8_LDB(B0, 0, 0); PG8_LDB(B1, 0, 1); PG8_SCHED; PG8_LDA(At, 0, 0); PG8_STAGE(PG8_SA(1, 1), a1 + hA, voffA);
            PG8_WAIT_V(8); PG8_WAIT_L(0); PG8_BAR; PG8_MMA(0, 0, At, B0); PG8_MMA(0, 1, At, B1); PG8_BAR; PG8_SCHED;
            PG8_LDA(At, 0, 1); PG8_STAGE(PG8_SB(0, 0), b2, voffB); PG8_STAGE(PG8_SB(0, 1), b2 + hB, voffB); PG8_STAGE(PG8_SA(0, 0), a2, voffA);
            PG8_WAIT_V(8); PG8_WAIT_L(0); PG8_BAR; PG8_MMA(1, 0, At, B0); PG8_MMA(1, 1, At, B1); PG8_BAR; PG8_SCHED;
            PG8_LDB(B0, 1, 0); PG8_LDB(B1, 1, 1); PG8_SCHED; PG8_LDA(At, 1, 0); PG8_STAGE(PG8_SA(0, 1), a2 + hA, voffA);
            PG8_WAIT_V(8); PG8_WAIT_L(0); PG8_BAR; PG8_MMA(0, 0, At, B0); PG8_MMA(0, 1, At, B1); PG8_BAR; PG8_SCHED;
            PG8_LDA(At, 1, 1); PG8_STAGE(PG8_SB(1, 0), b3, voffB); PG8_STAGE(PG8_SB(1, 1), b3 + hB, voffB); PG8_STAGE(PG8_SA(1, 0), a3, voffA);
            PG8_WAIT_V(8); PG8_WAIT_L(0); PG8_BAR; PG8_MMA(1, 0, At, B0); PG8_MMA(1, 1, At, B1); PG8_BAR; PG8_SCHED;
        }
        if (wr == 0) PG8_BAR;
        E(acc, cur, wr, wc, fr, fq);
        if (!has_next) break;
#pragma unroll
        for (int a = 0; a < 2; ++a)
#pragma unroll
            for (int b = 0; b < 2; ++b)
#pragma unroll
                for (int m = 0; m < 4; ++m)
#pragma unroll
                    for (int n = 0; n < 2; ++n) acc[a][b][m][n] = (f32x4){0.f, 0.f, 0.f, 0.f};
        cur = nxt; cA = nA; cB = nB; ++ui;
        if (wr == 1) PG8_BAR;
    }
    PG8_WAIT_V(0);
    PG8_BAR;
#undef PG8_SA
#undef PG8_SB
#undef PG8_STAGE
#undef PG8_LDA
#undef PG8_LDB
#undef PG8_MMA
#undef PG8_WAIT_V
#undef PG8_WAIT_L
#undef PG8_BAR
#undef PG8_SCHED
#undef PG8_ABASE
#undef PG8_BBASE
}
}

#define XB_TMO      128
#define XB_XCNT(j)  (256  + 64 * (j))
#define XB_XSUB(j)  (1280 + 64 * (j))
#define XB_XGEN(j)  (2304 + 64 * (j))
#define XB_TOP      3328
#define XB_TOPGEN   3392
#define XCD_BAR_WORDS 3456
#define XB_SPIN_CAP (1u << 18)
__device__ __forceinline__ unsigned xb_ld(unsigned* p)              { return __hip_atomic_load(p, __ATOMIC_RELAXED, __HIP_MEMORY_SCOPE_AGENT); }
__device__ __forceinline__ unsigned xb_add(unsigned* p, unsigned v) { return __hip_atomic_fetch_add(p, v, __ATOMIC_RELAXED, __HIP_MEMORY_SCOPE_AGENT); }
__device__ __forceinline__ unsigned xb_xcc_id() { return (unsigned)__builtin_amdgcn_s_getreg((3 << 11) | 20) & 0xFu; }
#define XB_SPIN(cond, bar) do { unsigned _sp = 0; while (cond) { __builtin_amdgcn_s_sleep(1); \
    if ((++_sp & 255u) == 0u) { if (xb_ld(&(bar)[XB_TMO])) break; if (_sp > XB_SPIN_CAP) { atomicAdd(&(bar)[XB_TMO], 1u); break; } } } } while (0)
struct XcdBarrier { unsigned* bar; unsigned x; volatile LAS unsigned* st; };
__device__ __forceinline__ XcdBarrier xcd_barrier_post(unsigned* bar, volatile LAS unsigned* st) {
    XcdBarrier b; b.bar = bar; b.x = xb_xcc_id(); b.st = st;
    if (threadIdx.x == 0) (void)xb_add(&bar[XB_XCNT(b.x)], 1u);
    return b;
}
__device__ __forceinline__ void xcd_barrier_complete(unsigned* bar, unsigned x, unsigned& nloc, unsigned& nx) {
    const unsigned G = gridDim.x * gridDim.y * gridDim.z;
    unsigned sum, cnt, mine, sp = 0u;
    for (;;) {
        sum = 0u; cnt = 0u; mine = 0u;
#pragma unroll
        for (unsigned j = 0; j < 16; ++j) { const unsigned c = xb_ld(&bar[XB_XCNT(j)]); sum += c; cnt += (c > 0u) ? 1u : 0u; mine = (j == x) ? c : mine; }
        if (sum == G) break;
        __builtin_amdgcn_s_sleep(1);
        if ((++sp & 255u) == 0u) { if (xb_ld(&bar[XB_TMO])) break; if (sp > XB_SPIN_CAP) { atomicAdd(&bar[XB_TMO], 1u); break; } }
    }
    nloc = mine > 0u ? mine : 1u; nx = cnt > 0u ? cnt : 1u;
}
__device__ __forceinline__ void xcd_barrier(const XcdBarrier& b) {
    asm volatile("s_waitcnt vmcnt(0)" ::: "memory");
    __syncthreads();
    if (threadIdx.x == 0) {
        unsigned* bar = b.bar;
        __builtin_amdgcn_s_waitcnt(0);
        unsigned nloc = b.st[0], nx = b.st[1];
        if (nloc == 0u) { xcd_barrier_complete(bar, b.x, nloc, nx); b.st[0] = nloc; b.st[1] = nx; }
        const unsigned old = xb_add(&bar[XB_XSUB(b.x)], 1u);
        const unsigned gen = old / nloc;
        if (old + 1u == (gen + 1u) * nloc) {
            __builtin_amdgcn_fence(__ATOMIC_RELEASE, "agent");
            asm volatile("s_waitcnt vmcnt(0)" ::: "memory");
            const unsigned og = xb_add(&bar[XB_TOP], 1u);
            const unsigned tg = og / nx;
            if (og + 1u == (tg + 1u) * nx) xb_add(&bar[XB_TOPGEN], 1u);
            else XB_SPIN(xb_ld(&bar[XB_TOPGEN]) == tg, bar);
            __builtin_amdgcn_fence(__ATOMIC_ACQUIRE, "agent");
            xb_add(&bar[XB_XGEN(b.x)], 1u);
            asm volatile("s_waitcnt vmcnt(0)" ::: "memory");
        } else {
            XB_SPIN(xb_ld(&bar[XB_XGEN(b.x)]) == gen, bar);
            __builtin_amdgcn_fence(__ATOMIC_ACQUIRE, "agent");
            asm volatile("s_waitcnt vmcnt(0)" ::: "memory");
        }
    }
    __syncthreads();
}

constexpr int NWAVES = 8, NTHR = 512;
constexpr int RING_BYTES = 131072, MISC_OFF = RING_BYTES + 320, LDS_BYTES = 147456;
struct Args { const float* in[25]; float* out; unsigned char* ws; int ph_lo, ph_hi; };
static_assert(sizeof(Args) == 25 * 8 + 8 + 8 + 8, "Args has no padding");

struct Ctx {
    LAS unsigned char* lds; int tid, lane, wave, G, gw, NGW;
    unsigned char* ws; float* out; const float* const* in;
};

__device__ __forceinline__ void store8(bf16_t* p, f32x4 a, f32x4 b) { u32x4 w; w.x = pk2(a[0], a[1]); w.y = pk2(a[2], a[3]); w.z = pk2(b[0], b[1]); w.w = pk2(b[2], b[3]); *(u32x4*)p = w; }
struct NoPre {};
struct FInproj {
    typedef NoPre Pre;
    bf16_t *XR, *GR, *CQKV, *GRNN, *GATT;
    __device__ __forceinline__ Pre load(int, int, int) const { return Pre(); }
    __device__ __forceinline__ void apply(const Pre&, int pn, int row, int col, f32x4 a, f32x4 b) const {
        if (pn < 4) { store8(XR + (size_t)row * 1024 + col, a, b); }
        else if (pn < 8) {
#pragma unroll
            for (int i = 0; i < 4; ++i) { a[i] = gelu_t(a[i]); b[i] = gelu_t(b[i]); }
            store8(GR + (size_t)row * 1024 + (col - 1024), a, b); }
        else if (pn < 11) { store8(CQKV + (size_t)row * CQKV_LD + (col - 2048), a, b); }
        else {
#pragma unroll
            for (int i = 0; i < 4; ++i) { a[i] = sigm(a[i]); b[i] = sigm(b[i]); }
            if (pn < 15) store8(GRNN + (size_t)row * 1024 + (col - 2816), a, b); else store8(GATT + (size_t)row * 1024 + (col - 3840), a, b); }
    }
};
struct FGate {
    struct Pre { u32x4 xc; };
    const bf16_t* XC; const float *ba, *bx, *clam; bf16_t *LA, *UU;
    __device__ __forceinline__ Pre load(int pn, int row, int cl) const { Pre p; p.xc = *(const u32x4*)(XC + (size_t)row * 1024 + pn * 128 + cl); return p; }
    __device__ __forceinline__ void apply(const Pre& pr, int pn, int row, int cl, f32x4 a0, f32x4 a1, f32x4 x0, f32x4 x1) const {
        const int ch = pn * 128 + cl; const size_t off = (size_t)row * 1024 + ch;
        float xc[8]; unpack8(pr.xc, xc);
        const f32x4 ba0 = *(const f32x4*)(ba + ch), ba1 = *(const f32x4*)(ba + ch + 4), bx0 = *(const f32x4*)(bx + ch), bx1 = *(const f32x4*)(bx + ch + 4), cl0 = *(const f32x4*)(clam + ch), cl1 = *(const f32x4*)(clam + ch + 4);
        float la[8], uu[8];
#pragma unroll
        for (int i = 0; i < 8; ++i) {
            const float ga = (i < 4 ? a0[i & 3] + ba0[i & 3] : a1[i & 3] + ba1[i & 3]), gx = (i < 4 ? x0[i & 3] + bx0[i & 3] : x1[i & 3] + bx1[i & 3]), cc = (i < 4 ? cl0[i & 3] : cl1[i & 3]);
            const float r = sigm(ga), ig = sigm(gx), l = r * cc;
            la[i] = l; uu[i] = sqrtf(fmaxf(1.f - ex2(2.f * LOG2E * l), 0.f)) * (ig * xc[i]);
        }
        *(u32x4*)(LA + off) = pack8(la); *(u32x4*)(UU + off) = pack8(uu);
    }
};
struct FQ {
    struct Pre { float sc; };
    const float* rsq; bf16_t* Q;
    __device__ __forceinline__ Pre load(int, int row, int) const { Pre p; p.sc = rsq[row]; return p; }
    __device__ __forceinline__ void apply(const Pre& pr, int pn, int row, int col, f32x4 a, f32x4 b) const {
        const float sc = pr.sc * QSCALE; a = a * sc; b = b * sc;
        store8(Q + (size_t)row * QLD + col, a, b);
    }
};
struct FKV {
    struct Pre { float sc; };
    const float* rskv; bf16_t *KN, *V;
    __device__ __forceinline__ Pre load(int, int row, int) const { Pre p; p.sc = rskv[row]; return p; }
    __device__ __forceinline__ void apply(const Pre& pr, int pn, int row, int col, f32x4 a, f32x4 b) const {
        const float sc = pr.sc; a = a * sc; b = b * sc;
        if (pn < 4) store8(KN + (size_t)row * 1024 + col, a, b); else store8(V + (size_t)row * 1024 + (col - 1024), a, b);
    }
};
template <bool HAS_ADD> struct FMul {
    struct Pre { u32x4 g, ad; };
    const bf16_t* Gt; const bf16_t* ADD; bf16_t* O;
    __device__ __forceinline__ Pre load(int, int row, int col) const { const size_t off = (size_t)row * 1024 + col; Pre p; p.g = *(const u32x4*)(Gt + off); if (HAS_ADD) p.ad = *(const u32x4*)(ADD + off); else p.ad = (u32x4){0u, 0u, 0u, 0u}; return p; }
    __device__ __forceinline__ void apply(const Pre& pr, int pn, int row, int col, f32x4 a, f32x4 b) const {
        const size_t off = (size_t)row * 1024 + col; float gg[8]; unpack8(pr.g, gg);
        if (HAS_ADD) { float ad[8]; unpack8(pr.ad, ad);
#pragma unroll
            for (int i = 0; i < 4; ++i) { a[i] = ad[i] + gg[i] * a[i]; b[i] = ad[4 + i] + gg[4 + i] * b[i]; } }
        else {
#pragma unroll
            for (int i = 0; i < 4; ++i) { a[i] = gg[i] * a[i]; b[i] = gg[4 + i] * b[i]; } }
        store8(O + off, a, b);
    }
};
struct FRes {
    struct Pre { f32x4 x0, x1; };
    const float* X; bf16_t* H1B;
    __device__ __forceinline__ Pre load(int, int row, int col) const { const size_t off = (size_t)row * 1024 + col; Pre p; p.x0 = *(const f32x4*)(X + off); p.x1 = *(const f32x4*)(X + off + 4); return p; }
    __device__ __forceinline__ void apply(const Pre& pr, int pn, int row, int col, f32x4 a, f32x4 b) const {
        store8(H1B + (size_t)row * 1024 + col, a + pr.x0, b + pr.x1);
    }
};
typedef _Float16 f16x8 __attribute__((ext_vector_type(8)));
struct FF16 { typedef NoPre Pre; _Float16* O; int ldc;
    __device__ __forceinline__ Pre load(int, int, int) const { return Pre(); }
    __device__ __forceinline__ void apply(const Pre&, int pn, int row, int col, f32x4 a, f32x4 b) const {
        f16x8 h = {(_Float16)a[0], (_Float16)a[1], (_Float16)a[2], (_Float16)a[3], (_Float16)b[0], (_Float16)b[1], (_Float16)b[2], (_Float16)b[3]};
        *(f16x8*)(O + (size_t)row * ldc + col) = h; } };
struct FF32 { typedef NoPre Pre; float* O; int ldc;
    __device__ __forceinline__ Pre load(int, int, int) const { return Pre(); }
    __device__ __forceinline__ void apply(const Pre&, int pn, int row, int col, f32x4 a, f32x4 b) const { float* p = O + (size_t)row * ldc + col; *(f32x4*)p = a; *(f32x4*)(p + 4) = b; } };

struct MapId { __device__ __forceinline__ int operator()(int n) const { return n; } };
struct MapWin { __device__ __forceinline__ int operator()(int n) const {
    if (n < 2048) return n;
    if (n < 2816) { const int c = n - 2048; if (c < 256) return 2432 + c; if (c < 288) return 2688 + (c - 256); if (c < 384) return -1; return 2048 + (c - 384); }
    if (n < 3840) return 2720 + (n - 2816);
    return 3744 + (n - 3840); } };
struct MapUq { __device__ __forceinline__ int operator()(int n) const { const int h = n / 96, w = n % 96; if (w < 64) return n; const int t = w - 64; return h * 96 + 64 + (t >> 1) + 16 * (t & 1); } };
struct MapUkv { __device__ __forceinline__ int operator()(int n) const { if (n < 1024) return (n >> 6) * 128 + (n & 63); const int m = n - 1024; return (m >> 6) * 128 + 64 + (m & 63); } };

template <class Map> __device__ __forceinline__ void transpose_item(const float* W, int ldw, int Ndst, bf16_t* WT, int ldt, const float* kscale, LAS float* scr, int item, int lane, Map map) {
    const int nblk = Ndst / 32, kb = item / nblk, nb = item % nblk, k0 = 64 * kb, n0 = 32 * nb;
    const int src = map(n0 + (lane & 31));
#pragma unroll 8
    for (int i = 0; i < 32; ++i) { const int kk = 2 * i + (lane >> 5); float v = 0.f; if (src >= 0) { v = W[(size_t)(k0 + kk) * ldw + src]; if (kscale) v *= kscale[k0 + kk]; } scr[kk * 33 + (lane & 31)] = v; }
    LDS_WAIT(); asm volatile("" ::: "memory");
    const int c = lane & 7;
#pragma unroll
    for (int j = 0; j < 4; ++j) { const int n = (lane >> 3) + 8 * j; const LAS float* s = scr + (8 * c) * 33 + n;
        u32x4 o; o.x = pk2(s[0 * 33], s[1 * 33]); o.y = pk2(s[2 * 33], s[3 * 33]); o.z = pk2(s[4 * 33], s[5 * 33]); o.w = pk2(s[6 * 33], s[7 * 33]);
        *(u32x4*)(WT + (size_t)(n0 + n) * ldt + k0 + 8 * c) = o; }
    LDS_WAIT(); asm volatile("" ::: "memory");
}
__device__ __forceinline__ void rms_row_bf16(const float* xrow, const float* g, bf16_t* orow, int lane) {
    const f32x4* xr = (const f32x4*)xrow + lane; f32x4 v[4]; float s = 0.f;
#pragma unroll
    for (int j = 0; j < 4; ++j) { v[j] = xr[64 * j]; s += (v[j][0] * v[j][0] + v[j][1] * v[j][1]) + (v[j][2] * v[j][2] + v[j][3] * v[j][3]); }
    const float rstd = 1.f / sqrtf(wave_sum(s) * (1.f / 1024.f) + EPS);
    u32x2* o8 = (u32x2*)orow + lane;
#pragma unroll
    for (int j = 0; j < 4; ++j) { const f32x4 gg = ((const f32x4*)g)[lane + 64 * j]; u32x2 w; w.x = pk2(v[j][0] * rstd * gg[0], v[j][1] * rstd * gg[1]); w.y = pk2(v[j][2] * rstd * gg[2], v[j][3] * rstd * gg[3]); o8[64 * j] = w; }
}
__device__ __forceinline__ void rms_row_f32(const float* xrow, const float* g, float* orow, int lane) {
    const f32x4* xr = (const f32x4*)xrow + lane; f32x4 v[4]; float s = 0.f;
#pragma unroll
    for (int j = 0; j < 4; ++j) { v[j] = xr[64 * j]; s += (v[j][0] * v[j][0] + v[j][1] * v[j][1]) + (v[j][2] * v[j][2] + v[j][3] * v[j][3]); }
    const float rstd = 1.f / sqrtf(wave_sum(s) * (1.f / 1024.f) + EPS);
#pragma unroll
    for (int j = 0; j < 4; ++j) { const f32x4 gg = ((const f32x4*)g)[lane + 64 * j]; ((f32x4*)orow)[lane + 64 * j] = v[j] * rstd * gg; }
}

__device__ __forceinline__ void phase_prologue(const Ctx& C) {
    unsigned char* ws = C.ws; const float* const* in = C.in;
    LAS float* scr = (LAS float*)(C.lds + C.wave * 16384);
    const int gw = C.gw, NGW = C.NGW, lane = C.lane;
    constexpr int I_WIN = 16 * (DIN_P / 32), I_UQ = 6 * (1536 / 32), I_UKV = 4 * (2048 / 32), I_SQ = 16 * 32, I_G = 2 * 4;
    constexpr int NITEMS = I_WIN + I_UQ + I_UKV + 3 * I_SQ + 16 * I_G;
    for (int it = gw; it < NITEMS; it += NGW) {
        int r = it;
        if (r < I_WIN) { transpose_item(in[3], 4768, DIN_P, (bf16_t*)(ws + WS_WIN), 1024, nullptr, scr, r, lane, MapWin()); continue; } r -= I_WIN;
        if (r < I_UQ) { transpose_item(in[13], 1536, 1536, (bf16_t*)(ws + WS_WUQ), 384, in[12], scr, r, lane, MapUq()); continue; } r -= I_UQ;
        if (r < I_UKV) { transpose_item(in[15], 2048, 2048, (bf16_t*)(ws + WS_WUKV), 256, in[14], scr, r, lane, MapUkv()); continue; } r -= I_UKV;
        if (r < I_SQ) { transpose_item(in[11], 1024, 1024, (bf16_t*)(ws + WS_WRNN), 1024, nullptr, scr, r, lane, MapId()); continue; } r -= I_SQ;
        if (r < I_SQ) { transpose_item(in[16], 1024, 1024, (bf16_t*)(ws + WS_WATT), 1024, nullptr, scr, r, lane, MapId()); continue; } r -= I_SQ;
        if (r < I_SQ) { transpose_item(in[17], 1024, 1024, (bf16_t*)(ws + WS_WOUT), 1024, nullptr, scr, r, lane, MapId()); continue; } r -= I_SQ;
        { const int mat = r / I_G, sub = r % I_G, blk = mat >> 1, which = mat & 1;
          transpose_item((which ? in[8] : in[6]) + (size_t)blk * 16384, 128, 128, (bf16_t*)(ws + WS_WGATE) + (size_t)(blk * 256 + which * 128) * 128, 128, nullptr, scr, sub, lane, MapId()); }
    }
    const int gt = blockIdx.x * NTHR + C.tid, NT = C.G * NTHR;
    for (int it = blockIdx.x; it < 256; it += C.G) {
        const int hh = it >> 4, kc = it & 15, half = hh & 1, k = kc * 64 + lane, c0 = 16 * C.wave;
        const f32x4* keys = (const f32x4*)((half ? in[21] : in[20]) + (size_t)c0 * 128);
        LAS f32x4* ks = (LAS f32x4*)scr;
#pragma unroll
        for (int j = 0; j < 8; ++j) ks[j * 64 + lane] = keys[j * 64 + lane];
        const f32x4* wq = (const f32x4*)(in[19] + (size_t)k * 2048 + hh * 128); const float g2k = in[18][k];
        f32x4 a[32];
#pragma unroll
        for (int d4 = 0; d4 < 32; ++d4) a[d4] = wq[d4];
        LDS_WAIT(); asm volatile("" ::: "memory");
        bf16_t* o = (bf16_t*)(ws + WS_WPQ) + (size_t)(hh * 128 + c0) * 1024 + k;
#pragma unroll 4
        for (int c = 0; c < 16; ++c) { float s0 = 0.f, s1 = 0.f;
#pragma unroll
            for (int d4 = 0; d4 < 32; d4 += 2) { const f32x4 k0 = ks[c * 32 + d4], k1 = ks[c * 32 + d4 + 1]; s0 += (a[d4][0] * k0[0] + a[d4][1] * k0[1]) + (a[d4][2] * k0[2] + a[d4][3] * k0[3]); s1 += (a[d4 + 1][0] * k1[0] + a[d4 + 1][1] * k1[1]) + (a[d4 + 1][2] * k1[2] + a[d4 + 1][3] * k1[3]); }
            o[(size_t)c * 1024] = (bf16_t)(pk2((s0 + s1) * g2k, 0.f) & 0xffffu); }
        LDS_WAIT(); asm volatile("" ::: "memory");
    }
    for (int i = gt; i < NPOS * 16; i += NT) { const int pos = i >> 4, j = i & 15; const float inv = exp2f(-(float)j * (13.287712379549449f / 16.f)); const float ang = (float)pos * inv;
        float t = ang * 0.15915494309189535f; t = t - floorf(t);
        ((float*)(ws + WS_CTAB))[i] = __builtin_amdgcn_cosf(t); ((float*)(ws + WS_STAB))[i] = __builtin_amdgcn_sinf(t); }
    for (int i = gt; i < 1024; i += NT) { const float lam = in[10][i]; ((float*)(ws + WS_CLAM))[i] = -8.f * log1pf(expf(-lam)); }
    {
        f32x4 g2n[4];
#pragma unroll
        for (int j = 0; j < 4; ++j) g2n[j] = ((const f32x4*)(in[18] + 16 * lane))[j];
        for (int e = gw; e < NEXP; e += NGW) {
            f32x4 v[4]; float am = 0.f;
#pragma unroll
            for (int j = 0; j < 4; ++j) { v[j] = ((const f32x4*)(in[22] + (size_t)e * 1024 + 16 * lane))[j] * g2n[j]; am = fmaxf(am, fmaxf(fmaxf(fabsf(v[j][0]), fabsf(v[j][1])), fmaxf(fabsf(v[j][2]), fabsf(v[j][3])))); }
#pragma unroll
            for (int o = 1; o < 64; o <<= 1) am = fmaxf(am, __shfl_xor(am, o));
            const float scale = am > 0.f ? am * (1.f / 127.f) : 1.f, inv = 1.f / scale;
            u32x4 w;
#pragma unroll
            for (int j = 0; j < 4; ++j) { const int q0 = (int)rintf(v[j][0] * inv), q1 = (int)rintf(v[j][1] * inv), q2 = (int)rintf(v[j][2] * inv), q3 = (int)rintf(v[j][3] * inv);
                w[j] = (unsigned)(q0 & 255) | ((unsigned)(q1 & 255) << 8) | ((unsigned)(q2 & 255) << 16) | ((unsigned)q3 << 24); }
            *(u32x4*)(ws + WS_PU + (size_t)e * 1024 + 16 * lane) = w;
            if (lane == 0) ((float*)(ws + WS_SU))[e] = scale;
        }
    }
    {
        int sgv[32]; fp6_sigma<false>(sgv);
        const int ll = lane & 31;
        for (int pr = gw; pr < NEXP / 2; pr += NGW) {
            const int e = 2 * pr + (lane >> 5);
            const f32x4* src = (const f32x4*)(in[23] + (size_t)e * 1024 + 32 * ll);
            f32x4 v[8]; float am = 0.f;
#pragma unroll
            for (int j = 0; j < 8; ++j) { v[j] = src[j]; am = fmaxf(am, fmaxf(fmaxf(fabsf(v[j][0]), fabsf(v[j][1])), fmaxf(fabsf(v[j][2]), fabsf(v[j][3])))); }
#pragma unroll
            for (int o = 1; o < 32; o <<= 1) am = fmaxf(am, __shfl_xor(am, o));
            const float scale = am > 0.f ? am * (1.f / 7.5f) : 1.f, inv = 1.f / scale;
#pragma unroll
            for (int j = 0; j < 32; ++j) scr[33 * lane + sgv[j]] = v[j >> 2][j & 3] * inv;
            LDS_WAIT(); asm volatile("" ::: "memory");
            f32x16 lo, hi;
#pragma unroll
            for (int i = 0; i < 16; ++i) { lo[i] = scr[33 * lane + i]; hi[i] = scr[33 * lane + 16 + i]; }
            LDS_WAIT(); asm volatile("" ::: "memory");
            const u32x6 p = __builtin_amdgcn_cvt_scalef32_2xpk16_fp6_f32(lo, hi, 1.0f);
            unsigned char* rp = ws + WS_PV + (size_t)e * 768;
            *(u32x4*)(rp + 16 * ll) = (u32x4){p[0], p[1], p[2], p[3]}; *(u32x2*)(rp + 512 + 8 * ll) = (u32x2){p[4], p[5]};
            if (ll == 0) ((float*)(ws + WS_SV))[e] = scale;
        }
    }
    bf16_t* N1 = (bf16_t*)(ws + SLOT(0));
    {
        f32x4 gg[4];
#pragma unroll
        for (int j = 0; j < 4; ++j) gg[j] = ((const f32x4*)in[2])[lane + 64 * j];
        int m = gw; f32x4 nv[4];
        if (m < M) {
#pragma unroll
            for (int j = 0; j < 4; ++j) nv[j] = ((const f32x4*)(in[0] + (size_t)m * 1024))[lane + 64 * j]; }
        for (; m < M; m += NGW) {
            f32x4 v[4]; float sq = 0.f;
#pragma unroll
            for (int j = 0; j < 4; ++j) { v[j] = nv[j]; sq += (v[j][0] * v[j][0] + v[j][1] * v[j][1]) + (v[j][2] * v[j][2] + v[j][3] * v[j][3]); }
            if (m + NGW < M) {
#pragma unroll
                for (int j = 0; j < 4; ++j) nv[j] = ((const f32x4*)(in[0] + (size_t)(m + NGW) * 1024))[lane + 64 * j]; }
            const float rstd = 1.f / sqrtf(wave_sum(sq) * (1.f / 1024.f) + EPS);
            u32x2* o8 = (u32x2*)(N1 + (size_t)m * 1024) + lane;
#pragma unroll
            for (int j = 0; j < 4; ++j) { u32x2 w; w.x = pk2(v[j][0] * rstd * gg[j][0], v[j][1] * rstd * gg[j][1]); w.y = pk2(v[j][2] * rstd * gg[j][2], v[j][3] * rstd * gg[j][3]); o8[64 * j] = w; }
        }
    }
    for (int m = gw; m < 256; m += NGW) {
        if (m < NMETA) rms_row_bf16(in[1] + (size_t)m * 1024, in[2], N1 + (size_t)(METAROW + m) * 1024, lane);
        else { u32x4* o = (u32x4*)(N1 + (size_t)(METAROW + m) * 1024); o[lane] = (u32x4){0u, 0u, 0u, 0u}; o[64 + lane] = (u32x4){0u, 0u, 0u, 0u}; }
    }
}

__device__ __forceinline__ int prev_row(int r, int j) {
    if (r < M) { const int s = r & (SEQ - 1); return s >= j ? r - j : METAROW + NMETA + (s - j); }
    const int p = r - METAROW; return p >= j ? r - j : -1;
}
struct ThinRow { u32x4 xa, xb, cq, ckv; unsigned k1, k2; };
__device__ __forceinline__ ThinRow thin_load(const bf16_t* XR, const bf16_t* CQKV, int r, int lane) {
    ThinRow d; const bf16_t* z = CQKV + (size_t)r * CQKV_LD;
    d.xa = *(const u32x4*)(XR + (size_t)r * 1024 + lane * 8); d.xb = *(const u32x4*)(XR + (size_t)r * 1024 + 512 + lane * 8);
    d.cq = *(const u32x4*)(z + CQ_OFF + (lane < 48 ? lane : 0) * 8); d.ckv = *(const u32x4*)(z + (lane & 31) * 8);
    d.k1 = z[KR_OFF + (lane & 15)]; d.k2 = z[KR_OFF + 16 + (lane & 15)];
    return d;
}
__device__ __forceinline__ void thin_row_stats(unsigned char* ws, const ThinRow& d, int r, int lane) {
    float* RSQ = (float*)(ws + WS_RSQ); float* RSKV = (float*)(ws + WS_RSKV); bf16_t* KROPE = (bf16_t*)(ws + WS_KROPE);
    float sq = 0.f, skv = 0.f;
    { float v[8]; unpack8(d.cq, v); float a = 0.f;
#pragma unroll
      for (int i = 0; i < 8; ++i) a += v[i] * v[i];
      sq = lane < 48 ? a : 0.f; }
    { float v[8]; unpack8(d.ckv, v); float a = 0.f;
#pragma unroll
      for (int i = 0; i < 8; ++i) a += v[i] * v[i];
      skv = lane < 32 ? a : 0.f; }
    sq = wave_sum(sq); skv = wave_sum(skv);
    if (lane == 0) { RSQ[r] = 1.f / sqrtf(sq * (1.f / 384.f) + EPS); RSKV[r] = 1.f / sqrtf(skv * (1.f / 256.f) + EPS); }
    if (lane < 16) { const int pos = r < M ? NMETA + (r & (SEQ - 1)) : r - METAROW; const float x1 = bf2f((bf16_t)d.k1), x2 = bf2f((bf16_t)d.k2);
        const float c = ((const float*)(ws + WS_CTAB))[pos * 16 + lane], s = ((const float*)(ws + WS_STAB))[pos * 16 + lane];
        ((unsigned*)(KROPE + (size_t)r * 32))[lane] = pk2(x1 * c - x2 * s, x1 * s + x2 * c); }
}
__device__ __forceinline__ void phase_thin(const Ctx& C) {
    unsigned char* ws = C.ws; const float* const* in = C.in; const int lane = C.lane;
    const bf16_t* XR = (const bf16_t*)(ws + SLOT(1)); const bf16_t* CQKV = (const bf16_t*)(ws + SLOT(3)); bf16_t* XC = (bf16_t*)(ws + SLOT(0));
    const float* cw = in[4]; const float* cb = in[5];
    float w[4][16], bias[16];
#pragma unroll
    for (int hh = 0; hh < 2; ++hh)
#pragma unroll
        for (int i = 0; i < 8; ++i) { const int ch = hh * 512 + lane * 8 + i; bias[hh * 8 + i] = cb[ch];
#pragma unroll
            for (int t = 0; t < 4; ++t) w[t][hh * 8 + i] = cw[t * 1024 + ch]; }
    for (int st = C.gw; st < M / 32 + 1; st += C.NGW) {
        const bool meta = st == M / 32; const int r0 = meta ? METAROW : st * 32, nrow = meta ? NMETA : 32;
        float x1[16], x2[16], x3[16];
        const bool first = meta || (r0 & (SEQ - 1)) == 0;
        ThinRow nx = thin_load(XR, CQKV, r0, lane);
#pragma unroll
        for (int j = 1; j <= 3; ++j) { const int pr = first ? (meta ? -1 : METAROW + NMETA - j) : r0 - j;
#pragma unroll
            for (int hh = 0; hh < 2; ++hh) { float v[8];
                if (pr >= 0) unpack8(*(const u32x4*)(XR + (size_t)pr * 1024 + hh * 512 + lane * 8), v); else {
#pragma unroll
                    for (int i = 0; i < 8; ++i) v[i] = 0.f; }
#pragma unroll
                for (int i = 0; i < 8; ++i) { if (j == 1) x1[hh * 8 + i] = v[i]; else if (j == 2) x2[hh * 8 + i] = v[i]; else x3[hh * 8 + i] = v[i]; } } }
        for (int t = 0; t < nrow; ++t) { const int r = r0 + t; float x0[16];
            const ThinRow d = nx;
            if (t + 1 < nrow) nx = thin_load(XR, CQKV, r + 1, lane);
            { float v[8]; unpack8(d.xa, v);
#pragma unroll
              for (int i = 0; i < 8; ++i) x0[i] = v[i];
              unpack8(d.xb, v);
#pragma unroll
              for (int i = 0; i < 8; ++i) x0[8 + i] = v[i]; }
#pragma unroll
            for (int hh = 0; hh < 2; ++hh) { float y[8];
#pragma unroll
                for (int i = 0; i < 8; ++i) { const int q = hh * 8 + i; y[i] = bias[q] + w[3][q] * x0[q] + w[2][q] * x1[q] + w[1][q] * x2[q] + w[0][q] * x3[q]; }
                *(u32x4*)(XC + (size_t)r * 1024 + hh * 512 + lane * 8) = pack8(y); }
#pragma unroll
            for (int q = 0; q < 16; ++q) { x3[q] = x2[q]; x2[q] = x1[q]; x1[q] = x0[q]; }
            thin_row_stats(ws, d, r, lane);
        }
    }
    float* RSQ = (float*)(ws + WS_RSQ); float* RSKV = (float*)(ws + WS_RSKV); bf16_t* KROPE = (bf16_t*)(ws + WS_KROPE);
    for (int r = M + NMETA + C.gw; r < MTOT; r += C.NGW) {
        u32x4* o = (u32x4*)(XC + (size_t)r * 1024); o[lane] = (u32x4){0u, 0u, 0u, 0u}; o[64 + lane] = (u32x4){0u, 0u, 0u, 0u};
        if (lane == 0) { RSQ[r] = 0.f; RSKV[r] = 0.f; }
        if (lane < 16) ((unsigned*)(KROPE + (size_t)r * 32))[lane] = 0u;
    }
}

__device__ __forceinline__ void phase_scan1(const Ctx& C) {
    unsigned char* ws = C.ws; const int lane = C.lane;
    const bf16_t* LA = (const bf16_t*)(ws + SLOT(1)); const bf16_t* UU = (const bf16_t*)(ws + SLOT(6));
    float* SCP = (float*)(ws + WS_SCP); float* SCH = (float*)(ws + WS_SCH); float* CARRY0 = (float*)(ws + WS_CARRY0);
    for (int it = C.gw; it < 2048 + 4; it += C.NGW) {
        const bool meta = it >= 2048; const int q = it & 3, bc = it >> 2, ch = q * 256 + lane * 4;
        const int row0 = meta ? METAROW : bc * 128, nrow = meta ? NMETA : 128;
        float P[4] = {1.f, 1.f, 1.f, 1.f}, H[4] = {0.f, 0.f, 0.f, 0.f};
#pragma unroll 8
        for (int t = 0; t < nrow; ++t) { const u32x2 l2 = *(const u32x2*)(LA + (size_t)(row0 + t) * 1024 + ch), u2 = *(const u32x2*)(UU + (size_t)(row0 + t) * 1024 + ch);
            const float a0 = ex2(LOG2E * bf_lo(l2.x)), a1 = ex2(LOG2E * bf_hi(l2.x)), a2 = ex2(LOG2E * bf_lo(l2.y)), a3 = ex2(LOG2E * bf_hi(l2.y));
            P[0] *= a0; P[1] *= a1; P[2] *= a2; P[3] *= a3;
            H[0] = a0 * H[0] + bf_lo(u2.x); H[1] = a1 * H[1] + bf_hi(u2.x); H[2] = a2 * H[2] + bf_lo(u2.y); H[3] = a3 * H[3] + bf_hi(u2.y); }
        if (meta) *(f32x4*)(CARRY0 + ch) = (f32x4){H[0], H[1], H[2], H[3]};
        else { *(f32x4*)(SCP + (size_t)bc * 1024 + ch) = (f32x4){P[0], P[1], P[2], P[3]}; *(f32x4*)(SCH + (size_t)bc * 1024 + ch) = (f32x4){H[0], H[1], H[2], H[3]}; }
    }
}
__device__ __forceinline__ void phase_scan2(const Ctx& C) {
    unsigned char* ws = C.ws; const int lane = C.lane;
    const bf16_t* LA = (const bf16_t*)(ws + SLOT(1)); const bf16_t* UU = (const bf16_t*)(ws + SLOT(6)); const bf16_t* GR = (const bf16_t*)(ws + SLOT(2)); bf16_t* HRG = (bf16_t*)(ws + SLOT(0));
    const float* SCP = (const float*)(ws + WS_SCP); const float* SCH = (const float*)(ws + WS_SCH); const float* CARRY0 = (const float*)(ws + WS_CARRY0);
    for (int it = C.gw; it < 2048; it += C.NGW) {
        const int q = it & 3, bc = it >> 2, b = bc >> 4, c = bc & 15, ch = q * 256 + lane * 4;
        f32x4 h = *(const f32x4*)(CARRY0 + ch);
        for (int cc = 0; cc < c; ++cc) { const f32x4 p = *(const f32x4*)(SCP + (size_t)(b * 16 + cc) * 1024 + ch), e = *(const f32x4*)(SCH + (size_t)(b * 16 + cc) * 1024 + ch); h = p * h + e; }
        float H[4] = {h[0], h[1], h[2], h[3]};
        const int row0 = bc * 128;
#pragma unroll 8
        for (int t = 0; t < 128; ++t) { const size_t off = (size_t)(row0 + t) * 1024 + ch; const u32x2 l2 = *(const u32x2*)(LA + off), u2 = *(const u32x2*)(UU + off), g2 = *(const u32x2*)(GR + off);
            H[0] = ex2(LOG2E * bf_lo(l2.x)) * H[0] + bf_lo(u2.x); H[1] = ex2(LOG2E * bf_hi(l2.x)) * H[1] + bf_hi(u2.x); H[2] = ex2(LOG2E * bf_lo(l2.y)) * H[2] + bf_lo(u2.y); H[3] = ex2(LOG2E * bf_hi(l2.y)) * H[3] + bf_hi(u2.y);
            u32x2 o; o.x = pk2(H[0] * bf_lo(g2.x), H[1] * bf_hi(g2.x)); o.y = pk2(H[2] * bf_lo(g2.y), H[3] * bf_hi(g2.y)); *(u32x2*)(HRG + off) = o; }
    }
}

constexpr int AT_KSLOT = 12 * 1024, AT_VSLOT = 8192;
#define AT_K(j) (((j) & 3) * AT_KSLOT)
#define AT_V(j) (4 * AT_KSLOT + ((j) & 7) * AT_VSLOT)
static_assert(4 * AT_KSLOT + 8 * AT_VSLOT <= 131072, "attention rings fit the phase scratch");
__device__ __forceinline__ void glds16(const void* gsrc, unsigned lds_dst) { unsigned keep;
    asm volatile("s_mov_b32 %0, m0\n\ts_mov_b32 m0, %2\n\ts_nop 0\n\tglobal_load_lds_dwordx4 %1, off\n\ts_mov_b32 m0, %0" : "=&s"(keep) : "v"(gsrc), "s"(lds_dst) : "memory"); }
#define AT_BAR(N) asm volatile("s_waitcnt vmcnt(" #N ") lgkmcnt(0)\n\ts_barrier" ::: "memory")
__device__ __forceinline__ int crow(int r, int hi) { return (r & 3) + 8 * (r >> 2) + 4 * hi; }
__device__ __forceinline__ void attn_q(LAS unsigned char* lds, int j, int s0, int q, int hi, const bf16x8 (&qf)[6], const f32x16& negm, f32x16& p0, f32x16& p1) {
    const int kb = AT_K(j);
    __builtin_amdgcn_s_setprio(1);
#pragma unroll
    for (int ks = 0; ks < 6; ++ks) {
        const bf16x8 a0 = *(const LAS bf16x8*)(lds + kb + (2 * ks + hi) * 1024 + q * 16);
        const bf16x8 a1 = *(const LAS bf16x8*)(lds + kb + (2 * ks + hi) * 1024 + (32 + q) * 16);
        if (ks == 0) { p0 = __builtin_amdgcn_mfma_f32_32x32x16_bf16(a0, qf[0], negm, 0, 0, 0); p1 = __builtin_amdgcn_mfma_f32_32x32x16_bf16(a1, qf[0], negm, 0, 0, 0); }
        else { p0 = __builtin_amdgcn_mfma_f32_32x32x16_bf16(a0, qf[ks], p0, 0, 0, 0); p1 = __builtin_amdgcn_mfma_f32_32x32x16_bf16(a1, qf[ks], p1, 0, 0, 0); }
    }
    __builtin_amdgcn_s_setprio(0);
    if (j == 0) {
#pragma unroll
        for (int r = 0; r < 16; ++r) { if (crow(r, hi) >= NMETA) p0[r] = -INFINITY; p1[r] = -INFINITY; }
    } else if ((j - 1) * 64 + 63 > s0) {
        const int qs = s0 + q, k0 = (j - 1) * 64;
#pragma unroll
        for (int r = 0; r < 16; ++r) { const int kk = k0 + crow(r, hi); if (kk > qs) p0[r] = -INFINITY; if (kk + 32 > qs) p1[r] = -INFINITY; }
    }
}
__device__ __forceinline__ void attn_pv(LAS unsigned char* lds, int vbase, const bf16x8 (&pb)[4], f32x16& o0, f32x16& o1) {
#pragma unroll
    for (int s = 0; s < 4; ++s)
#pragma unroll
        for (int db = 0; db < 2; ++db) {
            const v4i16_t lo = __builtin_amdgcn_ds_read_tr16_b64_v4i16((LAS v4i16_t*)(lds + vbase + db * 4096 + s * 1024));
            const v4i16_t hh = __builtin_amdgcn_ds_read_tr16_b64_v4i16((LAS v4i16_t*)(lds + vbase + db * 4096 + s * 1024 + 512));
            const bf16x8 va = {lo[0], lo[1], lo[2], lo[3], hh[0], hh[1], hh[2], hh[3]};
            if (db == 0) o0 = __builtin_amdgcn_mfma_f32_32x32x16_bf16(va, pb[s], o0, 0, 0, 0); else o1 = __builtin_amdgcn_mfma_f32_32x32x16_bf16(va, pb[s], o1, 0, 0, 0);
        }
}
#ifndef ATT_THR
#define ATT_THR 8.0f
#endif
template <bool DOPV, bool FIRST> __device__ __forceinline__ void attn_sp(LAS unsigned char* lds, int vbase, f32x16& p0, f32x16& p1, bf16x8 (&pb)[4], f32x16& o0, f32x16& o1, f32x16& negm, float& m_run, float& l_run) {
    float mx = fmaxf(p0[0], p1[0]);
#pragma unroll
    for (int r = 1; r < 16; ++r) mx = fmaxf(fmaxf(mx, p0[r]), p1[r]);
    mx = fmaxf(mx, __shfl_xor(mx, 32));
    if (DOPV) attn_pv(lds, vbase, pb, o0, o1);
    float rs = 0.f;
#pragma unroll
    for (int r = 0; r < 16; ++r) { p0[r] = ex2(p0[r]); p1[r] = ex2(p1[r]); rs += p0[r] + p1[r]; }
    if (FIRST || !__all(mx <= ATT_THR)) {
        const float d = FIRST ? mx : fmaxf(mx, 0.f), alpha = ex2(-d);
#pragma unroll
        for (int r = 0; r < 16; ++r) { p0[r] *= alpha; p1[r] *= alpha; o0[r] *= alpha; o1[r] *= alpha; }
        rs *= alpha; l_run *= alpha; m_run += d;
#pragma unroll
        for (int r = 0; r < 16; ++r) negm[r] = -m_run;
    }
    l_run += rs;
#pragma unroll
    for (int s = 0; s < 4; ++s) { unsigned w[4];
#pragma unroll
        for (int jj = 0; jj < 4; ++jj) w[jj] = (s < 2) ? pk2(p0[8 * (s & 1) + 2 * jj], p0[8 * (s & 1) + 2 * jj + 1]) : pk2(p1[8 * (s & 1) + 2 * jj], p1[8 * (s & 1) + 2 * jj + 1]);
        u32x4 ww = {w[0], w[1], w[2], w[3]}; pb[s] = __builtin_bit_cast(bf16x8, ww); }
}
__device__ __forceinline__ void attn_unit(const Ctx& C, int b, int h, int qb, const bf16_t* Q, const bf16_t* KN, const bf16_t* KR, const bf16_t* V, bf16_t* O) {
    const int tid = C.tid, lane = C.lane, wid = C.wave, q = lane & 31, hi = lane >> 5;
    LAS unsigned char* lds = C.lds;
    const int s0 = qb * 256 + wid * 32;
    const size_t qrow = (size_t)b * SEQ + s0 + q;
    bf16x8 qf[6];
#pragma unroll
    for (int ks = 0; ks < 6; ++ks) qf[ks] = *(const bf16x8*)(Q + qrow * QLD + h * 96 + ks * 16 + hi * 8);
    {
        const float* ctab = (const float*)(C.ws + WS_CTAB) + (NMETA + s0 + q) * 16; const float* stab = (const float*)(C.ws + WS_STAB) + (NMETA + s0 + q) * 16;
#pragma unroll
        for (int ks = 4; ks < 6; ++ks) { const f32x4 cc = *(const f32x4*)(ctab + 8 * (ks - 4) + 4 * hi), sn = *(const f32x4*)(stab + 8 * (ks - 4) + 4 * hi);
            const u32x4 w = __builtin_bit_cast(u32x4, qf[ks]); u32x4 r;
            { const float x1 = bf_lo(w.x), x2 = bf_hi(w.x); r.x = pk2(x1 * cc[0] - x2 * sn[0], x1 * sn[0] + x2 * cc[0]); }
            { const float x1 = bf_lo(w.y), x2 = bf_hi(w.y); r.y = pk2(x1 * cc[1] - x2 * sn[1], x1 * sn[1] + x2 * cc[1]); }
            { const float x1 = bf_lo(w.z), x2 = bf_hi(w.z); r.z = pk2(x1 * cc[2] - x2 * sn[2], x1 * sn[2] + x2 * cc[2]); }
            { const float x1 = bf_lo(w.w), x2 = bf_hi(w.w); r.w = pk2(x1 * cc[3] - x2 * sn[3], x1 * sn[3] + x2 * cc[3]); }
            qf[ks] = __builtin_bit_cast(bf16x8, r); }
    }
    f32x16 o0 = {}, o1 = {}, p0 = {}, p1 = {};
    bf16x8 pb[4] = {};
    float m_run = 0.f, l_run = 0.f; f32x16 negm = {};
    const int NJ = 4 * qb + 5;
    const unsigned lds0 = (unsigned)(size_t)lds;
    const bf16_t* ksrc = KN + (size_t)lane * 1024 + h * 64 + wid * 8;
    const bf16_t* rsrc = KR + (size_t)lane * 32 + (wid & 3) * 8;
    const bf16_t* vsrc = V + (size_t)(16 * (wid & 3) + (lane >> 2)) * 1024 + h * 64 + (wid >> 2) * 32 + (lane & 3) * 8;
#define AT_DMA(j) do { const size_t row_ = (j) == 0 ? (size_t)METAROW : (size_t)b * SEQ + (size_t)((j) - 1) * 64; \
        glds16(ksrc + row_ * 1024, (unsigned)__builtin_amdgcn_readfirstlane(lds0 + AT_K(j) + wid * 1024)); \
        if (wid < 4) glds16(rsrc + row_ * 32, (unsigned)__builtin_amdgcn_readfirstlane(lds0 + AT_K(j) + (8 + wid) * 1024)); \
        glds16(vsrc + row_ * 1024, (unsigned)__builtin_amdgcn_readfirstlane(lds0 + AT_V(j) + wid * 1024)); } while (0)
#define AT_STEP(n) do { if ((n) + 2 < NJ) { if (wid < 4) AT_BAR(6); else AT_BAR(4); } else if ((n) + 1 < NJ) { if (wid < 4) AT_BAR(3); else AT_BAR(2); } else AT_BAR(0); if ((n) + 3 < NJ) AT_DMA((n) + 3); } while (0)
    AT_BAR(0);
    AT_DMA(0); AT_DMA(1); AT_DMA(2);
    const int g16 = lane >> 4, qq = (lane & 15) >> 2, pp = lane & 3;
    const int vtr_off = (4 * hi + qq) * 64 + (16 * (g16 & 1) + 4 * pp) * 2;
    {
        AT_STEP(0);
        attn_q(lds, 0, s0, q, hi, qf, negm, p0, p1);
        attn_sp<false, true>(lds, 0, p0, p1, pb, o0, o1, negm, m_run, l_run);
    }
    const int jend = (s0 + 31) / 64 + 2 < NJ ? (s0 + 31) / 64 + 2 : NJ;
    for (int j = 1; j < jend; ++j) {
        AT_STEP(j);
        attn_q(lds, j, s0, q, hi, qf, negm, p0, p1);
        attn_sp<true, false>(lds, AT_V(j - 1) + vtr_off, p0, p1, pb, o0, o1, negm, m_run, l_run);
    }
    attn_pv(lds, AT_V(jend - 1) + vtr_off, pb, o0, o1);
    for (int j = jend; j < NJ; ++j) AT_STEP(j);
#undef AT_DMA
#undef AT_STEP
    const float inv = 1.f / (l_run + __shfl_xor(l_run, 32));
    bf16_t* orow = O + qrow * 1024 + h * 64;
#pragma unroll
    for (int g4 = 0; g4 < 4; ++g4) {
        u32x2 w0, w1; w0.x = pk2(o0[4 * g4] * inv, o0[4 * g4 + 1] * inv); w0.y = pk2(o0[4 * g4 + 2] * inv, o0[4 * g4 + 3] * inv);
        w1.x = pk2(o1[4 * g4] * inv, o1[4 * g4 + 1] * inv); w1.y = pk2(o1[4 * g4 + 2] * inv, o1[4 * g4 + 3] * inv);
        *(u32x2*)(orow + 8 * g4 + 4 * hi) = w0; *(u32x2*)(orow + 32 + 8 * g4 + 4 * hi) = w1;
    }
}
__device__ __forceinline__ void phase_attn(const Ctx& C) {
    unsigned char* ws = C.ws;
    const bf16_t* Q = (const bf16_t*)(ws + SLOT(0)); const bf16_t* KN = (const bf16_t*)(ws + SLOT(4)); const bf16_t* V = (const bf16_t*)(ws + SLOT(6)); const bf16_t* KR = (const bf16_t*)(ws + WS_KROPE);
    bf16_t* O = (bf16_t*)(ws + SLOT(3));
    const int G = C.G, c = blockIdx.x; const int vcu = (G % 8 == 0) ? (c % 8) * (G / 8) + c / 8 : c;
    for (int bh = vcu; bh < NB * 16; bh += G)
        for (int i = 0; i < 8; ++i) { const int qb = (i & 1) ? 7 - (i >> 1) : (i >> 1); attn_unit(C, bh >> 4, bh & 15, qb, Q, KN, KR, V, O); }
    __syncthreads();
}

__device__ __forceinline__ int tk_enc(float f) { const int x = __float_as_int(f); return x ^ ((x >> 31) & 0x7fffffff); }
__device__ __forceinline__ float tk_dec(int k) { return __int_as_float(k ^ ((k >> 31) & 0x7fffffff)); }
#define TK_CE(a, b) do { const int hi_ = max((a), (b)), lo_ = min((a), (b)); (a) = hi_; (b) = lo_; } while (0)
__device__ __forceinline__ void tk_sort16(int (&v)[16]) {
#pragma unroll
    for (int k = 2; k <= 16; k <<= 1)
#pragma unroll
        for (int j = k >> 1; j > 0; j >>= 1)
#pragma unroll
            for (int i = 0; i < 16; ++i) { const int l = i ^ j; if (l > i) { if ((i & k) == 0) TK_CE(v[i], v[l]); else TK_CE(v[l], v[i]); } }
}
__device__ __forceinline__ void tk_merge16(int (&a)[16], const int (&b)[16]) {
#pragma unroll
    for (int i = 0; i < 16; ++i) a[i] = max(a[i], b[15 - i]);
#pragma unroll
    for (int j = 8; j > 0; j >>= 1)
#pragma unroll
        for (int i = 0; i < 16; ++i) { const int l = i ^ j; if (l > i) TK_CE(a[i], a[l]); }
}
__host__ __device__ constexpr int tk_pos(int i) { int n = 0; for (int a = 0; a < i; ++a) n += 16 / (a + 1); return n; }
__device__ __forceinline__ int tk_lookup(const int (&w)[4], int i) {
    const unsigned long long lo = ((unsigned long long)(unsigned)w[1] << 32) | (unsigned long long)(unsigned)w[0], hi = ((unsigned long long)(unsigned)w[3] << 32) | (unsigned long long)(unsigned)w[2];
    const unsigned long long a = (i & 8) ? hi : lo;
    return (int)(a >> (8 * (i & 7))) & 127;
}
__device__ __forceinline__ void phase_topk(const Ctx& C) {
    unsigned char* ws = C.ws;
    const _Float16* SC = (const _Float16*)(ws + SLOT(0)); int* TIDX = (int*)(ws + SLOT(5)); float* TVAL = (float*)(ws + SLOT(5) + (size_t)M * 128 * 4);
    const int gt = blockIdx.x * NTHR + C.tid, NT = C.G * NTHR;
    for (int it = gt; it < M * 8 * 4; it += NT) {
        const int p = it >> 2, q = it & 3;
        const f16x8* s = (const f16x8*)(SC + (size_t)p * 256 + 64 * q);
        f16x8 raw[8];
#pragma unroll
        for (int c = 0; c < 8; ++c) raw[c] = s[c];
        const int ibase = 127 - 64 * (q & 1);
        int ch[4][16];
#pragma unroll
        for (int c = 0; c < 4; ++c)
#pragma unroll
            for (int e = 0; e < 16; ++e) ch[c][e] = (tk_enc((float)raw[2 * c + (e >> 3)][e & 7]) & ~127) | (ibase - (16 * c + e));
        tk_sort16(ch[0]); tk_sort16(ch[1]); tk_sort16(ch[2]); tk_sort16(ch[3]);
        tk_merge16(ch[0], ch[1]); tk_merge16(ch[2], ch[3]); tk_merge16(ch[0], ch[2]);
        int oth[16];
#pragma unroll
        for (int i = 0; i < 16; ++i) oth[i] = __builtin_amdgcn_mov_dpp(ch[0][i], 0xB1, 0xF, 0xF, true);
        tk_merge16(ch[0], oth);
#pragma unroll
        for (int i = 0; i < 16; ++i) oth[i] = __builtin_amdgcn_mov_dpp(ch[0][i], 0x4E, 0xF, 0xF, true);
        int t1[16], t2[16];
#pragma unroll
        for (int i = 0; i < 16; ++i) { t1[i] = (q < 2) ? ch[0][i] : oth[i]; t2[i] = (q < 2) ? oth[i] : ch[0][i]; }
        float f1[16], f2[16];
#pragma unroll
        for (int i = 0; i < 16; ++i) { f1[i] = tk_dec(t1[i]); f2[i] = tk_dec(t2[i]); }
        int cd[4][16];
#pragma unroll
        for (int i = 0; i < 16; ++i)
#pragma unroll
            for (int j = 0; j < 16; ++j) if ((i + 1) * (j + 1) <= 16) { constexpr int dummy = 0; (void)dummy; const int n = tk_pos(i) + j; cd[n >> 4][n & 15] = (tk_enc(f1[i] + f2[j]) & ~255) | (255 - (16 * i + j)); }
#pragma unroll
        for (int n = 50; n < 64; ++n) cd[n >> 4][n & 15] = (int)0x80000000;
        tk_sort16(cd[0]); tk_sort16(cd[1]); tk_sort16(cd[2]); tk_sort16(cd[3]);
        tk_merge16(cd[0], cd[1]); tk_merge16(cd[2], cd[3]); tk_merge16(cd[0], cd[2]);
        int w1[4], w2[4];
#pragma unroll
        for (int m = 0; m < 4; ++m) { w1[m] = (t1[4 * m] & 127) | ((t1[4 * m + 1] & 127) << 8) | ((t1[4 * m + 2] & 127) << 16) | ((t1[4 * m + 3] & 127) << 24);
                                      w2[m] = (t2[4 * m] & 127) | ((t2[4 * m + 1] & 127) << 8) | ((t2[4 * m + 2] & 127) << 16) | ((t2[4 * m + 3] & 127) << 24); }
        if (q == 0) {
            int id[16];
#pragma unroll
            for (int k = 0; k < 16; ++k) { const int c = 255 - (cd[0][k] & 255); id[k] = (127 - tk_lookup(w1, c >> 4)) * 128 + (127 - tk_lookup(w2, c & 15)); }
            int* oi = TIDX + (size_t)p * 16;
#pragma unroll
            for (int k = 0; k < 16; k += 4) *(int4*)(oi + k) = make_int4(id[k], id[k + 1], id[k + 2], id[k + 3]);
        } else if (q == 1) {
            float* ov = TVAL + (size_t)p * 16;
#pragma unroll
            for (int k = 0; k < 16; k += 4) *(f32x4*)(ov + k) = (f32x4){tk_dec(cd[0][k]), tk_dec(cd[0][k + 1]), tk_dec(cd[0][k + 2]), tk_dec(cd[0][k + 3])};
        }
    }
}

__device__ __forceinline__ float dpp_ror8(float v) { return __uint_as_float(__builtin_amdgcn_update_dpp(0, __float_as_uint(v), 0x128, 0xF, 0xF, true)); }
__device__ __forceinline__ float dpp_hmir(float v) { return __uint_as_float(__builtin_amdgcn_update_dpp(0, __float_as_uint(v), 0x141, 0xF, 0xF, true)); }
__device__ __forceinline__ float dpp_x2(float v) { return __uint_as_float(__builtin_amdgcn_mov_dpp(__float_as_uint(v), 0x4E, 0xF, 0xF, true)); }
__device__ __forceinline__ float dpp_x1(float v) { return __uint_as_float(__builtin_amdgcn_mov_dpp(__float_as_uint(v), 0xB1, 0xF, 0xF, true)); }
__device__ __forceinline__ void phase_x8(const Ctx& C) {
    unsigned char* ws = C.ws; const int lane = C.lane;
    const bf16_t* H1B = (const bf16_t*)(ws + SLOT(4)); unsigned char* X8 = ws + SLOT(2); float* XS = (float*)(ws + SLOT(2) + (size_t)M * 1024);
    for (int tok = C.gw; tok < M; tok += C.NGW) {
        const u32x4 xa = *(const u32x4*)(H1B + (size_t)tok * 1024 + 16 * lane), xb = *(const u32x4*)(H1B + (size_t)tok * 1024 + 16 * lane + 8);
        float hv[16]; { float t8[8]; unpack8(xa, t8);
#pragma unroll
            for (int i = 0; i < 8; ++i) hv[i] = t8[i];
            unpack8(xb, t8);
#pragma unroll
            for (int i = 0; i < 8; ++i) hv[8 + i] = t8[i]; }
        float am = 0.f;
#pragma unroll
        for (int i = 0; i < 16; ++i) am = fmaxf(am, fabsf(hv[i]));
#pragma unroll
        for (int o = 1; o < 64; o <<= 1) am = fmaxf(am, __shfl_xor(am, o));
        const float scale = am > 0.f ? am * (1.f / 127.f) : 1.f, inv = 1.f / scale;
        u32x4 w;
#pragma unroll
        for (int j = 0; j < 4; ++j) { const int q0 = (int)rintf(hv[4 * j] * inv), q1 = (int)rintf(hv[4 * j + 1] * inv), q2 = (int)rintf(hv[4 * j + 2] * inv), q3 = (int)rintf(hv[4 * j + 3] * inv);
            w[j] = (unsigned)(q0 & 255) | ((unsigned)(q1 & 255) << 8) | ((unsigned)(q2 & 255) << 16) | ((unsigned)q3 << 24); }
        *(u32x4*)(X8 + (size_t)tok * 1024 + 16 * lane) = w;
        if (lane == 0) XS[tok] = scale;
    }
}
__device__ __forceinline__ float idot16(const u32x4 w, const u32x4 x) {
    int a = __builtin_amdgcn_sdot4((int)w.x, (int)x.x, 0, false); a = __builtin_amdgcn_sdot4((int)w.y, (int)x.y, a, false);
    a = __builtin_amdgcn_sdot4((int)w.z, (int)x.z, a, false); a = __builtin_amdgcn_sdot4((int)w.w, (int)x.w, a, false);
    return (float)a;
}
__device__ __forceinline__ void u_process(unsigned c, unsigned co, int n, int tok, const u32x4 x, float xscale, const unsigned char* PU, float* ACT, int lane, bool b3) {
    for (int base = 0; base < n; base += 32) {
        u32x4 w[32];
#pragma unroll
        for (int g = 0; g < 4; ++g) if (base + 8 * g < n) {
#pragma unroll
            for (int k = 0; k < 8; ++k) { const unsigned off = __builtin_amdgcn_readlane(co, (base + 8 * g + k) & 63); w[8 * g + k] = *(const u32x4*)(PU + off + 16 * lane); } }
        __builtin_amdgcn_sched_barrier(0);
#pragma unroll
        for (int g = 0; g < 4; ++g) if (base + 8 * g < n) {
            float p[8];
#pragma unroll
            for (int k = 0; k < 8; ++k) p[k] = idot16(w[8 * g + k], x);
            float q4[4], q2[2];
#pragma unroll
            for (int i = 0; i < 4; ++i) { auto rr = __builtin_amdgcn_permlane32_swap(__float_as_uint(p[i]), __float_as_uint(p[4 + i]), false, false); q4[i] = __uint_as_float(rr[0]) + __uint_as_float(rr[1]); }
#pragma unroll
            for (int i = 0; i < 2; ++i) { auto rr = __builtin_amdgcn_permlane16_swap(__float_as_uint(q4[i]), __float_as_uint(q4[2 + i]), false, false); q2[i] = __uint_as_float(rr[0]) + __uint_as_float(rr[1]); }
            float t; { const float keep = b3 ? q2[1] : q2[0], send = b3 ? q2[0] : q2[1]; t = keep + dpp_ror8(send); }
            t += dpp_hmir(t); t += dpp_x2(t); t += dpp_x1(t);
            const int slot = base + 8 * g + (lane >> 3);
            const unsigned mine = (unsigned)__builtin_amdgcn_ds_bpermute((slot & 63) * 4, (int)c);
            if ((lane & 7) == 0 && slot < n) ACT[(size_t)tok * 128 + (mine >> 16)] = t * xscale;
        }
    }
}
__device__ __forceinline__ void phase_upart(const Ctx& C, int xcc, int rank) {
    unsigned char* ws = C.ws; const int lane = C.lane;
    const unsigned char* X8 = ws + SLOT(2); const float* XS = (const float*)(ws + SLOT(2) + (size_t)M * 1024);
    const int* TIDX = (const int*)(ws + SLOT(5)); float* ACT = (float*)(ws + SLOT(0));
    const unsigned char* PU = ws + WS_PU;
    int nloc, xi, nx;
    if ((C.G & 7) == 0) { nx = 8; xi = xcc; nloc = C.G >> 3; } else { nx = 1; xi = 0; nloc = C.G; rank = blockIdx.x; }
    const bool b3 = (lane & 8) != 0;
    const int tstep = nloc * NWAVES;
    for (int sub = xi; sub < 8; sub += nx) {
        const unsigned dummy = (unsigned)(sub << 11) * 1024u;
        int tok = rank * NWAVES + C.wave;
        u32x4 xn = {0u, 0u, 0u, 0u}; float sn = 0.f; int ia = 0, ib = 0;
        if (tok < M) { xn = *(const u32x4*)(X8 + (size_t)tok * 1024 + 16 * lane); sn = XS[tok]; ia = TIDX[(size_t)tok * 128 + lane]; ib = TIDX[(size_t)tok * 128 + 64 + lane]; }
        for (; tok < M; tok += tstep) {
            const u32x4 x = xn; const float xscale = sn; const int ca = ia, cb = ib;
            const int nt = tok + tstep;
            if (nt < M) { xn = *(const u32x4*)(X8 + (size_t)nt * 1024 + 16 * lane); sn = XS[nt]; ia = TIDX[(size_t)nt * 128 + lane]; ib = TIDX[(size_t)nt * 128 + 64 + lane]; }
            const bool fa = (ca >> 11) == sub, fb = (cb >> 11) == sub;
            const unsigned long long ma = __ballot(fa), mb = __ballot(fb);
            const int npa = __builtin_popcountll(ma), npb = __builtin_popcountll(mb);
            const int ra_ = (int)__builtin_amdgcn_mbcnt_hi((unsigned)(ma >> 32), __builtin_amdgcn_mbcnt_lo((unsigned)ma, 0u));
            const int rb_ = (int)__builtin_amdgcn_mbcnt_hi((unsigned)(mb >> 32), __builtin_amdgcn_mbcnt_lo((unsigned)mb, 0u));
            const int da = fa ? ra_ : npa + (lane - ra_), db = fb ? rb_ : npb + (lane - rb_);
            const unsigned cA = (unsigned)__builtin_amdgcn_ds_permute(da * 4, ca | (lane << 16));
            const unsigned cB = (unsigned)__builtin_amdgcn_ds_permute(db * 4, cb | ((64 + lane) << 16));
            if (npa + npb <= 64) {
                const unsigned pulled = (unsigned)__builtin_amdgcn_ds_bpermute(((lane - npa) & 63) * 4, (int)cB);
                const unsigned cc = lane < npa ? cA : pulled; const int n = npa + npb;
                u_process(cc, lane < n ? (cc & 0xffffu) * 1024u : dummy, n, tok, x, xscale, PU, ACT, lane, b3);
            } else { u_process(cA, lane < npa ? (cA & 0xffffu) * 1024u : dummy, npa, tok, x, xscale, PU, ACT, lane, b3);
                     u_process(cB, lane < npb ? (cB & 0xffffu) * 1024u : dummy, npb, tok, x, xscale, PU, ACT, lane, b3); }
        }
    }
}
__device__ __forceinline__ void phase_gather(const Ctx& C, float* DST) {
    unsigned char* ws = C.ws; const int lane = C.lane;
    const bf16_t* H1B = (const bf16_t*)(ws + SLOT(4)); const int* TIDX = (const int*)(ws + SLOT(5)); const float* TVAL = (const float*)(ws + SLOT(5) + (size_t)M * 128 * 4);
    const float* ACT = (const float*)(ws + SLOT(0));
    const unsigned char* PV = ws + WS_PV; const float* SU = (const float*)(ws + WS_SU); const float* SV = (const float*)(ws + WS_SV);
    const float* fg = C.in[24];
    const int l4 = lane >> 2, ll = lane & 31; const bool hb = lane >= 32;
    const int ln = 2 * ll + (lane >> 5);
    int tok = C.gw;
    u32x4 ra = {0u, 0u, 0u, 0u}, rb = {0u, 0u, 0u, 0u};
    if (tok < M) { ra = *(const u32x4*)(H1B + (size_t)tok * 1024 + 16 * ln); rb = *(const u32x4*)(H1B + (size_t)tok * 1024 + 16 * ln + 8); }
    for (; tok < M; tok += C.NGW) {
        f32x4 e[4]; float ss = 0.f;
        { float hv[16]; { float t8[8]; unpack8(ra, t8);
#pragma unroll
            for (int i = 0; i < 8; ++i) hv[i] = t8[i];
            unpack8(rb, t8);
#pragma unroll
            for (int i = 0; i < 8; ++i) hv[8 + i] = t8[i]; }
#pragma unroll
          for (int j = 0; j < 4; ++j) { e[j] = (f32x4){hv[4 * j], hv[4 * j + 1], hv[4 * j + 2], hv[4 * j + 3]}; ss += (e[j][0] * e[j][0] + e[j][1] * e[j][1]) + (e[j][2] * e[j][2] + e[j][3] * e[j][3]); } }
        { const int nt = tok + C.NGW; if (nt < M) { ra = *(const u32x4*)(H1B + (size_t)nt * 1024 + 16 * ln); rb = *(const u32x4*)(H1B + (size_t)nt * 1024 + 16 * ln + 8); } }
        f32x4* dp = (f32x4*)(DST + (size_t)tok * 1024 + 16 * ln);
        const float rstd = 1.f / sqrtf(wave_sum(ss) * (1.f / 1024.f) + EPS);
        f32x2 acc[16];
#pragma unroll
        for (int i = 0; i < 16; ++i) acc[i] = (f32x2){0.f, 0.f};
        int idxn0 = TIDX[(size_t)tok * 128 + l4], idxn1 = TIDX[(size_t)tok * 128 + 16 + l4];
        float tsn0 = TVAL[(size_t)tok * 128 + l4], tsn1 = TVAL[(size_t)tok * 128 + 16 + l4], dtn0 = ACT[(size_t)tok * 128 + l4], dtn1 = ACT[(size_t)tok * 128 + 16 + l4];
        for (int hp = 0; hp < 8; hp += 2) {
            const int idx0 = idxn0, idx1 = idxn1; const float ts0 = tsn0 * rstd, ts1 = tsn1 * rstd, dot0 = dtn0, dot1 = dtn1;
            u32x4 pa[16]; u32x2 pb[16];
#pragma unroll
            for (int m = 0; m < 16; ++m) { const int src = m < 8 ? idx0 : idx1; const int ida = __builtin_amdgcn_readlane(src, 4 * ((2 * m) & 15)), idb = __builtin_amdgcn_readlane(src, 4 * ((2 * m + 1) & 15));
                const unsigned char* rp = PV + (size_t)(hb ? idb : ida) * 768; pa[m] = *(const u32x4*)(rp + 16 * ll); pb[m] = *(const u32x2*)(rp + 512 + 8 * ll); }
            __builtin_amdgcn_sched_barrier(0);
            const float su0 = SU[idx0], sv0 = SV[idx0], su1 = SU[idx1], sv1 = SV[idx1];
            if (hp < 6) { const size_t nb = (size_t)tok * 128 + (hp + 2) * 16 + l4; idxn0 = TIDX[nb]; idxn1 = TIDX[nb + 16]; tsn0 = TVAL[nb]; tsn1 = TVAL[nb + 16]; dtn0 = ACT[nb]; dtn1 = ACT[nb + 16]; }
            __builtin_amdgcn_sched_barrier(0);
            float mx0 = ts0, mx1 = ts1;
#pragma unroll
            for (int o = 4; o < 64; o <<= 1) { mx0 = fmaxf(mx0, __shfl_xor(mx0, o)); mx1 = fmaxf(mx1, __shfl_xor(mx1, o)); }
            const float ee0 = ex2((ts0 - mx0) * LOG2E), ee1 = ex2((ts1 - mx1) * LOG2E); float sm0 = ee0, sm1 = ee1;
#pragma unroll
            for (int o = 4; o < 64; o <<= 1) { sm0 += __shfl_xor(sm0, o); sm1 += __shfl_xor(sm1, o); }
            const float coef0 = (ee0 / sm0) * gelu_t(dot0 * su0 * rstd) * sv0, coef1 = (ee1 / sm1) * gelu_t(dot1 * su1 * rstd) * sv1;
#pragma unroll
            for (int m = 0; m < 16; ++m) {
                const unsigned cs = __float_as_uint(m < 8 ? coef0 : coef1);
                const float ca = __uint_as_float(__builtin_amdgcn_readlane(cs, 4 * ((2 * m) & 15))), cb = __uint_as_float(__builtin_amdgcn_readlane(cs, 4 * ((2 * m + 1) & 15)));
                const float ck = hb ? cb : ca;
                const f32x32 r = __builtin_amdgcn_cvt_scalef32_pk32_f32_fp6((u32x6){pa[m].x, pa[m].y, pa[m].z, pa[m].w, pb[m].x, pb[m].y}, 1.0f);
#pragma unroll
                for (int j = 0; j < 16; ++j) acc[j] = __builtin_elementwise_fma((f32x2){r[2 * j], r[2 * j + 1]}, (f32x2){ck, ck}, acc[j]);
                __builtin_amdgcn_sched_barrier(0);
            }
        }
        float s2 = 0.f;
#pragma unroll
        for (int j = 0; j < 4; ++j) {
#pragma unroll
            for (int i = 0; i < 4; ++i) { const int q = 4 * j + i; auto rr = __builtin_amdgcn_permlane32_swap(__float_as_uint(acc[q >> 1][q & 1]), __float_as_uint(acc[8 + (q >> 1)][q & 1]), false, false);
                e[j][i] += __uint_as_float(rr[0]) + __uint_as_float(rr[1]); }
            s2 += (e[j][0] * e[j][0] + e[j][1] * e[j][1]) + (e[j][2] * e[j][2] + e[j][3] * e[j][3]); }
        const float r2 = 1.f / sqrtf(wave_sum(s2) * (1.f / 1024.f) + EPS);
        const f32x4* fp = (const f32x4*)(fg + 16 * ln);
#pragma unroll
        for (int j = 0; j < 4; ++j) dp[j] = e[j] * r2 * fp[j];
    }
}

constexpr int NPHASE = 16;
__global__ void __launch_bounds__(NTHR, 2) hybrid_fwd(Args args) {
    extern __shared__ __attribute__((aligned(16))) unsigned char lds_raw[];
    Ctx C;
    C.lds = (LAS unsigned char*)lds_raw; C.tid = threadIdx.x; C.lane = C.tid & 63; C.wave = __builtin_amdgcn_readfirstlane(C.tid >> 6);
    C.G = gridDim.x; C.gw = blockIdx.x * NWAVES + C.wave; C.NGW = C.G * NWAVES; C.ws = args.ws; C.out = args.out; C.in = args.in;
    unsigned char* ws = args.ws;
    volatile LAS unsigned* MISC = (volatile LAS unsigned*)(C.lds + MISC_OFF);
    for (int u = C.tid; u < (LDS_BYTES - RING_BYTES) / 4; u += NTHR) ((LAS unsigned*)(C.lds + RING_BYTES))[u] = 0u;
    __syncthreads();
    XcdBarrier bar; bar.bar = (unsigned*)(ws + WS_CTL) + 1024; bar.x = 0; bar.st = nullptr;
    if (ONE_LAUNCH) bar = xcd_barrier_post((unsigned*)(ws + WS_CTL) + 1024, MISC + 8);
    const int lo = args.ph_lo, hi = args.ph_hi;
#ifndef PHMASK
#define PHMASK 0xffff
#endif
#define IN(k) (((PHMASK >> (k)) & 1) && lo <= (k) && (k) < hi)
#ifndef PROBE_PHASE
#define PROBE_PHASE -1
#endif
#define REPS(k) for (int rep_ = 0; rep_ < ((k) == PROBE_PHASE ? 2 : 1); ++rep_)
#define SEAM(k) do { if (IN(k) && IN((k) + 1)) xcd_barrier(bar); } while (0)
    const int G = C.G, cb = blockIdx.x;
    LAS unsigned char* ring = C.lds;

    if (IN(0)) REPS(0) { phase_prologue(C); }
    SEAM(0);
    if (IN(1)) REPS(1) {
        pg8::Gemm g{(const bf16_t*)(ws + SLOT(0)), (const bf16_t*)(ws + WS_WIN), 1024, 1024, 1024, 0, 256 * 1024};
        pg8::Sched S; S.init(256, 19, G, cb, 256, 6, 4);
        pg8::Epi8<FInproj> E{{(bf16_t*)(ws + SLOT(1)), (bf16_t*)(ws + SLOT(2)), (bf16_t*)(ws + SLOT(3)), (bf16_t*)(ws + SLOT(4)), (bf16_t*)(ws + SLOT(5))}};
        pg8::gemm_phase(ring, g, S, E);
    }
    SEAM(1);
    if (IN(2)) REPS(2) { phase_thin(C); }
    SEAM(2);
    if (IN(3)) REPS(3) {
        pg8::Gemm g{(const bf16_t*)(ws + SLOT(0)), (const bf16_t*)(ws + WS_WGATE), 1024, 128, 128, 128, 256 * 128};
        pg8::Sched S; S.init(256, 8, G, cb, 256, 8, 0);
        pg8::EpiPair<FGate> E{{(const bf16_t*)(ws + SLOT(0)), args.in[7], args.in[9], (const float*)(ws + WS_CLAM), (bf16_t*)(ws + SLOT(1)), (bf16_t*)(ws + SLOT(6))}};
        pg8::gemm_phase(ring, g, S, E);
    }
    SEAM(3);
    if (IN(4)) REPS(4) { phase_scan1(C); }
    SEAM(4);
    if (IN(5)) REPS(5) { phase_scan2(C); }
    SEAM(5);
    if (IN(6)) REPS(6) {
        pg8::Gemm g{(const bf16_t*)(ws + SLOT(0)), (const bf16_t*)(ws + WS_WRNN), 1024, 1024, 1024, 0, 256 * 1024};
        pg8::Sched S; S.init(256, 4, G, cb, 0, 0, 0);
        pg8::Epi8<FMul<false>> E{{(const bf16_t*)(ws + SLOT(4)), nullptr, (bf16_t*)(ws + SLOT(2))}};
        pg8::gemm_phase(ring, g, S, E);
    }
    SEAM(6);
    if (IN(7)) REPS(7) {
        { pg8::Gemm g{(const bf16_t*)(ws + SLOT(3)) + CQ_OFF, (const bf16_t*)(ws + WS_WUQ), CQKV_LD, 384, 384, 0, 256 * 384};
          pg8::Sched S; S.init(256, 6, G, cb, 0, 0, 0);
          pg8::Epi8<FQ> E{{(const float*)(ws + WS_RSQ), (bf16_t*)(ws + SLOT(0))}};
          pg8::gemm_phase(ring, g, S, E); }
        { pg8::Gemm g{(const bf16_t*)(ws + SLOT(3)), (const bf16_t*)(ws + WS_WUKV), CQKV_LD, 256, 256, 0, 256 * 256};
          pg8::Sched S; S.init(256, 8, G, cb, 256, 8, 0);
          pg8::Epi8<FKV> E{{(const float*)(ws + WS_RSKV), (bf16_t*)(ws + SLOT(4)), (bf16_t*)(ws + SLOT(6))}};
          pg8::gemm_phase(ring, g, S, E); }
    }
    SEAM(7);
    if (IN(8)) REPS(8) { phase_attn(C); }
    SEAM(8);
    if (IN(9)) REPS(9) {
        pg8::Gemm g{(const bf16_t*)(ws + SLOT(3)), (const bf16_t*)(ws + WS_WATT), 1024, 1024, 1024, 0, 256 * 1024};
        pg8::Sched S; S.init(256, 4, G, cb, 0, 0, 0);
        pg8::Epi8<FMul<true>> E{{(const bf16_t*)(ws + SLOT(5)), (const bf16_t*)(ws + SLOT(2)), (bf16_t*)(ws + SLOT(0))}};
        pg8::gemm_phase(ring, g, S, E);
    }
    SEAM(9);
    if (IN(10)) REPS(10) {
        pg8::Gemm g{(const bf16_t*)(ws + SLOT(0)), (const bf16_t*)(ws + WS_WOUT), 1024, 1024, 1024, 0, 256 * 1024};
        pg8::Sched S; S.init(256, 4, G, cb, 0, 0, 0);
        pg8::Epi8<FRes> E{{args.in[0], (bf16_t*)(ws + SLOT(4))}};
        pg8::gemm_phase(ring, g, S, E);
    }
    SEAM(10);
    if (IN(11)) REPS(11) {
        pg8::Gemm g{(const bf16_t*)(ws + SLOT(4)), (const bf16_t*)(ws + WS_WPQ), 1024, 1024, 1024, 0, 256 * 1024};
        pg8::Sched S; S.init(256, 8, G, cb, 0, 0, 0);
        pg8::Epi8<FF16> E{{(_Float16*)(ws + SLOT(0)), 2048}};
        pg8::gemm_phase(ring, g, S, E);
    }
    SEAM(11);
    if (IN(13)) REPS(13) { phase_x8(C); phase_topk(C); }
    SEAM(13);
    if (IN(14)) REPS(14) { phase_upart(C, (int)(blockIdx.x & 7), (int)(blockIdx.x >> 3)); }
    SEAM(14);
    if (IN(15)) REPS(15) { phase_gather(C, C.out); }
#undef IN
#undef SEAM
}

extern "C" void kernel_launch(void* const* d_in, const int* in_sizes, int n_in, void* d_out, int out_size, void* d_ws, size_t ws_size, hipStream_t stream) {
    static int grid = 0;
    if (grid == 0) {
        if (n_in != 25 || in_sizes[0] != M * DM || out_size != M * DM || ws_size < WS_END) { fprintf(stderr, "kernel_launch: unexpected shapes (n_in %d in0 %d out %d ws %zu need %zu); nothing launched\n", n_in, n_in > 0 ? in_sizes[0] : -1, out_size, ws_size, (size_t)WS_END); grid = -1; return; }
        int dev = 0, cus = 0, per_cu = 0;
        if (hipGetDevice(&dev) != hipSuccess || hipDeviceGetAttribute(&cus, hipDeviceAttributeMultiprocessorCount, dev) != hipSuccess) { grid = -1; return; }
        if (hipFuncSetAttribute((const void*)hybrid_fwd, hipFuncAttributeMaxDynamicSharedMemorySize, LDS_BYTES) != hipSuccess) { fprintf(stderr, "kernel_launch: hipFuncSetAttribute failed\n"); grid = -1; return; }
        if (hipOccupancyMaxActiveBlocksPerMultiprocessor(&per_cu, (const void*)hybrid_fwd, NTHR, LDS_BYTES) != hipSuccess || per_cu < 1) fprintf(stderr, "kernel_launch: occupancy query reports %d\n", per_cu);
        (void)hipGetLastError();
        grid = cus;
    }
    if (grid < 0) return;
    if (hipMemsetAsync((char*)d_ws + WS_CTL, 0, CTL_ZERO_BYTES, stream) != hipSuccess) return;
    Args a{};
    for (int i = 0; i < 25; ++i) a.in[i] = (const float*)d_in[i];
    a.out = (float*)d_out; a.ws = (unsigned char*)d_ws;
#if ONE_LAUNCH
    a.ph_lo = 0; a.ph_hi = NPHASE;
    hipLaunchKernelGGL(hybrid_fwd, dim3(grid), dim3(NTHR), LDS_BYTES, stream, a);
#else
    for (int p = 0; p < NPHASE; ++p) { a.ph_lo = p; a.ph_hi = p + 1; hipLaunchKernelGGL(hybrid_fwd, dim3(grid), dim3(NTHR), LDS_BYTES, stream, a); }
#endif
}
```

```cpp
#include <hip/hip_runtime.h>
#include <cstdio>
#include <cstdint>

#ifndef ONE_LAUNCH
#define ONE_LAUNCH 1
#endif

#define LAS __attribute__((address_space(3)))
#define GAS __attribute__((address_space(1)))
typedef unsigned short bf16_t;
typedef short bf16x8 __attribute__((ext_vector_type(8)));
typedef float f32x4 __attribute__((ext_vector_type(4)));
typedef float f32x2 __attribute__((ext_vector_type(2)));
typedef float f32x16 __attribute__((ext_vector_type(16)));
typedef unsigned u32x4 __attribute__((ext_vector_type(4)));
typedef unsigned u32x2 __attribute__((ext_vector_type(2)));
typedef __bf16 bf16x2_t __attribute__((ext_vector_type(2)));
typedef short v4i16_t __attribute__((ext_vector_type(4)));

constexpr int DM = 1024, NB = 32, SEQ = 2048, NMETA = 16;
constexpr int M = NB * SEQ;
constexpr int METAROW = M;
constexpr int MTOT = M + 256;
constexpr int NPOS = SEQ + NMETA;
constexpr int DIN_P = 4864;
constexpr int CQKV_LD = 768, CQ_OFF = 384, KR_OFF = 256;
constexpr int QLD = 1536;
constexpr int NEXP = 16384;
constexpr float EPS = 1e-6f;
constexpr float LOG2E = 1.4426950408889634f;
constexpr float QSCALE = 0.10206207261596577f * 1.4426950408889634f;

constexpr size_t A1 = (size_t)MTOT * 1024 * 2;
constexpr size_t WS_CTL = 0, CTL_ZERO_BYTES = 65536;
constexpr size_t WS_WIN = 1u << 20;
constexpr size_t WS_WGATE = WS_WIN + (size_t)DIN_P * 1024 * 2;
constexpr size_t WS_WUQ = WS_WGATE + 2048 * 128 * 2;
constexpr size_t WS_WUKV = WS_WUQ + 1536 * 384 * 2;
constexpr size_t WS_WRNN = WS_WUKV + 2048 * 256 * 2;
constexpr size_t WS_WATT = WS_WRNN + 1024 * 1024 * 2;
constexpr size_t WS_WOUT = WS_WATT + 1024 * 1024 * 2;
constexpr size_t WS_WPQ = WS_WOUT + 1024 * 1024 * 2;
constexpr size_t WS_KEYS = WS_WPQ + 2048 * 1024 * 2;
constexpr size_t WS_PU = WS_KEYS + 256 * 256 * 2;
constexpr size_t WS_PV = WS_PU + (size_t)NEXP * 1024;
constexpr size_t WS_SU = WS_PV + (size_t)NEXP * 1024;
constexpr size_t WS_SV = WS_SU + (size_t)NEXP * 4;
constexpr size_t WS_CTAB = WS_SV + (size_t)NEXP * 4;
constexpr size_t WS_STAB = WS_CTAB + NPOS * 16 * 4;
constexpr size_t WS_CLAM = WS_STAB + NPOS * 16 * 4;
constexpr size_t WS_RSQ = WS_CLAM + 4096;
constexpr size_t WS_RSKV = WS_RSQ + (size_t)MTOT * 4;
constexpr size_t WS_KROPE = WS_RSKV + (size_t)MTOT * 4;
constexpr size_t WS_SCP = WS_KROPE + (size_t)MTOT * 32 * 2;
constexpr size_t WS_SCH = WS_SCP + 512 * 1024 * 4;
constexpr size_t WS_CARRY0 = WS_SCH + 512 * 1024 * 4;
constexpr size_t WS_SLOTS = ((WS_CARRY0 + 4096 + 4095) / 4096) * 4096;
constexpr size_t WS_END = WS_SLOTS + 7 * A1;
#define SLOT(i) (WS_SLOTS + (size_t)(i) * A1)

#define LDS_WAIT() asm volatile("s_waitcnt lgkmcnt(0)" ::: "memory")
#define VM_WAIT() asm volatile("s_waitcnt vmcnt(0)" ::: "memory")
__device__ __forceinline__ unsigned pk2(float lo, float hi) { f32x2 v = {lo, hi}; bf16x2_t b = __builtin_convertvector(v, bf16x2_t); return __builtin_bit_cast(unsigned, b); }
__device__ __forceinline__ float bf_lo(unsigned w) { return __uint_as_float(w << 16); }
__device__ __forceinline__ float bf_hi(unsigned w) { return __uint_as_float(w & 0xffff0000u); }
__device__ __forceinline__ float bf2f(bf16_t h) { return __uint_as_float((unsigned)h << 16); }
__device__ __forceinline__ float ex2(float x) { return __builtin_amdgcn_exp2f(x); }
__device__ __forceinline__ float rcpf_(float x) { return __builtin_amdgcn_rcpf(x); }
__device__ __forceinline__ float sigm(float v) { return rcpf_(1.f + ex2(-LOG2E * v)); }
__device__ __forceinline__ float gelu_t(float v) { const float y = v * (1.f + 0.044715f * v * v); return v * rcpf_(1.f + ex2(-2.302208198f * y)); }
__device__ __forceinline__ float wave_sum(float v) {
#pragma unroll
    for (int o = 1; o < 64; o <<= 1) v += __shfl_xor(v, o);
    return v;
}
__device__ __forceinline__ void unpack8(u32x4 w, float (&o)[8]) { o[0] = bf_lo(w.x); o[1] = bf_hi(w.x); o[2] = bf_lo(w.y); o[3] = bf_hi(w.y); o[4] = bf_lo(w.z); o[5] = bf_hi(w.z); o[6] = bf_lo(w.w); o[7] = bf_hi(w.w); }
__device__ __forceinline__ u32x4 pack8(const float (&o)[8]) { u32x4 w; w.x = pk2(o[0], o[1]); w.y = pk2(o[2], o[3]); w.z = pk2(o[4], o[5]); w.w = pk2(o[6], o[7]); return w; }
__device__ __forceinline__ float dot2bf(unsigned a, unsigned b, float acc) { return __builtin_amdgcn_fdot2_f32_bf16(__builtin_bit_cast(bf16x2_t, a), __builtin_bit_cast(bf16x2_t, b), acc, false); }

typedef float f32x32 __attribute__((ext_vector_type(32)));
typedef unsigned u32x6 __attribute__((ext_vector_type(6)));
typedef __bf16 bf16x32 __attribute__((ext_vector_type(32)));
__device__ __forceinline__ float fp6_probe_val(int i) { return i < 8 ? 0.125f * i : i < 16 ? 1.f + 0.125f * (i - 8) : i < 24 ? 2.f + 0.25f * (i - 16) : 4.f + 0.5f * (i - 24); }
__device__ __forceinline__ int fp6_code(float v) { return v < 1.f ? (int)(v * 8.f + 0.5f) : (int)(__float_as_uint(v) >> 20) - 1016 + 8; }
template <bool BF> __device__ __forceinline__ void fp6_sigma(int (&sig)[32]) {
    f32x16 lo, hi;
#pragma unroll
    for (int i = 0; i < 16; ++i) { lo[i] = fp6_probe_val(i); hi[i] = fp6_probe_val(16 + i); }
    asm volatile("" : "+v"(lo), "+v"(hi));
    const u32x6 p = __builtin_amdgcn_cvt_scalef32_2xpk16_fp6_f32(lo, hi, 1.0f);
    if (BF) { const bf16x32 r = __builtin_amdgcn_cvt_scalef32_pk32_bf16_fp6(p, 1.0f);
#pragma unroll
        for (int j = 0; j < 32; ++j) sig[j] = __builtin_amdgcn_readfirstlane(fp6_code((float)r[j])) & 31;
    } else { const f32x32 r = __builtin_amdgcn_cvt_scalef32_pk32_f32_fp6(p, 1.0f);
#pragma unroll
        for (int j = 0; j < 32; ++j) sig[j] = __builtin_amdgcn_readfirstlane(fp6_code(r[j])) & 31; }
}

namespace pg8 {
constexpr int BM = 256, BK = 64, HALF = 128, HTB = HALF * BK * 2, STAGE_BYTES = 8 * HTB, NXCD = 8, WGM = 8;
__host__ __device__ __forceinline__ int lds_byte(int r, int c) { const int st = (r >> 4) * 2 + (c >> 5), rr = r & 15, cc = c & 31, ob = rr * 64 + cc * 2; return st * 1024 + (ob ^ (((ob >> 9) & 1) << 5)); }
__host__ __device__ __forceinline__ void stage_rc(int b, int& R, int& C) { const int st = b / 1024, sb = b % 1024, swz = sb ^ (((sb >> 9) & 1) << 5); R = (st >> 1) * 16 + swz / 64; C = (st & 1) * 32 + (swz % 64) / 2; }
__host__ __device__ __forceinline__ int perm32(int rho) { const int n = rho >> 4, i = rho & 15; return 8 * (i >> 2) + 4 * n + (i & 3); }

struct Unit { int pm, pn; };
struct Gemm { const bf16_t* A; const bf16_t* Bt; int lda, ldb, K, a_pn_off, b_pn_stride; };

struct Sched {
    int nM, nN, nwg, G, c, xpm, xn, xskip;
    __device__ __forceinline__ void init(int nM_, int nN_, int G_, int c_, int xpm_, int xn_, int xskip_) { nM = nM_; nN = nN_; nwg = nM_ * nN_; G = G_; c = c_; xpm = xpm_; xn = xn_; xskip = xskip_; }
    __device__ __forceinline__ bool next(int i, Unit& u) const {
        const int nmain = nwg > c ? (nwg - c - 1) / G + 1 : 0;
        if (i < nmain) {
            int wgid = i * G + c; { const int q = nwg / NXCD, r = nwg % NXCD, xcd = wgid % NXCD, off = wgid / NXCD; wgid = (xcd < r ? xcd * (q + 1) : r * (q + 1) + (xcd - r) * q) + off; }
            const int nig = WGM * nN, gid = wgid / nig, fm = gid * WGM, gsz = (nM - fm) < WGM ? (nM - fm) : WGM;
            u.pm = fm + ((wgid % nig) % gsz); u.pn = (wgid % nig) / gsz; return true;
        }
        const int e = G - 1 - c;
        if (i == nmain && e < xn) { u.pm = xpm; u.pn = e + (e >= 4 ? xskip : 0); return true; }
        return false;
    }
};

template <class F> struct Epi8 {
    static constexpr bool PERM = true;
    F f;
    __device__ __forceinline__ void operator()(const f32x4 (&acc)[2][2][4][2], const Unit& u, int wr, int wc, int fr, int fq) const {
        const int row0 = u.pm * BM + wr * 64 + fr, col0 = u.pn * BM + wc * 32 + 8 * fq;
#pragma unroll
        for (int ai = 0; ai < 2; ++ai) {
            typename F::Pre pre[4][2];
#pragma unroll
            for (int m = 0; m < 4; ++m)
#pragma unroll
                for (int bj = 0; bj < 2; ++bj) pre[m][bj] = f.load(u.pn, row0 + ai * HALF + m * 16, col0 + bj * HALF);
#pragma unroll
            for (int m = 0; m < 4; ++m)
#pragma unroll
                for (int bj = 0; bj < 2; ++bj) f.apply(pre[m][bj], u.pn, row0 + ai * HALF + m * 16, col0 + bj * HALF, acc[ai][bj][m][0], acc[ai][bj][m][1]);
        }
    }
};
template <class F> struct EpiPair {
    static constexpr bool PERM = true;
    F f;
    __device__ __forceinline__ void operator()(const f32x4 (&acc)[2][2][4][2], const Unit& u, int wr, int wc, int fr, int fq) const {
        const int row0 = u.pm * BM + wr * 64 + fr, col0 = wc * 32 + 8 * fq;
#pragma unroll
        for (int ai = 0; ai < 2; ++ai) {
            typename F::Pre pre[4];
#pragma unroll
            for (int m = 0; m < 4; ++m) pre[m] = f.load(u.pn, row0 + ai * HALF + m * 16, col0);
#pragma unroll
            for (int m = 0; m < 4; ++m) f.apply(pre[m], u.pn, row0 + ai * HALF + m * 16, col0, acc[ai][0][m][0], acc[ai][0][m][1], acc[ai][1][m][0], acc[ai][1][m][1]);
        }
    }
};

template <class Epi>
__device__ __forceinline__ void gemm_phase(LAS unsigned char* lds, const Gemm g, const Sched& S, const Epi& E) {
    int tid_ = threadIdx.x; asm volatile("" : "+v"(tid_));
    const int tid = tid_, wid = __builtin_amdgcn_readfirstlane(tid >> 6), lane = tid & 63, wr = wid >> 2, wc = wid & 3, fr = lane & 15, fq = lane >> 4;
    int nt_ = g.K / BK; asm volatile("" : "+s"(nt_));
    const int nt = nt_;
    unsigned voffA[2], voffB[2];
#pragma unroll
    for (int i = 0; i < 2; ++i) { int R, C; stage_rc(tid * 16 + i * 8192, R, C); const int Rb = Epi::PERM ? ((R & ~31) + perm32(R & 31)) : R;
        voffA[i] = (unsigned)(R * g.lda + C) * 2u; voffB[i] = (unsigned)(Rb * g.ldb + C) * 2u; }
    const size_t kstep = (size_t)(BK * 2);
    const size_t hA = (size_t)HALF * g.lda * 2, hB = (size_t)HALF * g.ldb * 2;
    const unsigned ldsw = (unsigned)wid * 1024u;
    const int aoff = lds_byte(wr * 64 + fr, fq * 8), boff = lds_byte(wc * 32 + fr, fq * 8);
#define PG8_SA(b, h) (((b) * 2 + (h)) * HTB)
#define PG8_SB(b, h) ((4 + (b) * 2 + (h)) * HTB)
#define PG8_STAGE(bufoff, gbase, voff) do { _Pragma("unroll") for (int _i = 0; _i < 2; ++_i) \
        __builtin_amdgcn_global_load_lds((const unsigned*)((const char*)(gbase) + (voff)[_i]), (LAS unsigned*)(lds + (bufoff) + ldsw + _i * 8192), 16, 0, 0); } while (0)
#define PG8_LDA(dst, b, h) do { _Pragma("unroll") for (int m = 0; m < 4; ++m) _Pragma("unroll") for (int k = 0; k < 2; ++k) dst[m][k] = *(const LAS bf16x8*)(lds + PG8_SA(b, h) + aoff + m * 2048 + k * 1024); } while (0)
#define PG8_LDB(dst, b, h) do { _Pragma("unroll") for (int n = 0; n < 2; ++n) _Pragma("unroll") for (int k = 0; k < 2; ++k) dst[n][k] = *(const LAS bf16x8*)(lds + PG8_SB(b, h) + boff + n * 2048 + k * 1024); } while (0)
#define PG8_MMA(ai, bj, At, Bt) do { __builtin_amdgcn_s_setprio(1); _Pragma("unroll") for (int m = 0; m < 4; ++m) _Pragma("unroll") for (int n = 0; n < 2; ++n) _Pragma("unroll") for (int k = 0; k < 2; ++k) \
        acc[ai][bj][m][n] = __builtin_amdgcn_mfma_f32_16x16x32_bf16(Bt[n][k], At[m][k], acc[ai][bj][m][n], 0, 0, 0); __builtin_amdgcn_s_setprio(0); } while (0)
#define PG8_WAIT_V(n) asm volatile("s_waitcnt vmcnt(" #n ")" ::: "memory")
#define PG8_WAIT_L(n) asm volatile("s_waitcnt lgkmcnt(" #n ")" ::: "memory")
#define PG8_BAR __builtin_amdgcn_s_barrier()
#define PG8_SCHED __builtin_amdgcn_sched_barrier(0)
#define PG8_ABASE(u) ((const char*)g.A + ((size_t)(u).pm * BM * g.lda + (size_t)(u).pn * g.a_pn_off) * 2)
#define PG8_BBASE(u) ((const char*)g.Bt + (size_t)(u).pn * g.b_pn_stride * 2)
    Unit cur, nxt; int ui = 0;
    if (!S.next(0, cur)) return;
    f32x4 acc[2][2][4][2];
#pragma unroll
    for (int a = 0; a < 2; ++a)
#pragma unroll
        for (int b = 0; b < 2; ++b)
#pragma unroll
            for (int m = 0; m < 4; ++m)
#pragma unroll
                for (int n = 0; n < 2; ++n) acc[a][b][m][n] = (f32x4){0.f, 0.f, 0.f, 0.f};
    bf16x8 At[4][2], B0[2][2], B1[2][2];
    const char* cA = PG8_ABASE(cur); const char* cB = PG8_BBASE(cur);
    PG8_STAGE(PG8_SB(0, 0), cB, voffB); PG8_STAGE(PG8_SB(0, 1), cB + hB, voffB); PG8_STAGE(PG8_SA(0, 0), cA, voffA); PG8_STAGE(PG8_SA(0, 1), cA + hA, voffA);
    if (wr == 1) PG8_BAR;
    PG8_WAIT_V(2); PG8_BAR;
    PG8_STAGE(PG8_SB(1, 0), cB + kstep, voffB); PG8_STAGE(PG8_SA(1, 0), cA + kstep, voffA); PG8_STAGE(PG8_SB(1, 1), cB + hB + kstep, voffB);
    PG8_WAIT_V(6); PG8_BAR;
    for (;;) {
        const bool has_next = S.next(ui + 1, nxt);
        const char* nA = has_next ? PG8_ABASE(nxt) : cA; const char* nB = has_next ? PG8_BBASE(nxt) : cB;
        asm volatile("" : "+s"(cA), "+s"(cB), "+s"(nA), "+s"(nB));
#pragma unroll 1
        for (int t = 0; t < nt; t += 2) {
            const bool last = (t == nt - 2);
            const char* a1 = cA + (size_t)(t + 1) * kstep;
            const char* a2 = last ? nA : cA + (size_t)(t + 2) * kstep; const char* b2 = last ? nB : cB + (size_t)(t + 2) * kstep;
            const char* a3 = a2 + kstep; const char* b3 = b2 + kstep;
            PG8_LDB(B0, 0, 0); PG8_LDB(B1, 0, 1); PG8_SCHED; PG8_LDA(At, 0, 0); PG8_STAGE(PG8_SA(1, 1), a1 + hA, voffA);
            PG8_WAIT_V(8); PG8_WAIT_L(0); PG8_BAR; PG8_MMA(0, 0, At, B0); PG8_MMA(0, 1, At, B1); PG8_BAR; PG8_SCHED;
            PG8_LDA(At, 0, 1); PG8_STAGE(PG8_SB(0, 0), b2, voffB); PG8_STAGE(PG8_SB(0, 1), b2 + hB, voffB); PG8_STAGE(PG8_SA(0, 0), a2, voffA);
            PG8_WAIT_V(8); PG8_WAIT_L(0); PG8_BAR; PG8_MMA(1, 0, At, B0); PG8_MMA(1, 1, At, B1); PG8_BAR; PG8_SCHED;
            PG8_LDB(B0, 1, 0); PG8_LDB(B1, 1, 1); PG8_SCHED; PG8_LDA(At, 1, 0); PG8_STAGE(PG8_SA(0, 1), a2 + hA, voffA);
            PG8_WAIT_V(8); PG8_WAIT_L(0); PG8_BAR; PG8_MMA(0, 0, At, B0); PG8_MMA(0, 1, At, B1); PG8_BAR; PG8_SCHED;
            PG8_LDA(At, 1, 1); PG8_STAGE(PG8_SB(1, 0), b3, voffB); PG8_STAGE(PG8_SB(1, 1), b3 + hB, voffB); PG8_STAGE(PG8_SA(1, 0), a3, voffA);
            PG8_WAIT_V(8); PG8_WAIT_L(0); PG8_BAR; PG8_MMA(1, 0, At, B0); PG8_MMA(1, 1, At, B1); PG8_BAR; PG8_SCHED;
        }
        if (wr == 0) PG8_BAR;
        E(acc, cur, wr, wc, fr, fq);
        if (!has_next) break;
#pragma unroll
        for (int a = 0; a < 2; ++a)
#pragma unroll
            for (int b = 0; b < 2; ++b)
#pragma unroll
                for (int m = 0; m < 4; ++m)
#pragma unroll
                    for (int n = 0; n < 2; ++n) acc[a][b][m][n] = (f32x4){0.f, 0.f, 0.f, 0.f};
        cur = nxt; cA = nA; cB = nB; ++ui;
        if (wr == 1) PG8_BAR;
    }
    PG8_WAIT_V(0);
    PG8_BAR;
#undef PG8_SA
#undef PG8_SB
#undef PG8_STAGE
#undef PG8_LDA
#undef PG8_LDB
#undef PG8_MMA
#undef PG8_WAIT_V
#undef PG8_WAIT_L
#undef PG8_BAR
#undef PG8_SCHED
#undef PG8_ABASE
#undef PG8_BBASE
}
}

#define XB_TMO      128
#define XB_XCNT(j)  (256  + 64 * (j))
#define XB_XSUB(j)  (1280 + 64 * (j))
#define XB_XGEN(j)  (2304 + 64 * (j))
#define XB_TOP      3328
#define XB_TOPGEN   3392
#define XCD_BAR_WORDS 3456
#define XB_SPIN_CAP (1u << 18)
__device__ __forceinline__ unsigned xb_ld(unsigned* p)              { return __hip_atomic_load(p, __ATOMIC_RELAXED, __HIP_MEMORY_SCOPE_AGENT); }
__device__ __forceinline__ unsigned xb_add(unsigned* p, unsigned v) { return __hip_atomic_fetch_add(p, v, __ATOMIC_RELAXED, __HIP_MEMORY_SCOPE_AGENT); }
__device__ __forceinline__ unsigned xb_xcc_id() { return (unsigned)__builtin_amdgcn_s_getreg((3 << 11) | 20) & 0xFu; }
#define XB_SPIN(cond, bar) do { unsigned _sp = 0; while (cond) { __builtin_amdgcn_s_sleep(1); \
    if ((++_sp & 255u) == 0u) { if (xb_ld(&(bar)[XB_TMO])) break; if (_sp > XB_SPIN_CAP) { atomicAdd(&(bar)[XB_TMO], 1u); break; } } } } while (0)
struct XcdBarrier { unsigned* bar; unsigned x; volatile LAS unsigned* st; };
__device__ __forceinline__ XcdBarrier xcd_barrier_post(unsigned* bar, volatile LAS unsigned* st) {
    XcdBarrier b; b.bar = bar; b.x = xb_xcc_id(); b.st = st;
    if (threadIdx.x == 0) (void)xb_add(&bar[XB_XCNT(b.x)], 1u);
    return b;
}
__device__ __forceinline__ void xcd_barrier_complete(unsigned* bar, unsigned x, unsigned& nloc, unsigned& nx) {
    const unsigned G = gridDim.x * gridDim.y * gridDim.z;
    unsigned sum, cnt, mine, sp = 0u;
    for (;;) {
        sum = 0u; cnt = 0u; mine = 0u;
#pragma unroll
        for (unsigned j = 0; j < 16; ++j) { const unsigned c = xb_ld(&bar[XB_XCNT(j)]); sum += c; cnt += (c > 0u) ? 1u : 0u; mine = (j == x) ? c : mine; }
        if (sum == G) break;
        __builtin_amdgcn_s_sleep(1);
        if ((++sp & 255u) == 0u) { if (xb_ld(&bar[XB_TMO])) break; if (sp > XB_SPIN_CAP) { atomicAdd(&bar[XB_TMO], 1u); break; } }
    }
    nloc = mine > 0u ? mine : 1u; nx = cnt > 0u ? cnt : 1u;
}
__device__ __forceinline__ void xcd_barrier(const XcdBarrier& b) {
    asm volatile("s_waitcnt vmcnt(0)" ::: "memory");
    __syncthreads();
    if (threadIdx.x == 0) {
        unsigned* bar = b.bar;
        __builtin_amdgcn_s_waitcnt(0);
        unsigned nloc = b.st[0], nx = b.st[1];
        if (nloc == 0u) { xcd_barrier_complete(bar, b.x, nloc, nx); b.st[0] = nloc; b.st[1] = nx; }
        const unsigned old = xb_add(&bar[XB_XSUB(b.x)], 1u);
        const unsigned gen = old / nloc;
        if (old + 1u == (gen + 1u) * nloc) {
            __builtin_amdgcn_fence(__ATOMIC_RELEASE, "agent");
            asm volatile("s_waitcnt vmcnt(0)" ::: "memory");
            const unsigned og = xb_add(&bar[XB_TOP], 1u);
            const unsigned tg = og / nx;
            if (og + 1u == (tg + 1u) * nx) xb_add(&bar[XB_TOPGEN], 1u);
            else XB_SPIN(xb_ld(&bar[XB_TOPGEN]) == tg, bar);
            __builtin_amdgcn_fence(__ATOMIC_ACQUIRE, "agent");
            xb_add(&bar[XB_XGEN(b.x)], 1u);
            asm volatile("s_waitcnt vmcnt(0)" ::: "memory");
        } else {
            XB_SPIN(xb_ld(&bar[XB_XGEN(b.x)]) == gen, bar);
            __builtin_amdgcn_fence(__ATOMIC_ACQUIRE, "agent");
            asm volatile("s_waitcnt vmcnt(0)" ::: "memory");
        }
    }
    __syncthreads();
}

constexpr int NWAVES = 8, NTHR = 512;
constexpr int RING_BYTES = 131072, MISC_OFF = RING_BYTES + 320, LDS_BYTES = 147456;
struct Args { const float* in[25]; float* out; unsigned char* ws; int ph_lo, ph_hi; };
static_assert(sizeof(Args) == 25 * 8 + 8 + 8 + 8, "Args has no padding");

struct Ctx {
    LAS unsigned char* lds; int tid, lane, wave, G, gw, NGW;
    unsigned char* ws; float* out; const float* const* in;
};

__device__ __forceinline__ void store8(bf16_t* p, f32x4 a, f32x4 b) { u32x4 w; w.x = pk2(a[0], a[1]); w.y = pk2(a[2], a[3]); w.z = pk2(b[0], b[1]); w.w = pk2(b[2], b[3]); *(u32x4*)p = w; }
struct NoPre {};
struct FInproj {
    typedef NoPre Pre;
    bf16_t *XR, *GR, *CQKV, *GRNN, *GATT;
    __device__ __forceinline__ Pre load(int, int, int) const { return Pre(); }
    __device__ __forceinline__ void apply(const Pre&, int pn, int row, int col, f32x4 a, f32x4 b) const {
        if (pn < 4) { store8(XR + (size_t)row * 1024 + col, a, b); }
        else if (pn < 8) {
#pragma unroll
            for (int i = 0; i < 4; ++i) { a[i] = gelu_t(a[i]); b[i] = gelu_t(b[i]); }
            store8(GR + (size_t)row * 1024 + (col - 1024), a, b); }
        else if (pn < 11) { store8(CQKV + (size_t)row * CQKV_LD + (col - 2048), a, b); }
        else {
#pragma unroll
            for (int i = 0; i < 4; ++i) { a[i] = sigm(a[i]); b[i] = sigm(b[i]); }
            if (pn < 15) store8(GRNN + (size_t)row * 1024 + (col - 2816), a, b); else store8(GATT + (size_t)row * 1024 + (col - 3840), a, b); }
    }
};
struct FGate {
    struct Pre { u32x4 xc; };
    const bf16_t* XC; const float *ba, *bx, *clam; bf16_t *LA, *UU;
    __device__ __forceinline__ Pre load(int pn, int row, int cl) const { Pre p; p.xc = *(const u32x4*)(XC + (size_t)row * 1024 + pn * 128 + cl); return p; }
    __device__ __forceinline__ void apply(const Pre& pr, int pn, int row, int cl, f32x4 a0, f32x4 a1, f32x4 x0, f32x4 x1) const {
        const int ch = pn * 128 + cl; const size_t off = (size_t)row * 1024 + ch;
        float xc[8]; unpack8(pr.xc, xc);
        const f32x4 ba0 = *(const f32x4*)(ba + ch), ba1 = *(const f32x4*)(ba + ch + 4), bx0 = *(const f32x4*)(bx + ch), bx1 = *(const f32x4*)(bx + ch + 4), cl0 = *(const f32x4*)(clam + ch), cl1 = *(const f32x4*)(clam + ch + 4);
        float la[8], uu[8];
#pragma unroll
        for (int i = 0; i < 8; ++i) {
            const float ga = (i < 4 ? a0[i & 3] + ba0[i & 3] : a1[i & 3] + ba1[i & 3]), gx = (i < 4 ? x0[i & 3] + bx0[i & 3] : x1[i & 3] + bx1[i & 3]), cc = (i < 4 ? cl0[i & 3] : cl1[i & 3]);
            const float r = sigm(ga), ig = sigm(gx), l = r * cc;
            la[i] = l; uu[i] = sqrtf(fmaxf(1.f - ex2(2.f * LOG2E * l), 0.f)) * (ig * xc[i]);
        }
        *(u32x4*)(LA + off) = pack8(la); *(u32x4*)(UU + off) = pack8(uu);
    }
};
struct FQ {
    struct Pre { float sc; };
    const float* rsq; bf16_t* Q;
    __device__ __forceinline__ Pre load(int, int row, int) const { Pre p; p.sc = rsq[row]; return p; }
    __device__ __forceinline__ void apply(const Pre& pr, int pn, int row, int col, f32x4 a, f32x4 b) const {
        const float sc = pr.sc * QSCALE; a = a * sc; b = b * sc;
        store8(Q + (size_t)row * QLD + col, a, b);
    }
};
struct FKV {
    struct Pre { float sc; };
    const float* rskv; bf16_t *KN, *V;
    __device__ __forceinline__ Pre load(int, int row, int) const { Pre p; p.sc = rskv[row]; return p; }
    __device__ __forceinline__ void apply(const Pre& pr, int pn, int row, int col, f32x4 a, f32x4 b) const {
        const float sc = pr.sc; a = a * sc; b = b * sc;
        if (pn < 4) store8(KN + (size_t)row * 1024 + col, a, b); else store8(V + (size_t)row * 1024 + (col - 1024), a, b);
    }
};
template <bool HAS_ADD> struct FMul {
    struct Pre { u32x4 g, ad; };
    const bf16_t* Gt; const bf16_t* ADD; bf16_t* O;
    __device__ __forceinline__ Pre load(int, int row, int col) const { const size_t off = (size_t)row * 1024 + col; Pre p; p.g = *(const u32x4*)(Gt + off); if (HAS_ADD) p.ad = *(const u32x4*)(ADD + off); else p.ad = (u32x4){0u, 0u, 0u, 0u}; return p; }
    __device__ __forceinline__ void apply(const Pre& pr, int pn, int row, int col, f32x4 a, f32x4 b) const {
        const size_t off = (size_t)row * 1024 + col; float gg[8]; unpack8(pr.g, gg);
        if (HAS_ADD) { float ad[8]; unpack8(pr.ad, ad);
#pragma unroll
            for (int i = 0; i < 4; ++i) { a[i] = ad[i] + gg[i] * a[i]; b[i] = ad[4 + i] + gg[4 + i] * b[i]; } }
        else {
#pragma unroll
            for (int i = 0; i < 4; ++i) { a[i] = gg[i] * a[i]; b[i] = gg[4 + i] * b[i]; } }
        store8(O + off, a, b);
    }
};
struct FRes {
    struct Pre { f32x4 x0, x1; };
    const float* X; bf16_t* H1B;
    __device__ __forceinline__ Pre load(int, int row, int col) const { const size_t off = (size_t)row * 1024 + col; Pre p; p.x0 = *(const f32x4*)(X + off); p.x1 = *(const f32x4*)(X + off + 4); return p; }
    __device__ __forceinline__ void apply(const Pre& pr, int pn, int row, int col, f32x4 a, f32x4 b) const {
        store8(H1B + (size_t)row * 1024 + col, a + pr.x0, b + pr.x1);
    }
};
typedef _Float16 f16x8 __attribute__((ext_vector_type(8)));
struct FF16 { typedef NoPre Pre; _Float16* O; int ldc;
    __device__ __forceinline__ Pre load(int, int, int) const { return Pre(); }
    __device__ __forceinline__ void apply(const Pre&, int pn, int row, int col, f32x4 a, f32x4 b) const {
        f16x8 h = {(_Float16)a[0], (_Float16)a[1], (_Float16)a[2], (_Float16)a[3], (_Float16)b[0], (_Float16)b[1], (_Float16)b[2], (_Float16)b[3]};
        *(f16x8*)(O + (size_t)row * ldc + col) = h; } };
struct FF32 { typedef NoPre Pre; float* O; int ldc;
    __device__ __forceinline__ Pre load(int, int, int) const { return Pre(); }
    __device__ __forceinline__ void apply(const Pre&, int pn, int row, int col, f32x4 a, f32x4 b) const { float* p = O + (size_t)row * ldc + col; *(f32x4*)p = a; *(f32x4*)(p + 4) = b; } };

struct MapId { __device__ __forceinline__ int operator()(int n) const { return n; } };
struct MapWin { __device__ __forceinline__ int operator()(int n) const {
    if (n < 2048) return n;
    if (n < 2816) { const int c = n - 2048; if (c < 256) return 2432 + c; if (c < 288) return 2688 + (c - 256); if (c < 384) return -1; return 2048 + (c - 384); }
    if (n < 3840) return 2720 + (n - 2816);
    return 3744 + (n - 3840); } };
struct MapUq { __device__ __forceinline__ int operator()(int n) const { const int h = n / 96, w = n % 96; if (w < 64) return n; const int t = w - 64; return h * 96 + 64 + (t >> 1) + 16 * (t & 1); } };
struct MapUkv { __device__ __forceinline__ int operator()(int n) const { if (n < 1024) return (n >> 6) * 128 + (n & 63); const int m = n - 1024; return (m >> 6) * 128 + 64 + (m & 63); } };

template <class Map> __device__ __forceinline__ void transpose_item(const float* W, int ldw, int Ndst, bf16_t* WT, int ldt, const float* kscale, LAS float* scr, int item, int lane, Map map) {
    const int nblk = Ndst / 32, kb = item / nblk, nb = item % nblk, k0 = 64 * kb, n0 = 32 * nb;
    const int src = map(n0 + (lane & 31));
#pragma unroll 8
    for (int i = 0; i < 32; ++i) { const int kk = 2 * i + (lane >> 5); float v = 0.f; if (src >= 0) { v = W[(size_t)(k0 + kk) * ldw + src]; if (kscale) v *= kscale[k0 + kk]; } scr[kk * 33 + (lane & 31)] = v; }
    LDS_WAIT(); asm volatile("" ::: "memory");
    const int c = lane & 7;
#pragma unroll
    for (int j = 0; j < 4; ++j) { const int n = (lane >> 3) + 8 * j; const LAS float* s = scr + (8 * c) * 33 + n;
        u32x4 o; o.x = pk2(s[0 * 33], s[1 * 33]); o.y = pk2(s[2 * 33], s[3 * 33]); o.z = pk2(s[4 * 33], s[5 * 33]); o.w = pk2(s[6 * 33], s[7 * 33]);
        *(u32x4*)(WT + (size_t)(n0 + n) * ldt + k0 + 8 * c) = o; }
    LDS_WAIT(); asm volatile("" ::: "memory");
}
__device__ __forceinline__ void rms_row_bf16(const float* xrow, const float* g, bf16_t* orow, int lane) {
    const f32x4* xr = (const f32x4*)xrow + lane; f32x4 v[4]; float s = 0.f;
#pragma unroll
    for (int j = 0; j < 4; ++j) { v[j] = xr[64 * j]; s += (v[j][0] * v[j][0] + v[j][1] * v[j][1]) + (v[j][2] * v[j][2] + v[j][3] * v[j][3]); }
    const float rstd = 1.f / sqrtf(wave_sum(s) * (1.f / 1024.f) + EPS);
    u32x2* o8 = (u32x2*)orow + lane;
#pragma unroll
    for (int j = 0; j < 4; ++j) { const f32x4 gg = ((const f32x4*)g)[lane + 64 * j]; u32x2 w; w.x = pk2(v[j][0] * rstd * gg[0], v[j][1] * rstd * gg[1]); w.y = pk2(v[j][2] * rstd * gg[2], v[j][3] * rstd * gg[3]); o8[64 * j] = w; }
}
__device__ __forceinline__ void rms_row_f32(const float* xrow, const float* g, float* orow, int lane) {
    const f32x4* xr = (const f32x4*)xrow + lane; f32x4 v[4]; float s = 0.f;
#pragma unroll
    for (int j = 0; j < 4; ++j) { v[j] = xr[64 * j]; s += (v[j][0] * v[j][0] + v[j][1] * v[j][1]) + (v[j][2] * v[j][2] + v[j][3] * v[j][3]); }
    const float rstd = 1.f / sqrtf(wave_sum(s) * (1.f / 1024.f) + EPS);
#pragma unroll
    for (int j = 0; j < 4; ++j) { const f32x4 gg = ((const f32x4*)g)[lane + 64 * j]; ((f32x4*)orow)[lane + 64 * j] = v[j] * rstd * gg; }
}

__device__ __forceinline__ void phase_prologue(const Ctx& C) {
    unsigned char* ws = C.ws; const float* const* in = C.in;
    LAS float* scr = (LAS float*)(C.lds + C.wave * 16384);
    const int gw = C.gw, NGW = C.NGW, lane = C.lane;
    constexpr int I_WIN = 16 * (DIN_P / 32), I_UQ = 6 * (1536 / 32), I_UKV = 4 * (2048 / 32), I_SQ = 16 * 32, I_G = 2 * 4;
    constexpr int NITEMS = I_WIN + I_UQ + I_UKV + 3 * I_SQ + 16 * I_G;
    for (int it = gw; it < NITEMS; it += NGW) {
        int r = it;
        if (r < I_WIN) { transpose_item(in[3], 4768, DIN_P, (bf16_t*)(ws + WS_WIN), 1024, nullptr, scr, r, lane, MapWin()); continue; } r -= I_WIN;
        if (r < I_UQ) { transpose_item(in[13], 1536, 1536, (bf16_t*)(ws + WS_WUQ), 384, in[12], scr, r, lane, MapUq()); continue; } r -= I_UQ;
        if (r < I_UKV) { transpose_item(in[15], 2048, 2048, (bf16_t*)(ws + WS_WUKV), 256, in[14], scr, r, lane, MapUkv()); continue; } r -= I_UKV;
        if (r < I_SQ) { transpose_item(in[11], 1024, 1024, (bf16_t*)(ws + WS_WRNN), 1024, nullptr, scr, r, lane, MapId()); continue; } r -= I_SQ;
        if (r < I_SQ) { transpose_item(in[16], 1024, 1024, (bf16_t*)(ws + WS_WATT), 1024, nullptr, scr, r, lane, MapId()); continue; } r -= I_SQ;
        if (r < I_SQ) { transpose_item(in[17], 1024, 1024, (bf16_t*)(ws + WS_WOUT), 1024, nullptr, scr, r, lane, MapId()); continue; } r -= I_SQ;
        { const int mat = r / I_G, sub = r % I_G, blk = mat >> 1, which = mat & 1;
          transpose_item((which ? in[8] : in[6]) + (size_t)blk * 16384, 128, 128, (bf16_t*)(ws + WS_WGATE) + (size_t)(blk * 256 + which * 128) * 128, 128, nullptr, scr, sub, lane, MapId()); }
    }
    const int gt = blockIdx.x * NTHR + C.tid, NT = C.G * NTHR;
    for (int it = blockIdx.x; it < 256; it += C.G) {
        const int hh = it >> 4, kc = it & 15, half = hh & 1, k = kc * 64 + lane, c0 = 16 * C.wave;
        const f32x4* keys = (const f32x4*)((half ? in[21] : in[20]) + (size_t)c0 * 128);
        LAS f32x4* ks = (LAS f32x4*)scr;
#pragma unroll
        for (int j = 0; j < 8; ++j) ks[j * 64 + lane] = keys[j * 64 + lane];
        const f32x4* wq = (const f32x4*)(in[19] + (size_t)k * 2048 + hh * 128); const float g2k = in[18][k];
        f32x4 a[32];
#pragma unroll
        for (int d4 = 0; d4 < 32; ++d4) a[d4] = wq[d4];
        LDS_WAIT(); asm volatile("" ::: "memory");
        bf16_t* o = (bf16_t*)(ws + WS_WPQ) + (size_t)(hh * 128 + c0) * 1024 + k;
#pragma unroll 4
        for (int c = 0; c < 16; ++c) { float s0 = 0.f, s1 = 0.f;
#pragma unroll
            for (int d4 = 0; d4 < 32; d4 += 2) { const f32x4 k0 = ks[c * 32 + d4], k1 = ks[c * 32 + d4 + 1]; s0 += (a[d4][0] * k0[0] + a[d4][1] * k0[1]) + (a[d4][2] * k0[2] + a[d4][3] * k0[3]); s1 += (a[d4 + 1][0] * k1[0] + a[d4 + 1][1] * k1[1]) + (a[d4 + 1][2] * k1[2] + a[d4 + 1][3] * k1[3]); }
            o[(size_t)c * 1024] = (bf16_t)(pk2((s0 + s1) * g2k, 0.f) & 0xffffu); }
        LDS_WAIT(); asm volatile("" ::: "memory");
    }
    for (int i = gt; i < NPOS * 16; i += NT) { const int pos = i >> 4, j = i & 15; const float inv = exp2f(-(float)j * (13.287712379549449f / 16.f)); const float ang = (float)pos * inv;
        float t = ang * 0.15915494309189535f; t = t - floorf(t);
        ((float*)(ws + WS_CTAB))[i] = __builtin_amdgcn_cosf(t); ((float*)(ws + WS_STAB))[i] = __builtin_amdgcn_sinf(t); }
    for (int i = gt; i < 1024; i += NT) { const float lam = in[10][i]; ((float*)(ws + WS_CLAM))[i] = -8.f * log1pf(expf(-lam)); }
    {
        f32x4 g2n[4];
#pragma unroll
        for (int j = 0; j < 4; ++j) g2n[j] = ((const f32x4*)(in[18] + 16 * lane))[j];
        for (int e = gw; e < NEXP; e += NGW) {
            f32x4 v[4]; float am = 0.f;
#pragma unroll
            for (int j = 0; j < 4; ++j) { v[j] = ((const f32x4*)(in[22] + (size_t)e * 1024 + 16 * lane))[j] * g2n[j]; am = fmaxf(am, fmaxf(fmaxf(fabsf(v[j][0]), fabsf(v[j][1])), fmaxf(fabsf(v[j][2]), fabsf(v[j][3])))); }
#pragma unroll
            for (int o = 1; o < 64; o <<= 1) am = fmaxf(am, __shfl_xor(am, o));
            const float scale = am > 0.f ? am * (1.f / 127.f) : 1.f, inv = 1.f / scale;
            u32x4 w;
#pragma unroll
            for (int j = 0; j < 4; ++j) { const int q0 = (int)rintf(v[j][0] * inv), q1 = (int)rintf(v[j][1] * inv), q2 = (int)rintf(v[j][2] * inv), q3 = (int)rintf(v[j][3] * inv);
                w[j] = (unsigned)(q0 & 255) | ((unsigned)(q1 & 255) << 8) | ((unsigned)(q2 & 255) << 16) | ((unsigned)q3 << 24); }
            *(u32x4*)(ws + WS_PU + (size_t)e * 1024 + 16 * lane) = w;
            if (lane == 0) ((float*)(ws + WS_SU))[e] = scale;
        }
    }
    {
        const int ll = lane & 31;
        for (int pr = gw; pr < NEXP / 2; pr += NGW) {
            const int e = 2 * pr + (lane >> 5);
            const f32x4* src = (const f32x4*)(in[23] + (size_t)e * 1024 + 32 * ll);
            f32x4 v[8]; float am = 0.f;
#pragma unroll
            for (int j = 0; j < 8; ++j) { v[j] = src[j]; am = fmaxf(am, fmaxf(fmaxf(fabsf(v[j][0]), fabsf(v[j][1])), fmaxf(fabsf(v[j][2]), fabsf(v[j][3])))); }
#pragma unroll
            for (int o = 1; o < 32; o <<= 1) am = fmaxf(am, __shfl_xor(am, o));
            const float scale = am > 0.f ? am * (1.f / 6.f) : 1.f, inv = 1.f / scale;
            u32x4 w;
#pragma unroll
            for (int d = 0; d < 4; ++d) { unsigned p = 0u;
                p = __builtin_amdgcn_cvt_scalef32_pk_fp4_f32(p, v[2 * d][0] * inv, v[2 * d][1] * inv, 1.0f, 0); p = __builtin_amdgcn_cvt_scalef32_pk_fp4_f32(p, v[2 * d][2] * inv, v[2 * d][3] * inv, 1.0f, 1);
                p = __builtin_amdgcn_cvt_scalef32_pk_fp4_f32(p, v[2 * d + 1][0] * inv, v[2 * d + 1][1] * inv, 1.0f, 2); p = __builtin_amdgcn_cvt_scalef32_pk_fp4_f32(p, v[2 * d + 1][2] * inv, v[2 * d + 1][3] * inv, 1.0f, 3);
                w[d] = p; }
            *(u32x4*)(ws + WS_PV + (size_t)e * 512 + 16 * ll) = w;
            if (ll == 0) ((float*)(ws + WS_SV))[e] = scale;
        }
    }
    bf16_t* N1 = (bf16_t*)(ws + SLOT(0));
    {
        f32x4 gg[4];
#pragma unroll
        for (int j = 0; j < 4; ++j) gg[j] = ((const f32x4*)in[2])[lane + 64 * j];
        int m = gw; f32x4 nv[4];
        if (m < M) {
#pragma unroll
            for (int j = 0; j < 4; ++j) nv[j] = ((const f32x4*)(in[0] + (size_t)m * 1024))[lane + 64 * j]; }
        for (; m < M; m += NGW) {
            f32x4 v[4]; float sq = 0.f;
#pragma unroll
            for (int j = 0; j < 4; ++j) { v[j] = nv[j]; sq += (v[j][0] * v[j][0] + v[j][1] * v[j][1]) + (v[j][2] * v[j][2] + v[j][3] * v[j][3]); }
            if (m + NGW < M) {
#pragma unroll
                for (int j = 0; j < 4; ++j) nv[j] = ((const f32x4*)(in[0] + (size_t)(m + NGW) * 1024))[lane + 64 * j]; }
            const float rstd = 1.f / sqrtf(wave_sum(sq) * (1.f / 1024.f) + EPS);
            u32x2* o8 = (u32x2*)(N1 + (size_t)m * 1024) + lane;
#pragma unroll
            for (int j = 0; j < 4; ++j) { u32x2 w; w.x = pk2(v[j][0] * rstd * gg[j][0], v[j][1] * rstd * gg[j][1]); w.y = pk2(v[j][2] * rstd * gg[j][2], v[j][3] * rstd * gg[j][3]); o8[64 * j] = w; }
        }
    }
    for (int m = gw; m < 256; m += NGW) {
        if (m < NMETA) rms_row_bf16(in[1] + (size_t)m * 1024, in[2], N1 + (size_t)(METAROW + m) * 1024, lane);
        else { u32x4* o = (u32x4*)(N1 + (size_t)(METAROW + m) * 1024); o[lane] = (u32x4){0u, 0u, 0u, 0u}; o[64 + lane] = (u32x4){0u, 0u, 0u, 0u}; }
    }
}

__device__ __forceinline__ int prev_row(int r, int j) {
    if (r < M) { const int s = r & (SEQ - 1); return s >= j ? r - j : METAROW + NMETA + (s - j); }
    const int p = r - METAROW; return p >= j ? r - j : -1;
}
struct ThinRow { u32x4 xa, xb, cq, ckv; unsigned k1, k2; };
__device__ __forceinline__ ThinRow thin_load(const bf16_t* XR, const bf16_t* CQKV, int r, int lane) {
    ThinRow d; const bf16_t* z = CQKV + (size_t)r * CQKV_LD;
    d.xa = *(const u32x4*)(XR + (size_t)r * 1024 + lane * 8); d.xb = *(const u32x4*)(XR + (size_t)r * 1024 + 512 + lane * 8);
    d.cq = *(const u32x4*)(z + CQ_OFF + (lane < 48 ? lane : 0) * 8); d.ckv = *(const u32x4*)(z + (lane & 31) * 8);
    d.k1 = z[KR_OFF + (lane & 15)]; d.k2 = z[KR_OFF + 16 + (lane & 15)];
    return d;
}
__device__ __forceinline__ void thin_row_stats(unsigned char* ws, const ThinRow& d, int r, int lane) {
    float* RSQ = (float*)(ws + WS_RSQ); float* RSKV = (float*)(ws + WS_RSKV); bf16_t* KROPE = (bf16_t*)(ws + WS_KROPE);
    float sq = 0.f, skv = 0.f;
    { float v[8]; unpack8(d.cq, v); float a = 0.f;
#pragma unroll
      for (int i = 0; i < 8; ++i) a += v[i] * v[i];
      sq = lane < 48 ? a : 0.f; }
    { float v[8]; unpack8(d.ckv, v); float a = 0.f;
#pragma unroll
      for (int i = 0; i < 8; ++i) a += v[i] * v[i];
      skv = lane < 32 ? a : 0.f; }
    sq = wave_sum(sq); skv = wave_sum(skv);
    if (lane == 0) { RSQ[r] = 1.f / sqrtf(sq * (1.f / 384.f) + EPS); RSKV[r] = 1.f / sqrtf(skv * (1.f / 256.f) + EPS); }
    if (lane < 16) { const int pos = r < M ? NMETA + (r & (SEQ - 1)) : r - METAROW; const float x1 = bf2f((bf16_t)d.k1), x2 = bf2f((bf16_t)d.k2);
        const float c = ((const float*)(ws + WS_CTAB))[pos * 16 + lane], s = ((const float*)(ws + WS_STAB))[pos * 16 + lane];
        ((unsigned*)(KROPE + (size_t)r * 32))[lane] = pk2(x1 * c - x2 * s, x1 * s + x2 * c); }
}
__device__ __forceinline__ void phase_thin(const Ctx& C) {
    unsigned char* ws = C.ws; const float* const* in = C.in; const int lane = C.lane;
    const bf16_t* XR = (const bf16_t*)(ws + SLOT(1)); const bf16_t* CQKV = (const bf16_t*)(ws + SLOT(3)); bf16_t* XC = (bf16_t*)(ws + SLOT(0));
    const float* cw = in[4]; const float* cb = in[5];
    float w[4][16], bias[16];
#pragma unroll
    for (int hh = 0; hh < 2; ++hh)
#pragma unroll
        for (int i = 0; i < 8; ++i) { const int ch = hh * 512 + lane * 8 + i; bias[hh * 8 + i] = cb[ch];
#pragma unroll
            for (int t = 0; t < 4; ++t) w[t][hh * 8 + i] = cw[t * 1024 + ch]; }
    for (int st = C.gw; st < M / 32 + 1; st += C.NGW) {
        const bool meta = st == M / 32; const int r0 = meta ? METAROW : st * 32, nrow = meta ? NMETA : 32;
        float x1[16], x2[16], x3[16];
        const bool first = meta || (r0 & (SEQ - 1)) == 0;
        ThinRow nx = thin_load(XR, CQKV, r0, lane);
#pragma unroll
        for (int j = 1; j <= 3; ++j) { const int pr = first ? (meta ? -1 : METAROW + NMETA - j) : r0 - j;
#pragma unroll
            for (int hh = 0; hh < 2; ++hh) { float v[8];
                if (pr >= 0) unpack8(*(const u32x4*)(XR + (size_t)pr * 1024 + hh * 512 + lane * 8), v); else {
#pragma unroll
                    for (int i = 0; i < 8; ++i) v[i] = 0.f; }
#pragma unroll
                for (int i = 0; i < 8; ++i) { if (j == 1) x1[hh * 8 + i] = v[i]; else if (j == 2) x2[hh * 8 + i] = v[i]; else x3[hh * 8 + i] = v[i]; } } }
        for (int t = 0; t < nrow; ++t) { const int r = r0 + t; float x0[16];
            const ThinRow d = nx;
            if (t + 1 < nrow) nx = thin_load(XR, CQKV, r + 1, lane);
            { float v[8]; unpack8(d.xa, v);
#pragma unroll
              for (int i = 0; i < 8; ++i) x0[i] = v[i];
              unpack8(d.xb, v);
#pragma unroll
              for (int i = 0; i < 8; ++i) x0[8 + i] = v[i]; }
#pragma unroll
            for (int hh = 0; hh < 2; ++hh) { float y[8];
#pragma unroll
                for (int i = 0; i < 8; ++i) { const int q = hh * 8 + i; y[i] = bias[q] + w[3][q] * x0[q] + w[2][q] * x1[q] + w[1][q] * x2[q] + w[0][q] * x3[q]; }
                *(u32x4*)(XC + (size_t)r * 1024 + hh * 512 + lane * 8) = pack8(y); }
#pragma unroll
            for (int q = 0; q < 16; ++q) { x3[q] = x2[q]; x2[q] = x1[q]; x1[q] = x0[q]; }
            thin_row_stats(ws, d, r, lane);
        }
    }
    float* RSQ = (float*)(ws + WS_RSQ); float* RSKV = (float*)(ws + WS_RSKV); bf16_t* KROPE = (bf16_t*)(ws + WS_KROPE);
    for (int r = M + NMETA + C.gw; r < MTOT; r += C.NGW) {
        u32x4* o = (u32x4*)(XC + (size_t)r * 1024); o[lane] = (u32x4){0u, 0u, 0u, 0u}; o[64 + lane] = (u32x4){0u, 0u, 0u, 0u};
        if (lane == 0) { RSQ[r] = 0.f; RSKV[r] = 0.f; }
        if (lane < 16) ((unsigned*)(KROPE + (size_t)r * 32))[lane] = 0u;
    }
}

__device__ __forceinline__ void phase_scan1(const Ctx& C) {
    unsigned char* ws = C.ws; const int lane = C.lane;
    const bf16_t* LA = (const bf16_t*)(ws + SLOT(1)); const bf16_t* UU = (const bf16_t*)(ws + SLOT(6));
    float* SCP = (float*)(ws + WS_SCP); float* SCH = (float*)(ws + WS_SCH); float* CARRY0 = (float*)(ws + WS_CARRY0);
    for (int it = C.gw; it < 2048 + 4; it += C.NGW) {
        const bool meta = it >= 2048; const int q = it & 3, bc = it >> 2, ch = q * 256 + lane * 4;
        const int row0 = meta ? METAROW : bc * 128, nrow = meta ? NMETA : 128;
        float P[4] = {1.f, 1.f, 1.f, 1.f}, H[4] = {0.f, 0.f, 0.f, 0.f};
#pragma unroll 8
        for (int t = 0; t < nrow; ++t) { const u32x2 l2 = *(const u32x2*)(LA + (size_t)(row0 + t) * 1024 + ch), u2 = *(const u32x2*)(UU + (size_t)(row0 + t) * 1024 + ch);
            const float a0 = ex2(LOG2E * bf_lo(l2.x)), a1 = ex2(LOG2E * bf_hi(l2.x)), a2 = ex2(LOG2E * bf_lo(l2.y)), a3 = ex2(LOG2E * bf_hi(l2.y));
            P[0] *= a0; P[1] *= a1; P[2] *= a2; P[3] *= a3;
            H[0] = a0 * H[0] + bf_lo(u2.x); H[1] = a1 * H[1] + bf_hi(u2.x); H[2] = a2 * H[2] + bf_lo(u2.y); H[3] = a3 * H[3] + bf_hi(u2.y); }
        if (meta) *(f32x4*)(CARRY0 + ch) = (f32x4){H[0], H[1], H[2], H[3]};
        else { *(f32x4*)(SCP + (size_t)bc * 1024 + ch) = (f32x4){P[0], P[1], P[2], P[3]}; *(f32x4*)(SCH + (size_t)bc * 1024 + ch) = (f32x4){H[0], H[1], H[2], H[3]}; }
    }
}
__device__ __forceinline__ void phase_scan2(const Ctx& C) {
    unsigned char* ws = C.ws; const int lane = C.lane;
    const bf16_t* LA = (const bf16_t*)(ws + SLOT(1)); const bf16_t* UU = (const bf16_t*)(ws + SLOT(6)); const bf16_t* GR = (const bf16_t*)(ws + SLOT(2)); bf16_t* HRG = (bf16_t*)(ws + SLOT(0));
    const float* SCP = (const float*)(ws + WS_SCP); const float* SCH = (const float*)(ws + WS_SCH); const float* CARRY0 = (const float*)(ws + WS_CARRY0);
    for (int it = C.gw; it < 2048; it += C.NGW) {
        const int q = it & 3, bc = it >> 2, b = bc >> 4, c = bc & 15, ch = q * 256 + lane * 4;
        f32x4 h = *(const f32x4*)(CARRY0 + ch);
        for (int cc = 0; cc < c; ++cc) { const f32x4 p = *(const f32x4*)(SCP + (size_t)(b * 16 + cc) * 1024 + ch), e = *(const f32x4*)(SCH + (size_t)(b * 16 + cc) * 1024 + ch); h = p * h + e; }
        float H[4] = {h[0], h[1], h[2], h[3]};
        const int row0 = bc * 128;
#pragma unroll 8
        for (int t = 0; t < 128; ++t) { const size_t off = (size_t)(row0 + t) * 1024 + ch; const u32x2 l2 = *(const u32x2*)(LA + off), u2 = *(const u32x2*)(UU + off), g2 = *(const u32x2*)(GR + off);
            H[0] = ex2(LOG2E * bf_lo(l2.x)) * H[0] + bf_lo(u2.x); H[1] = ex2(LOG2E * bf_hi(l2.x)) * H[1] + bf_hi(u2.x); H[2] = ex2(LOG2E * bf_lo(l2.y)) * H[2] + bf_lo(u2.y); H[3] = ex2(LOG2E * bf_hi(l2.y)) * H[3] + bf_hi(u2.y);
            u32x2 o; o.x = pk2(H[0] * bf_lo(g2.x), H[1] * bf_hi(g2.x)); o.y = pk2(H[2] * bf_lo(g2.y), H[3] * bf_hi(g2.y)); *(u32x2*)(HRG + off) = o; }
    }
}

constexpr int AT_KSLOT = 12 * 1024, AT_VSLOT = 8192;
#define AT_K(j) (((j) & 3) * AT_KSLOT)
#define AT_V(j) (4 * AT_KSLOT + ((j) & 7) * AT_VSLOT)
static_assert(4 * AT_KSLOT + 8 * AT_VSLOT <= 131072, "attention rings fit the phase scratch");
__device__ __forceinline__ void glds16(const void* gsrc, unsigned lds_dst) { unsigned keep;
    asm volatile("s_mov_b32 %0, m0\n\ts_mov_b32 m0, %2\n\ts_nop 0\n\tglobal_load_lds_dwordx4 %1, off\n\ts_mov_b32 m0, %0" : "=&s"(keep) : "v"(gsrc), "s"(lds_dst) : "memory"); }
#define AT_BAR(N) asm volatile("s_waitcnt vmcnt(" #N ") lgkmcnt(0)\n\ts_barrier" ::: "memory")
__device__ __forceinline__ int crow(int r, int hi) { return (r & 3) + 8 * (r >> 2) + 4 * hi; }
__device__ __forceinline__ void attn_q(LAS unsigned char* lds, int j, int s0, int q, int hi, const bf16x8 (&qf)[6], const f32x16& negm, f32x16& p0, f32x16& p1) {
    const int kb = AT_K(j);
    __builtin_amdgcn_s_setprio(1);
#pragma unroll
    for (int ks = 0; ks < 6; ++ks) {
        const bf16x8 a0 = *(const LAS bf16x8*)(lds + kb + (2 * ks + hi) * 1024 + q * 16);
        const bf16x8 a1 = *(const LAS bf16x8*)(lds + kb + (2 * ks + hi) * 1024 + (32 + q) * 16);
        if (ks == 0) { p0 = __builtin_amdgcn_mfma_f32_32x32x16_bf16(a0, qf[0], negm, 0, 0, 0); p1 = __builtin_amdgcn_mfma_f32_32x32x16_bf16(a1, qf[0], negm, 0, 0, 0); }
        else { p0 = __builtin_amdgcn_mfma_f32_32x32x16_bf16(a0, qf[ks], p0, 0, 0, 0); p1 = __builtin_amdgcn_mfma_f32_32x32x16_bf16(a1, qf[ks], p1, 0, 0, 0); }
    }
    __builtin_amdgcn_s_setprio(0);
    if (j == 0) {
#pragma unroll
        for (int r = 0; r < 16; ++r) { if (crow(r, hi) >= NMETA) p0[r] = -INFINITY; p1[r] = -INFINITY; }
    } else if ((j - 1) * 64 + 63 > s0) {
        const int qs = s0 + q, k0 = (j - 1) * 64;
#pragma unroll
        for (int r = 0; r < 16; ++r) { const int kk = k0 + crow(r, hi); if (kk > qs) p0[r] = -INFINITY; if (kk + 32 > qs) p1[r] = -INFINITY; }
    }
}
__device__ __forceinline__ void attn_pv(LAS unsigned char* lds, int vbase, const bf16x8 (&pb)[4], f32x16& o0, f32x16& o1) {
#pragma unroll
    for (int s = 0; s < 4; ++s)
#pragma unroll
        for (int db = 0; db < 2; ++db) {
            const v4i16_t lo = __builtin_amdgcn_ds_read_tr16_b64_v4i16((LAS v4i16_t*)(lds + vbase + db * 4096 + s * 1024));
            const v4i16_t hh = __builtin_amdgcn_ds_read_tr16_b64_v4i16((LAS v4i16_t*)(lds + vbase + db * 4096 + s * 1024 + 512));
            const bf16x8 va = {lo[0], lo[1], lo[2], lo[3], hh[0], hh[1], hh[2], hh[3]};
            if (db == 0) o0 = __builtin_amdgcn_mfma_f32_32x32x16_bf16(va, pb[s], o0, 0, 0, 0); else o1 = __builtin_amdgcn_mfma_f32_32x32x16_bf16(va, pb[s], o1, 0, 0, 0);
        }
}
#ifndef ATT_THR
#define ATT_THR 8.0f
#endif
template <bool DOPV, bool FIRST> __device__ __forceinline__ void attn_sp(LAS unsigned char* lds, int vbase, f32x16& p0, f32x16& p1, bf16x8 (&pb)[4], f32x16& o0, f32x16& o1, f32x16& negm, float& m_run, float& l_run) {
    float mx = fmaxf(p0[0], p1[0]);
#pragma unroll
    for (int r = 1; r < 16; ++r) mx = fmaxf(fmaxf(mx, p0[r]), p1[r]);
    mx = fmaxf(mx, __shfl_xor(mx, 32));
    if (DOPV) attn_pv(lds, vbase, pb, o0, o1);
    float rs = 0.f;
#pragma unroll
    for (int r = 0; r < 16; ++r) { p0[r] = ex2(p0[r]); p1[r] = ex2(p1[r]); rs += p0[r] + p1[r]; }
    if (FIRST || !__all(mx <= ATT_THR)) {
        const float d = FIRST ? mx : fmaxf(mx, 0.f), alpha = ex2(-d);
#pragma unroll
        for (int r = 0; r < 16; ++r) { p0[r] *= alpha; p1[r] *= alpha; o0[r] *= alpha; o1[r] *= alpha; }
        rs *= alpha; l_run *= alpha; m_run += d;
#pragma unroll
        for (int r = 0; r < 16; ++r) negm[r] = -m_run;
    }
    l_run += rs;
#pragma unroll
    for (int s = 0; s < 4; ++s) { unsigned w[4];
#pragma unroll
        for (int jj = 0; jj < 4; ++jj) w[jj] = (s < 2) ? pk2(p0[8 * (s & 1) + 2 * jj], p0[8 * (s & 1) + 2 * jj + 1]) : pk2(p1[8 * (s & 1) + 2 * jj], p1[8 * (s & 1) + 2 * jj + 1]);
        u32x4 ww = {w[0], w[1], w[2], w[3]}; pb[s] = __builtin_bit_cast(bf16x8, ww); }
}
__device__ __forceinline__ void attn_unit(const Ctx& C, int b, int h, int qb, const bf16_t* Q, const bf16_t* KN, const bf16_t* KR, const bf16_t* V, bf16_t* O) {
    const int tid = C.tid, lane = C.lane, wid = C.wave, q = lane & 31, hi = lane >> 5;
    LAS unsigned char* lds = C.lds;
    const int s0 = qb * 256 + wid * 32;
    const size_t qrow = (size_t)b * SEQ + s0 + q;
    bf16x8 qf[6];
#pragma unroll
    for (int ks = 0; ks < 6; ++ks) qf[ks] = *(const bf16x8*)(Q + qrow * QLD + h * 96 + ks * 16 + hi * 8);
    {
        const float* ctab = (const float*)(C.ws + WS_CTAB) + (NMETA + s0 + q) * 16; const float* stab = (const float*)(C.ws + WS_STAB) + (NMETA + s0 + q) * 16;
#pragma unroll
        for (int ks = 4; ks < 6; ++ks) { const f32x4 cc = *(const f32x4*)(ctab + 8 * (ks - 4) + 4 * hi), sn = *(const f32x4*)(stab + 8 * (ks - 4) + 4 * hi);
            const u32x4 w = __builtin_bit_cast(u32x4, qf[ks]); u32x4 r;
            { const float x1 = bf_lo(w.x), x2 = bf_hi(w.x); r.x = pk2(x1 * cc[0] - x2 * sn[0], x1 * sn[0] + x2 * cc[0]); }
            { const float x1 = bf_lo(w.y), x2 = bf_hi(w.y); r.y = pk2(x1 * cc[1] - x2 * sn[1], x1 * sn[1] + x2 * cc[1]); }
            { const float x1 = bf_lo(w.z), x2 = bf_hi(w.z); r.z = pk2(x1 * cc[2] - x2 * sn[2], x1 * sn[2] + x2 * cc[2]); }
            { const float x1 = bf_lo(w.w), x2 = bf_hi(w.w); r.w = pk2(x1 * cc[3] - x2 * sn[3], x1 * sn[3] + x2 * cc[3]); }
            qf[ks] = __builtin_bit_cast(bf16x8, r); }
    }
    f32x16 o0 = {}, o1 = {}, p0 = {}, p1 = {};
    bf16x8 pb[4] = {};
    float m_run = 0.f, l_run = 0.f; f32x16 negm = {};
    const int NJ = 4 * qb + 5;
    const unsigned lds0 = (unsigned)(size_t)lds;
    const bf16_t* ksrc = KN + (size_t)lane * 1024 + h * 64 + wid * 8;
    const bf16_t* rsrc = KR + (size_t)lane * 32 + (wid & 3) * 8;
    const bf16_t* vsrc = V + (size_t)(16 * (wid & 3) + (lane >> 2)) * 1024 + h * 64 + (wid >> 2) * 32 + (lane & 3) * 8;
#define AT_DMA(j) do { const size_t row_ = (j) == 0 ? (size_t)METAROW : (size_t)b * SEQ + (size_t)((j) - 1) * 64; \
        glds16(ksrc + row_ * 1024, (unsigned)__builtin_amdgcn_readfirstlane(lds0 + AT_K(j) + wid * 1024)); \
        if (wid < 4) glds16(rsrc + row_ * 32, (unsigned)__builtin_amdgcn_readfirstlane(lds0 + AT_K(j) + (8 + wid) * 1024)); \
        glds16(vsrc + row_ * 1024, (unsigned)__builtin_amdgcn_readfirstlane(lds0 + AT_V(j) + wid * 1024)); } while (0)
#define AT_STEP(n) do { if ((n) + 2 < NJ) { if (wid < 4) AT_BAR(6); else AT_BAR(4); } else if ((n) + 1 < NJ) { if (wid < 4) AT_BAR(3); else AT_BAR(2); } else AT_BAR(0); if ((n) + 3 < NJ) AT_DMA((n) + 3); } while (0)
    AT_BAR(0);
    AT_DMA(0); AT_DMA(1); AT_DMA(2);
    const int g16 = lane >> 4, qq = (lane & 15) >> 2, pp = lane & 3;
    const int vtr_off = (4 * hi + qq) * 64 + (16 * (g16 & 1) + 4 * pp) * 2;
    {
        AT_STEP(0);
        attn_q(lds, 0, s0, q, hi, qf, negm, p0, p1);
        attn_sp<false, true>(lds, 0, p0, p1, pb, o0, o1, negm, m_run, l_run);
    }
    const int jend = (s0 + 31) / 64 + 2 < NJ ? (s0 + 31) / 64 + 2 : NJ;
    for (int j = 1; j < jend; ++j) {
        AT_STEP(j);
        attn_q(lds, j, s0, q, hi, qf, negm, p0, p1);
        attn_sp<true, false>(lds, AT_V(j - 1) + vtr_off, p0, p1, pb, o0, o1, negm, m_run, l_run);
    }
    attn_pv(lds, AT_V(jend - 1) + vtr_off, pb, o0, o1);
    for (int j = jend; j < NJ; ++j) AT_STEP(j);
#undef AT_DMA
#undef AT_STEP
    const float inv = 1.f / (l_run + __shfl_xor(l_run, 32));
    bf16_t* orow = O + qrow * 1024 + h * 64;
#pragma unroll
    for (int g4 = 0; g4 < 4; ++g4) {
        u32x2 w0, w1; w0.x = pk2(o0[4 * g4] * inv, o0[4 * g4 + 1] * inv); w0.y = pk2(o0[4 * g4 + 2] * inv, o0[4 * g4 + 3] * inv);
        w1.x = pk2(o1[4 * g4] * inv, o1[4 * g4 + 1] * inv); w1.y = pk2(o1[4 * g4 + 2] * inv, o1[4 * g4 + 3] * inv);
        *(u32x2*)(orow + 8 * g4 + 4 * hi) = w0; *(u32x2*)(orow + 32 + 8 * g4 + 4 * hi) = w1;
    }
}
__device__ __forceinline__ void phase_attn(const Ctx& C) {
    unsigned char* ws = C.ws;
    const bf16_t* Q = (const bf16_t*)(ws + SLOT(0)); const bf16_t* KN = (const bf16_t*)(ws + SLOT(4)); const bf16_t* V = (const bf16_t*)(ws + SLOT(6)); const bf16_t* KR = (const bf16_t*)(ws + WS_KROPE);
    bf16_t* O = (bf16_t*)(ws + SLOT(3));
    const int G = C.G, c = blockIdx.x; const int vcu = (G % 8 == 0) ? (c % 8) * (G / 8) + c / 8 : c;
    for (int bh = vcu; bh < NB * 16; bh += G)
        for (int i = 0; i < 8; ++i) { const int qb = (i & 1) ? 7 - (i >> 1) : (i >> 1); attn_unit(C, bh >> 4, bh & 15, qb, Q, KN, KR, V, O); }
    __syncthreads();
}

__device__ __forceinline__ int tk_enc(float f) { const int x = __float_as_int(f); return x ^ ((x >> 31) & 0x7fffffff); }
__device__ __forceinline__ float tk_dec(int k) { return __int_as_float(k ^ ((k >> 31) & 0x7fffffff)); }
#define TK_CE(a, b) do { const int hi_ = max((a), (b)), lo_ = min((a), (b)); (a) = hi_; (b) = lo_; } while (0)
__device__ __forceinline__ void tk_sort16(int (&v)[16]) {
#pragma unroll
    for (int k = 2; k <= 16; k <<= 1)
#pragma unroll
        for (int j = k >> 1; j > 0; j >>= 1)
#pragma unroll
            for (int i = 0; i < 16; ++i) { const int l = i ^ j; if (l > i) { if ((i & k) == 0) TK_CE(v[i], v[l]); else TK_CE(v[l], v[i]); } }
}
__device__ __forceinline__ void tk_merge16(int (&a)[16], const int (&b)[16]) {
#pragma unroll
    for (int i = 0; i < 16; ++i) a[i] = max(a[i], b[15 - i]);
#pragma unroll
    for (int j = 8; j > 0; j >>= 1)
#pragma unroll
        for (int i = 0; i < 16; ++i) { const int l = i ^ j; if (l > i) TK_CE(a[i], a[l]); }
}
__host__ __device__ constexpr int tk_pos(int i) { int n = 0; for (int a = 0; a < i; ++a) n += 16 / (a + 1); return n; }
__device__ __forceinline__ int tk_lookup(const int (&w)[4], int i) {
    const unsigned long long lo = ((unsigned long long)(unsigned)w[1] << 32) | (unsigned long long)(unsigned)w[0], hi = ((unsigned long long)(unsigned)w[3] << 32) | (unsigned long long)(unsigned)w[2];
    const unsigned long long a = (i & 8) ? hi : lo;
    return (int)(a >> (8 * (i & 7))) & 127;
}
__device__ __forceinline__ void phase_topk(const Ctx& C) {
    unsigned char* ws = C.ws;
    const _Float16* SC = (const _Float16*)(ws + SLOT(0)); int* TIDX = (int*)(ws + SLOT(5)); float* TVAL = (float*)(ws + SLOT(5) + (size_t)M * 128 * 4);
    const int gt = blockIdx.x * NTHR + C.tid, NT = C.G * NTHR;
    for (int it = gt; it < M * 8 * 4; it += NT) {
        const int p = it >> 2, q = it & 3;
        const f16x8* s = (const f16x8*)(SC + (size_t)p * 256 + 64 * q);
        f16x8 raw[8];
#pragma unroll
        for (int c = 0; c < 8; ++c) raw[c] = s[c];
        const int ibase = 127 - 64 * (q & 1);
        int ch[4][16];
#pragma unroll
        for (int c = 0; c < 4; ++c)
#pragma unroll
            for (int e = 0; e < 16; ++e) ch[c][e] = (tk_enc((float)raw[2 * c + (e >> 3)][e & 7]) & ~127) | (ibase - (16 * c + e));
        tk_sort16(ch[0]); tk_sort16(ch[1]); tk_sort16(ch[2]); tk_sort16(ch[3]);
        tk_merge16(ch[0], ch[1]); tk_merge16(ch[2], ch[3]); tk_merge16(ch[0], ch[2]);
        int oth[16];
#pragma unroll
        for (int i = 0; i < 16; ++i) oth[i] = __builtin_amdgcn_mov_dpp(ch[0][i], 0xB1, 0xF, 0xF, true);
        tk_merge16(ch[0], oth);
#pragma unroll
        for (int i = 0; i < 16; ++i) oth[i] = __builtin_amdgcn_mov_dpp(ch[0][i], 0x4E, 0xF, 0xF, true);
        int t1[16], t2[16];
#pragma unroll
        for (int i = 0; i < 16; ++i) { t1[i] = (q < 2) ? ch[0][i] : oth[i]; t2[i] = (q < 2) ? oth[i] : ch[0][i]; }
        float f1[16], f2[16];
#pragma unroll
        for (int i = 0; i < 16; ++i) { f1[i] = tk_dec(t1[i]); f2[i] = tk_dec(t2[i]); }
        int cd[4][16];
#pragma unroll
        for (int i = 0; i < 16; ++i)
#pragma unroll
            for (int j = 0; j < 16; ++j) if ((i + 1) * (j + 1) <= 16) { constexpr int dummy = 0; (void)dummy; const int n = tk_pos(i) + j; cd[n >> 4][n & 15] = (tk_enc(f1[i] + f2[j]) & ~255) | (255 - (16 * i + j)); }
#pragma unroll
        for (int n = 50; n < 64; ++n) cd[n >> 4][n & 15] = (int)0x80000000;
        tk_sort16(cd[0]); tk_sort16(cd[1]); tk_sort16(cd[2]); tk_sort16(cd[3]);
        tk_merge16(cd[0], cd[1]); tk_merge16(cd[2], cd[3]); tk_merge16(cd[0], cd[2]);
        int w1[4], w2[4];
#pragma unroll
        for (int m = 0; m < 4; ++m) { w1[m] = (t1[4 * m] & 127) | ((t1[4 * m + 1] & 127) << 8) | ((t1[4 * m + 2] & 127) << 16) | ((t1[4 * m + 3] & 127) << 24);
                                      w2[m] = (t2[4 * m] & 127) | ((t2[4 * m + 1] & 127) << 8) | ((t2[4 * m + 2] & 127) << 16) | ((t2[4 * m + 3] & 127) << 24); }
        if (q == 0) {
            int id[16];
#pragma unroll
            for (int k = 0; k < 16; ++k) { const int c = 255 - (cd[0][k] & 255); id[k] = (127 - tk_lookup(w1, c >> 4)) * 128 + (127 - tk_lookup(w2, c & 15)); }
            int* oi = TIDX + (size_t)p * 16;
#pragma unroll
            for (int k = 0; k < 16; k += 4) *(int4*)(oi + k) = make_int4(id[k], id[k + 1], id[k + 2], id[k + 3]);
        } else if (q == 1) {
            float* ov = TVAL + (size_t)p * 16;
#pragma unroll
            for (int k = 0; k < 16; k += 4) *(f32x4*)(ov + k) = (f32x4){tk_dec(cd[0][k]), tk_dec(cd[0][k + 1]), tk_dec(cd[0][k + 2]), tk_dec(cd[0][k + 3])};
        }
    }
}

__device__ __forceinline__ float dpp_ror8(float v) { return __uint_as_float(__builtin_amdgcn_update_dpp(0, __float_as_uint(v), 0x128, 0xF, 0xF, true)); }
__device__ __forceinline__ float dpp_hmir(float v) { return __uint_as_float(__builtin_amdgcn_update_dpp(0, __float_as_uint(v), 0x141, 0xF, 0xF, true)); }
__device__ __forceinline__ float dpp_x2(float v) { return __uint_as_float(__builtin_amdgcn_mov_dpp(__float_as_uint(v), 0x4E, 0xF, 0xF, true)); }
__device__ __forceinline__ float dpp_x1(float v) { return __uint_as_float(__builtin_amdgcn_mov_dpp(__float_as_uint(v), 0xB1, 0xF, 0xF, true)); }
__device__ __forceinline__ void phase_x8(const Ctx& C) {
    unsigned char* ws = C.ws; const int lane = C.lane;
    const bf16_t* H1B = (const bf16_t*)(ws + SLOT(4)); unsigned char* X8 = ws + SLOT(2); float* XS = (float*)(ws + SLOT(2) + (size_t)M * 1024);
    for (int tok = C.gw; tok < M; tok += C.NGW) {
        const u32x4 xa = *(const u32x4*)(H1B + (size_t)tok * 1024 + 16 * lane), xb = *(const u32x4*)(H1B + (size_t)tok * 1024 + 16 * lane + 8);
        float hv[16]; { float t8[8]; unpack8(xa, t8);
#pragma unroll
            for (int i = 0; i < 8; ++i) hv[i] = t8[i];
            unpack8(xb, t8);
#pragma unroll
            for (int i = 0; i < 8; ++i) hv[8 + i] = t8[i]; }
        float am = 0.f;
#pragma unroll
        for (int i = 0; i < 16; ++i) am = fmaxf(am, fabsf(hv[i]));
#pragma unroll
        for (int o = 1; o < 64; o <<= 1) am = fmaxf(am, __shfl_xor(am, o));
        const float scale = am > 0.f ? am * (1.f / 127.f) : 1.f, inv = 1.f / scale;
        u32x4 w;
#pragma unroll
        for (int j = 0; j < 4; ++j) { const int q0 = (int)rintf(hv[4 * j] * inv), q1 = (int)rintf(hv[4 * j + 1] * inv), q2 = (int)rintf(hv[4 * j + 2] * inv), q3 = (int)rintf(hv[4 * j + 3] * inv);
            w[j] = (unsigned)(q0 & 255) | ((unsigned)(q1 & 255) << 8) | ((unsigned)(q2 & 255) << 16) | ((unsigned)q3 << 24); }
        *(u32x4*)(X8 + (size_t)tok * 1024 + 16 * lane) = w;
        if (lane == 0) XS[tok] = scale;
    }
}
__device__ __forceinline__ int idpp_ror8(int v) { return __builtin_amdgcn_update_dpp(0, v, 0x128, 0xF, 0xF, true); }
__device__ __forceinline__ int idpp_hmir(int v) { return __builtin_amdgcn_update_dpp(0, v, 0x141, 0xF, 0xF, true); }
__device__ __forceinline__ int idpp_x2(int v) { return __builtin_amdgcn_mov_dpp(v, 0x4E, 0xF, 0xF, true); }
__device__ __forceinline__ int idpp_x1(int v) { return __builtin_amdgcn_mov_dpp(v, 0xB1, 0xF, 0xF, true); }
__device__ __forceinline__ int idot16(const u32x4 w, const u32x4 x, int a) {
    a = __builtin_amdgcn_sdot4((int)w.x, (int)x.x, a, false); a = __builtin_amdgcn_sdot4((int)w.y, (int)x.y, a, false);
    a = __builtin_amdgcn_sdot4((int)w.z, (int)x.z, a, false); return __builtin_amdgcn_sdot4((int)w.w, (int)x.w, a, false);
}
__device__ __forceinline__ void u_process(unsigned c, unsigned co, int n, int tok, const u32x4 (&x)[4], float xscale, const unsigned char* PU, float* ACT, int lane, bool b3, bool b2) {
    const int rs = lane >> 4; const unsigned p16 = 16u * (unsigned)(lane & 15);
    for (int base = 0; base < n; base += 32) {
        u32x4 w[8][4];
#pragma unroll
        for (int m = 0; m < 8; ++m) if (base + 4 * m < n) {
            const unsigned off = (unsigned)__builtin_amdgcn_ds_bpermute(((base + 4 * m + rs) & 63) * 4, (int)co);
            const unsigned char* rp = PU + (off + p16);
#pragma unroll
            for (int i = 0; i < 4; ++i) w[m][i] = *(const u32x4*)(rp + 256 * i); }
        __builtin_amdgcn_sched_barrier(0);
#pragma unroll
        for (int G = 0; G < 2; ++G) if (base + 16 * G < n) {
            int p4[4];
#pragma unroll
            for (int mm = 0; mm < 4; ++mm) { int a = 0;
#pragma unroll
                for (int i = 0; i < 4; ++i) a = idot16(w[4 * G + mm][i], x[i], a);
                p4[mm] = a; }
            int t0, t1, u;
            { const int keep = b3 ? p4[1] : p4[0], send = b3 ? p4[0] : p4[1]; t0 = keep + idpp_ror8(send); }
            { const int keep = b3 ? p4[3] : p4[2], send = b3 ? p4[2] : p4[3]; t1 = keep + idpp_ror8(send); }
            { const int keep = b2 ? t1 : t0, send = b2 ? t0 : t1; u = keep + idpp_hmir(send); }
            u += idpp_x2(u); u += idpp_x1(u);
            const int slot = base + 16 * G + 4 * ((b2 ? 2 : 0) + (b3 ? 1 : 0)) + rs;
            const unsigned mine = (unsigned)__builtin_amdgcn_ds_bpermute((slot & 63) * 4, (int)c);
            if ((lane & 3) == 0 && slot < n) ACT[(size_t)tok * 128 + (mine >> 16)] = (float)u * xscale;
        }
    }
}
constexpr int UB = 8;
__device__ __forceinline__ float u_batch_request(const unsigned char* X8, const float* XS, const int* TIDX, int tb, int tstep, unsigned xs_addr, int lane) {
#pragma unroll
    for (int k = 0; k < UB; ++k) { const int tk = tb + k * tstep; if (tk < M) glds16(X8 + (size_t)tk * 1024 + 16 * lane, xs_addr + k * 1024); }
#pragma unroll
    for (int k = 0; k < UB; k += 2) { if (tb + k * tstep < M) { int tk = tb + (k + (lane >> 5)) * tstep; tk = tk < M ? tk : tb;
        glds16(TIDX + (size_t)tk * 128 + 4 * (lane & 31), xs_addr + UB * 1024 + k * 512); } }
    const int tl = tb + (lane & (UB - 1)) * tstep;
    return XS[tl < M ? tl : tb];
}
__device__ __forceinline__ void phase_upart(const Ctx& C, int xcc, int rank) {
    unsigned char* ws = C.ws; const int lane = C.lane;
    const unsigned char* X8 = ws + SLOT(2); const float* XS = (const float*)(ws + SLOT(2) + (size_t)M * 1024);
    const int* TIDX = (const int*)(ws + SLOT(5)); float* ACT = (float*)(ws + SLOT(0));
    const unsigned char* PU = ws + WS_PU;
    LAS unsigned char* xs = C.lds + C.wave * (UB * 1536);
    const unsigned xs_addr = (unsigned)__builtin_amdgcn_readfirstlane((int)(unsigned)(size_t)xs);
    int nloc, xi, nx;
    if ((C.G & 7) == 0) { nx = 8; xi = xcc; nloc = C.G >> 3; } else { nx = 1; xi = 0; nloc = C.G; rank = blockIdx.x; }
    const bool b3 = (lane & 8) != 0, b2 = (lane & 4) != 0; const int pos = lane & 15;
    const int tstep = nloc * NWAVES;
    for (int sub = xi; sub < 8; sub += nx) {
        const unsigned dummy = (unsigned)(sub << 11) * 1024u;
        int tb = rank * NWAVES + C.wave;
        float svn = 0.f;
        if (tb < M) svn = u_batch_request(X8, XS, TIDX, tb, tstep, xs_addr, lane);
        for (; tb < M; tb += UB * tstep) {
            asm volatile("s_waitcnt vmcnt(0)" ::: "memory");
            const float sv = svn;
#pragma unroll 1
            for (int k = 0; k < UB; ++k) {
                const int tok = tb + k * tstep; if (tok >= M) break;
                u32x4 x[4];
#pragma unroll
                for (int i = 0; i < 4; ++i) x[i] = *(LAS const u32x4*)(xs + k * 1024 + 256 * i + 16 * pos);
                const int ca = *(LAS const int*)(xs + UB * 1024 + k * 512 + 4 * lane), cb = *(LAS const int*)(xs + UB * 1024 + k * 512 + 256 + 4 * lane);
                const float xscale = __uint_as_float(__builtin_amdgcn_readlane(__float_as_uint(sv), k));
                const bool fa = (ca >> 11) == sub, fb = (cb >> 11) == sub;
                const unsigned long long ma = __ballot(fa), mb = __ballot(fb);
                const int npa = __builtin_popcountll(ma), npb = __builtin_popcountll(mb);
                const int ra_ = (int)__builtin_amdgcn_mbcnt_hi((unsigned)(ma >> 32), __builtin_amdgcn_mbcnt_lo((unsigned)ma, 0u));
                const int rb_ = (int)__builtin_amdgcn_mbcnt_hi((unsigned)(mb >> 32), __builtin_amdgcn_mbcnt_lo((unsigned)mb, 0u));
                const int da = fa ? ra_ : npa + (lane - ra_), db = fb ? rb_ : npb + (lane - rb_);
                const unsigned cA = (unsigned)__builtin_amdgcn_ds_permute(da * 4, ca | (lane << 16));
                const unsigned cB = (unsigned)__builtin_amdgcn_ds_permute(db * 4, cb | ((64 + lane) << 16));
                if (npa + npb <= 64) {
                    const unsigned pulled = (unsigned)__builtin_amdgcn_ds_bpermute(((lane - npa) & 63) * 4, (int)cB);
                    const unsigned cc = lane < npa ? cA : pulled; const int n = npa + npb;
                    u_process(cc, lane < n ? (cc & 0xffffu) * 1024u : dummy, n, tok, x, xscale, PU, ACT, lane, b3, b2);
                } else { u_process(cA, lane < npa ? (cA & 0xffffu) * 1024u : dummy, npa, tok, x, xscale, PU, ACT, lane, b3, b2);
                         u_process(cB, lane < npb ? (cB & 0xffffu) * 1024u : dummy, npb, tok, x, xscale, PU, ACT, lane, b3, b2); }
            }
            asm volatile("s_waitcnt lgkmcnt(0)" ::: "memory");
            if (tb + UB * tstep < M) svn = u_batch_request(X8, XS, TIDX, tb + UB * tstep, tstep, xs_addr, lane);
        }
    }
}
__device__ __forceinline__ void phase_gather(const Ctx& C, float* DST) {
    unsigned char* ws = C.ws; const int lane = C.lane;
    const bf16_t* H1B = (const bf16_t*)(ws + SLOT(4)); const int* TIDX = (const int*)(ws + SLOT(5)); const float* TVAL = (const float*)(ws + SLOT(5) + (size_t)M * 128 * 4);
    const float* ACT = (const float*)(ws + SLOT(0));
    const unsigned char* PV = ws + WS_PV; const float* SU = (const float*)(ws + WS_SU); const float* SV = (const float*)(ws + WS_SV);
    const float* fg = C.in[24];
    const int l4 = lane >> 2, ll = lane & 31; const bool hb = lane >= 32;
    const int ln = 2 * ll + (lane >> 5);
    int tok = C.gw;
    u32x4 ra = {0u, 0u, 0u, 0u}, rb = {0u, 0u, 0u, 0u};
    if (tok < M) { ra = *(const u32x4*)(H1B + (size_t)tok * 1024 + 16 * ln); rb = *(const u32x4*)(H1B + (size_t)tok * 1024 + 16 * ln + 8); }
    for (; tok < M; tok += C.NGW) {
        f32x4 e[4]; float ss = 0.f;
        { float hv[16]; { float t8[8]; unpack8(ra, t8);
#pragma unroll
            for (int i = 0; i < 8; ++i) hv[i] = t8[i];
            unpack8(rb, t8);
#pragma unroll
            for (int i = 0; i < 8; ++i) hv[8 + i] = t8[i]; }
#pragma unroll
          for (int j = 0; j < 4; ++j) { e[j] = (f32x4){hv[4 * j], hv[4 * j + 1], hv[4 * j + 2], hv[4 * j + 3]}; ss += (e[j][0] * e[j][0] + e[j][1] * e[j][1]) + (e[j][2] * e[j][2] + e[j][3] * e[j][3]); } }
        { const int nt = tok + C.NGW; if (nt < M) { ra = *(const u32x4*)(H1B + (size_t)nt * 1024 + 16 * ln); rb = *(const u32x4*)(H1B + (size_t)nt * 1024 + 16 * ln + 8); } }
        f32x4* dp = (f32x4*)(DST + (size_t)tok * 1024 + 16 * ln);
        const float rstd = 1.f / sqrtf(wave_sum(ss) * (1.f / 1024.f) + EPS);
        f32x2 acc[16];
#pragma unroll
        for (int i = 0; i < 16; ++i) acc[i] = (f32x2){0.f, 0.f};
        int idxn0 = TIDX[(size_t)tok * 128 + l4], idxn1 = TIDX[(size_t)tok * 128 + 16 + l4];
        float tsn0 = TVAL[(size_t)tok * 128 + l4], tsn1 = TVAL[(size_t)tok * 128 + 16 + l4], dtn0 = ACT[(size_t)tok * 128 + l4], dtn1 = ACT[(size_t)tok * 128 + 16 + l4];
        for (int hp = 0; hp < 8; hp += 2) {
            const int idx0 = idxn0, idx1 = idxn1; const float ts0 = tsn0 * rstd, ts1 = tsn1 * rstd, dot0 = dtn0, dot1 = dtn1;
            u32x4 pa[16];
#pragma unroll
            for (int m = 0; m < 16; ++m) { const int src = m < 8 ? idx0 : idx1; const int ida = __builtin_amdgcn_readlane(src, 4 * ((2 * m) & 15)), idb = __builtin_amdgcn_readlane(src, 4 * ((2 * m + 1) & 15));
                pa[m] = *(const u32x4*)(PV + (size_t)(hb ? idb : ida) * 512 + 16 * ll); }
            __builtin_amdgcn_sched_barrier(0);
            const float su0 = SU[idx0], sv0 = SV[idx0], su1 = SU[idx1], sv1 = SV[idx1];
            if (hp < 6) { const size_t nb = (size_t)tok * 128 + (hp + 2) * 16 + l4; idxn0 = TIDX[nb]; idxn1 = TIDX[nb + 16]; tsn0 = TVAL[nb]; tsn1 = TVAL[nb + 16]; dtn0 = ACT[nb]; dtn1 = ACT[nb + 16]; }
            __builtin_amdgcn_sched_barrier(0);
            float mx0 = ts0, mx1 = ts1;
#pragma unroll
            for (int o = 4; o < 64; o <<= 1) { mx0 = fmaxf(mx0, __shfl_xor(mx0, o)); mx1 = fmaxf(mx1, __shfl_xor(mx1, o)); }
            const float ee0 = ex2((ts0 - mx0) * LOG2E), ee1 = ex2((ts1 - mx1) * LOG2E); float sm0 = ee0, sm1 = ee1;
#pragma unroll
            for (int o = 4; o < 64; o <<= 1) { sm0 += __shfl_xor(sm0, o); sm1 += __shfl_xor(sm1, o); }
            const float coef0 = (ee0 / sm0) * gelu_t(dot0 * su0 * rstd) * sv0, coef1 = (ee1 / sm1) * gelu_t(dot1 * su1 * rstd) * sv1;
#pragma unroll
            for (int m = 0; m < 16; ++m) {
                const unsigned cs = __float_as_uint(m < 8 ? coef0 : coef1);
                const float ca = __uint_as_float(__builtin_amdgcn_readlane(cs, 4 * ((2 * m) & 15))), cb = __uint_as_float(__builtin_amdgcn_readlane(cs, 4 * ((2 * m + 1) & 15)));
                const float ck = hb ? cb : ca;
#pragma unroll
                for (int d = 0; d < 4; ++d) {
                    acc[4 * d] = __builtin_elementwise_fma(__builtin_amdgcn_cvt_scalef32_pk_f32_fp4(pa[m][d], 1.0f, 0), (f32x2){ck, ck}, acc[4 * d]);
                    acc[4 * d + 1] = __builtin_elementwise_fma(__builtin_amdgcn_cvt_scalef32_pk_f32_fp4(pa[m][d], 1.0f, 1), (f32x2){ck, ck}, acc[4 * d + 1]);
                    acc[4 * d + 2] = __builtin_elementwise_fma(__builtin_amdgcn_cvt_scalef32_pk_f32_fp4(pa[m][d], 1.0f, 2), (f32x2){ck, ck}, acc[4 * d + 2]);
                    acc[4 * d + 3] = __builtin_elementwise_fma(__builtin_amdgcn_cvt_scalef32_pk_f32_fp4(pa[m][d], 1.0f, 3), (f32x2){ck, ck}, acc[4 * d + 3]); }
                __builtin_amdgcn_sched_barrier(0);
            }
        }
        float s2 = 0.f;
#pragma unroll
        for (int j = 0; j < 4; ++j) {
#pragma unroll
            for (int i = 0; i < 4; ++i) { const int q = 4 * j + i; auto rr = __builtin_amdgcn_permlane32_swap(__float_as_uint(acc[q >> 1][q & 1]), __float_as_uint(acc[8 + (q >> 1)][q & 1]), false, false);
                e[j][i] += __uint_as_float(rr[0]) + __uint_as_float(rr[1]); }
            s2 += (e[j][0] * e[j][0] + e[j][1] * e[j][1]) + (e[j][2] * e[j][2] + e[j][3] * e[j][3]); }
        const float r2 = 1.f / sqrtf(wave_sum(s2) * (1.f / 1024.f) + EPS);
        const f32x4* fp = (const f32x4*)(fg + 16 * ln);
#pragma unroll
        for (int j = 0; j < 4; ++j) dp[j] = e[j] * r2 * fp[j];
    }
}

constexpr int NPHASE = 16;
__global__ void __launch_bounds__(NTHR, 2) hybrid_fwd(Args args) {
    extern __shared__ __attribute__((aligned(16))) unsigned char lds_raw[];
    Ctx C;
    C.lds = (LAS unsigned char*)lds_raw; C.tid = threadIdx.x; C.lane = C.tid & 63; C.wave = __builtin_amdgcn_readfirstlane(C.tid >> 6);
    C.G = gridDim.x; C.gw = blockIdx.x * NWAVES + C.wave; C.NGW = C.G * NWAVES; C.ws = args.ws; C.out = args.out; C.in = args.in;
    unsigned char* ws = args.ws;
    volatile LAS unsigned* MISC = (volatile LAS unsigned*)(C.lds + MISC_OFF);
    for (int u = C.tid; u < (LDS_BYTES - RING_BYTES) / 4; u += NTHR) ((LAS unsigned*)(C.lds + RING_BYTES))[u] = 0u;
    __syncthreads();
    XcdBarrier bar; bar.bar = (unsigned*)(ws + WS_CTL) + 1024; bar.x = 0; bar.st = nullptr;
    if (ONE_LAUNCH) bar = xcd_barrier_post((unsigned*)(ws + WS_CTL) + 1024, MISC + 8);
    const int lo = args.ph_lo, hi = args.ph_hi;
#ifndef PHMASK
#define PHMASK 0xffff
#endif
#define IN(k) (((PHMASK >> (k)) & 1) && lo <= (k) && (k) < hi)
#ifndef PROBE_PHASE
#define PROBE_PHASE -1
#endif
#define REPS(k) for (int rep_ = 0; rep_ < ((k) == PROBE_PHASE ? 2 : 1); ++rep_)
#define SEAM(k) do { if (IN(k) && IN((k) + 1)) xcd_barrier(bar); } while (0)
    const int G = C.G, cb = blockIdx.x;
    LAS unsigned char* ring = C.lds;

    if (IN(0)) REPS(0) { phase_prologue(C); }
    SEAM(0);
    if (IN(1)) REPS(1) {
        pg8::Gemm g{(const bf16_t*)(ws + SLOT(0)), (const bf16_t*)(ws + WS_WIN), 1024, 1024, 1024, 0, 256 * 1024};
        pg8::Sched S; S.init(256, 19, G, cb, 256, 6, 4);
        pg8::Epi8<FInproj> E{{(bf16_t*)(ws + SLOT(1)), (bf16_t*)(ws + SLOT(2)), (bf16_t*)(ws + SLOT(3)), (bf16_t*)(ws + SLOT(4)), (bf16_t*)(ws + SLOT(5))}};
        pg8::gemm_phase(ring, g, S, E);
    }
    SEAM(1);
    if (IN(2)) REPS(2) { phase_thin(C); }
    SEAM(2);
    if (IN(3)) REPS(3) {
        pg8::Gemm g{(const bf16_t*)(ws + SLOT(0)), (const bf16_t*)(ws + WS_WGATE), 1024, 128, 128, 128, 256 * 128};
        pg8::Sched S; S.init(256, 8, G, cb, 256, 8, 0);
        pg8::EpiPair<FGate> E{{(const bf16_t*)(ws + SLOT(0)), args.in[7], args.in[9], (const float*)(ws + WS_CLAM), (bf16_t*)(ws + SLOT(1)), (bf16_t*)(ws + SLOT(6))}};
        pg8::gemm_phase(ring, g, S, E);
    }
    SEAM(3);
    if (IN(4)) REPS(4) { phase_scan1(C); }
    SEAM(4);
    if (IN(5)) REPS(5) { phase_scan2(C); }
    SEAM(5);
    if (IN(6)) REPS(6) {
        pg8::Gemm g{(const bf16_t*)(ws + SLOT(0)), (const bf16_t*)(ws + WS_WRNN), 1024, 1024, 1024, 0, 256 * 1024};
        pg8::Sched S; S.init(256, 4, G, cb, 0, 0, 0);
        pg8::Epi8<FMul<false>> E{{(const bf16_t*)(ws + SLOT(4)), nullptr, (bf16_t*)(ws + SLOT(2))}};
        pg8::gemm_phase(ring, g, S, E);
    }
    SEAM(6);
    if (IN(7)) REPS(7) {
        { pg8::Gemm g{(const bf16_t*)(ws + SLOT(3)) + CQ_OFF, (const bf16_t*)(ws + WS_WUQ), CQKV_LD, 384, 384, 0, 256 * 384};
          pg8::Sched S; S.init(256, 6, G, cb, 0, 0, 0);
          pg8::Epi8<FQ> E{{(const float*)(ws + WS_RSQ), (bf16_t*)(ws + SLOT(0))}};
          pg8::gemm_phase(ring, g, S, E); }
        { pg8::Gemm g{(const bf16_t*)(ws + SLOT(3)), (const bf16_t*)(ws + WS_WUKV), CQKV_LD, 256, 256, 0, 256 * 256};
          pg8::Sched S; S.init(256, 8, G, cb, 256, 8, 0);
          pg8::Epi8<FKV> E{{(const float*)(ws + WS_RSKV), (bf16_t*)(ws + SLOT(4)), (bf16_t*)(ws + SLOT(6))}};
          pg8::gemm_phase(ring, g, S, E); }
    }
    SEAM(7);
    if (IN(8)) REPS(8) { phase_attn(C); }
    SEAM(8);
    if (IN(9)) REPS(9) {
        pg8::Gemm g{(const bf16_t*)(ws + SLOT(3)), (const bf16_t*)(ws + WS_WATT), 1024, 1024, 1024, 0, 256 * 1024};
        pg8::Sched S; S.init(256, 4, G, cb, 0, 0, 0);
        pg8::Epi8<FMul<true>> E{{(const bf16_t*)(ws + SLOT(5)), (const bf16_t*)(ws + SLOT(2)), (bf16_t*)(ws + SLOT(0))}};
        pg8::gemm_phase(ring, g, S, E);
    }
    SEAM(9);
    if (IN(10)) REPS(10) {
        pg8::Gemm g{(const bf16_t*)(ws + SLOT(0)), (const bf16_t*)(ws + WS_WOUT), 1024, 1024, 1024, 0, 256 * 1024};
        pg8::Sched S; S.init(256, 4, G, cb, 0, 0, 0);
        pg8::Epi8<FRes> E{{args.in[0], (bf16_t*)(ws + SLOT(4))}};
        pg8::gemm_phase(ring, g, S, E);
    }
    SEAM(10);
    if (IN(11)) REPS(11) {
        pg8::Gemm g{(const bf16_t*)(ws + SLOT(4)), (const bf16_t*)(ws + WS_WPQ), 1024, 1024, 1024, 0, 256 * 1024};
        pg8::Sched S; S.init(256, 8, G, cb, 0, 0, 0);
        pg8::Epi8<FF16> E{{(_Float16*)(ws + SLOT(0)), 2048}};
        pg8::gemm_phase(ring, g, S, E);
    }
    SEAM(11);
    if (IN(13)) REPS(13) { phase_x8(C); phase_topk(C); }
    SEAM(13);
    if (IN(14)) REPS(14) { phase_upart(C, (int)(blockIdx.x & 7), (int)(blockIdx.x >> 3)); }
    SEAM(14);
    if (IN(15)) REPS(15) { phase_gather(C, C.out); }
#undef IN
#undef SEAM
}

extern "C" void kernel_launch(void* const* d_in, const int* in_sizes, int n_in, void* d_out, int out_size, void* d_ws, size_t ws_size, hipStream_t stream) {
    static int grid = 0;
    if (grid == 0) {
        if (n_in != 25 || in_sizes[0] != M * DM || out_size != M * DM || ws_size < WS_END) { fprintf(stderr, "kernel_launch: unexpected shapes (n_in %d in0 %d out %d ws %zu need %zu); nothing launched\n", n_in, n_in > 0 ? in_sizes[0] : -1, out_size, ws_size, (size_t)WS_END); grid = -1; return; }
        int dev = 0, cus = 0, per_cu = 0;
        if (hipGetDevice(&dev) != hipSuccess || hipDeviceGetAttribute(&cus, hipDeviceAttributeMultiprocessorCount, dev) != hipSuccess) { grid = -1; return; }
        if (hipFuncSetAttribute((const void*)hybrid_fwd, hipFuncAttributeMaxDynamicSharedMemorySize, LDS_BYTES) != hipSuccess) { fprintf(stderr, "kernel_launch: hipFuncSetAttribute failed\n"); grid = -1; return; }
        if (hipOccupancyMaxActiveBlocksPerMultiprocessor(&per_cu, (const void*)hybrid_fwd, NTHR, LDS_BYTES) != hipSuccess || per_cu < 1) fprintf(stderr, "kernel_launch: occupancy query reports %d\n", per_cu);
        (void)hipGetLastError();
        grid = cus;
    }
    if (grid < 0) return;
    if (hipMemsetAsync((char*)d_ws + WS_CTL, 0, CTL_ZERO_BYTES, stream) != hipSuccess) return;
    Args a{};
    for (int i = 0; i < 25; ++i) a.in[i] = (const float*)d_in[i];
    a.out = (float*)d_out; a.ws = (unsigned char*)d_ws;
#if ONE_LAUNCH
    a.ph_lo = 0; a.ph_hi = NPHASE;
    hipLaunchKernelGGL(hybrid_fwd, dim3(grid), dim3(NTHR), LDS_BYTES, stream, a);
#else
    for (int p = 0; p < NPHASE; ++p) { a.ph_lo = p; a.ph_hi = p + 1; hipLaunchKernelGGL(hybrid_fwd, dim3(grid), dim3(NTHR), LDS_BYTES, stream, a); }
#endif
}
```

```cpp
#include <hip/hip_runtime.h>
#include <cstdio>
#include <cstdint>

#ifndef ONE_LAUNCH
#define ONE_LAUNCH 1
#endif

#define LAS __attribute__((address_space(3)))
#define GAS __attribute__((address_space(1)))
typedef unsigned short bf16_t;
typedef short bf16x8 __attribute__((ext_vector_type(8)));
typedef float f32x4 __attribute__((ext_vector_type(4)));
typedef float f32x2 __attribute__((ext_vector_type(2)));
typedef float f32x16 __attribute__((ext_vector_type(16)));
typedef unsigned u32x4 __attribute__((ext_vector_type(4)));
typedef unsigned u32x2 __attribute__((ext_vector_type(2)));
typedef __bf16 bf16x2_t __attribute__((ext_vector_type(2)));
typedef short v4i16_t __attribute__((ext_vector_type(4)));

constexpr int DM = 1024, NB = 32, SEQ = 2048, NMETA = 16;
constexpr int M = NB * SEQ;
constexpr int METAROW = M;
constexpr int MTOT = M + 256;
constexpr int NPOS = SEQ + NMETA;
constexpr int DIN_P = 4864;
constexpr int CQKV_LD = 768, CQ_OFF = 384, KR_OFF = 256;
constexpr int QLD = 1536;
constexpr int NEXP = 16384;
constexpr float EPS = 1e-6f;
constexpr float LOG2E = 1.4426950408889634f;
constexpr float QSCALE = 0.10206207261596577f * 1.4426950408889634f;

constexpr size_t A1 = (size_t)MTOT * 1024 * 2;
constexpr size_t WS_CTL = 0, CTL_ZERO_BYTES = 65536;
constexpr size_t WS_WIN = 1u << 20;
constexpr size_t WS_WGATE = WS_WIN + (size_t)DIN_P * 1024 * 2;
constexpr size_t WS_WUQ = WS_WGATE + 2048 * 128 * 2;
constexpr size_t WS_WUKV = WS_WUQ + 1536 * 384 * 2;
constexpr size_t WS_WRNN = WS_WUKV + 2048 * 256 * 2;
constexpr size_t WS_WATT = WS_WRNN + 1024 * 1024 * 2;
constexpr size_t WS_WOUT = WS_WATT + 1024 * 1024 * 2;
constexpr size_t WS_WPQ = WS_WOUT + 1024 * 1024 * 2;
constexpr size_t WS_KEYS = WS_WPQ + 2048 * 1024 * 2;
constexpr size_t WS_PU = WS_KEYS + 256 * 256 * 2;
constexpr size_t WS_PV = WS_PU + (size_t)NEXP * 1024;
constexpr size_t WS_SU = WS_PV + (size_t)NEXP * 1024;
constexpr size_t WS_SV = WS_SU + (size_t)NEXP * 4;
constexpr size_t WS_CTAB = WS_SV + (size_t)NEXP * 4;
constexpr size_t WS_STAB = WS_CTAB + NPOS * 16 * 4;
constexpr size_t WS_CLAM = WS_STAB + NPOS * 16 * 4;
constexpr size_t WS_RSQ = WS_CLAM + 4096;
constexpr size_t WS_RSKV = WS_RSQ + (size_t)MTOT * 4;
constexpr size_t WS_KROPE = WS_RSKV + (size_t)MTOT * 4;
constexpr size_t WS_SCP = WS_KROPE + (size_t)MTOT * 32 * 2;
constexpr size_t WS_SCH = WS_SCP + 512 * 1024 * 4;
constexpr size_t WS_CARRY0 = WS_SCH + 512 * 1024 * 4;
constexpr size_t WS_SLOTS = ((WS_CARRY0 + 4096 + 4095) / 4096) * 4096;
constexpr size_t WS_END = WS_SLOTS + 7 * A1;
#define SLOT(i) (WS_SLOTS + (size_t)(i) * A1)

#define LDS_WAIT() asm volatile("s_waitcnt lgkmcnt(0)" ::: "memory")
#define VM_WAIT() asm volatile("s_waitcnt vmcnt(0)" ::: "memory")
__device__ __forceinline__ unsigned pk2(float lo, float hi) { f32x2 v = {lo, hi}; bf16x2_t b = __builtin_convertvector(v, bf16x2_t); return __builtin_bit_cast(unsigned, b); }
__device__ __forceinline__ float bf_lo(unsigned w) { return __uint_as_float(w << 16); }
__device__ __forceinline__ float bf_hi(unsigned w) { return __uint_as_float(w & 0xffff0000u); }
__device__ __forceinline__ float bf2f(bf16_t h) { return __uint_as_float((unsigned)h << 16); }
__device__ __forceinline__ float ex2(float x) { return __builtin_amdgcn_exp2f(x); }
__device__ __forceinline__ float rcpf_(float x) { return __builtin_amdgcn_rcpf(x); }
__device__ __forceinline__ float sigm(float v) { return rcpf_(1.f + ex2(-LOG2E * v)); }
__device__ __forceinline__ float gelu_t(float v) { const float y = v * (1.f + 0.044715f * v * v); return v * rcpf_(1.f + ex2(-2.302208198f * y)); }
__device__ __forceinline__ float wave_sum(float v) {
#pragma unroll
    for (int o = 1; o < 64; o <<= 1) v += __shfl_xor(v, o);
    return v;
}
__device__ __forceinline__ void unpack8(u32x4 w, float (&o)[8]) { o[0] = bf_lo(w.x); o[1] = bf_hi(w.x); o[2] = bf_lo(w.y); o[3] = bf_hi(w.y); o[4] = bf_lo(w.z); o[5] = bf_hi(w.z); o[6] = bf_lo(w.w); o[7] = bf_hi(w.w); }
__device__ __forceinline__ u32x4 pack8(const float (&o)[8]) { u32x4 w; w.x = pk2(o[0], o[1]); w.y = pk2(o[2], o[3]); w.z = pk2(o[4], o[5]); w.w = pk2(o[6], o[7]); return w; }
__device__ __forceinline__ float dot2bf(unsigned a, unsigned b, float acc) { return __builtin_amdgcn_fdot2_f32_bf16(__builtin_bit_cast(bf16x2_t, a), __builtin_bit_cast(bf16x2_t, b), acc, false); }

typedef float f32x32 __attribute__((ext_vector_type(32)));
typedef unsigned u32x6 __attribute__((ext_vector_type(6)));
typedef __bf16 bf16x32 __attribute__((ext_vector_type(32)));
__device__ __forceinline__ float fp6_probe_val(int i) { return i < 8 ? 0.125f * i : i < 16 ? 1.f + 0.125f * (i - 8) : i < 24 ? 2.f + 0.25f * (i - 16) : 4.f + 0.5f * (i - 24); }
__device__ __forceinline__ int fp6_code(float v) { return v < 1.f ? (int)(v * 8.f + 0.5f) : (int)(__float_as_uint(v) >> 20) - 1016 + 8; }
template <bool BF> __device__ __forceinline__ void fp6_sigma(int (&sig)[32]) {
    f32x16 lo, hi;
#pragma unroll
    for (int i = 0; i < 16; ++i) { lo[i] = fp6_probe_val(i); hi[i] = fp6_probe_val(16 + i); }
    asm volatile("" : "+v"(lo), "+v"(hi));
    const u32x6 p = __builtin_amdgcn_cvt_scalef32_2xpk16_fp6_f32(lo, hi, 1.0f);
    if (BF) { const bf16x32 r = __builtin_amdgcn_cvt_scalef32_pk32_bf16_fp6(p, 1.0f);
#pragma unroll
        for (int j = 0; j < 32; ++j) sig[j] = __builtin_amdgcn_readfirstlane(fp6_code((float)r[j])) & 31;
    } else { const f32x32 r = __builtin_amdgcn_cvt_scalef32_pk32_f32_fp6(p, 1.0f);
#pragma unroll
        for (int j = 0; j < 32; ++j) sig[j] = __builtin_amdgcn_readfirstlane(fp6_code(r[j])) & 31; }
}

namespace pg8 {
constexpr int BM = 256, BK = 64, HALF = 128, HTB = HALF * BK * 2, STAGE_BYTES = 8 * HTB, NXCD = 8, WGM = 8;
__host__ __device__ __forceinline__ int lds_byte(int r, int c) { const int st = (r >> 4) * 2 + (c >> 5), rr = r & 15, cc = c & 31, ob = rr * 64 + cc * 2; return st * 1024 + (ob ^ (((ob >> 9) & 1) << 5)); }
__host__ __device__ __forceinline__ void stage_rc(int b, int& R, int& C) { const int st = b / 1024, sb = b % 1024, swz = sb ^ (((sb >> 9) & 1) << 5); R = (st >> 1) * 16 + swz / 64; C = (st & 1) * 32 + (swz % 64) / 2; }
__host__ __device__ __forceinline__ int perm32(int rho) { const int n = rho >> 4, i = rho & 15; return 8 * (i >> 2) + 4 * n + (i & 3); }

struct Unit { int pm, pn; };
struct Gemm { const bf16_t* A; const bf16_t* Bt; int lda, ldb, K, a_pn_off, b_pn_stride; };

struct Sched {
    int nM, nN, nwg, G, c, xpm, xn, xskip;
    __device__ __forceinline__ void init(int nM_, int nN_, int G_, int c_, int xpm_, int xn_, int xskip_) { nM = nM_; nN = nN_; nwg = nM_ * nN_; G = G_; c = c_; xpm = xpm_; xn = xn_; xskip = xskip_; }
    __device__ __forceinline__ bool next(int i, Unit& u) const {
        const int nmain = nwg > c ? (nwg - c - 1) / G + 1 : 0;
        if (i < nmain) {
            int wgid = i * G + c; { const int q = nwg / NXCD, r = nwg % NXCD, xcd = wgid % NXCD, off = wgid / NXCD; wgid = (xcd < r ? xcd * (q + 1) : r * (q + 1) + (xcd - r) * q) + off; }
            const int nig = WGM * nN, gid = wgid / nig, fm = gid * WGM, gsz = (nM - fm) < WGM ? (nM - fm) : WGM;
            u.pm = fm + ((wgid % nig) % gsz); u.pn = (wgid % nig) / gsz; return true;
        }
        const int e = G - 1 - c;
        if (i == nmain && e < xn) { u.pm = xpm; u.pn = e + (e >= 4 ? xskip : 0); return true; }
        return false;
    }
};

template <class F> struct Epi8 {
    static constexpr bool PERM = true;
    F f;
    __device__ __forceinline__ void operator()(const f32x4 (&acc)[2][2][4][2], const Unit& u, int wr, int wc, int fr, int fq) const {
        const int row0 = u.pm * BM + wr * 64 + fr, col0 = u.pn * BM + wc * 32 + 8 * fq;
#pragma unroll
        for (int ai = 0; ai < 2; ++ai) {
            typename F::Pre pre[4][2];
#pragma unroll
            for (int m = 0; m < 4; ++m)
#pragma unroll
                for (int bj = 0; bj < 2; ++bj) pre[m][bj] = f.load(u.pn, row0 + ai * HALF + m * 16, col0 + bj * HALF);
#pragma unroll
            for (int m = 0; m < 4; ++m)
#pragma unroll
                for (int bj = 0; bj < 2; ++bj) f.apply(pre[m][bj], u.pn, row0 + ai * HALF + m * 16, col0 + bj * HALF, acc[ai][bj][m][0], acc[ai][bj][m][1]);
        }
    }
};
template <class F> struct EpiPair {
    static constexpr bool PERM = true;
    F f;
    __device__ __forceinline__ void operator()(const f32x4 (&acc)[2][2][4][2], const Unit& u, int wr, int wc, int fr, int fq) const {
        const int row0 = u.pm * BM + wr * 64 + fr, col0 = wc * 32 + 8 * fq;
#pragma unroll
        for (int ai = 0; ai < 2; ++ai) {
            typename F::Pre pre[4];
#pragma unroll
            for (int m = 0; m < 4; ++m) pre[m] = f.load(u.pn, row0 + ai * HALF + m * 16, col0);
#pragma unroll
            for (int m = 0; m < 4; ++m) f.apply(pre[m], u.pn, row0 + ai * HALF + m * 16, col0, acc[ai][0][m][0], acc[ai][0][m][1], acc[ai][1][m][0], acc[ai][1][m][1]);
        }
    }
};

template <class Epi>
__device__ __forceinline__ void gemm_phase(LAS unsigned char* lds, const Gemm g, const Sched& S, const Epi& E) {
    int tid_ = threadIdx.x; asm volatile("" : "+v"(tid_));
    const int tid = tid_, wid = __builtin_amdgcn_readfirstlane(tid >> 6), lane = tid & 63, wr = wid >> 2, wc = wid & 3, fr = lane & 15, fq = lane >> 4;
    int nt_ = g.K / BK; asm volatile("" : "+s"(nt_));
    const int nt = nt_;
    unsigned voffA[2], voffB[2];
#pragma unroll
    for (int i = 0; i < 2; ++i) { int R, C; stage_rc(tid * 16 + i * 8192, R, C); const int Rb = Epi::PERM ? ((R & ~31) + perm32(R & 31)) : R;
        voffA[i] = (unsigned)(R * g.lda + C) * 2u; voffB[i] = (unsigned)(Rb * g.ldb + C) * 2u; }
    const size_t kstep = (size_t)(BK * 2);
    const size_t hA = (size_t)HALF * g.lda * 2, hB = (size_t)HALF * g.ldb * 2;
    const unsigned ldsw = (unsigned)wid * 1024u;
    const int aoff = lds_byte(wr * 64 + fr, fq * 8), boff = lds_byte(wc * 32 + fr, fq * 8);
#define PG8_SA(b, h) (((b) * 2 + (h)) * HTB)
#define PG8_SB(b, h) ((4 + (b) * 2 + (h)) * HTB)
#define PG8_STAGE(bufoff, gbase, voff) do { _Pragma("unroll") for (int _i = 0; _i < 2; ++_i) \
        __builtin_amdgcn_global_load_lds((const unsigned*)((const char*)(gbase) + (voff)[_i]), (LAS unsigned*)(lds + (bufoff) + ldsw + _i * 8192), 16, 0, 0); } while (0)
#define PG8_LDA(dst, b, h) do { _Pragma("unroll") for (int m = 0; m < 4; ++m) _Pragma("unroll") for (int k = 0; k < 2; ++k) dst[m][k] = *(const LAS bf16x8*)(lds + PG8_SA(b, h) + aoff + m * 2048 + k * 1024); } while (0)
#define PG8_LDB(dst, b, h) do { _Pragma("unroll") for (int n = 0; n < 2; ++n) _Pragma("unroll") for (int k = 0; k < 2; ++k) dst[n][k] = *(const LAS bf16x8*)(lds + PG8_SB(b, h) + boff + n * 2048 + k * 1024); } while (0)
#define PG8_MMA(ai, bj, At, Bt) do { __builtin_amdgcn_s_setprio(1); _Pragma("unroll") for (int m = 0; m < 4; ++m) _Pragma("unroll") for (int n = 0; n < 2; ++n) _Pragma("unroll") for (int k = 0; k < 2; ++k) \
        acc[ai][bj][m][n] = __builtin_amdgcn_mfma_f32_16x16x32_bf16(Bt[n][k], At[m][k], acc[ai][bj][m][n], 0, 0, 0); __builtin_amdgcn_s_setprio(0); } while (0)
#define PG8_WAIT_V(n) asm volatile("s_waitcnt vmcnt(" #n ")" ::: "memory")
#define PG8_WAIT_L(n) asm volatile("s_waitcnt lgkmcnt(" #n ")" ::: "memory")
#define PG8_BAR __builtin_amdgcn_s_barrier()
#define PG8_SCHED __builtin_amdgcn_sched_barrier(0)
#define PG8_ABASE(u) ((const char*)g.A + ((size_t)(u).pm * BM * g.lda + (size_t)(u).pn * g.a_pn_off) * 2)
#define PG8_BBASE(u) ((const char*)g.Bt + (size_t)(u).pn * g.b_pn_stride * 2)
    Unit cur, nxt; int ui = 0;
    if (!S.next(0, cur)) return;
    f32x4 acc[2][2][4][2];
#pragma unroll
    for (int a = 0; a < 2; ++a)
#pragma unroll
        for (int b = 0; b < 2; ++b)
#pragma unroll
            for (int m = 0; m < 4; ++m)
#pragma unroll
                for (int n = 0; n < 2; ++n) acc[a][b][m][n] = (f32x4){0.f, 0.f, 0.f, 0.f};
    bf16x8 At[4][2], B0[2][2], B1[2][2];
    const char* cA = PG8_ABASE(cur); const char* cB = PG8_BBASE(cur);
    PG8_STAGE(PG8_SB(0, 0), cB, voffB); PG8_STAGE(PG8_SB(0, 1), cB + hB, voffB); PG8_STAGE(PG8_SA(0, 0), cA, voffA); PG8_STAGE(PG8_SA(0, 1), cA + hA, voffA);
    if (wr == 1) PG8_BAR;
    PG8_WAIT_V(2); PG8_BAR;
    PG8_STAGE(PG8_SB(1, 0), cB + kstep, voffB); PG8_STAGE(PG8_SA(1, 0), cA + kstep, voffA); PG8_STAGE(PG8_SB(1, 1), cB + hB + kstep, voffB);
    PG8_WAIT_V(6); PG8_BAR;
    for (;;) {
        const bool has_next = S.next(ui + 1, nxt);
        const char* nA = has_next ? PG8_ABASE(nxt) : cA; const char* nB = has_next ? PG8_BBASE(nxt) : cB;
        asm volatile("" : "+s"(cA), "+s"(cB), "+s"(nA), "+s"(nB));
#pragma unroll 1
        for (int t = 0; t < nt; t += 2) {
            const bool last = (t == nt - 2);
            const char* a1 = cA + (size_t)(t + 1) * kstep;
            const char* a2 = last ? nA : cA + (size_t)(t + 2) * kstep; const char* b2 = last ? nB : cB + (size_t)(t + 2) * kstep;
            const char* a3 = a2 + kstep; const char* b3 = b2 + kstep;
            PG8_LDB(B0, 0, 0); PG8_LDB(B1, 0, 1); PG8_SCHED; PG8_LDA(At, 0, 0); PG8_STAGE(PG8_SA(1, 1), a1 + hA, voffA);
            PG8_WAIT_V(8); PG8_WAIT_L(0); PG8_BAR; PG8_MMA(0, 0, At, B0); PG8_MMA(0, 1, At, B1); PG8_BAR; PG8_SCHED;
            PG8_LDA(At, 0, 1); PG8_STAGE(PG8_SB(0, 0), b2, voffB); PG8_STAGE(PG8_SB(0, 1), b2 + hB, voffB); PG8_STAGE(PG8_SA(0, 0), a2, voffA);
            PG8_WAIT_V(8); PG8_WAIT_L(0); PG8_BAR; PG8_MMA(1, 0, At, B0); PG8_MMA(1, 1, At, B1); PG8_BAR; PG8_SCHED;
            PG8_LDB(B0, 1, 0); PG8_LDB(B1, 1, 1); PG8_SCHED; PG8_LDA(At, 1, 0); PG8_STAGE(PG8_SA(0, 1), a2 + hA, voffA);
            PG8_WAIT_V(8); PG8_WAIT_L(0); PG8_BAR; PG8_MMA(0, 0, At, B0); PG8_MMA(0, 1, At, B1); PG8_BAR; PG8_SCHED;
            PG8_LDA(At, 1, 1); PG8_STAGE(PG8_SB(1, 0), b3, voffB); PG8_STAGE(PG8_SB(1, 1), b3 + hB, voffB); PG8_STAGE(PG8_SA(1, 0), a3, voffA);
            PG8_WAIT_V(8); PG8_WAIT_L(0); PG8_BAR; PG8_MMA(1, 0, At, B0); PG8_MMA(1, 1, At, B1); PG8_BAR; PG8_SCHED;
        }
        if (wr == 0) PG8_BAR;
        E(acc, cur, wr, wc, fr, fq);
        if (!has_next) break;
#pragma unroll
        for (int a = 0; a < 2; ++a)
#pragma unroll
            for (int b = 0; b < 2; ++b)
#pragma unroll
                for (int m = 0; m < 4; ++m)
#pragma unroll
                    for (int n = 0; n < 2; ++n) acc[a][b][m][n] = (f32x4){0.f, 0.f, 0.f, 0.f};
        cur = nxt; cA = nA; cB = nB; ++ui;
        if (wr == 1) PG8_BAR;
    }
    PG8_WAIT_V(0);
    PG8_BAR;
#undef PG8_SA
#undef PG8_SB
#undef PG8_STAGE
#undef PG8_LDA
#undef PG8_LDB
#undef PG8_MMA
#undef PG8_WAIT_V
#undef PG8_WAIT_L
#undef PG8_BAR
#undef PG8_SCHED
#undef PG8_ABASE
#undef PG8_BBASE
}
}

#define XB_TMO      128
#define XB_XCNT(j)  (256  + 64 * (j))
#define XB_XSUB(j)  (1280 + 64 * (j))
#define XB_XGEN(j)  (2304 + 64 * (j))
#define XB_TOP      3328
#define XB_TOPGEN   3392
#define XCD_BAR_WORDS 3456
#define XB_SPIN_CAP (1u << 18)
__device__ __forceinline__ unsigned xb_ld(unsigned* p)              { return __hip_atomic_load(p, __ATOMIC_RELAXED, __HIP_MEMORY_SCOPE_AGENT); }
__device__ __forceinline__ unsigned xb_add(unsigned* p, unsigned v) { return __hip_atomic_fetch_add(p, v, __ATOMIC_RELAXED, __HIP_MEMORY_SCOPE_AGENT); }
__device__ __forceinline__ unsigned xb_xcc_id() { return (unsigned)__builtin_amdgcn_s_getreg((3 << 11) | 20) & 0xFu; }
#define XB_SPIN(cond, bar) do { unsigned _sp = 0; while (cond) { __builtin_amdgcn_s_sleep(1); \
    if ((++_sp & 255u) == 0u) { if (xb_ld(&(bar)[XB_TMO])) break; if (_sp > XB_SPIN_CAP) { atomicAdd(&(bar)[XB_TMO], 1u); break; } } } } while (0)
struct XcdBarrier { unsigned* bar; unsigned x; volatile LAS unsigned* st; };
__device__ __forceinline__ XcdBarrier xcd_barrier_post(unsigned* bar, volatile LAS unsigned* st) {
    XcdBarrier b; b.bar = bar; b.x = xb_xcc_id(); b.st = st;
    if (threadIdx.x == 0) (void)xb_add(&bar[XB_XCNT(b.x)], 1u);
    return b;
}
__device__ __forceinline__ void xcd_barrier_complete(unsigned* bar, unsigned x, unsigned& nloc, unsigned& nx) {
    const unsigned G = gridDim.x * gridDim.y * gridDim.z;
    unsigned sum, cnt, mine, sp = 0u;
    for (;;) {
        sum = 0u; cnt = 0u; mine = 0u;
#pragma unroll
        for (unsigned j = 0; j < 16; ++j) { const unsigned c = xb_ld(&bar[XB_XCNT(j)]); sum += c; cnt += (c > 0u) ? 1u : 0u; mine = (j == x) ? c : mine; }
        if (sum == G) break;
        __builtin_amdgcn_s_sleep(1);
        if ((++sp & 255u) == 0u) { if (xb_ld(&bar[XB_TMO])) break; if (sp > XB_SPIN_CAP) { atomicAdd(&bar[XB_TMO], 1u); break; } }
    }
    nloc = mine > 0u ? mine : 1u; nx = cnt > 0u ? cnt : 1u;
}
__device__ __forceinline__ void xcd_barrier(const XcdBarrier& b) {
    asm volatile("s_waitcnt vmcnt(0)" ::: "memory");
    __syncthreads();
    if (threadIdx.x == 0) {
        unsigned* bar = b.bar;
        __builtin_amdgcn_s_waitcnt(0);
        unsigned nloc = b.st[0], nx = b.st[1];
        if (nloc == 0u) { xcd_barrier_complete(bar, b.x, nloc, nx); b.st[0] = nloc; b.st[1] = nx; }
        const unsigned old = xb_add(&bar[XB_XSUB(b.x)], 1u);
        const unsigned gen = old / nloc;
        if (old + 1u == (gen + 1u) * nloc) {
            __builtin_amdgcn_fence(__ATOMIC_RELEASE, "agent");
            asm volatile("s_waitcnt vmcnt(0)" ::: "memory");
            const unsigned og = xb_add(&bar[XB_TOP], 1u);
            const unsigned tg = og / nx;
            if (og + 1u == (tg + 1u) * nx) xb_add(&bar[XB_TOPGEN], 1u);
            else XB_SPIN(xb_ld(&bar[XB_TOPGEN]) == tg, bar);
            __builtin_amdgcn_fence(__ATOMIC_ACQUIRE, "agent");
            xb_add(&bar[XB_XGEN(b.x)], 1u);
            asm volatile("s_waitcnt vmcnt(0)" ::: "memory");
        } else {
            XB_SPIN(xb_ld(&bar[XB_XGEN(b.x)]) == gen, bar);
            __builtin_amdgcn_fence(__ATOMIC_ACQUIRE, "agent");
            asm volatile("s_waitcnt vmcnt(0)" ::: "memory");
        }
    }
    __syncthreads();
}

constexpr int NWAVES = 8, NTHR = 512;
constexpr int RING_BYTES = 131072, MISC_OFF = RING_BYTES + 320, LDS_BYTES = 147456;
struct Args { const float* in[25]; float* out; unsigned char* ws; int ph_lo, ph_hi; };
static_assert(sizeof(Args) == 25 * 8 + 8 + 8 + 8, "Args has no padding");

struct Ctx {
    LAS unsigned char* lds; int tid, lane, wave, G, gw, NGW;
    unsigned char* ws; float* out; const float* const* in;
};

__device__ __forceinline__ void store8(bf16_t* p, f32x4 a, f32x4 b) { u32x4 w; w.x = pk2(a[0], a[1]); w.y = pk2(a[2], a[3]); w.z = pk2(b[0], b[1]); w.w = pk2(b[2], b[3]); *(u32x4*)p = w; }
struct NoPre {};
struct FInproj {
    typedef NoPre Pre;
    bf16_t *XR, *GR, *CQKV, *GRNN, *GATT;
    __device__ __forceinline__ Pre load(int, int, int) const { return Pre(); }
    __device__ __forceinline__ void apply(const Pre&, int pn, int row, int col, f32x4 a, f32x4 b) const {
        if (pn < 4) { store8(XR + (size_t)row * 1024 + col, a, b); }
        else if (pn < 8) {
#pragma unroll
            for (int i = 0; i < 4; ++i) { a[i] = gelu_t(a[i]); b[i] = gelu_t(b[i]); }
            store8(GR + (size_t)row * 1024 + (col - 1024), a, b); }
        else if (pn < 11) { store8(CQKV + (size_t)row * CQKV_LD + (col - 2048), a, b); }
        else {
#pragma unroll
            for (int i = 0; i < 4; ++i) { a[i] = sigm(a[i]); b[i] = sigm(b[i]); }
            if (pn < 15) store8(GRNN + (size_t)row * 1024 + (col - 2816), a, b); else store8(GATT + (size_t)row * 1024 + (col - 3840), a, b); }
    }
};
struct FGate {
    struct Pre { u32x4 xc; };
    const bf16_t* XC; const float *ba, *bx, *clam; bf16_t *LA, *UU;
    __device__ __forceinline__ Pre load(int pn, int row, int cl) const { Pre p; p.xc = *(const u32x4*)(XC + (size_t)row * 1024 + pn * 128 + cl); return p; }
    __device__ __forceinline__ void apply(const Pre& pr, int pn, int row, int cl, f32x4 a0, f32x4 a1, f32x4 x0, f32x4 x1) const {
        const int ch = pn * 128 + cl; const size_t off = (size_t)row * 1024 + ch;
        float xc[8]; unpack8(pr.xc, xc);
        const f32x4 ba0 = *(const f32x4*)(ba + ch), ba1 = *(const f32x4*)(ba + ch + 4), bx0 = *(const f32x4*)(bx + ch), bx1 = *(const f32x4*)(bx + ch + 4), cl0 = *(const f32x4*)(clam + ch), cl1 = *(const f32x4*)(clam + ch + 4);
        float la[8], uu[8];
#pragma unroll
        for (int i = 0; i < 8; ++i) {
            const float ga = (i < 4 ? a0[i & 3] + ba0[i & 3] : a1[i & 3] + ba1[i & 3]), gx = (i < 4 ? x0[i & 3] + bx0[i & 3] : x1[i & 3] + bx1[i & 3]), cc = (i < 4 ? cl0[i & 3] : cl1[i & 3]);
            const float r = sigm(ga), ig = sigm(gx), l = r * cc;
            la[i] = l; uu[i] = sqrtf(fmaxf(1.f - ex2(2.f * LOG2E * l), 0.f)) * (ig * xc[i]);
        }
        *(u32x4*)(LA + off) = pack8(la); *(u32x4*)(UU + off) = pack8(uu);
    }
};
struct FQ {
    struct Pre { float sc; };
    const float* rsq; bf16_t* Q;
    __device__ __forceinline__ Pre load(int, int row, int) const { Pre p; p.sc = rsq[row]; return p; }
    __device__ __forceinline__ void apply(const Pre& pr, int pn, int row, int col, f32x4 a, f32x4 b) const {
        const float sc = pr.sc * QSCALE; a = a * sc; b = b * sc;
        store8(Q + (size_t)row * QLD + col, a, b);
    }
};
struct FKV {
    struct Pre { float sc; };
    const float* rskv; bf16_t *KN, *V;
    __device__ __forceinline__ Pre load(int, int row, int) const { Pre p; p.sc = rskv[row]; return p; }
    __device__ __forceinline__ void apply(const Pre& pr, int pn, int row, int col, f32x4 a, f32x4 b) const {
        const float sc = pr.sc; a = a * sc; b = b * sc;
        if (pn < 4) store8(KN + (size_t)row * 1024 + col, a, b); else store8(V + (size_t)row * 1024 + (col - 1024), a, b);
    }
};
template <bool HAS_ADD> struct FMul {
    struct Pre { u32x4 g, ad; };
    const bf16_t* Gt; const bf16_t* ADD; bf16_t* O;
    __device__ __forceinline__ Pre load(int, int row, int col) const { const size_t off = (size_t)row * 1024 + col; Pre p; p.g = *(const u32x4*)(Gt + off); if (HAS_ADD) p.ad = *(const u32x4*)(ADD + off); else p.ad = (u32x4){0u, 0u, 0u, 0u}; return p; }
    __device__ __forceinline__ void apply(const Pre& pr, int pn, int row, int col, f32x4 a, f32x4 b) const {
        const size_t off = (size_t)row * 1024 + col; float gg[8]; unpack8(pr.g, gg);
        if (HAS_ADD) { float ad[8]; unpack8(pr.ad, ad);
#pragma unroll
            for (int i = 0; i < 4; ++i) { a[i] = ad[i] + gg[i] * a[i]; b[i] = ad[4 + i] + gg[4 + i] * b[i]; } }
        else {
#pragma unroll
            for (int i = 0; i < 4; ++i) { a[i] = gg[i] * a[i]; b[i] = gg[4 + i] * b[i]; } }
        store8(O + off, a, b);
    }
};
struct FRes {
    struct Pre { f32x4 x0, x1; };
    const float* X; bf16_t* H1B;
    __device__ __forceinline__ Pre load(int, int row, int col) const { const size_t off = (size_t)row * 1024 + col; Pre p; p.x0 = *(const f32x4*)(X + off); p.x1 = *(const f32x4*)(X + off + 4); return p; }
    __device__ __forceinline__ void apply(const Pre& pr, int pn, int row, int col, f32x4 a, f32x4 b) const {
        store8(H1B + (size_t)row * 1024 + col, a + pr.x0, b + pr.x1);
    }
};
typedef _Float16 f16x8 __attribute__((ext_vector_type(8)));
struct FF16 { typedef NoPre Pre; _Float16* O; int ldc;
    __device__ __forceinline__ Pre load(int, int, int) const { return Pre(); }
    __device__ __forceinline__ void apply(const Pre&, int pn, int row, int col, f32x4 a, f32x4 b) const {
        f16x8 h = {(_Float16)a[0], (_Float16)a[1], (_Float16)a[2], (_Float16)a[3], (_Float16)b[0], (_Float16)b[1], (_Float16)b[2], (_Float16)b[3]};
        *(f16x8*)(O + (size_t)row * ldc + col) = h; } };
struct FF32 { typedef NoPre Pre; float* O; int ldc;
    __device__ __forceinline__ Pre load(int, int, int) const { return Pre(); }
    __device__ __forceinline__ void apply(const Pre&, int pn, int row, int col, f32x4 a, f32x4 b) const { float* p = O + (size_t)row * ldc + col; *(f32x4*)p = a; *(f32x4*)(p + 4) = b; } };

struct MapId { __device__ __forceinline__ int operator()(int n) const { return n; } };
struct MapWin { __device__ __forceinline__ int operator()(int n) const {
    if (n < 2048) return n;
    if (n < 2816) { const int c = n - 2048; if (c < 256) return 2432 + c; if (c < 288) return 2688 + (c - 256); if (c < 384) return -1; return 2048 + (c - 384); }
    if (n < 3840) return 2720 + (n - 2816);
    return 3744 + (n - 3840); } };
struct MapUq { __device__ __forceinline__ int operator()(int n) const { const int h = n / 96, w = n % 96; if (w < 64) return n; const int t = w - 64; return h * 96 + 64 + (t >> 1) + 16 * (t & 1); } };
struct MapUkv { __device__ __forceinline__ int operator()(int n) const { if (n < 1024) return (n >> 6) * 128 + (n & 63); const int m = n - 1024; return (m >> 6) * 128 + 64 + (m & 63); } };

template <class Map> __device__ __forceinline__ void transpose_item(const float* W, int ldw, int Ndst, bf16_t* WT, int ldt, const float* kscale, LAS float* scr, int item, int lane, Map map) {
    const int nblk = Ndst / 32, kb = item / nblk, nb = item % nblk, k0 = 64 * kb, n0 = 32 * nb;
    const int src = map(n0 + (lane & 31));
#pragma unroll 8
    for (int i = 0; i < 32; ++i) { const int kk = 2 * i + (lane >> 5); float v = 0.f; if (src >= 0) { v = W[(size_t)(k0 + kk) * ldw + src]; if (kscale) v *= kscale[k0 + kk]; } scr[kk * 33 + (lane & 31)] = v; }
    LDS_WAIT(); asm volatile("" ::: "memory");
    const int c = lane & 7;
#pragma unroll
    for (int j = 0; j < 4; ++j) { const int n = (lane >> 3) + 8 * j; const LAS float* s = scr + (8 * c) * 33 + n;
        u32x4 o; o.x = pk2(s[0 * 33], s[1 * 33]); o.y = pk2(s[2 * 33], s[3 * 33]); o.z = pk2(s[4 * 33], s[5 * 33]); o.w = pk2(s[6 * 33], s[7 * 33]);
        *(u32x4*)(WT + (size_t)(n0 + n) * ldt + k0 + 8 * c) = o; }
    LDS_WAIT(); asm volatile("" ::: "memory");
}
__device__ __forceinline__ void rms_row_bf16(const float* xrow, const float* g, bf16_t* orow, int lane) {
    const f32x4* xr = (const f32x4*)xrow + lane; f32x4 v[4]; float s = 0.f;
#pragma unroll
    for (int j = 0; j < 4; ++j) { v[j] = xr[64 * j]; s += (v[j][0] * v[j][0] + v[j][1] * v[j][1]) + (v[j][2] * v[j][2] + v[j][3] * v[j][3]); }
    const float rstd = 1.f / sqrtf(wave_sum(s) * (1.f / 1024.f) + EPS);
    u32x2* o8 = (u32x2*)orow + lane;
#pragma unroll
    for (int j = 0; j < 4; ++j) { const f32x4 gg = ((const f32x4*)g)[lane + 64 * j]; u32x2 w; w.x = pk2(v[j][0] * rstd * gg[0], v[j][1] * rstd * gg[1]); w.y = pk2(v[j][2] * rstd * gg[2], v[j][3] * rstd * gg[3]); o8[64 * j] = w; }
}
__device__ __forceinline__ void rms_row_f32(const float* xrow, const float* g, float* orow, int lane) {
    const f32x4* xr = (const f32x4*)xrow + lane; f32x4 v[4]; float s = 0.f;
#pragma unroll
    for (int j = 0; j < 4; ++j) { v[j] = xr[64 * j]; s += (v[j][0] * v[j][0] + v[j][1] * v[j][1]) + (v[j][2] * v[j][2] + v[j][3] * v[j][3]); }
    const float rstd = 1.f / sqrtf(wave_sum(s) * (1.f / 1024.f) + EPS);
#pragma unroll
    for (int j = 0; j < 4; ++j) { const f32x4 gg = ((const f32x4*)g)[lane + 64 * j]; ((f32x4*)orow)[lane + 64 * j] = v[j] * rstd * gg; }
}

__device__ __forceinline__ void phase_prologue(const Ctx& C) {
    unsigned char* ws = C.ws; const float* const* in = C.in;
    LAS float* scr = (LAS float*)(C.lds + C.wave * 16384);
    const int gw = C.gw, NGW = C.NGW, lane = C.lane;
    constexpr int I_WIN = 16 * (DIN_P / 32), I_UQ = 6 * (1536 / 32), I_UKV = 4 * (2048 / 32), I_SQ = 16 * 32, I_G = 2 * 4;
    constexpr int NITEMS = I_WIN + I_UQ + I_UKV + 3 * I_SQ + 16 * I_G;
    for (int it = gw; it < NITEMS; it += NGW) {
        int r = it;
        if (r < I_WIN) { transpose_item(in[3], 4768, DIN_P, (bf16_t*)(ws + WS_WIN), 1024, nullptr, scr, r, lane, MapWin()); continue; } r -= I_WIN;
        if (r < I_UQ) { transpose_item(in[13], 1536, 1536, (bf16_t*)(ws + WS_WUQ), 384, in[12], scr, r, lane, MapUq()); continue; } r -= I_UQ;
        if (r < I_UKV) { transpose_item(in[15], 2048, 2048, (bf16_t*)(ws + WS_WUKV), 256, in[14], scr, r, lane, MapUkv()); continue; } r -= I_UKV;
        if (r < I_SQ) { transpose_item(in[11], 1024, 1024, (bf16_t*)(ws + WS_WRNN), 1024, nullptr, scr, r, lane, MapId()); continue; } r -= I_SQ;
        if (r < I_SQ) { transpose_item(in[16], 1024, 1024, (bf16_t*)(ws + WS_WATT), 1024, nullptr, scr, r, lane, MapId()); continue; } r -= I_SQ;
        if (r < I_SQ) { transpose_item(in[17], 1024, 1024, (bf16_t*)(ws + WS_WOUT), 1024, nullptr, scr, r, lane, MapId()); continue; } r -= I_SQ;
        { const int mat = r / I_G, sub = r % I_G, blk = mat >> 1, which = mat & 1;
          transpose_item((which ? in[8] : in[6]) + (size_t)blk * 16384, 128, 128, (bf16_t*)(ws + WS_WGATE) + (size_t)(blk * 256 + which * 128) * 128, 128, nullptr, scr, sub, lane, MapId()); }
    }
    const int gt = blockIdx.x * NTHR + C.tid, NT = C.G * NTHR;
    for (int it = blockIdx.x; it < 256; it += C.G) {
        const int hh = it >> 4, kc = it & 15, half = hh & 1, k = kc * 64 + lane, c0 = 16 * C.wave;
        const f32x4* keys = (const f32x4*)((half ? in[21] : in[20]) + (size_t)c0 * 128);
        LAS f32x4* ks = (LAS f32x4*)scr;
#pragma unroll
        for (int j = 0; j < 8; ++j) ks[j * 64 + lane] = keys[j * 64 + lane];
        const f32x4* wq = (const f32x4*)(in[19] + (size_t)k * 2048 + hh * 128); const float g2k = in[18][k];
        f32x4 a[32];
#pragma unroll
        for (int d4 = 0; d4 < 32; ++d4) a[d4] = wq[d4];
        LDS_WAIT(); asm volatile("" ::: "memory");
        bf16_t* o = (bf16_t*)(ws + WS_WPQ) + (size_t)(hh * 128 + c0) * 1024 + k;
#pragma unroll 4
        for (int c = 0; c < 16; ++c) { float s0 = 0.f, s1 = 0.f;
#pragma unroll
            for (int d4 = 0; d4 < 32; d4 += 2) { const f32x4 k0 = ks[c * 32 + d4], k1 = ks[c * 32 + d4 + 1]; s0 += (a[d4][0] * k0[0] + a[d4][1] * k0[1]) + (a[d4][2] * k0[2] + a[d4][3] * k0[3]); s1 += (a[d4 + 1][0] * k1[0] + a[d4 + 1][1] * k1[1]) + (a[d4 + 1][2] * k1[2] + a[d4 + 1][3] * k1[3]); }
            o[(size_t)c * 1024] = (bf16_t)(pk2((s0 + s1) * g2k, 0.f) & 0xffffu); }
        LDS_WAIT(); asm volatile("" ::: "memory");
    }
    for (int i = gt; i < NPOS * 16; i += NT) { const int pos = i >> 4, j = i & 15; const float inv = exp2f(-(float)j * (13.287712379549449f / 16.f)); const float ang = (float)pos * inv;
        float t = ang * 0.15915494309189535f; t = t - floorf(t);
        ((float*)(ws + WS_CTAB))[i] = __builtin_amdgcn_cosf(t); ((float*)(ws + WS_STAB))[i] = __builtin_amdgcn_sinf(t); }
    for (int i = gt; i < 1024; i += NT) { const float lam = in[10][i]; ((float*)(ws + WS_CLAM))[i] = -8.f * log1pf(expf(-lam)); }
    {
        f32x4 g2n[4];
#pragma unroll
        for (int j = 0; j < 4; ++j) g2n[j] = ((const f32x4*)(in[18] + 16 * lane))[j];
        for (int e = gw; e < NEXP; e += NGW) {
            f32x4 v[4]; float am = 0.f;
#pragma unroll
            for (int j = 0; j < 4; ++j) { v[j] = ((const f32x4*)(in[22] + (size_t)e * 1024 + 16 * lane))[j] * g2n[j]; am = fmaxf(am, fmaxf(fmaxf(fabsf(v[j][0]), fabsf(v[j][1])), fmaxf(fabsf(v[j][2]), fabsf(v[j][3])))); }
#pragma unroll
            for (int o = 1; o < 64; o <<= 1) am = fmaxf(am, __shfl_xor(am, o));
            const float scale = am > 0.f ? am * (1.f / 127.f) : 1.f, inv = 1.f / scale;
            u32x4 w;
#pragma unroll
            for (int j = 0; j < 4; ++j) { const int q0 = (int)rintf(v[j][0] * inv), q1 = (int)rintf(v[j][1] * inv), q2 = (int)rintf(v[j][2] * inv), q3 = (int)rintf(v[j][3] * inv);
                w[j] = (unsigned)(q0 & 255) | ((unsigned)(q1 & 255) << 8) | ((unsigned)(q2 & 255) << 16) | ((unsigned)q3 << 24); }
            *(u32x4*)(ws + WS_PU + (size_t)e * 1024 + 16 * lane) = w;
            if (lane == 0) ((float*)(ws + WS_SU))[e] = scale;
        }
    }
    for (int e = gw; e < NEXP; e += NGW) {
        f32x4 v[4]; float am = 0.f;
#pragma unroll
        for (int j = 0; j < 4; ++j) { v[j] = ((const f32x4*)(in[23] + (size_t)e * 1024 + 16 * lane))[j]; am = fmaxf(am, fmaxf(fmaxf(fabsf(v[j][0]), fabsf(v[j][1])), fmaxf(fabsf(v[j][2]), fabsf(v[j][3])))); }
#pragma unroll
        for (int o = 1; o < 64; o <<= 1) am = fmaxf(am, __shfl_xor(am, o));
        const float scale = am > 0.f ? am * (1.f / 6.f) : 1.f, inv = 1.f / scale;
        u32x2 w;
#pragma unroll
        for (int d = 0; d < 2; ++d) { unsigned p = 0u;
            p = __builtin_amdgcn_cvt_scalef32_pk_fp4_f32(p, v[2 * d][0] * inv, v[2 * d][1] * inv, 1.0f, 0); p = __builtin_amdgcn_cvt_scalef32_pk_fp4_f32(p, v[2 * d][2] * inv, v[2 * d][3] * inv, 1.0f, 1);
            p = __builtin_amdgcn_cvt_scalef32_pk_fp4_f32(p, v[2 * d + 1][0] * inv, v[2 * d + 1][1] * inv, 1.0f, 2); p = __builtin_amdgcn_cvt_scalef32_pk_fp4_f32(p, v[2 * d + 1][2] * inv, v[2 * d + 1][3] * inv, 1.0f, 3);
            w[d] = p; }
        *(u32x2*)(ws + WS_PV + (size_t)e * 512 + 8 * lane) = w;
        if (lane == 0) ((float*)(ws + WS_SV))[e] = scale;
    }
    bf16_t* N1 = (bf16_t*)(ws + SLOT(0));
    {
        f32x4 gg[4];
#pragma unroll
        for (int j = 0; j < 4; ++j) gg[j] = ((const f32x4*)in[2])[lane + 64 * j];
        int m = gw; f32x4 nv[4];
        if (m < M) {
#pragma unroll
            for (int j = 0; j < 4; ++j) nv[j] = ((const f32x4*)(in[0] + (size_t)m * 1024))[lane + 64 * j]; }
        for (; m < M; m += NGW) {
            f32x4 v[4]; float sq = 0.f;
#pragma unroll
            for (int j = 0; j < 4; ++j) { v[j] = nv[j]; sq += (v[j][0] * v[j][0] + v[j][1] * v[j][1]) + (v[j][2] * v[j][2] + v[j][3] * v[j][3]); }
            if (m + NGW < M) {
#pragma unroll
                for (int j = 0; j < 4; ++j) nv[j] = ((const f32x4*)(in[0] + (size_t)(m + NGW) * 1024))[lane + 64 * j]; }
            const float rstd = 1.f / sqrtf(wave_sum(sq) * (1.f / 1024.f) + EPS);
            u32x2* o8 = (u32x2*)(N1 + (size_t)m * 1024) + lane;
#pragma unroll
            for (int j = 0; j < 4; ++j) { u32x2 w; w.x = pk2(v[j][0] * rstd * gg[j][0], v[j][1] * rstd * gg[j][1]); w.y = pk2(v[j][2] * rstd * gg[j][2], v[j][3] * rstd * gg[j][3]); o8[64 * j] = w; }
        }
    }
    for (int m = gw; m < 256; m += NGW) {
        if (m < NMETA) rms_row_bf16(in[1] + (size_t)m * 1024, in[2], N1 + (size_t)(METAROW + m) * 1024, lane);
        else { u32x4* o = (u32x4*)(N1 + (size_t)(METAROW + m) * 1024); o[lane] = (u32x4){0u, 0u, 0u, 0u}; o[64 + lane] = (u32x4){0u, 0u, 0u, 0u}; }
    }
}

__device__ __forceinline__ int prev_row(int r, int j) {
    if (r < M) { const int s = r & (SEQ - 1); return s >= j ? r - j : METAROW + NMETA + (s - j); }
    const int p = r - METAROW; return p >= j ? r - j : -1;
}
struct ThinRow { u32x4 xa, xb, cq, ckv; unsigned k1, k2; };
__device__ __forceinline__ ThinRow thin_load(const bf16_t* XR, const bf16_t* CQKV, int r, int lane) {
    ThinRow d; const bf16_t* z = CQKV + (size_t)r * CQKV_LD;
    d.xa = *(const u32x4*)(XR + (size_t)r * 1024 + lane * 8); d.xb = *(const u32x4*)(XR + (size_t)r * 1024 + 512 + lane * 8);
    d.cq = *(const u32x4*)(z + CQ_OFF + (lane < 48 ? lane : 0) * 8); d.ckv = *(const u32x4*)(z + (lane & 31) * 8);
    d.k1 = z[KR_OFF + (lane & 15)]; d.k2 = z[KR_OFF + 16 + (lane & 15)];
    return d;
}
__device__ __forceinline__ void thin_row_stats(unsigned char* ws, const ThinRow& d, int r, int lane) {
    float* RSQ = (float*)(ws + WS_RSQ); float* RSKV = (float*)(ws + WS_RSKV); bf16_t* KROPE = (bf16_t*)(ws + WS_KROPE);
    float sq = 0.f, skv = 0.f;
    { float v[8]; unpack8(d.cq, v); float a = 0.f;
#pragma unroll
      for (int i = 0; i < 8; ++i) a += v[i] * v[i];
      sq = lane < 48 ? a : 0.f; }
    { float v[8]; unpack8(d.ckv, v); float a = 0.f;
#pragma unroll
      for (int i = 0; i < 8; ++i) a += v[i] * v[i];
      skv = lane < 32 ? a : 0.f; }
    sq = wave_sum(sq); skv = wave_sum(skv);
    if (lane == 0) { RSQ[r] = 1.f / sqrtf(sq * (1.f / 384.f) + EPS); RSKV[r] = 1.f / sqrtf(skv * (1.f / 256.f) + EPS); }
    if (lane < 16) { const int pos = r < M ? NMETA + (r & (SEQ - 1)) : r - METAROW; const float x1 = bf2f((bf16_t)d.k1), x2 = bf2f((bf16_t)d.k2);
        const float c = ((const float*)(ws + WS_CTAB))[pos * 16 + lane], s = ((const float*)(ws + WS_STAB))[pos * 16 + lane];
        ((unsigned*)(KROPE + (size_t)r * 32))[lane] = pk2(x1 * c - x2 * s, x1 * s + x2 * c); }
}
__device__ __forceinline__ void phase_thin(const Ctx& C) {
    unsigned char* ws = C.ws; const float* const* in = C.in; const int lane = C.lane;
    const bf16_t* XR = (const bf16_t*)(ws + SLOT(1)); const bf16_t* CQKV = (const bf16_t*)(ws + SLOT(3)); bf16_t* XC = (bf16_t*)(ws + SLOT(0));
    const float* cw = in[4]; const float* cb = in[5];
    float w[4][16], bias[16];
#pragma unroll
    for (int hh = 0; hh < 2; ++hh)
#pragma unroll
        for (int i = 0; i < 8; ++i) { const int ch = hh * 512 + lane * 8 + i; bias[hh * 8 + i] = cb[ch];
#pragma unroll
            for (int t = 0; t < 4; ++t) w[t][hh * 8 + i] = cw[t * 1024 + ch]; }
    for (int st = C.gw; st < M / 32 + 1; st += C.NGW) {
        const bool meta = st == M / 32; const int r0 = meta ? METAROW : st * 32, nrow = meta ? NMETA : 32;
        float x1[16], x2[16], x3[16];
        const bool first = meta || (r0 & (SEQ - 1)) == 0;
        ThinRow nx = thin_load(XR, CQKV, r0, lane);
#pragma unroll
        for (int j = 1; j <= 3; ++j) { const int pr = first ? (meta ? -1 : METAROW + NMETA - j) : r0 - j;
#pragma unroll
            for (int hh = 0; hh < 2; ++hh) { float v[8];
                if (pr >= 0) unpack8(*(const u32x4*)(XR + (size_t)pr * 1024 + hh * 512 + lane * 8), v); else {
#pragma unroll
                    for (int i = 0; i < 8; ++i) v[i] = 0.f; }
#pragma unroll
                for (int i = 0; i < 8; ++i) { if (j == 1) x1[hh * 8 + i] = v[i]; else if (j == 2) x2[hh * 8 + i] = v[i]; else x3[hh * 8 + i] = v[i]; } } }
        for (int t = 0; t < nrow; ++t) { const int r = r0 + t; float x0[16];
            const ThinRow d = nx;
            if (t + 1 < nrow) nx = thin_load(XR, CQKV, r + 1, lane);
            { float v[8]; unpack8(d.xa, v);
#pragma unroll
              for (int i = 0; i < 8; ++i) x0[i] = v[i];
              unpack8(d.xb, v);
#pragma unroll
              for (int i = 0; i < 8; ++i) x0[8 + i] = v[i]; }
#pragma unroll
            for (int hh = 0; hh < 2; ++hh) { float y[8];
#pragma unroll
                for (int i = 0; i < 8; ++i) { const int q = hh * 8 + i; y[i] = bias[q] + w[3][q] * x0[q] + w[2][q] * x1[q] + w[1][q] * x2[q] + w[0][q] * x3[q]; }
                *(u32x4*)(XC + (size_t)r * 1024 + hh * 512 + lane * 8) = pack8(y); }
#pragma unroll
            for (int q = 0; q < 16; ++q) { x3[q] = x2[q]; x2[q] = x1[q]; x1[q] = x0[q]; }
            thin_row_stats(ws, d, r, lane);
        }
    }
    float* RSQ = (float*)(ws + WS_RSQ); float* RSKV = (float*)(ws + WS_RSKV); bf16_t* KROPE = (bf16_t*)(ws + WS_KROPE);
    for (int r = M + NMETA + C.gw; r < MTOT; r += C.NGW) {
        u32x4* o = (u32x4*)(XC + (size_t)r * 1024); o[lane] = (u32x4){0u, 0u, 0u, 0u}; o[64 + lane] = (u32x4){0u, 0u, 0u, 0u};
        if (lane == 0) { RSQ[r] = 0.f; RSKV[r] = 0.f; }
        if (lane < 16) ((unsigned*)(KROPE + (size_t)r * 32))[lane] = 0u;
    }
}

__device__ __forceinline__ void phase_scan1(const Ctx& C) {
    unsigned char* ws = C.ws; const int lane = C.lane;
    const bf16_t* LA = (const bf16_t*)(ws + SLOT(1)); const bf16_t* UU = (const bf16_t*)(ws + SLOT(6));
    float* SCP = (float*)(ws + WS_SCP); float* SCH = (float*)(ws + WS_SCH); float* CARRY0 = (float*)(ws + WS_CARRY0);
    for (int it = C.gw; it < 2048 + 4; it += C.NGW) {
        const bool meta = it >= 2048; const int q = it & 3, bc = it >> 2, ch = q * 256 + lane * 4;
        const int row0 = meta ? METAROW : bc * 128, nrow = meta ? NMETA : 128;
        float P[4] = {1.f, 1.f, 1.f, 1.f}, H[4] = {0.f, 0.f, 0.f, 0.f};
#pragma unroll 8
        for (int t = 0; t < nrow; ++t) { const u32x2 l2 = *(const u32x2*)(LA + (size_t)(row0 + t) * 1024 + ch), u2 = *(const u32x2*)(UU + (size_t)(row0 + t) * 1024 + ch);
            const float a0 = ex2(LOG2E * bf_lo(l2.x)), a1 = ex2(LOG2E * bf_hi(l2.x)), a2 = ex2(LOG2E * bf_lo(l2.y)), a3 = ex2(LOG2E * bf_hi(l2.y));
            P[0] *= a0; P[1] *= a1; P[2] *= a2; P[3] *= a3;
            H[0] = a0 * H[0] + bf_lo(u2.x); H[1] = a1 * H[1] + bf_hi(u2.x); H[2] = a2 * H[2] + bf_lo(u2.y); H[3] = a3 * H[3] + bf_hi(u2.y); }
        if (meta) *(f32x4*)(CARRY0 + ch) = (f32x4){H[0], H[1], H[2], H[3]};
        else { *(f32x4*)(SCP + (size_t)bc * 1024 + ch) = (f32x4){P[0], P[1], P[2], P[3]}; *(f32x4*)(SCH + (size_t)bc * 1024 + ch) = (f32x4){H[0], H[1], H[2], H[3]}; }
    }
}
__device__ __forceinline__ void phase_scan2(const Ctx& C) {
    unsigned char* ws = C.ws; const int lane = C.lane;
    const bf16_t* LA = (const bf16_t*)(ws + SLOT(1)); const bf16_t* UU = (const bf16_t*)(ws + SLOT(6)); const bf16_t* GR = (const bf16_t*)(ws + SLOT(2)); bf16_t* HRG = (bf16_t*)(ws + SLOT(0));
    const float* SCP = (const float*)(ws + WS_SCP); const float* SCH = (const float*)(ws + WS_SCH); const float* CARRY0 = (const float*)(ws + WS_CARRY0);
    for (int it = C.gw; it < 2048; it += C.NGW) {
        const int q = it & 3, bc = it >> 2, b = bc >> 4, c = bc & 15, ch = q * 256 + lane * 4;
        f32x4 h = *(const f32x4*)(CARRY0 + ch);
        for (int cc = 0; cc < c; ++cc) { const f32x4 p = *(const f32x4*)(SCP + (size_t)(b * 16 + cc) * 1024 + ch), e = *(const f32x4*)(SCH + (size_t)(b * 16 + cc) * 1024 + ch); h = p * h + e; }
        float H[4] = {h[0], h[1], h[2], h[3]};
        const int row0 = bc * 128;
#pragma unroll 8
        for (int t = 0; t < 128; ++t) { const size_t off = (size_t)(row0 + t) * 1024 + ch; const u32x2 l2 = *(const u32x2*)(LA + off), u2 = *(const u32x2*)(UU + off), g2 = *(const u32x2*)(GR + off);
            H[0] = ex2(LOG2E * bf_lo(l2.x)) * H[0] + bf_lo(u2.x); H[1] = ex2(LOG2E * bf_hi(l2.x)) * H[1] + bf_hi(u2.x); H[2] = ex2(LOG2E * bf_lo(l2.y)) * H[2] + bf_lo(u2.y); H[3] = ex2(LOG2E * bf_hi(l2.y)) * H[3] + bf_hi(u2.y);
            u32x2 o; o.x = pk2(H[0] * bf_lo(g2.x), H[1] * bf_hi(g2.x)); o.y = pk2(H[2] * bf_lo(g2.y), H[3] * bf_hi(g2.y)); *(u32x2*)(HRG + off) = o; }
    }
}

constexpr int AT_KSLOT = 12 * 1024, AT_VSLOT = 8192;
#define AT_K(j) (((j) & 3) * AT_KSLOT)
#define AT_V(j) (4 * AT_KSLOT + ((j) & 7) * AT_VSLOT)
static_assert(4 * AT_KSLOT + 8 * AT_VSLOT <= 131072, "attention rings fit the phase scratch");
__device__ __forceinline__ void glds16(const void* gsrc, unsigned lds_dst) { unsigned keep;
    asm volatile("s_mov_b32 %0, m0\n\ts_mov_b32 m0, %2\n\ts_nop 0\n\tglobal_load_lds_dwordx4 %1, off\n\ts_mov_b32 m0, %0" : "=&s"(keep) : "v"(gsrc), "s"(lds_dst) : "memory"); }
#define AT_BAR(N) asm volatile("s_waitcnt vmcnt(" #N ") lgkmcnt(0)\n\ts_barrier" ::: "memory")
__device__ __forceinline__ int crow(int r, int hi) { return (r & 3) + 8 * (r >> 2) + 4 * hi; }
__device__ __forceinline__ void attn_q(LAS unsigned char* lds, int j, int s0, int q, int hi, const bf16x8 (&qf)[6], const f32x16& negm, f32x16& p0, f32x16& p1) {
    const int kb = AT_K(j);
    __builtin_amdgcn_s_setprio(1);
#pragma unroll
    for (int ks = 0; ks < 6; ++ks) {
        const bf16x8 a0 = *(const LAS bf16x8*)(lds + kb + (2 * ks + hi) * 1024 + q * 16);
        const bf16x8 a1 = *(const LAS bf16x8*)(lds + kb + (2 * ks + hi) * 1024 + (32 + q) * 16);
        if (ks == 0) { p0 = __builtin_amdgcn_mfma_f32_32x32x16_bf16(a0, qf[0], negm, 0, 0, 0); p1 = __builtin_amdgcn_mfma_f32_32x32x16_bf16(a1, qf[0], negm, 0, 0, 0); }
        else { p0 = __builtin_amdgcn_mfma_f32_32x32x16_bf16(a0, qf[ks], p0, 0, 0, 0); p1 = __builtin_amdgcn_mfma_f32_32x32x16_bf16(a1, qf[ks], p1, 0, 0, 0); }
    }
    __builtin_amdgcn_s_setprio(0);
    if (j == 0) {
#pragma unroll
        for (int r = 0; r < 16; ++r) { if (crow(r, hi) >= NMETA) p0[r] = -INFINITY; p1[r] = -INFINITY; }
    } else if ((j - 1) * 64 + 63 > s0) {
        const int qs = s0 + q, k0 = (j - 1) * 64;
#pragma unroll
        for (int r = 0; r < 16; ++r) { const int kk = k0 + crow(r, hi); if (kk > qs) p0[r] = -INFINITY; if (kk + 32 > qs) p1[r] = -INFINITY; }
    }
}
__device__ __forceinline__ void attn_pv(LAS unsigned char* lds, int vbase, const bf16x8 (&pb)[4], f32x16& o0, f32x16& o1) {
#pragma unroll
    for (int s = 0; s < 4; ++s)
#pragma unroll
        for (int db = 0; db < 2; ++db) {
            const v4i16_t lo = __builtin_amdgcn_ds_read_tr16_b64_v4i16((LAS v4i16_t*)(lds + vbase + db * 4096 + s * 1024));
            const v4i16_t hh = __builtin_amdgcn_ds_read_tr16_b64_v4i16((LAS v4i16_t*)(lds + vbase + db * 4096 + s * 1024 + 512));
            const bf16x8 va = {lo[0], lo[1], lo[2], lo[3], hh[0], hh[1], hh[2], hh[3]};
            if (db == 0) o0 = __builtin_amdgcn_mfma_f32_32x32x16_bf16(va, pb[s], o0, 0, 0, 0); else o1 = __builtin_amdgcn_mfma_f32_32x32x16_bf16(va, pb[s], o1, 0, 0, 0);
        }
}
#ifndef ATT_THR
#define ATT_THR 8.0f
#endif
template <bool DOPV, bool FIRST> __device__ __forceinline__ void attn_sp(LAS unsigned char* lds, int vbase, f32x16& p0, f32x16& p1, bf16x8 (&pb)[4], f32x16& o0, f32x16& o1, f32x16& negm, float& m_run, float& l_run) {
    float mx = fmaxf(p0[0], p1[0]);
#pragma unroll
    for (int r = 1; r < 16; ++r) mx = fmaxf(fmaxf(mx, p0[r]), p1[r]);
    mx = fmaxf(mx, __shfl_xor(mx, 32));
    if (DOPV) attn_pv(lds, vbase, pb, o0, o1);
    float rs = 0.f;
#pragma unroll
    for (int r = 0; r < 16; ++r) { p0[r] = ex2(p0[r]); p1[r] = ex2(p1[r]); rs += p0[r] + p1[r]; }
    if (FIRST || !__all(mx <= ATT_THR)) {
        const float d = FIRST ? mx : fmaxf(mx, 0.f), alpha = ex2(-d);
#pragma unroll
        for (int r = 0; r < 16; ++r) { p0[r] *= alpha; p1[r] *= alpha; o0[r] *= alpha; o1[r] *= alpha; }
        rs *= alpha; l_run *= alpha; m_run += d;
#pragma unroll
        for (int r = 0; r < 16; ++r) negm[r] = -m_run;
    }
    l_run += rs;
#pragma unroll
    for (int s = 0; s < 4; ++s) { unsigned w[4];
#pragma unroll
        for (int jj = 0; jj < 4; ++jj) w[jj] = (s < 2) ? pk2(p0[8 * (s & 1) + 2 * jj], p0[8 * (s & 1) + 2 * jj + 1]) : pk2(p1[8 * (s & 1) + 2 * jj], p1[8 * (s & 1) + 2 * jj + 1]);
        u32x4 ww = {w[0], w[1], w[2], w[3]}; pb[s] = __builtin_bit_cast(bf16x8, ww); }
}
__device__ __forceinline__ void attn_unit(const Ctx& C, int b, int h, int qb, const bf16_t* Q, const bf16_t* KN, const bf16_t* KR, const bf16_t* V, bf16_t* O) {
    const int tid = C.tid, lane = C.lane, wid = C.wave, q = lane & 31, hi = lane >> 5;
    LAS unsigned char* lds = C.lds;
    const int s0 = qb * 256 + wid * 32;
    const size_t qrow = (size_t)b * SEQ + s0 + q;
    bf16x8 qf[6];
#pragma unroll
    for (int ks = 0; ks < 6; ++ks) qf[ks] = *(const bf16x8*)(Q + qrow * QLD + h * 96 + ks * 16 + hi * 8);
    {
        const float* ctab = (const float*)(C.ws + WS_CTAB) + (NMETA + s0 + q) * 16; const float* stab = (const float*)(C.ws + WS_STAB) + (NMETA + s0 + q) * 16;
#pragma unroll
        for (int ks = 4; ks < 6; ++ks) { const f32x4 cc = *(const f32x4*)(ctab + 8 * (ks - 4) + 4 * hi), sn = *(const f32x4*)(stab + 8 * (ks - 4) + 4 * hi);
            const u32x4 w = __builtin_bit_cast(u32x4, qf[ks]); u32x4 r;
            { const float x1 = bf_lo(w.x), x2 = bf_hi(w.x); r.x = pk2(x1 * cc[0] - x2 * sn[0], x1 * sn[0] + x2 * cc[0]); }
            { const float x1 = bf_lo(w.y), x2 = bf_hi(w.y); r.y = pk2(x1 * cc[1] - x2 * sn[1], x1 * sn[1] + x2 * cc[1]); }
            { const float x1 = bf_lo(w.z), x2 = bf_hi(w.z); r.z = pk2(x1 * cc[2] - x2 * sn[2], x1 * sn[2] + x2 * cc[2]); }
            { const float x1 = bf_lo(w.w), x2 = bf_hi(w.w); r.w = pk2(x1 * cc[3] - x2 * sn[3], x1 * sn[3] + x2 * cc[3]); }
            qf[ks] = __builtin_bit_cast(bf16x8, r); }
    }
    f32x16 o0 = {}, o1 = {}, p0 = {}, p1 = {};
    bf16x8 pb[4] = {};
    float m_run = 0.f, l_run = 0.f; f32x16 negm = {};
    const int NJ = 4 * qb + 5;
    const unsigned lds0 = (unsigned)(size_t)lds;
    const bf16_t* ksrc = KN + (size_t)lane * 1024 + h * 64 + wid * 8;
    const bf16_t* rsrc = KR + (size_t)lane * 32 + (wid & 3) * 8;
    const bf16_t* vsrc = V + (size_t)(16 * (wid & 3) + (lane >> 2)) * 1024 + h * 64 + (wid >> 2) * 32 + (lane & 3) * 8;
#define AT_DMA(j) do { const size_t row_ = (j) == 0 ? (size_t)METAROW : (size_t)b * SEQ + (size_t)((j) - 1) * 64; \
        glds16(ksrc + row_ * 1024, (unsigned)__builtin_amdgcn_readfirstlane(lds0 + AT_K(j) + wid * 1024)); \
        if (wid < 4) glds16(rsrc + row_ * 32, (unsigned)__builtin_amdgcn_readfirstlane(lds0 + AT_K(j) + (8 + wid) * 1024)); \
        glds16(vsrc + row_ * 1024, (unsigned)__builtin_amdgcn_readfirstlane(lds0 + AT_V(j) + wid * 1024)); } while (0)
#define AT_STEP(n) do { if ((n) + 2 < NJ) { if (wid < 4) AT_BAR(6); else AT_BAR(4); } else if ((n) + 1 < NJ) { if (wid < 4) AT_BAR(3); else AT_BAR(2); } else AT_BAR(0); if ((n) + 3 < NJ) AT_DMA((n) + 3); } while (0)
    AT_BAR(0);
    AT_DMA(0); AT_DMA(1); AT_DMA(2);
    const int g16 = lane >> 4, qq = (lane & 15) >> 2, pp = lane & 3;
    const int vtr_off = (4 * hi + qq) * 64 + (16 * (g16 & 1) + 4 * pp) * 2;
    {
        AT_STEP(0);
        attn_q(lds, 0, s0, q, hi, qf, negm, p0, p1);
        attn_sp<false, true>(lds, 0, p0, p1, pb, o0, o1, negm, m_run, l_run);
    }
    const int jend = (s0 + 31) / 64 + 2 < NJ ? (s0 + 31) / 64 + 2 : NJ;
    for (int j = 1; j < jend; ++j) {
        AT_STEP(j);
        attn_q(lds, j, s0, q, hi, qf, negm, p0, p1);
        attn_sp<true, false>(lds, AT_V(j - 1) + vtr_off, p0, p1, pb, o0, o1, negm, m_run, l_run);
    }
    attn_pv(lds, AT_V(jend - 1) + vtr_off, pb, o0, o1);
    for (int j = jend; j < NJ; ++j) AT_STEP(j);
#undef AT_DMA
#undef AT_STEP
    const float inv = 1.f / (l_run + __shfl_xor(l_run, 32));
    bf16_t* orow = O + qrow * 1024 + h * 64;
#pragma unroll
    for (int g4 = 0; g4 < 4; ++g4) {
        u32x2 w0, w1; w0.x = pk2(o0[4 * g4] * inv, o0[4 * g4 + 1] * inv); w0.y = pk2(o0[4 * g4 + 2] * inv, o0[4 * g4 + 3] * inv);
        w1.x = pk2(o1[4 * g4] * inv, o1[4 * g4 + 1] * inv); w1.y = pk2(o1[4 * g4 + 2] * inv, o1[4 * g4 + 3] * inv);
        *(u32x2*)(orow + 8 * g4 + 4 * hi) = w0; *(u32x2*)(orow + 32 + 8 * g4 + 4 * hi) = w1;
    }
}
__device__ __forceinline__ void phase_attn(const Ctx& C) {
    unsigned char* ws = C.ws;
    const bf16_t* Q = (const bf16_t*)(ws + SLOT(0)); const bf16_t* KN = (const bf16_t*)(ws + SLOT(4)); const bf16_t* V = (const bf16_t*)(ws + SLOT(6)); const bf16_t* KR = (const bf16_t*)(ws + WS_KROPE);
    bf16_t* O = (bf16_t*)(ws + SLOT(3));
    const int G = C.G, c = blockIdx.x; const int vcu = (G % 8 == 0) ? (c % 8) * (G / 8) + c / 8 : c;
    for (int bh = vcu; bh < NB * 16; bh += G)
        for (int i = 0; i < 8; ++i) { const int qb = (i & 1) ? 7 - (i >> 1) : (i >> 1); attn_unit(C, bh >> 4, bh & 15, qb, Q, KN, KR, V, O); }
    __syncthreads();
}

__device__ __forceinline__ int tk_enc(float f) { const int x = __float_as_int(f); return x ^ ((x >> 31) & 0x7fffffff); }
__device__ __forceinline__ float tk_dec(int k) { return __int_as_float(k ^ ((k >> 31) & 0x7fffffff)); }
#define TK_CE(a, b) do { const int hi_ = max((a), (b)), lo_ = min((a), (b)); (a) = hi_; (b) = lo_; } while (0)
__device__ __forceinline__ void tk_sort16(int (&v)[16]) {
#pragma unroll
    for (int k = 2; k <= 16; k <<= 1)
#pragma unroll
        for (int j = k >> 1; j > 0; j >>= 1)
#pragma unroll
            for (int i = 0; i < 16; ++i) { const int l = i ^ j; if (l > i) { if ((i & k) == 0) TK_CE(v[i], v[l]); else TK_CE(v[l], v[i]); } }
}
__device__ __forceinline__ void tk_merge16(int (&a)[16], const int (&b)[16]) {
#pragma unroll
    for (int i = 0; i < 16; ++i) a[i] = max(a[i], b[15 - i]);
#pragma unroll
    for (int j = 8; j > 0; j >>= 1)
#pragma unroll
        for (int i = 0; i < 16; ++i) { const int l = i ^ j; if (l > i) TK_CE(a[i], a[l]); }
}
__host__ __device__ constexpr int tk_pos(int i) { int n = 0; for (int a = 0; a < i; ++a) n += 16 / (a + 1); return n; }
__device__ __forceinline__ int tk_lookup(const int (&w)[4], int i) {
    const unsigned long long lo = ((unsigned long long)(unsigned)w[1] << 32) | (unsigned long long)(unsigned)w[0], hi = ((unsigned long long)(unsigned)w[3] << 32) | (unsigned long long)(unsigned)w[2];
    const unsigned long long a = (i & 8) ? hi : lo;
    return (int)(a >> (8 * (i & 7))) & 127;
}
__device__ __forceinline__ void phase_topk(const Ctx& C) {
    unsigned char* ws = C.ws;
    const _Float16* SC = (const _Float16*)(ws + SLOT(0)); int* TIDX = (int*)(ws + SLOT(5)); float* TVAL = (float*)(ws + SLOT(5) + (size_t)M * 128 * 4);
    const int gt = blockIdx.x * NTHR + C.tid, NT = C.G * NTHR;
    for (int it = gt; it < M * 8 * 4; it += NT) {
        const int p = it >> 2, q = it & 3;
        const f16x8* s = (const f16x8*)(SC + (size_t)p * 256 + 64 * q);
        f16x8 raw[8];
#pragma unroll
        for (int c = 0; c < 8; ++c) raw[c] = s[c];
        const int ibase = 127 - 64 * (q & 1);
        int ch[4][16];
#pragma unroll
        for (int c = 0; c < 4; ++c)
#pragma unroll
            for (int e = 0; e < 16; ++e) ch[c][e] = (tk_enc((float)raw[2 * c + (e >> 3)][e & 7]) & ~127) | (ibase - (16 * c + e));
        tk_sort16(ch[0]); tk_sort16(ch[1]); tk_sort16(ch[2]); tk_sort16(ch[3]);
        tk_merge16(ch[0], ch[1]); tk_merge16(ch[2], ch[3]); tk_merge16(ch[0], ch[2]);
        int oth[16];
#pragma unroll
        for (int i = 0; i < 16; ++i) oth[i] = __builtin_amdgcn_mov_dpp(ch[0][i], 0xB1, 0xF, 0xF, true);
        tk_merge16(ch[0], oth);
#pragma unroll
        for (int i = 0; i < 16; ++i) oth[i] = __builtin_amdgcn_mov_dpp(ch[0][i], 0x4E, 0xF, 0xF, true);
        int t1[16], t2[16];
#pragma unroll
        for (int i = 0; i < 16; ++i) { t1[i] = (q < 2) ? ch[0][i] : oth[i]; t2[i] = (q < 2) ? oth[i] : ch[0][i]; }
        float f1[16], f2[16];
#pragma unroll
        for (int i = 0; i < 16; ++i) { f1[i] = tk_dec(t1[i]); f2[i] = tk_dec(t2[i]); }
        int cd[4][16];
#pragma unroll
        for (int i = 0; i < 16; ++i)
#pragma unroll
            for (int j = 0; j < 16; ++j) if ((i + 1) * (j + 1) <= 16) { constexpr int dummy = 0; (void)dummy; const int n = tk_pos(i) + j; cd[n >> 4][n & 15] = (tk_enc(f1[i] + f2[j]) & ~255) | (255 - (16 * i + j)); }
#pragma unroll
        for (int n = 50; n < 64; ++n) cd[n >> 4][n & 15] = (int)0x80000000;
        tk_sort16(cd[0]); tk_sort16(cd[1]); tk_sort16(cd[2]); tk_sort16(cd[3]);
        tk_merge16(cd[0], cd[1]); tk_merge16(cd[2], cd[3]); tk_merge16(cd[0], cd[2]);
        int w1[4], w2[4];
#pragma unroll
        for (int m = 0; m < 4; ++m) { w1[m] = (t1[4 * m] & 127) | ((t1[4 * m + 1] & 127) << 8) | ((t1[4 * m + 2] & 127) << 16) | ((t1[4 * m + 3] & 127) << 24);
                                      w2[m] = (t2[4 * m] & 127) | ((t2[4 * m + 1] & 127) << 8) | ((t2[4 * m + 2] & 127) << 16) | ((t2[4 * m + 3] & 127) << 24); }
        if (q == 0) {
            int id[16];
#pragma unroll
            for (int k = 0; k < 16; ++k) { const int c = 255 - (cd[0][k] & 255); id[k] = (127 - tk_lookup(w1, c >> 4)) * 128 + (127 - tk_lookup(w2, c & 15)); }
            int* oi = TIDX + (size_t)p * 16;
#pragma unroll
            for (int k = 0; k < 16; k += 4) *(int4*)(oi + k) = make_int4(id[k], id[k + 1], id[k + 2], id[k + 3]);
        } else if (q == 1) {
            float* ov = TVAL + (size_t)p * 16;
#pragma unroll
            for (int k = 0; k < 16; k += 4) *(f32x4*)(ov + k) = (f32x4){tk_dec(cd[0][k]), tk_dec(cd[0][k + 1]), tk_dec(cd[0][k + 2]), tk_dec(cd[0][k + 3])};
        }
    }
}

__device__ __forceinline__ float dpp_ror8(float v) { return __uint_as_float(__builtin_amdgcn_update_dpp(0, __float_as_uint(v), 0x128, 0xF, 0xF, true)); }
__device__ __forceinline__ float dpp_hmir(float v) { return __uint_as_float(__builtin_amdgcn_update_dpp(0, __float_as_uint(v), 0x141, 0xF, 0xF, true)); }
__device__ __forceinline__ float dpp_x2(float v) { return __uint_as_float(__builtin_amdgcn_mov_dpp(__float_as_uint(v), 0x4E, 0xF, 0xF, true)); }
__device__ __forceinline__ float dpp_x1(float v) { return __uint_as_float(__builtin_amdgcn_mov_dpp(__float_as_uint(v), 0xB1, 0xF, 0xF, true)); }
__device__ __forceinline__ void phase_x8(const Ctx& C) {
    unsigned char* ws = C.ws; const int lane = C.lane;
    const bf16_t* H1B = (const bf16_t*)(ws + SLOT(4)); unsigned char* X8 = ws + SLOT(2); float* XS = (float*)(ws + SLOT(2) + (size_t)M * 1024);
    for (int tok = C.gw; tok < M; tok += C.NGW) {
        const u32x4 xa = *(const u32x4*)(H1B + (size_t)tok * 1024 + 16 * lane), xb = *(const u32x4*)(H1B + (size_t)tok * 1024 + 16 * lane + 8);
        float hv[16]; { float t8[8]; unpack8(xa, t8);
#pragma unroll
            for (int i = 0; i < 8; ++i) hv[i] = t8[i];
            unpack8(xb, t8);
#pragma unroll
            for (int i = 0; i < 8; ++i) hv[8 + i] = t8[i]; }
        float am = 0.f;
#pragma unroll
        for (int i = 0; i < 16; ++i) am = fmaxf(am, fabsf(hv[i]));
#pragma unroll
        for (int o = 1; o < 64; o <<= 1) am = fmaxf(am, __shfl_xor(am, o));
        const float scale = am > 0.f ? am * (1.f / 127.f) : 1.f, inv = 1.f / scale;
        u32x4 w;
#pragma unroll
        for (int j = 0; j < 4; ++j) { const int q0 = (int)rintf(hv[4 * j] * inv), q1 = (int)rintf(hv[4 * j + 1] * inv), q2 = (int)rintf(hv[4 * j + 2] * inv), q3 = (int)rintf(hv[4 * j + 3] * inv);
            w[j] = (unsigned)(q0 & 255) | ((unsigned)(q1 & 255) << 8) | ((unsigned)(q2 & 255) << 16) | ((unsigned)q3 << 24); }
        *(u32x4*)(X8 + (size_t)tok * 1024 + 16 * lane) = w;
        if (lane == 0) XS[tok] = scale;
    }
}
__device__ __forceinline__ int idpp_ror8(int v) { return __builtin_amdgcn_update_dpp(0, v, 0x128, 0xF, 0xF, true); }
__device__ __forceinline__ int idpp_hmir(int v) { return __builtin_amdgcn_update_dpp(0, v, 0x141, 0xF, 0xF, true); }
__device__ __forceinline__ int idpp_x2(int v) { return __builtin_amdgcn_mov_dpp(v, 0x4E, 0xF, 0xF, true); }
__device__ __forceinline__ int idpp_x1(int v) { return __builtin_amdgcn_mov_dpp(v, 0xB1, 0xF, 0xF, true); }
__device__ __forceinline__ int idot16(const u32x4 w, const u32x4 x, int a) {
    a = __builtin_amdgcn_sdot4((int)w.x, (int)x.x, a, false); a = __builtin_amdgcn_sdot4((int)w.y, (int)x.y, a, false);
    a = __builtin_amdgcn_sdot4((int)w.z, (int)x.z, a, false); return __builtin_amdgcn_sdot4((int)w.w, (int)x.w, a, false);
}
__device__ __forceinline__ void u_process(unsigned c, unsigned co, int n, int tok, const u32x4 (&x)[4], float xscale, const unsigned char* PU, float* ACT, int lane, bool b3, bool b2) {
    const int rs = lane >> 4; const unsigned p16 = 16u * (unsigned)(lane & 15);
    for (int base = 0; base < n; base += 32) {
        u32x4 w[8][4];
#pragma unroll
        for (int m = 0; m < 8; ++m) if (base + 4 * m < n) {
            const unsigned off = (unsigned)__builtin_amdgcn_ds_bpermute(((base + 4 * m + rs) & 63) * 4, (int)co);
            const unsigned char* rp = PU + (off + p16);
#pragma unroll
            for (int i = 0; i < 4; ++i) w[m][i] = *(const u32x4*)(rp + 256 * i); }
        __builtin_amdgcn_sched_barrier(0);
#pragma unroll
        for (int G = 0; G < 2; ++G) if (base + 16 * G < n) {
            int p4[4];
#pragma unroll
            for (int mm = 0; mm < 4; ++mm) { int a = 0;
#pragma unroll
                for (int i = 0; i < 4; ++i) a = idot16(w[4 * G + mm][i], x[i], a);
                p4[mm] = a; }
            int t0, t1, u;
            { const int keep = b3 ? p4[1] : p4[0], send = b3 ? p4[0] : p4[1]; t0 = keep + idpp_ror8(send); }
            { const int keep = b3 ? p4[3] : p4[2], send = b3 ? p4[2] : p4[3]; t1 = keep + idpp_ror8(send); }
            { const int keep = b2 ? t1 : t0, send = b2 ? t0 : t1; u = keep + idpp_hmir(send); }
            u += idpp_x2(u); u += idpp_x1(u);
            const int slot = base + 16 * G + 4 * ((b2 ? 2 : 0) + (b3 ? 1 : 0)) + rs;
            const unsigned mine = (unsigned)__builtin_amdgcn_ds_bpermute((slot & 63) * 4, (int)c);
            if ((lane & 3) == 0 && slot < n) ACT[(size_t)tok * 128 + (mine >> 16)] = (float)u * xscale;
        }
    }
}
constexpr int UB = 8;
__device__ __forceinline__ float u_batch_request(const unsigned char* X8, const float* XS, const int* TIDX, int tb, int tstep, unsigned xs_addr, int lane) {
#pragma unroll
    for (int k = 0; k < UB; ++k) { const int tk = tb + k * tstep; if (tk < M) glds16(X8 + (size_t)tk * 1024 + 16 * lane, xs_addr + k * 1024); }
#pragma unroll
    for (int k = 0; k < UB; k += 2) { if (tb + k * tstep < M) { int tk = tb + (k + (lane >> 5)) * tstep; tk = tk < M ? tk : tb;
        glds16(TIDX + (size_t)tk * 128 + 4 * (lane & 31), xs_addr + UB * 1024 + k * 512); } }
    const int tl = tb + (lane & (UB - 1)) * tstep;
    return XS[tl < M ? tl : tb];
}
__device__ __forceinline__ void phase_upart(const Ctx& C, int xcc, int rank) {
    unsigned char* ws = C.ws; const int lane = C.lane;
    const unsigned char* X8 = ws + SLOT(2); const float* XS = (const float*)(ws + SLOT(2) + (size_t)M * 1024);
    const int* TIDX = (const int*)(ws + SLOT(5)); float* ACT = (float*)(ws + SLOT(0));
    const unsigned char* PU = ws + WS_PU;
    LAS unsigned char* xs = C.lds + C.wave * (UB * 1536);
    const unsigned xs_addr = (unsigned)__builtin_amdgcn_readfirstlane((int)(unsigned)(size_t)xs);
    int nloc, xi, nx;
    if ((C.G & 7) == 0) { nx = 8; xi = xcc; nloc = C.G >> 3; } else { nx = 1; xi = 0; nloc = C.G; rank = blockIdx.x; }
    const bool b3 = (lane & 8) != 0, b2 = (lane & 4) != 0; const int pos = lane & 15;
    const int tstep = nloc * NWAVES;
    for (int sub = xi; sub < 8; sub += nx) {
        const unsigned dummy = (unsigned)(sub << 11) * 1024u;
        int tb = rank * NWAVES + C.wave;
        float svn = 0.f;
        if (tb < M) svn = u_batch_request(X8, XS, TIDX, tb, tstep, xs_addr, lane);
        for (; tb < M; tb += UB * tstep) {
            asm volatile("s_waitcnt vmcnt(0)" ::: "memory");
            const float sv = svn;
#pragma unroll 1
            for (int k = 0; k < UB; ++k) {
                const int tok = tb + k * tstep; if (tok >= M) break;
                u32x4 x[4];
#pragma unroll
                for (int i = 0; i < 4; ++i) x[i] = *(LAS const u32x4*)(xs + k * 1024 + 256 * i + 16 * pos);
                const int ca = *(LAS const int*)(xs + UB * 1024 + k * 512 + 4 * lane), cb = *(LAS const int*)(xs + UB * 1024 + k * 512 + 256 + 4 * lane);
                const float xscale = __uint_as_float(__builtin_amdgcn_readlane(__float_as_uint(sv), k));
                const bool fa = (ca >> 11) == sub, fb = (cb >> 11) == sub;
                const unsigned long long ma = __ballot(fa), mb = __ballot(fb);
                const int npa = __builtin_popcountll(ma), npb = __builtin_popcountll(mb);
                const int ra_ = (int)__builtin_amdgcn_mbcnt_hi((unsigned)(ma >> 32), __builtin_amdgcn_mbcnt_lo((unsigned)ma, 0u));
                const int rb_ = (int)__builtin_amdgcn_mbcnt_hi((unsigned)(mb >> 32), __builtin_amdgcn_mbcnt_lo((unsigned)mb, 0u));
                const int da = fa ? ra_ : npa + (lane - ra_), db = fb ? rb_ : npb + (lane - rb_);
                const unsigned cA = (unsigned)__builtin_amdgcn_ds_permute(da * 4, ca | (lane << 16));
                const unsigned cB = (unsigned)__builtin_amdgcn_ds_permute(db * 4, cb | ((64 + lane) << 16));
                if (npa + npb <= 64) {
                    const unsigned pulled = (unsigned)__builtin_amdgcn_ds_bpermute(((lane - npa) & 63) * 4, (int)cB);
                    const unsigned cc = lane < npa ? cA : pulled; const int n = npa + npb;
                    u_process(cc, lane < n ? (cc & 0xffffu) * 1024u : dummy, n, tok, x, xscale, PU, ACT, lane, b3, b2);
                } else { u_process(cA, lane < npa ? (cA & 0xffffu) * 1024u : dummy, npa, tok, x, xscale, PU, ACT, lane, b3, b2);
                         u_process(cB, lane < npb ? (cB & 0xffffu) * 1024u : dummy, npb, tok, x, xscale, PU, ACT, lane, b3, b2); }
            }
            asm volatile("s_waitcnt lgkmcnt(0)" ::: "memory");
            if (tb + UB * tstep < M) svn = u_batch_request(X8, XS, TIDX, tb + UB * tstep, tstep, xs_addr, lane);
        }
    }
}
__device__ __forceinline__ void phase_gather(const Ctx& C, float* DST) {
    unsigned char* ws = C.ws; const int lane = C.lane;
    const bf16_t* H1B = (const bf16_t*)(ws + SLOT(4)); const int* TIDX = (const int*)(ws + SLOT(5)); const float* TVAL = (const float*)(ws + SLOT(5) + (size_t)M * 128 * 4);
    const float* ACT = (const float*)(ws + SLOT(0));
    const unsigned char* PV = ws + WS_PV; const float* SU = (const float*)(ws + WS_SU); const float* SV = (const float*)(ws + WS_SV);
    const float* fg = C.in[24];
    const int l4 = lane >> 2; const unsigned l8 = 8u * (unsigned)lane;
    int tok = C.gw;
    u32x4 ra = {0u, 0u, 0u, 0u}, rb = {0u, 0u, 0u, 0u};
    if (tok < M) { ra = *(const u32x4*)(H1B + (size_t)tok * 1024 + 16 * lane); rb = *(const u32x4*)(H1B + (size_t)tok * 1024 + 16 * lane + 8); }
    for (; tok < M; tok += C.NGW) {
        f32x4 e[4]; float ss = 0.f;
        { float hv[16]; { float t8[8]; unpack8(ra, t8);
#pragma unroll
            for (int i = 0; i < 8; ++i) hv[i] = t8[i];
            unpack8(rb, t8);
#pragma unroll
            for (int i = 0; i < 8; ++i) hv[8 + i] = t8[i]; }
#pragma unroll
          for (int j = 0; j < 4; ++j) { e[j] = (f32x4){hv[4 * j], hv[4 * j + 1], hv[4 * j + 2], hv[4 * j + 3]}; ss += (e[j][0] * e[j][0] + e[j][1] * e[j][1]) + (e[j][2] * e[j][2] + e[j][3] * e[j][3]); } }
        { const int nt = tok + C.NGW; if (nt < M) { ra = *(const u32x4*)(H1B + (size_t)nt * 1024 + 16 * lane); rb = *(const u32x4*)(H1B + (size_t)nt * 1024 + 16 * lane + 8); } }
        f32x4* dp = (f32x4*)(DST + (size_t)tok * 1024 + 16 * lane);
        const float rstd = 1.f / sqrtf(wave_sum(ss) * (1.f / 1024.f) + EPS);
        f32x2 acc[8];
#pragma unroll
        for (int i = 0; i < 8; ++i) acc[i] = (f32x2){0.f, 0.f};
        int idxn0 = TIDX[(size_t)tok * 128 + l4], idxn1 = TIDX[(size_t)tok * 128 + 16 + l4];
        float tsn0 = TVAL[(size_t)tok * 128 + l4], tsn1 = TVAL[(size_t)tok * 128 + 16 + l4], dtn0 = ACT[(size_t)tok * 128 + l4], dtn1 = ACT[(size_t)tok * 128 + 16 + l4];
        for (int hp = 0; hp < 8; hp += 2) {
            const int idx0 = idxn0, idx1 = idxn1; const float ts0 = tsn0 * rstd, ts1 = tsn1 * rstd, dot0 = dtn0, dot1 = dtn1;
            u32x2 pa[32];
#pragma unroll
            for (int m = 0; m < 32; ++m) { const unsigned id = (unsigned)__builtin_amdgcn_readlane(m < 16 ? idx0 : idx1, 4 * (m & 15)); pa[m] = *(const u32x2*)(PV + (id * 512u + l8)); }
            __builtin_amdgcn_sched_barrier(0);
            const float su0 = SU[idx0], sv0 = SV[idx0], su1 = SU[idx1], sv1 = SV[idx1];
            if (hp < 6) { const size_t nb = (size_t)tok * 128 + (hp + 2) * 16 + l4; idxn0 = TIDX[nb]; idxn1 = TIDX[nb + 16]; tsn0 = TVAL[nb]; tsn1 = TVAL[nb + 16]; dtn0 = ACT[nb]; dtn1 = ACT[nb + 16]; }
            __builtin_amdgcn_sched_barrier(0);
            float mx0 = ts0, mx1 = ts1;
#pragma unroll
            for (int o = 4; o < 64; o <<= 1) { mx0 = fmaxf(mx0, __shfl_xor(mx0, o)); mx1 = fmaxf(mx1, __shfl_xor(mx1, o)); }
            const float ee0 = ex2((ts0 - mx0) * LOG2E), ee1 = ex2((ts1 - mx1) * LOG2E); float sm0 = ee0, sm1 = ee1;
#pragma unroll
            for (int o = 4; o < 64; o <<= 1) { sm0 += __shfl_xor(sm0, o); sm1 += __shfl_xor(sm1, o); }
            const float coef0 = (ee0 / sm0) * gelu_t(dot0 * su0 * rstd) * sv0, coef1 = (ee1 / sm1) * gelu_t(dot1 * su1 * rstd) * sv1;
#pragma unroll
            for (int m = 0; m < 32; ++m) {
                const float ck = __uint_as_float(__builtin_amdgcn_readlane(__float_as_uint(m < 16 ? coef0 : coef1), 4 * (m & 15)));
#pragma unroll
                for (int d = 0; d < 2; ++d) {
                    acc[4 * d] = __builtin_elementwise_fma(__builtin_amdgcn_cvt_scalef32_pk_f32_fp4(pa[m][d], 1.0f, 0), (f32x2){ck, ck}, acc[4 * d]);
                    acc[4 * d + 1] = __builtin_elementwise_fma(__builtin_amdgcn_cvt_scalef32_pk_f32_fp4(pa[m][d], 1.0f, 1), (f32x2){ck, ck}, acc[4 * d + 1]);
                    acc[4 * d + 2] = __builtin_elementwise_fma(__builtin_amdgcn_cvt_scalef32_pk_f32_fp4(pa[m][d], 1.0f, 2), (f32x2){ck, ck}, acc[4 * d + 2]);
                    acc[4 * d + 3] = __builtin_elementwise_fma(__builtin_amdgcn_cvt_scalef32_pk_f32_fp4(pa[m][d], 1.0f, 3), (f32x2){ck, ck}, acc[4 * d + 3]); }
                __builtin_amdgcn_sched_barrier(0);
            }
        }
        float s2 = 0.f;
#pragma unroll
        for (int j = 0; j < 4; ++j) {
            e[j][0] += acc[2 * j].x; e[j][1] += acc[2 * j].y; e[j][2] += acc[2 * j + 1].x; e[j][3] += acc[2 * j + 1].y;
            s2 += (e[j][0] * e[j][0] + e[j][1] * e[j][1]) + (e[j][2] * e[j][2] + e[j][3] * e[j][3]); }
        const float r2 = 1.f / sqrtf(wave_sum(s2) * (1.f / 1024.f) + EPS);
        const f32x4* fp = (const f32x4*)(fg + 16 * lane);
#pragma unroll
        for (int j = 0; j < 4; ++j) dp[j] = e[j] * r2 * fp[j];
    }
}

constexpr int NPHASE = 16;
__global__ void __launch_bounds__(NTHR, 2) hybrid_fwd(Args args) {
    extern __shared__ __attribute__((aligned(16))) unsigned char lds_raw[];
    Ctx C;
    C.lds = (LAS unsigned char*)lds_raw; C.tid = threadIdx.x; C.lane = C.tid & 63; C.wave = __builtin_amdgcn_readfirstlane(C.tid >> 6);
    C.G = gridDim.x; C.gw = blockIdx.x * NWAVES + C.wave; C.NGW = C.G * NWAVES; C.ws = args.ws; C.out = args.out; C.in = args.in;
    unsigned char* ws = args.ws;
    volatile LAS unsigned* MISC = (volatile LAS unsigned*)(C.lds + MISC_OFF);
    for (int u = C.tid; u < (LDS_BYTES - RING_BYTES) / 4; u += NTHR) ((LAS unsigned*)(C.lds + RING_BYTES))[u] = 0u;
    __syncthreads();
    XcdBarrier bar; bar.bar = (unsigned*)(ws + WS_CTL) + 1024; bar.x = 0; bar.st = nullptr;
    if (ONE_LAUNCH) bar = xcd_barrier_post((unsigned*)(ws + WS_CTL) + 1024, MISC + 8);
    const int lo = args.ph_lo, hi = args.ph_hi;
#ifndef PHMASK
#define PHMASK 0xffff
#endif
#define IN(k) (((PHMASK >> (k)) & 1) && lo <= (k) && (k) < hi)
#ifndef PROBE_PHASE
#define PROBE_PHASE -1
#endif
#define REPS(k) for (int rep_ = 0; rep_ < ((k) == PROBE_PHASE ? 2 : 1); ++rep_)
#define SEAM(k) do { if (IN(k) && IN((k) + 1)) xcd_barrier(bar); } while (0)
    const int G = C.G, cb = blockIdx.x;
    LAS unsigned char* ring = C.lds;

    if (IN(0)) REPS(0) { phase_prologue(C); }
    SEAM(0);
    if (IN(1)) REPS(1) {
        pg8::Gemm g{(const bf16_t*)(ws + SLOT(0)), (const bf16_t*)(ws + WS_WIN), 1024, 1024, 1024, 0, 256 * 1024};
        pg8::Sched S; S.init(256, 19, G, cb, 256, 6, 4);
        pg8::Epi8<FInproj> E{{(bf16_t*)(ws + SLOT(1)), (bf16_t*)(ws + SLOT(2)), (bf16_t*)(ws + SLOT(3)), (bf16_t*)(ws + SLOT(4)), (bf16_t*)(ws + SLOT(5))}};
        pg8::gemm_phase(ring, g, S, E);
    }
    SEAM(1);
    if (IN(2)) REPS(2) { phase_thin(C); }
    SEAM(2);
    if (IN(3)) REPS(3) {
        pg8::Gemm g{(const bf16_t*)(ws + SLOT(0)), (const bf16_t*)(ws + WS_WGATE), 1024, 128, 128, 128, 256 * 128};
        pg8::Sched S; S.init(256, 8, G, cb, 256, 8, 0);
        pg8::EpiPair<FGate> E{{(const bf16_t*)(ws + SLOT(0)), args.in[7], args.in[9], (const float*)(ws + WS_CLAM), (bf16_t*)(ws + SLOT(1)), (bf16_t*)(ws + SLOT(6))}};
        pg8::gemm_phase(ring, g, S, E);
    }
    SEAM(3);
    if (IN(4)) REPS(4) { phase_scan1(C); }
    SEAM(4);
    if (IN(5)) REPS(5) { phase_scan2(C); }
    SEAM(5);
    if (IN(6)) REPS(6) {
        pg8::Gemm g{(const bf16_t*)(ws + SLOT(0)), (const bf16_t*)(ws + WS_WRNN), 1024, 1024, 1024, 0, 256 * 1024};
        pg8::Sched S; S.init(256, 4, G, cb, 0, 0, 0);
        pg8::Epi8<FMul<false>> E{{(const bf16_t*)(ws + SLOT(4)), nullptr, (bf16_t*)(ws + SLOT(2))}};
        pg8::gemm_phase(ring, g, S, E);
    }
    SEAM(6);
    if (IN(7)) REPS(7) {
        { pg8::Gemm g{(const bf16_t*)(ws + SLOT(3)) + CQ_OFF, (const bf16_t*)(ws + WS_WUQ), CQKV_LD, 384, 384, 0, 256 * 384};
          pg8::Sched S; S.init(256, 6, G, cb, 0, 0, 0);
          pg8::Epi8<FQ> E{{(const float*)(ws + WS_RSQ), (bf16_t*)(ws + SLOT(0))}};
          pg8::gemm_phase(ring, g, S, E); }
        { pg8::Gemm g{(const bf16_t*)(ws + SLOT(3)), (const bf16_t*)(ws + WS_WUKV), CQKV_LD, 256, 256, 0, 256 * 256};
          pg8::Sched S; S.init(256, 8, G, cb, 256, 8, 0);
          pg8::Epi8<FKV> E{{(const float*)(ws + WS_RSKV), (bf16_t*)(ws + SLOT(4)), (bf16_t*)(ws + SLOT(6))}};
          pg8::gemm_phase(ring, g, S, E); }
    }
    SEAM(7);
    if (IN(8)) REPS(8) { phase_attn(C); }
    SEAM(8);
    if (IN(9)) REPS(9) {
        pg8::Gemm g{(const bf16_t*)(ws + SLOT(3)), (const bf16_t*)(ws + WS_WATT), 1024, 1024, 1024, 0, 256 * 1024};
        pg8::Sched S; S.init(256, 4, G, cb, 0, 0, 0);
        pg8::Epi8<FMul<true>> E{{(const bf16_t*)(ws + SLOT(5)), (const bf16_t*)(ws + SLOT(2)), (bf16_t*)(ws + SLOT(0))}};
        pg8::gemm_phase(ring, g, S, E);
    }
    SEAM(9);
    if (IN(10)) REPS(10) {
        pg8::Gemm g{(const bf16_t*)(ws + SLOT(0)), (const bf16_t*)(ws + WS_WOUT), 1024, 1024, 1024, 0, 256 * 1024};
        pg8::Sched S; S.init(256, 4, G, cb, 0, 0, 0);
        pg8::Epi8<FRes> E{{args.in[0], (bf16_t*)(ws + SLOT(4))}};
        pg8::gemm_phase(ring, g, S, E);
    }
    SEAM(10);
    if (IN(11)) REPS(11) {
        pg8::Gemm g{(const bf16_t*)(ws + SLOT(4)), (const bf16_t*)(ws + WS_WPQ), 1024, 1024, 1024, 0, 256 * 1024};
        pg8::Sched S; S.init(256, 8, G, cb, 0, 0, 0);
        pg8::Epi8<FF16> E{{(_Float16*)(ws + SLOT(0)), 2048}};
        pg8::gemm_phase(ring, g, S, E);
    }
    SEAM(11);
    if (IN(13)) REPS(13) { phase_x8(C); phase_topk(C); }
    SEAM(13);
    if (IN(14)) REPS(14) { phase_upart(C, (int)(blockIdx.x & 7), (int)(blockIdx.x >> 3)); }
    SEAM(14);
    if (IN(15)) REPS(15) { phase_gather(C, C.out); }
#undef IN
#undef SEAM
}

extern "C" void kernel_launch(void* const* d_in, const int* in_sizes, int n_in, void* d_out, int out_size, void* d_ws, size_t ws_size, hipStream_t stream) {
    static int grid = 0;
    if (grid == 0) {
        if (n_in != 25 || in_sizes[0] != M * DM || out_size != M * DM || ws_size < WS_END) { fprintf(stderr, "kernel_launch: unexpected shapes (n_in %d in0 %d out %d ws %zu need %zu); nothing launched\n", n_in, n_in > 0 ? in_sizes[0] : -1, out_size, ws_size, (size_t)WS_END); grid = -1; return; }
        int dev = 0, cus = 0, per_cu = 0;
        if (hipGetDevice(&dev) != hipSuccess || hipDeviceGetAttribute(&cus, hipDeviceAttributeMultiprocessorCount, dev) != hipSuccess) { grid = -1; return; }
        if (hipFuncSetAttribute((const void*)hybrid_fwd, hipFuncAttributeMaxDynamicSharedMemorySize, LDS_BYTES) != hipSuccess) { fprintf(stderr, "kernel_launch: hipFuncSetAttribute failed\n"); grid = -1; return; }
        if (hipOccupancyMaxActiveBlocksPerMultiprocessor(&per_cu, (const void*)hybrid_fwd, NTHR, LDS_BYTES) != hipSuccess || per_cu < 1) fprintf(stderr, "kernel_launch: occupancy query reports %d\n", per_cu);
        (void)hipGetLastError();
        grid = cus;
    }
    if (grid < 0) return;
    if (hipMemsetAsync((char*)d_ws + WS_CTL, 0, CTL_ZERO_BYTES, stream) != hipSuccess) return;
    Args a{};
    for (int i = 0; i < 25; ++i) a.in[i] = (const float*)d_in[i];
    a.out = (float*)d_out; a.ws = (unsigned char*)d_ws;
#if ONE_LAUNCH
    a.ph_lo = 0; a.ph_hi = NPHASE;
    hipLaunchKernelGGL(hybrid_fwd, dim3(grid), dim3(NTHR), LDS_BYTES, stream, a);
#else
    for (int p = 0; p < NPHASE; ++p) { a.ph_lo = p; a.ph_hi = p + 1; hipLaunchKernelGGL(hybrid_fwd, dim3(grid), dim3(NTHR), LDS_BYTES, stream, a); }
#endif
}
```

```cpp
#include <hip/hip_runtime.h>
#include <cstdio>
#include <cstdint>

#ifndef ONE_LAUNCH
#define ONE_LAUNCH 1
#endif

#define LAS __attribute__((address_space(3)))
#define GAS __attribute__((address_space(1)))
typedef unsigned short bf16_t;
typedef short bf16x8 __attribute__((ext_vector_type(8)));
typedef float f32x4 __attribute__((ext_vector_type(4)));
typedef float f32x2 __attribute__((ext_vector_type(2)));
typedef float f32x16 __attribute__((ext_vector_type(16)));
typedef unsigned u32x4 __attribute__((ext_vector_type(4)));
typedef unsigned u32x2 __attribute__((ext_vector_type(2)));
typedef __bf16 bf16x2_t __attribute__((ext_vector_type(2)));
typedef short v4i16_t __attribute__((ext_vector_type(4)));

constexpr int DM = 1024, NB = 32, SEQ = 2048, NMETA = 16;
constexpr int M = NB * SEQ;
constexpr int METAROW = M;
constexpr int MTOT = M + 256;
constexpr int NPOS = SEQ + NMETA;
constexpr int DIN_P = 4864;
constexpr int CQKV_LD = 768, CQ_OFF = 384, KR_OFF = 256;
constexpr int QLD = 1536;
constexpr int NEXP = 16384;
constexpr float EPS = 1e-6f;
constexpr float LOG2E = 1.4426950408889634f;
constexpr float QSCALE = 0.10206207261596577f * 1.4426950408889634f;

constexpr size_t A1 = (size_t)MTOT * 1024 * 2;
constexpr size_t WS_CTL = 0, CTL_ZERO_BYTES = 65536;
constexpr size_t WS_WIN = 1u << 20;
constexpr size_t WS_WGATE = WS_WIN + (size_t)DIN_P * 1024 * 2;
constexpr size_t WS_WUQ = WS_WGATE + 2048 * 128 * 2;
constexpr size_t WS_WUKV = WS_WUQ + 1536 * 384 * 2;
constexpr size_t WS_WRNN = WS_WUKV + 2048 * 256 * 2;
constexpr size_t WS_WATT = WS_WRNN + 1024 * 1024 * 2;
constexpr size_t WS_WOUT = WS_WATT + 1024 * 1024 * 2;
constexpr size_t WS_WPQ = WS_WOUT + 1024 * 1024 * 2;
constexpr size_t WS_KEYS = WS_WPQ + 2048 * 1024 * 2;
constexpr size_t WS_PU = WS_KEYS + 256 * 256 * 2;
constexpr size_t WS_PV = WS_PU + (size_t)NEXP * 1024;
constexpr size_t WS_SU = WS_PV + (size_t)NEXP * 1024;
constexpr size_t WS_SV = WS_SU + (size_t)NEXP * 4;
constexpr size_t WS_CTAB = WS_SV + (size_t)NEXP * 4;
constexpr size_t WS_STAB = WS_CTAB + NPOS * 16 * 4;
constexpr size_t WS_CLAM = WS_STAB + NPOS * 16 * 4;
constexpr size_t WS_RSQ = WS_CLAM + 4096;
constexpr size_t WS_RSKV = WS_RSQ + (size_t)MTOT * 4;
constexpr size_t WS_KROPE = WS_RSKV + (size_t)MTOT * 4;
constexpr size_t WS_SCP = WS_KROPE + (size_t)MTOT * 32 * 2;
constexpr size_t WS_SCH = WS_SCP + 512 * 1024 * 4;
constexpr size_t WS_CARRY0 = WS_SCH + 512 * 1024 * 4;
constexpr size_t WS_SLOTS = ((WS_CARRY0 + 4096 + 4095) / 4096) * 4096;
constexpr size_t WS_END = WS_SLOTS + 7 * A1;
#define SLOT(i) (WS_SLOTS + (size_t)(i) * A1)

#define LDS_WAIT() asm volatile("s_waitcnt lgkmcnt(0)" ::: "memory")
#define VM_WAIT() asm volatile("s_waitcnt vmcnt(0)" ::: "memory")
__device__ __forceinline__ unsigned pk2(float lo, float hi) { f32x2 v = {lo, hi}; bf16x2_t b = __builtin_convertvector(v, bf16x2_t); return __builtin_bit_cast(unsigned, b); }
__device__ __forceinline__ float bf_lo(unsigned w) { return __uint_as_float(w << 16); }
__device__ __forceinline__ float bf_hi(unsigned w) { return __uint_as_float(w & 0xffff0000u); }
__device__ __forceinline__ float bf2f(bf16_t h) { return __uint_as_float((unsigned)h << 16); }
__device__ __forceinline__ float ex2(float x) { return __builtin_amdgcn_exp2f(x); }
__device__ __forceinline__ float rcpf_(float x) { return __builtin_amdgcn_rcpf(x); }
__device__ __forceinline__ float sigm(float v) { return rcpf_(1.f + ex2(-LOG2E * v)); }
__device__ __forceinline__ float gelu_t(float v) { const float y = v * (1.f + 0.044715f * v * v); return v * rcpf_(1.f + ex2(-2.302208198f * y)); }
__device__ __forceinline__ float wave_sum(float v) {
#pragma unroll
    for (int o = 1; o < 64; o <<= 1) v += __shfl_xor(v, o);
    return v;
}
__device__ __forceinline__ void unpack8(u32x4 w, float (&o)[8]) { o[0] = bf_lo(w.x); o[1] = bf_hi(w.x); o[2] = bf_lo(w.y); o[3] = bf_hi(w.y); o[4] = bf_lo(w.z); o[5] = bf_hi(w.z); o[6] = bf_lo(w.w); o[7] = bf_hi(w.w); }
__device__ __forceinline__ u32x4 pack8(const float (&o)[8]) { u32x4 w; w.x = pk2(o[0], o[1]); w.y = pk2(o[2], o[3]); w.z = pk2(o[4], o[5]); w.w = pk2(o[6], o[7]); return w; }
__device__ __forceinline__ float dot2bf(unsigned a, unsigned b, float acc) { return __builtin_amdgcn_fdot2_f32_bf16(__builtin_bit_cast(bf16x2_t, a), __builtin_bit_cast(bf16x2_t, b), acc, false); }

namespace pg8 {
constexpr int BM = 256, BK = 64, HALF = 128, HTB = HALF * BK * 2, STAGE_BYTES = 8 * HTB, NXCD = 8, WGM = 8;
__host__ __device__ __forceinline__ int lds_byte(int r, int c) { const int st = (r >> 4) * 2 + (c >> 5), rr = r & 15, cc = c & 31, ob = rr * 64 + cc * 2; return st * 1024 + (ob ^ (((ob >> 9) & 1) << 5)); }
__host__ __device__ __forceinline__ void stage_rc(int b, int& R, int& C) { const int st = b / 1024, sb = b % 1024, swz = sb ^ (((sb >> 9) & 1) << 5); R = (st >> 1) * 16 + swz / 64; C = (st & 1) * 32 + (swz % 64) / 2; }
__host__ __device__ __forceinline__ int perm32(int rho) { const int n = rho >> 4, i = rho & 15; return 8 * (i >> 2) + 4 * n + (i & 3); }

struct Unit { int pm, pn; };
struct Gemm { const bf16_t* A; const bf16_t* Bt; int lda, ldb, K, a_pn_off, b_pn_stride; };

struct Sched {
    int nM, nN, nwg, G, c, xpm, xn, xskip;
    __device__ __forceinline__ void init(int nM_, int nN_, int G_, int c_, int xpm_, int xn_, int xskip_) { nM = nM_; nN = nN_; nwg = nM_ * nN_; G = G_; c = c_; xpm = xpm_; xn = xn_; xskip = xskip_; }
    __device__ __forceinline__ bool next(int i, Unit& u) const {
        const int nmain = nwg > c ? (nwg - c - 1) / G + 1 : 0;
        if (i < nmain) {
            int wgid = i * G + c; { const int q = nwg / NXCD, r = nwg % NXCD, xcd = wgid % NXCD, off = wgid / NXCD; wgid = (xcd < r ? xcd * (q + 1) : r * (q + 1) + (xcd - r) * q) + off; }
            const int nig = WGM * nN, gid = wgid / nig, fm = gid * WGM, gsz = (nM - fm) < WGM ? (nM - fm) : WGM;
            u.pm = fm + ((wgid % nig) % gsz); u.pn = (wgid % nig) / gsz; return true;
        }
        const int e = G - 1 - c;
        if (i == nmain && e < xn) { u.pm = xpm; u.pn = e + (e >= 4 ? xskip : 0); return true; }
        return false;
    }
};

template <class F> struct Epi8 {
    static constexpr bool PERM = true;
    F f;
    __device__ __forceinline__ void operator()(const f32x4 (&acc)[2][2][4][2], const Unit& u, int wr, int wc, int fr, int fq) const {
        const int row0 = u.pm * BM + wr * 64 + fr, col0 = u.pn * BM + wc * 32 + 8 * fq;
#pragma unroll
        for (int ai = 0; ai < 2; ++ai) {
            typename F::Pre pre[4][2];
#pragma unroll
            for (int m = 0; m < 4; ++m)
#pragma unroll
                for (int bj = 0; bj < 2; ++bj) pre[m][bj] = f.load(u.pn, row0 + ai * HALF + m * 16, col0 + bj * HALF);
#pragma unroll
            for (int m = 0; m < 4; ++m)
#pragma unroll
                for (int bj = 0; bj < 2; ++bj) f.apply(pre[m][bj], u.pn, row0 + ai * HALF + m * 16, col0 + bj * HALF, acc[ai][bj][m][0], acc[ai][bj][m][1]);
        }
    }
};
template <class F> struct EpiPair {
    static constexpr bool PERM = true;
    F f;
    __device__ __forceinline__ void operator()(const f32x4 (&acc)[2][2][4][2], const Unit& u, int wr, int wc, int fr, int fq) const {
        const int row0 = u.pm * BM + wr * 64 + fr, col0 = wc * 32 + 8 * fq;
#pragma unroll
        for (int ai = 0; ai < 2; ++ai) {
            typename F::Pre pre[4];
#pragma unroll
            for (int m = 0; m < 4; ++m) pre[m] = f.load(u.pn, row0 + ai * HALF + m * 16, col0);
#pragma unroll
            for (int m = 0; m < 4; ++m) f.apply(pre[m], u.pn, row0 + ai * HALF + m * 16, col0, acc[ai][0][m][0], acc[ai][0][m][1], acc[ai][1][m][0], acc[ai][1][m][1]);
        }
    }
};

template <class Epi>
__device__ __forceinline__ void gemm_phase(LAS unsigned char* lds, const Gemm g, const Sched& S, const Epi& E) {
    int tid_ = threadIdx.x; asm volatile("" : "+v"(tid_));
    const int tid = tid_, wid = __builtin_amdgcn_readfirstlane(tid >> 6), lane = tid & 63, wr = wid >> 2, wc = wid & 3, fr = lane & 15, fq = lane >> 4;
    int nt_ = g.K / BK; asm volatile("" : "+s"(nt_));
    const int nt = nt_;
    unsigned voffA[2], voffB[2];
#pragma unroll
    for (int i = 0; i < 2; ++i) { int R, C; stage_rc(tid * 16 + i * 8192, R, C); const int Rb = Epi::PERM ? ((R & ~31) + perm32(R & 31)) : R;
        voffA[i] = (unsigned)(R * g.lda + C) * 2u; voffB[i] = (unsigned)(Rb * g.ldb + C) * 2u; }
    const size_t kstep = (size_t)(BK * 2);
    const size_t hA = (size_t)HALF * g.lda * 2, hB = (size_t)HALF * g.ldb * 2;
    const unsigned ldsw = (unsigned)wid * 1024u;
    const int aoff = lds_byte(wr * 64 + fr, fq * 8), boff = lds_byte(wc * 32 + fr, fq * 8);
#define PG8_SA(b, h) (((b) * 2 + (h)) * HTB)
#define PG8_SB(b, h) ((4 + (b) * 2 + (h)) * HTB)
#define PG8_STAGE(bufoff, gbase, voff) do { _Pragma("unroll") for (int _i = 0; _i < 2; ++_i) \
        __builtin_amdgcn_global_load_lds((const unsigned*)((const char*)(gbase) + (voff)[_i]), (LAS unsigned*)(lds + (bufoff) + ldsw + _i * 8192), 16, 0, 0); } while (0)
#define PG8_LDA(dst, b, h) do { _Pragma("unroll") for (int m = 0; m < 4; ++m) _Pragma("unroll") for (int k = 0; k < 2; ++k) dst[m][k] = *(const LAS bf16x8*)(lds + PG8_SA(b, h) + aoff + m * 2048 + k * 1024); } while (0)
#define PG8_LDB(dst, b, h) do { _Pragma("unroll") for (int n = 0; n < 2; ++n) _Pragma("unroll") for (int k = 0; k < 2; ++k) dst[n][k] = *(const LAS bf16x8*)(lds + PG8_SB(b, h) + boff + n * 2048 + k * 1024); } while (0)
#define PG8_MMA(ai, bj, At, Bt) do { __builtin_amdgcn_s_setprio(1); _Pragma("unroll") for (int m = 0; m < 4; ++m) _Pragma("unroll") for (int n = 0; n < 2; ++n) _Pragma("unroll") for (int k = 0; k < 2; ++k) \
        acc[ai][bj][m][n] = __builtin_amdgcn_mfma_f32_16x16x32_bf16(Bt[n][k], At[m][k], acc[ai][bj][m][n], 0, 0, 0); __builtin_amdgcn_s_setprio(0); } while (0)
#define PG8_WAIT_V(n) asm volatile("s_waitcnt vmcnt(" #n ")" ::: "memory")
#define PG8_WAIT_L(n) asm volatile("s_waitcnt lgkmcnt(" #n ")" ::: "memory")
#define PG8_BAR __builtin_amdgcn_s_barrier()
#define PG8_SCHED __builtin_amdgcn_sched_barrier(0)
#define PG8_ABASE(u) ((const char*)g.A + ((size_t)(u).pm * BM * g.lda + (size_t)(u).pn * g.a_pn_off) * 2)
#define PG8_BBASE(u) ((const char*)g.Bt + (size_t)(u).pn * g.b_pn_stride * 2)
    Unit cur, nxt; int ui = 0;
    if (!S.next(0, cur)) return;
    f32x4 acc[2][2][4][2];
#pragma unroll
    for (int a = 0; a < 2; ++a)
#pragma unroll
        for (int b = 0; b < 2; ++b)
#pragma unroll
            for (int m = 0; m < 4; ++m)
#pragma unroll
                for (int n = 0; n < 2; ++n) acc[a][b][m][n] = (f32x4){0.f, 0.f, 0.f, 0.f};
    bf16x8 At[4][2], B0[2][2], B1[2][2];
    const char* cA = PG8_ABASE(cur); const char* cB = PG8_BBASE(cur);
    PG8_STAGE(PG8_SB(0, 0), cB, voffB); PG8_STAGE(PG8_SB(0, 1), cB + hB, voffB); PG8_STAGE(PG8_SA(0, 0), cA, voffA); PG8_STAGE(PG8_SA(0, 1), cA + hA, voffA);
    if (wr == 1) PG8_BAR;
    PG8_WAIT_V(2); PG8_BAR;
    PG8_STAGE(PG8_SB(1, 0), cB + kstep, voffB); PG8_STAGE(PG8_SA(1, 0), cA + kstep, voffA); PG8_STAGE(PG8_SB(1, 1), cB + hB + kstep, voffB);
    PG8_WAIT_V(6); PG8_BAR;
    for (;;) {
        const bool has_next = S.next(ui + 1, nxt);
        const char* nA = has_next ? PG8_ABASE(nxt) : cA; const char* nB = has_next ? PG8_BBASE(nxt) : cB;
        asm volatile("" : "+s"(cA), "+s"(cB), "+s"(nA), "+s"(nB));
#pragma unroll 1
        for (int t = 0; t < nt; t += 2) {
            const bool last = (t == nt - 2);
            const char* a1 = cA + (size_t)(t + 1) * kstep;
            const char* a2 = last ? nA : cA + (size_t)(t + 2) * kstep; const char* b2 = last ? nB : cB + (size_t)(t + 2) * kstep;
            const char* a3 = a2 + kstep; const char* b3 = b2 + kstep;
            PG8_LDB(B0, 0, 0); PG8_LDB(B1, 0, 1); PG8_SCHED; PG8_LDA(At, 0, 0); PG8_STAGE(PG8_SA(1, 1), a1 + hA, voffA);
            PG8_WAIT_V(8); PG8_WAIT_L(0); PG8_BAR; PG8_MMA(0, 0, At, B0); PG8_MMA(0, 1, At, B1); PG8_BAR; PG8_SCHED;
            PG8_LDA(At, 0, 1); PG8_STAGE(PG8_SB(0, 0), b2, voffB); PG8_STAGE(PG8_SB(0, 1), b2 + hB, voffB); PG8_STAGE(PG8_SA(0, 0), a2, voffA);
            PG8_WAIT_V(8); PG8_WAIT_L(0); PG8_BAR; PG8_MMA(1, 0, At, B0); PG8_MMA(1, 1, At, B1); PG8_BAR; PG8_SCHED;
            PG8_LDB(B0, 1, 0); PG8_LDB(B1, 1, 1); PG8_SCHED; PG8_LDA(At, 1, 0); PG8_STAGE(PG8_SA(0, 1), a2 + hA, voffA);
            PG8_WAIT_V(8); PG8_WAIT_L(0); PG8_BAR; PG8_MMA(0, 0, At, B0); PG8_MMA(0, 1, At, B1); PG8_BAR; PG8_SCHED;
            PG8_LDA(At, 1, 1); PG8_STAGE(PG8_SB(1, 0), b3, voffB); PG8_STAGE(PG8_SB(1, 1), b3 + hB, voffB); PG8_STAGE(PG8_SA(1, 0), a3, voffA);
            PG8_WAIT_V(8); PG8_WAIT_L(0); PG8_BAR; PG8_MMA(1, 0, At, B0); PG8_MMA(1, 1, At, B1); PG8_BAR; PG8_SCHED;
        }
        if (wr == 0) PG8_BAR;
        E(acc, cur, wr, wc, fr, fq);
        if (!has_next) break;
#pragma unroll
        for (int a = 0; a < 2; ++a)
#pragma unroll
            for (int b = 0; b < 2; ++b)
#pragma unroll
                for (int m = 0; m < 4; ++m)
#pragma unroll
                    for (int n = 0; n < 2; ++n) acc[a][b][m][n] = (f32x4){0.f, 0.f, 0.f, 0.f};
        cur = nxt; cA = nA; cB = nB; ++ui;
        if (wr == 1) PG8_BAR;
    }
    PG8_WAIT_V(0);
    PG8_BAR;
#undef PG8_SA
#undef PG8_SB
#undef PG8_STAGE
#undef PG8_LDA
#undef PG8_LDB
#undef PG8_MMA
#undef PG8_WAIT_V
#undef PG8_WAIT_L
#undef PG8_BAR
#undef PG8_SCHED
#undef PG8_ABASE
#undef PG8_BBASE
}
}

#define XB_TMO      128
#define XB_XCNT(j)  (256  + 64 * (j))
#define XB_XSUB(j)  (1280 + 64 * (j))
#define XB_XGEN(j)  (2304 + 64 * (j))
#define XB_TOP      3328
#define XB_TOPGEN   3392
#define XCD_BAR_WORDS 3456
#define XB_SPIN_CAP (1u << 18)
__device__ __forceinline__ unsigned xb_ld(unsigned* p)              { return __hip_atomic_load(p, __ATOMIC_RELAXED, __HIP_MEMORY_SCOPE_AGENT); }
__device__ __forceinline__ unsigned xb_add(unsigned* p, unsigned v) { return __hip_atomic_fetch_add(p, v, __ATOMIC_RELAXED, __HIP_MEMORY_SCOPE_AGENT); }
__device__ __forceinline__ unsigned xb_xcc_id() { return (unsigned)__builtin_amdgcn_s_getreg((3 << 11) | 20) & 0xFu; }
#define XB_SPIN(cond, bar) do { unsigned _sp = 0; while (cond) { __builtin_amdgcn_s_sleep(1); \
    if ((++_sp & 255u) == 0u) { if (xb_ld(&(bar)[XB_TMO])) break; if (_sp > XB_SPIN_CAP) { atomicAdd(&(bar)[XB_TMO], 1u); break; } } } } while (0)
struct XcdBarrier { unsigned* bar; unsigned x; volatile LAS unsigned* st; };
__device__ __forceinline__ XcdBarrier xcd_barrier_post(unsigned* bar, volatile LAS unsigned* st) {
    XcdBarrier b; b.bar = bar; b.x = xb_xcc_id(); b.st = st;
    if (threadIdx.x == 0) (void)xb_add(&bar[XB_XCNT(b.x)], 1u);
    return b;
}
__device__ __forceinline__ void xcd_barrier_complete(unsigned* bar, unsigned x, unsigned& nloc, unsigned& nx) {
    const unsigned G = gridDim.x * gridDim.y * gridDim.z;
    unsigned sum, cnt, mine, sp = 0u;
    for (;;) {
        sum = 0u; cnt = 0u; mine = 0u;
#pragma unroll
        for (unsigned j = 0; j < 16; ++j) { const unsigned c = xb_ld(&bar[XB_XCNT(j)]); sum += c; cnt += (c > 0u) ? 1u : 0u; mine = (j == x) ? c : mine; }
        if (sum == G) break;
        __builtin_amdgcn_s_sleep(1);
        if ((++sp & 255u) == 0u) { if (xb_ld(&bar[XB_TMO])) break; if (sp > XB_SPIN_CAP) { atomicAdd(&bar[XB_TMO], 1u); break; } }
    }
    nloc = mine > 0u ? mine : 1u; nx = cnt > 0u ? cnt : 1u;
}
__device__ __forceinline__ void xcd_barrier(const XcdBarrier& b) {
    asm volatile("s_waitcnt vmcnt(0)" ::: "memory");
    __syncthreads();
    if (threadIdx.x == 0) {
        unsigned* bar = b.bar;
        __builtin_amdgcn_s_waitcnt(0);
        unsigned nloc = b.st[0], nx = b.st[1];
        if (nloc == 0u) { xcd_barrier_complete(bar, b.x, nloc, nx); b.st[0] = nloc; b.st[1] = nx; }
        const unsigned old = xb_add(&bar[XB_XSUB(b.x)], 1u);
        const unsigned gen = old / nloc;
        if (old + 1u == (gen + 1u) * nloc) {
            __builtin_amdgcn_fence(__ATOMIC_RELEASE, "agent");
            asm volatile("s_waitcnt vmcnt(0)" ::: "memory");
            const unsigned og = xb_add(&bar[XB_TOP], 1u);
            const unsigned tg = og / nx;
            if (og + 1u == (tg + 1u) * nx) xb_add(&bar[XB_TOPGEN], 1u);
            else XB_SPIN(xb_ld(&bar[XB_TOPGEN]) == tg, bar);
            __builtin_amdgcn_fence(__ATOMIC_ACQUIRE, "agent");
            xb_add(&bar[XB_XGEN(b.x)], 1u);
            asm volatile("s_waitcnt vmcnt(0)" ::: "memory");
        } else {
            XB_SPIN(xb_ld(&bar[XB_XGEN(b.x)]) == gen, bar);
            __builtin_amdgcn_fence(__ATOMIC_ACQUIRE, "agent");
            asm volatile("s_waitcnt vmcnt(0)" ::: "memory");
        }
    }
    __syncthreads();
}

constexpr int NWAVES = 8, NTHR = 512;
constexpr int RING_BYTES = 131072, MISC_OFF = RING_BYTES + 320, LDS_BYTES = 147456;
struct Args { const float* in[25]; float* out; unsigned char* ws; int ph_lo, ph_hi; };
static_assert(sizeof(Args) == 25 * 8 + 8 + 8 + 8, "Args has no padding");

struct Ctx {
    LAS unsigned char* lds; int tid, lane, wave, G, gw, NGW;
    unsigned char* ws; float* out; const float* const* in;
};

__device__ __forceinline__ void store8(bf16_t* p, f32x4 a, f32x4 b) { u32x4 w; w.x = pk2(a[0], a[1]); w.y = pk2(a[2], a[3]); w.z = pk2(b[0], b[1]); w.w = pk2(b[2], b[3]); *(u32x4*)p = w; }
struct NoPre {};
struct FInproj {
    typedef NoPre Pre;
    bf16_t *XR, *GR, *CQKV, *GRNN, *GATT;
    __device__ __forceinline__ Pre load(int, int, int) const { return Pre(); }
    __device__ __forceinline__ void apply(const Pre&, int pn, int row, int col, f32x4 a, f32x4 b) const {
        if (pn < 4) { store8(XR + (size_t)row * 1024 + col, a, b); }
        else if (pn < 8) {
#pragma unroll
            for (int i = 0; i < 4; ++i) { a[i] = gelu_t(a[i]); b[i] = gelu_t(b[i]); }
            store8(GR + (size_t)row * 1024 + (col - 1024), a, b); }
        else if (pn < 11) { store8(CQKV + (size_t)row * CQKV_LD + (col - 2048), a, b); }
        else {
#pragma unroll
            for (int i = 0; i < 4; ++i) { a[i] = sigm(a[i]); b[i] = sigm(b[i]); }
            if (pn < 15) store8(GRNN + (size_t)row * 1024 + (col - 2816), a, b); else store8(GATT + (size_t)row * 1024 + (col - 3840), a, b); }
    }
};
struct FGate {
    struct Pre { u32x4 xc; };
    const bf16_t* XC; const float *ba, *bx, *clam; bf16_t *LA, *UU;
    __device__ __forceinline__ Pre load(int pn, int row, int cl) const { Pre p; p.xc = *(const u32x4*)(XC + (size_t)row * 1024 + pn * 128 + cl); return p; }
    __device__ __forceinline__ void apply(const Pre& pr, int pn, int row, int cl, f32x4 a0, f32x4 a1, f32x4 x0, f32x4 x1) const {
        const int ch = pn * 128 + cl; const size_t off = (size_t)row * 1024 + ch;
        float xc[8]; unpack8(pr.xc, xc);
        const f32x4 ba0 = *(const f32x4*)(ba + ch), ba1 = *(const f32x4*)(ba + ch + 4), bx0 = *(const f32x4*)(bx + ch), bx1 = *(const f32x4*)(bx + ch + 4), cl0 = *(const f32x4*)(clam + ch), cl1 = *(const f32x4*)(clam + ch + 4);
        float la[8], uu[8];
#pragma unroll
        for (int i = 0; i < 8; ++i) {
            const float ga = (i < 4 ? a0[i & 3] + ba0[i & 3] : a1[i & 3] + ba1[i & 3]), gx = (i < 4 ? x0[i & 3] + bx0[i & 3] : x1[i & 3] + bx1[i & 3]), cc = (i < 4 ? cl0[i & 3] : cl1[i & 3]);
            const float r = sigm(ga), ig = sigm(gx), l = r * cc;
            la[i] = l; uu[i] = sqrtf(fmaxf(1.f - ex2(2.f * LOG2E * l), 0.f)) * (ig * xc[i]);
        }
        *(u32x4*)(LA + off) = pack8(la); *(u32x4*)(UU + off) = pack8(uu);
    }
};
struct FQ {
    struct Pre { float sc; };
    const float* rsq; bf16_t* Q;
    __device__ __forceinline__ Pre load(int, int row, int) const { Pre p; p.sc = rsq[row]; return p; }
    __device__ __forceinline__ void apply(const Pre& pr, int pn, int row, int col, f32x4 a, f32x4 b) const {
        const float sc = pr.sc * QSCALE; a = a * sc; b = b * sc;
        store8(Q + (size_t)row * QLD + col, a, b);
    }
};
struct FKV {
    struct Pre { float sc; };
    const float* rskv; bf16_t *KN, *V;
    __device__ __forceinline__ Pre load(int, int row, int) const { Pre p; p.sc = rskv[row]; return p; }
    __device__ __forceinline__ void apply(const Pre& pr, int pn, int row, int col, f32x4 a, f32x4 b) const {
        const float sc = pr.sc; a = a * sc; b = b * sc;
        if (pn < 4) store8(KN + (size_t)row * 1024 + col, a, b); else store8(V + (size_t)row * 1024 + (col - 1024), a, b);
    }
};
template <bool HAS_ADD> struct FMul {
    struct Pre { u32x4 g, ad; };
    const bf16_t* Gt; const bf16_t* ADD; bf16_t* O;
    __device__ __forceinline__ Pre load(int, int row, int col) const { const size_t off = (size_t)row * 1024 + col; Pre p; p.g = *(const u32x4*)(Gt + off); if (HAS_ADD) p.ad = *(const u32x4*)(ADD + off); else p.ad = (u32x4){0u, 0u, 0u, 0u}; return p; }
    __device__ __forceinline__ void apply(const Pre& pr, int pn, int row, int col, f32x4 a, f32x4 b) const {
        const size_t off = (size_t)row * 1024 + col; float gg[8]; unpack8(pr.g, gg);
        if (HAS_ADD) { float ad[8]; unpack8(pr.ad, ad);
#pragma unroll
            for (int i = 0; i < 4; ++i) { a[i] = ad[i] + gg[i] * a[i]; b[i] = ad[4 + i] + gg[4 + i] * b[i]; } }
        else {
#pragma unroll
            for (int i = 0; i < 4; ++i) { a[i] = gg[i] * a[i]; b[i] = gg[4 + i] * b[i]; } }
        store8(O + off, a, b);
    }
};
struct FRes {
    struct Pre { f32x4 x0, x1; };
    const float* X; bf16_t* H1B;
    __device__ __forceinline__ Pre load(int, int row, int col) const { const size_t off = (size_t)row * 1024 + col; Pre p; p.x0 = *(const f32x4*)(X + off); p.x1 = *(const f32x4*)(X + off + 4); return p; }
    __device__ __forceinline__ void apply(const Pre& pr, int pn, int row, int col, f32x4 a, f32x4 b) const {
        store8(H1B + (size_t)row * 1024 + col, a + pr.x0, b + pr.x1);
    }
};
typedef _Float16 f16x8 __attribute__((ext_vector_type(8)));
struct FF16 { typedef NoPre Pre; _Float16* O; int ldc;
    __device__ __forceinline__ Pre load(int, int, int) const { return Pre(); }
    __device__ __forceinline__ void apply(const Pre&, int pn, int row, int col, f32x4 a, f32x4 b) const {
        f16x8 h = {(_Float16)a[0], (_Float16)a[1], (_Float16)a[2], (_Float16)a[3], (_Float16)b[0], (_Float16)b[1], (_Float16)b[2], (_Float16)b[3]};
        *(f16x8*)(O + (size_t)row * ldc + col) = h; } };
struct FF32 { typedef NoPre Pre; float* O; int ldc;
    __device__ __forceinline__ Pre load(int, int, int) const { return Pre(); }
    __device__ __forceinline__ void apply(const Pre&, int pn, int row, int col, f32x4 a, f32x4 b) const { float* p = O + (size_t)row * ldc + col; *(f32x4*)p = a; *(f32x4*)(p + 4) = b; } };

struct MapId { __device__ __forceinline__ int operator()(int n) const { return n; } };
struct MapWin { __device__ __forceinline__ int operator()(int n) const {
    if (n < 2048) return n;
    if (n < 2816) { const int c = n - 2048; if (c < 256) return 2432 + c; if (c < 288) return 2688 + (c - 256); if (c < 384) return -1; return 2048 + (c - 384); }
    if (n < 3840) return 2720 + (n - 2816);
    return 3744 + (n - 3840); } };
struct MapUq { __device__ __forceinline__ int operator()(int n) const { const int h = n / 96, w = n % 96; if (w < 64) return n; const int t = w - 64; return h * 96 + 64 + (t >> 1) + 16 * (t & 1); } };
struct MapUkv { __device__ __forceinline__ int operator()(int n) const { if (n < 1024) return (n >> 6) * 128 + (n & 63); const int m = n - 1024; return (m >> 6) * 128 + 64 + (m & 63); } };

template <class Map> __device__ __forceinline__ void transpose_item(const float* W, int ldw, int Ndst, bf16_t* WT, int ldt, const float* kscale, LAS float* scr, int item, int lane, Map map) {
    const int nblk = Ndst / 32, kb = item / nblk, nb = item % nblk, k0 = 64 * kb, n0 = 32 * nb;
    const int src = map(n0 + (lane & 31));
#pragma unroll 8
    for (int i = 0; i < 32; ++i) { const int kk = 2 * i + (lane >> 5); float v = 0.f; if (src >= 0) { v = W[(size_t)(k0 + kk) * ldw + src]; if (kscale) v *= kscale[k0 + kk]; } scr[kk * 33 + (lane & 31)] = v; }
    LDS_WAIT(); asm volatile("" ::: "memory");
    const int c = lane & 7;
#pragma unroll
    for (int j = 0; j < 4; ++j) { const int n = (lane >> 3) + 8 * j; const LAS float* s = scr + (8 * c) * 33 + n;
        u32x4 o; o.x = pk2(s[0 * 33], s[1 * 33]); o.y = pk2(s[2 * 33], s[3 * 33]); o.z = pk2(s[4 * 33], s[5 * 33]); o.w = pk2(s[6 * 33], s[7 * 33]);
        *(u32x4*)(WT + (size_t)(n0 + n) * ldt + k0 + 8 * c) = o; }
    LDS_WAIT(); asm volatile("" ::: "memory");
}
__device__ __forceinline__ void rms_row_bf16(const float* xrow, const float* g, bf16_t* orow, int lane) {
    const f32x4* xr = (const f32x4*)xrow + lane; f32x4 v[4]; float s = 0.f;
#pragma unroll
    for (int j = 0; j < 4; ++j) { v[j] = xr[64 * j]; s += (v[j][0] * v[j][0] + v[j][1] * v[j][1]) + (v[j][2] * v[j][2] + v[j][3] * v[j][3]); }
    const float rstd = 1.f / sqrtf(wave_sum(s) * (1.f / 1024.f) + EPS);
    u32x2* o8 = (u32x2*)orow + lane;
#pragma unroll
    for (int j = 0; j < 4; ++j) { const f32x4 gg = ((const f32x4*)g)[lane + 64 * j]; u32x2 w; w.x = pk2(v[j][0] * rstd * gg[0], v[j][1] * rstd * gg[1]); w.y = pk2(v[j][2] * rstd * gg[2], v[j][3] * rstd * gg[3]); o8[64 * j] = w; }
}
__device__ __forceinline__ void rms_row_f32(const float* xrow, const float* g, float* orow, int lane) {
    const f32x4* xr = (const f32x4*)xrow + lane; f32x4 v[4]; float s = 0.f;
#pragma unroll
    for (int j = 0; j < 4; ++j) { v[j] = xr[64 * j]; s += (v[j][0] * v[j][0] + v[j][1] * v[j][1]) + (v[j][2] * v[j][2] + v[j][3] * v[j][3]); }
    const float rstd = 1.f / sqrtf(wave_sum(s) * (1.f / 1024.f) + EPS);
#pragma unroll
    for (int j = 0; j < 4; ++j) { const f32x4 gg = ((const f32x4*)g)[lane + 64 * j]; ((f32x4*)orow)[lane + 64 * j] = v[j] * rstd * gg; }
}

__device__ __forceinline__ void phase_prologue(const Ctx& C) {
    unsigned char* ws = C.ws; const float* const* in = C.in;
    LAS float* scr = (LAS float*)(C.lds + C.wave * 16384);
    const int gw = C.gw, NGW = C.NGW, lane = C.lane;
    constexpr int I_WIN = 16 * (DIN_P / 32), I_UQ = 6 * (1536 / 32), I_UKV = 4 * (2048 / 32), I_SQ = 16 * 32, I_G = 2 * 4;
    constexpr int NITEMS = I_WIN + I_UQ + I_UKV + 3 * I_SQ + 16 * I_G;
    for (int it = gw; it < NITEMS; it += NGW) {
        int r = it;
        if (r < I_WIN) { transpose_item(in[3], 4768, DIN_P, (bf16_t*)(ws + WS_WIN), 1024, nullptr, scr, r, lane, MapWin()); continue; } r -= I_WIN;
        if (r < I_UQ) { transpose_item(in[13], 1536, 1536, (bf16_t*)(ws + WS_WUQ), 384, in[12], scr, r, lane, MapUq()); continue; } r -= I_UQ;
        if (r < I_UKV) { transpose_item(in[15], 2048, 2048, (bf16_t*)(ws + WS_WUKV), 256, in[14], scr, r, lane, MapUkv()); continue; } r -= I_UKV;
        if (r < I_SQ) { transpose_item(in[11], 1024, 1024, (bf16_t*)(ws + WS_WRNN), 1024, nullptr, scr, r, lane, MapId()); continue; } r -= I_SQ;
        if (r < I_SQ) { transpose_item(in[16], 1024, 1024, (bf16_t*)(ws + WS_WATT), 1024, nullptr, scr, r, lane, MapId()); continue; } r -= I_SQ;
        if (r < I_SQ) { transpose_item(in[17], 1024, 1024, (bf16_t*)(ws + WS_WOUT), 1024, nullptr, scr, r, lane, MapId()); continue; } r -= I_SQ;
        { const int mat = r / I_G, sub = r % I_G, blk = mat >> 1, which = mat & 1;
          transpose_item((which ? in[8] : in[6]) + (size_t)blk * 16384, 128, 128, (bf16_t*)(ws + WS_WGATE) + (size_t)(blk * 256 + which * 128) * 128, 128, nullptr, scr, sub, lane, MapId()); }
    }
    const int gt = blockIdx.x * NTHR + C.tid, NT = C.G * NTHR;
    for (int it = blockIdx.x; it < 256; it += C.G) {
        const int hh = it >> 4, kc = it & 15, half = hh & 1, k = kc * 64 + lane, c0 = 16 * C.wave;
        const f32x4* keys = (const f32x4*)((half ? in[21] : in[20]) + (size_t)c0 * 128);
        LAS f32x4* ks = (LAS f32x4*)scr;
#pragma unroll
        for (int j = 0; j < 8; ++j) ks[j * 64 + lane] = keys[j * 64 + lane];
        const f32x4* wq = (const f32x4*)(in[19] + (size_t)k * 2048 + hh * 128); const float g2k = in[18][k];
        f32x4 a[32];
#pragma unroll
        for (int d4 = 0; d4 < 32; ++d4) a[d4] = wq[d4];
        LDS_WAIT(); asm volatile("" ::: "memory");
        bf16_t* o = (bf16_t*)(ws + WS_WPQ) + (size_t)(hh * 128 + c0) * 1024 + k;
#pragma unroll 4
        for (int c = 0; c < 16; ++c) { float s0 = 0.f, s1 = 0.f;
#pragma unroll
            for (int d4 = 0; d4 < 32; d4 += 2) { const f32x4 k0 = ks[c * 32 + d4], k1 = ks[c * 32 + d4 + 1]; s0 += (a[d4][0] * k0[0] + a[d4][1] * k0[1]) + (a[d4][2] * k0[2] + a[d4][3] * k0[3]); s1 += (a[d4 + 1][0] * k1[0] + a[d4 + 1][1] * k1[1]) + (a[d4 + 1][2] * k1[2] + a[d4 + 1][3] * k1[3]); }
            o[(size_t)c * 1024] = (bf16_t)(pk2((s0 + s1) * g2k, 0.f) & 0xffffu); }
        LDS_WAIT(); asm volatile("" ::: "memory");
    }
    for (int i = gt; i < NPOS * 16; i += NT) { const int pos = i >> 4, j = i & 15; const float inv = exp2f(-(float)j * (13.287712379549449f / 16.f)); const float ang = (float)pos * inv;
        float t = ang * 0.15915494309189535f; t = t - floorf(t);
        ((float*)(ws + WS_CTAB))[i] = __builtin_amdgcn_cosf(t); ((float*)(ws + WS_STAB))[i] = __builtin_amdgcn_sinf(t); }
    for (int i = gt; i < 1024; i += NT) { const float lam = in[10][i]; ((float*)(ws + WS_CLAM))[i] = -8.f * log1pf(expf(-lam)); }
    {
        f32x4 g2n[4];
#pragma unroll
        for (int j = 0; j < 4; ++j) g2n[j] = ((const f32x4*)(in[18] + 16 * lane))[j];
        for (int e = gw; e < NEXP; e += NGW) {
            f32x4 v[4]; float am = 0.f;
#pragma unroll
            for (int j = 0; j < 4; ++j) { v[j] = ((const f32x4*)(in[22] + (size_t)e * 1024 + 16 * lane))[j] * g2n[j]; am = fmaxf(am, fmaxf(fmaxf(fabsf(v[j][0]), fabsf(v[j][1])), fmaxf(fabsf(v[j][2]), fabsf(v[j][3])))); }
#pragma unroll
            for (int o = 1; o < 64; o <<= 1) am = fmaxf(am, __shfl_xor(am, o));
            const float scale = am > 0.f ? am * (1.f / 127.f) : 1.f, inv = 1.f / scale;
            u32x4 w;
#pragma unroll
            for (int j = 0; j < 4; ++j) { const int q0 = (int)rintf(v[j][0] * inv), q1 = (int)rintf(v[j][1] * inv), q2 = (int)rintf(v[j][2] * inv), q3 = (int)rintf(v[j][3] * inv);
                w[j] = (unsigned)(q0 & 255) | ((unsigned)(q1 & 255) << 8) | ((unsigned)(q2 & 255) << 16) | ((unsigned)q3 << 24); }
            *(u32x4*)(ws + WS_PU + (size_t)e * 1024 + 16 * lane) = w;
            if (lane == 0) ((float*)(ws + WS_SU))[e] = scale;
        }
    }
    for (int e = gw; e < NEXP; e += NGW) {
        f32x4 v[4]; float am = 0.f;
#pragma unroll
        for (int j = 0; j < 4; ++j) { v[j] = ((const f32x4*)(in[23] + (size_t)e * 1024 + 16 * lane))[j]; am = fmaxf(am, fmaxf(fmaxf(fabsf(v[j][0]), fabsf(v[j][1])), fmaxf(fabsf(v[j][2]), fabsf(v[j][3])))); }
#pragma unroll
        for (int o = 1; o < 64; o <<= 1) am = fmaxf(am, __shfl_xor(am, o));
        const float scale = am > 0.f ? am * (1.f / 6.f) : 1.f, inv = 1.f / scale;
        u32x2 w;
#pragma unroll
        for (int d = 0; d < 2; ++d) { unsigned p = 0u;
            p = __builtin_amdgcn_cvt_scalef32_pk_fp4_f32(p, v[2 * d][0] * inv, v[2 * d][1] * inv, 1.0f, 0); p = __builtin_amdgcn_cvt_scalef32_pk_fp4_f32(p, v[2 * d][2] * inv, v[2 * d][3] * inv, 1.0f, 1);
            p = __builtin_amdgcn_cvt_scalef32_pk_fp4_f32(p, v[2 * d + 1][0] * inv, v[2 * d + 1][1] * inv, 1.0f, 2); p = __builtin_amdgcn_cvt_scalef32_pk_fp4_f32(p, v[2 * d + 1][2] * inv, v[2 * d + 1][3] * inv, 1.0f, 3);
            w[d] = p; }
        *(u32x2*)(ws + WS_PV + (size_t)e * 512 + 8 * lane) = w;
        if (lane == 0) ((float*)(ws + WS_SV))[e] = scale;
    }
    bf16_t* N1 = (bf16_t*)(ws + SLOT(0));
    {
        f32x4 gg[4];
#pragma unroll
        for (int j = 0; j < 4; ++j) gg[j] = ((const f32x4*)in[2])[lane + 64 * j];
        int m = gw; f32x4 nv[4];
        if (m < M) {
#pragma unroll
            for (int j = 0; j < 4; ++j) nv[j] = ((const f32x4*)(in[0] + (size_t)m * 1024))[lane + 64 * j]; }
        for (; m < M; m += NGW) {
            f32x4 v[4]; float sq = 0.f;
#pragma unroll
            for (int j = 0; j < 4; ++j) { v[j] = nv[j]; sq += (v[j][0] * v[j][0] + v[j][1] * v[j][1]) + (v[j][2] * v[j][2] + v[j][3] * v[j][3]); }
            if (m + NGW < M) {
#pragma unroll
                for (int j = 0; j < 4; ++j) nv[j] = ((const f32x4*)(in[0] + (size_t)(m + NGW) * 1024))[lane + 64 * j]; }
            const float rstd = 1.f / sqrtf(wave_sum(sq) * (1.f / 1024.f) + EPS);
            u32x2* o8 = (u32x2*)(N1 + (size_t)m * 1024) + lane;
#pragma unroll
            for (int j = 0; j < 4; ++j) { u32x2 w; w.x = pk2(v[j][0] * rstd * gg[j][0], v[j][1] * rstd * gg[j][1]); w.y = pk2(v[j][2] * rstd * gg[j][2], v[j][3] * rstd * gg[j][3]); o8[64 * j] = w; }
        }
    }
    for (int m = gw; m < 256; m += NGW) {
        if (m < NMETA) rms_row_bf16(in[1] + (size_t)m * 1024, in[2], N1 + (size_t)(METAROW + m) * 1024, lane);
        else { u32x4* o = (u32x4*)(N1 + (size_t)(METAROW + m) * 1024); o[lane] = (u32x4){0u, 0u, 0u, 0u}; o[64 + lane] = (u32x4){0u, 0u, 0u, 0u}; }
    }
}

__device__ __forceinline__ int prev_row(int r, int j) {
    if (r < M) { const int s = r & (SEQ - 1); return s >= j ? r - j : METAROW + NMETA + (s - j); }
    const int p = r - METAROW; return p >= j ? r - j : -1;
}
struct ThinRow { u32x4 xa, xb, cq, ckv; unsigned k1, k2; };
__device__ __forceinline__ ThinRow thin_load(const bf16_t* XR, const bf16_t* CQKV, int r, int lane) {
    ThinRow d; const bf16_t* z = CQKV + (size_t)r * CQKV_LD;
    d.xa = *(const u32x4*)(XR + (size_t)r * 1024 + lane * 8); d.xb = *(const u32x4*)(XR + (size_t)r * 1024 + 512 + lane * 8);
    d.cq = *(const u32x4*)(z + CQ_OFF + (lane < 48 ? lane : 0) * 8); d.ckv = *(const u32x4*)(z + (lane & 31) * 8);
    d.k1 = z[KR_OFF + (lane & 15)]; d.k2 = z[KR_OFF + 16 + (lane & 15)];
    return d;
}
__device__ __forceinline__ void thin_row_stats(unsigned char* ws, const ThinRow& d, int r, int lane) {
    float* RSQ = (float*)(ws + WS_RSQ); float* RSKV = (float*)(ws + WS_RSKV); bf16_t* KROPE = (bf16_t*)(ws + WS_KROPE);
    float sq = 0.f, skv = 0.f;
    { float v[8]; unpack8(d.cq, v); float a = 0.f;
#pragma unroll
      for (int i = 0; i < 8; ++i) a += v[i] * v[i];
      sq = lane < 48 ? a : 0.f; }
    { float v[8]; unpack8(d.ckv, v); float a = 0.f;
#pragma unroll
      for (int i = 0; i < 8; ++i) a += v[i] * v[i];
      skv = lane < 32 ? a : 0.f; }
    sq = wave_sum(sq); skv = wave_sum(skv);
    if (lane == 0) { RSQ[r] = 1.f / sqrtf(sq * (1.f / 384.f) + EPS); RSKV[r] = 1.f / sqrtf(skv * (1.f / 256.f) + EPS); }
    if (lane < 16) { const int pos = r < M ? NMETA + (r & (SEQ - 1)) : r - METAROW; const float x1 = bf2f((bf16_t)d.k1), x2 = bf2f((bf16_t)d.k2);
        const float c = ((const float*)(ws + WS_CTAB))[pos * 16 + lane], s = ((const float*)(ws + WS_STAB))[pos * 16 + lane];
        ((unsigned*)(KROPE + (size_t)r * 32))[lane] = pk2(x1 * c - x2 * s, x1 * s + x2 * c); }
}
__device__ __forceinline__ void phase_thin(const Ctx& C) {
    unsigned char* ws = C.ws; const float* const* in = C.in; const int lane = C.lane;
    const bf16_t* XR = (const bf16_t*)(ws + SLOT(1)); const bf16_t* CQKV = (const bf16_t*)(ws + SLOT(3)); bf16_t* XC = (bf16_t*)(ws + SLOT(0));
    const float* cw = in[4]; const float* cb = in[5];
    float w[4][16], bias[16];
#pragma unroll
    for (int hh = 0; hh < 2; ++hh)
#pragma unroll
        for (int i = 0; i < 8; ++i) { const int ch = hh * 512 + lane * 8 + i; bias[hh * 8 + i] = cb[ch];
#pragma unroll
            for (int t = 0; t < 4; ++t) w[t][hh * 8 + i] = cw[t * 1024 + ch]; }
    for (int st = C.gw; st < M / 32 + 1; st += C.NGW) {
        const bool meta = st == M / 32; const int r0 = meta ? METAROW : st * 32, nrow = meta ? NMETA : 32;
        float x1[16], x2[16], x3[16];
        const bool first = meta || (r0 & (SEQ - 1)) == 0;
        ThinRow nx = thin_load(XR, CQKV, r0, lane);
#pragma unroll
        for (int j = 1; j <= 3; ++j) { const int pr = first ? (meta ? -1 : METAROW + NMETA - j) : r0 - j;
#pragma unroll
            for (int hh = 0; hh < 2; ++hh) { float v[8];
                if (pr >= 0) unpack8(*(const u32x4*)(XR + (size_t)pr * 1024 + hh * 512 + lane * 8), v); else {
#pragma unroll
                    for (int i = 0; i < 8; ++i) v[i] = 0.f; }
#pragma unroll
                for (int i = 0; i < 8; ++i) { if (j == 1) x1[hh * 8 + i] = v[i]; else if (j == 2) x2[hh * 8 + i] = v[i]; else x3[hh * 8 + i] = v[i]; } } }
        for (int t = 0; t < nrow; ++t) { const int r = r0 + t; float x0[16];
            const ThinRow d = nx;
            if (t + 1 < nrow) nx = thin_load(XR, CQKV, r + 1, lane);
            { float v[8]; unpack8(d.xa, v);
#pragma unroll
              for (int i = 0; i < 8; ++i) x0[i] = v[i];
              unpack8(d.xb, v);
#pragma unroll
              for (int i = 0; i < 8; ++i) x0[8 + i] = v[i]; }
#pragma unroll
            for (int hh = 0; hh < 2; ++hh) { float y[8];
#pragma unroll
                for (int i = 0; i < 8; ++i) { const int q = hh * 8 + i; y[i] = bias[q] + w[3][q] * x0[q] + w[2][q] * x1[q] + w[1][q] * x2[q] + w[0][q] * x3[q]; }
                *(u32x4*)(XC + (size_t)r * 1024 + hh * 512 + lane * 8) = pack8(y); }
#pragma unroll
            for (int q = 0; q < 16; ++q) { x3[q] = x2[q]; x2[q] = x1[q]; x1[q] = x0[q]; }
            thin_row_stats(ws, d, r, lane);
        }
    }
    float* RSQ = (float*)(ws + WS_RSQ); float* RSKV = (float*)(ws + WS_RSKV); bf16_t* KROPE = (bf16_t*)(ws + WS_KROPE);
    for (int r = M + NMETA + C.gw; r < MTOT; r += C.NGW) {
        u32x4* o = (u32x4*)(XC + (size_t)r * 1024); o[lane] = (u32x4){0u, 0u, 0u, 0u}; o[64 + lane] = (u32x4){0u, 0u, 0u, 0u};
        if (lane == 0) { RSQ[r] = 0.f; RSKV[r] = 0.f; }
        if (lane < 16) ((unsigned*)(KROPE + (size_t)r * 32))[lane] = 0u;
    }
}

__device__ __forceinline__ void phase_scan1(const Ctx& C) {
    unsigned char* ws = C.ws; const int lane = C.lane;
    const bf16_t* LA = (const bf16_t*)(ws + SLOT(1)); const bf16_t* UU = (const bf16_t*)(ws + SLOT(6));
    float* SCP = (float*)(ws + WS_SCP); float* SCH = (float*)(ws + WS_SCH); float* CARRY0 = (float*)(ws + WS_CARRY0);
    for (int it = C.gw; it < 2048 + 4; it += C.NGW) {
        const bool meta = it >= 2048; const int q = it & 3, bc = it >> 2, ch = q * 256 + lane * 4;
        const int row0 = meta ? METAROW : bc * 128, nrow = meta ? NMETA : 128;
        float P[4] = {1.f, 1.f, 1.f, 1.f}, H[4] = {0.f, 0.f, 0.f, 0.f};
#pragma unroll 8
        for (int t = 0; t < nrow; ++t) { const u32x2 l2 = *(const u32x2*)(LA + (size_t)(row0 + t) * 1024 + ch), u2 = *(const u32x2*)(UU + (size_t)(row0 + t) * 1024 + ch);
            const float a0 = ex2(LOG2E * bf_lo(l2.x)), a1 = ex2(LOG2E * bf_hi(l2.x)), a2 = ex2(LOG2E * bf_lo(l2.y)), a3 = ex2(LOG2E * bf_hi(l2.y));
            P[0] *= a0; P[1] *= a1; P[2] *= a2; P[3] *= a3;
            H[0] = a0 * H[0] + bf_lo(u2.x); H[1] = a1 * H[1] + bf_hi(u2.x); H[2] = a2 * H[2] + bf_lo(u2.y); H[3] = a3 * H[3] + bf_hi(u2.y); }
        if (meta) *(f32x4*)(CARRY0 + ch) = (f32x4){H[0], H[1], H[2], H[3]};
        else { *(f32x4*)(SCP + (size_t)bc * 1024 + ch) = (f32x4){P[0], P[1], P[2], P[3]}; *(f32x4*)(SCH + (size_t)bc * 1024 + ch) = (f32x4){H[0], H[1], H[2], H[3]}; }
    }
}
__device__ __forceinline__ void phase_scan2(const Ctx& C) {
    unsigned char* ws = C.ws; const int lane = C.lane;
    const bf16_t* LA = (const bf16_t*)(ws + SLOT(1)); const bf16_t* UU = (const bf16_t*)(ws + SLOT(6)); const bf16_t* GR = (const bf16_t*)(ws + SLOT(2)); bf16_t* HRG = (bf16_t*)(ws + SLOT(0));
    const float* SCP = (const float*)(ws + WS_SCP); const float* SCH = (const float*)(ws + WS_SCH); const float* CARRY0 = (const float*)(ws + WS_CARRY0);
    for (int it = C.gw; it < 2048; it += C.NGW) {
        const int q = it & 3, bc = it >> 2, b = bc >> 4, c = bc & 15, ch = q * 256 + lane * 4;
        f32x4 h = *(const f32x4*)(CARRY0 + ch);
        for (int cc = 0; cc < c; ++cc) { const f32x4 p = *(const f32x4*)(SCP + (size_t)(b * 16 + cc) * 1024 + ch), e = *(const f32x4*)(SCH + (size_t)(b * 16 + cc) * 1024 + ch); h = p * h + e; }
        float H[4] = {h[0], h[1], h[2], h[3]};
        const int row0 = bc * 128;
#pragma unroll 8
        for (int t = 0; t < 128; ++t) { const size_t off = (size_t)(row0 + t) * 1024 + ch; const u32x2 l2 = *(const u32x2*)(LA + off), u2 = *(const u32x2*)(UU + off), g2 = *(const u32x2*)(GR + off);
            H[0] = ex2(LOG2E * bf_lo(l2.x)) * H[0] + bf_lo(u2.x); H[1] = ex2(LOG2E * bf_hi(l2.x)) * H[1] + bf_hi(u2.x); H[2] = ex2(LOG2E * bf_lo(l2.y)) * H[2] + bf_lo(u2.y); H[3] = ex2(LOG2E * bf_hi(l2.y)) * H[3] + bf_hi(u2.y);
            u32x2 o; o.x = pk2(H[0] * bf_lo(g2.x), H[1] * bf_hi(g2.x)); o.y = pk2(H[2] * bf_lo(g2.y), H[3] * bf_hi(g2.y)); *(u32x2*)(HRG + off) = o; }
    }
}

constexpr int AT_KSLOT = 12 * 1024, AT_VSLOT = 8192;
#define AT_K(j) (((j) & 3) * AT_KSLOT)
#define AT_V(j) (4 * AT_KSLOT + ((j) & 7) * AT_VSLOT)
static_assert(4 * AT_KSLOT + 8 * AT_VSLOT <= 131072, "attention rings fit the phase scratch");
__device__ __forceinline__ void glds16(const void* gsrc, unsigned lds_dst) { unsigned keep;
    asm volatile("s_mov_b32 %0, m0\n\ts_mov_b32 m0, %2\n\ts_nop 0\n\tglobal_load_lds_dwordx4 %1, off\n\ts_mov_b32 m0, %0" : "=&s"(keep) : "v"(gsrc), "s"(lds_dst) : "memory"); }
#define AT_BAR(N) asm volatile("s_waitcnt vmcnt(" #N ") lgkmcnt(0)\n\ts_barrier" ::: "memory")
__device__ __forceinline__ int crow(int r, int hi) { return (r & 3) + 8 * (r >> 2) + 4 * hi; }
__device__ __forceinline__ void attn_q(LAS unsigned char* lds, int j, int s0, int q, int hi, const bf16x8 (&qf)[6], const f32x16& negm, f32x16& p0, f32x16& p1) {
    const int kb = AT_K(j);
    __builtin_amdgcn_s_setprio(1);
#pragma unroll
    for (int ks = 0; ks < 6; ++ks) {
        const bf16x8 a0 = *(const LAS bf16x8*)(lds + kb + (2 * ks + hi) * 1024 + q * 16);
        const bf16x8 a1 = *(const LAS bf16x8*)(lds + kb + (2 * ks + hi) * 1024 + (32 + q) * 16);
        if (ks == 0) { p0 = __builtin_amdgcn_mfma_f32_32x32x16_bf16(a0, qf[0], negm, 0, 0, 0); p1 = __builtin_amdgcn_mfma_f32_32x32x16_bf16(a1, qf[0], negm, 0, 0, 0); }
        else { p0 = __builtin_amdgcn_mfma_f32_32x32x16_bf16(a0, qf[ks], p0, 0, 0, 0); p1 = __builtin_amdgcn_mfma_f32_32x32x16_bf16(a1, qf[ks], p1, 0, 0, 0); }
    }
    __builtin_amdgcn_s_setprio(0);
    if (j == 0) {
#pragma unroll
        for (int r = 0; r < 16; ++r) { if (crow(r, hi) >= NMETA) p0[r] = -INFINITY; p1[r] = -INFINITY; }
    } else if ((j - 1) * 64 + 63 > s0) {
        const int qs = s0 + q, k0 = (j - 1) * 64;
#pragma unroll
        for (int r = 0; r < 16; ++r) { const int kk = k0 + crow(r, hi); if (kk > qs) p0[r] = -INFINITY; if (kk + 32 > qs) p1[r] = -INFINITY; }
    }
}
__device__ __forceinline__ void attn_pv(LAS unsigned char* lds, int vbase, const bf16x8 (&pb)[4], f32x16& o0, f32x16& o1) {
#pragma unroll
    for (int s = 0; s < 4; ++s)
#pragma unroll
        for (int db = 0; db < 2; ++db) {
            const v4i16_t lo = __builtin_amdgcn_ds_read_tr16_b64_v4i16((LAS v4i16_t*)(lds + vbase + db * 4096 + s * 1024));
            const v4i16_t hh = __builtin_amdgcn_ds_read_tr16_b64_v4i16((LAS v4i16_t*)(lds + vbase + db * 4096 + s * 1024 + 512));
            const bf16x8 va = {lo[0], lo[1], lo[2], lo[3], hh[0], hh[1], hh[2], hh[3]};
            if (db == 0) o0 = __builtin_amdgcn_mfma_f32_32x32x16_bf16(va, pb[s], o0, 0, 0, 0); else o1 = __builtin_amdgcn_mfma_f32_32x32x16_bf16(va, pb[s], o1, 0, 0, 0);
        }
}
#ifndef ATT_THR
#define ATT_THR 8.0f
#endif
template <bool DOPV, bool FIRST> __device__ __forceinline__ void attn_sp(LAS unsigned char* lds, int vbase, f32x16& p0, f32x16& p1, bf16x8 (&pb)[4], f32x16& o0, f32x16& o1, f32x16& negm, float& m_run, float& l_run) {
    float mx = fmaxf(p0[0], p1[0]);
#pragma unroll
    for (int r = 1; r < 16; ++r) mx = fmaxf(fmaxf(mx, p0[r]), p1[r]);
    mx = fmaxf(mx, __shfl_xor(mx, 32));
    if (DOPV) attn_pv(lds, vbase, pb, o0, o1);
    float rs = 0.f;
#pragma unroll
    for (int r = 0; r < 16; ++r) { p0[r] = ex2(p0[r]); p1[r] = ex2(p1[r]); rs += p0[r] + p1[r]; }
    if (FIRST || !__all(mx <= ATT_THR)) {
        const float d = FIRST ? mx : fmaxf(mx, 0.f), alpha = ex2(-d);
#pragma unroll
        for (int r = 0; r < 16; ++r) { p0[r] *= alpha; p1[r] *= alpha; o0[r] *= alpha; o1[r] *= alpha; }
        rs *= alpha; l_run *= alpha; m_run += d;
#pragma unroll
        for (int r = 0; r < 16; ++r) negm[r] = -m_run;
    }
    l_run += rs;
#pragma unroll
    for (int s = 0; s < 4; ++s) { unsigned w[4];
#pragma unroll
        for (int jj = 0; jj < 4; ++jj) w[jj] = (s < 2) ? pk2(p0[8 * (s & 1) + 2 * jj], p0[8 * (s & 1) + 2 * jj + 1]) : pk2(p1[8 * (s & 1) + 2 * jj], p1[8 * (s & 1) + 2 * jj + 1]);
        u32x4 ww = {w[0], w[1], w[2], w[3]}; pb[s] = __builtin_bit_cast(bf16x8, ww); }
}
__device__ __forceinline__ void attn_unit(const Ctx& C, int b, int h, int qb, const bf16_t* Q, const bf16_t* KN, const bf16_t* KR, const bf16_t* V, bf16_t* O) {
    const int tid = C.tid, lane = C.lane, wid = C.wave, q = lane & 31, hi = lane >> 5;
    LAS unsigned char* lds = C.lds;
    const int s0 = qb * 256 + wid * 32;
    const size_t qrow = (size_t)b * SEQ + s0 + q;
    bf16x8 qf[6];
#pragma unroll
    for (int ks = 0; ks < 6; ++ks) qf[ks] = *(const bf16x8*)(Q + qrow * QLD + h * 96 + ks * 16 + hi * 8);
    {
        const float* ctab = (const float*)(C.ws + WS_CTAB) + (NMETA + s0 + q) * 16; const float* stab = (const float*)(C.ws + WS_STAB) + (NMETA + s0 + q) * 16;
#pragma unroll
        for (int ks = 4; ks < 6; ++ks) { const f32x4 cc = *(const f32x4*)(ctab + 8 * (ks - 4) + 4 * hi), sn = *(const f32x4*)(stab + 8 * (ks - 4) + 4 * hi);
            const u32x4 w = __builtin_bit_cast(u32x4, qf[ks]); u32x4 r;
            { const float x1 = bf_lo(w.x), x2 = bf_hi(w.x); r.x = pk2(x1 * cc[0] - x2 * sn[0], x1 * sn[0] + x2 * cc[0]); }
            { const float x1 = bf_lo(w.y), x2 = bf_hi(w.y); r.y = pk2(x1 * cc[1] - x2 * sn[1], x1 * sn[1] + x2 * cc[1]); }
            { const float x1 = bf_lo(w.z), x2 = bf_hi(w.z); r.z = pk2(x1 * cc[2] - x2 * sn[2], x1 * sn[2] + x2 * cc[2]); }
            { const float x1 = bf_lo(w.w), x2 = bf_hi(w.w); r.w = pk2(x1 * cc[3] - x2 * sn[3], x1 * sn[3] + x2 * cc[3]); }
            qf[ks] = __builtin_bit_cast(bf16x8, r); }
    }
    f32x16 o0 = {}, o1 = {}, p0 = {}, p1 = {};
    bf16x8 pb[4] = {};
    float m_run = 0.f, l_run = 0.f; f32x16 negm = {};
    const int NJ = 4 * qb + 5;
    const unsigned lds0 = (unsigned)(size_t)lds;
    const bf16_t* ksrc = KN + (size_t)lane * 1024 + h * 64 + wid * 8;
    const bf16_t* rsrc = KR + (size_t)lane * 32 + (wid & 3) * 8;
    const bf16_t* vsrc = V + (size_t)(16 * (wid & 3) + (lane >> 2)) * 1024 + h * 64 + (wid >> 2) * 32 + (lane & 3) * 8;
#define AT_DMA(j) do { const size_t row_ = (j) == 0 ? (size_t)METAROW : (size_t)b * SEQ + (size_t)((j) - 1) * 64; \
        glds16(ksrc + row_ * 1024, (unsigned)__builtin_amdgcn_readfirstlane(lds0 + AT_K(j) + wid * 1024)); \
        if (wid < 4) glds16(rsrc + row_ * 32, (unsigned)__builtin_amdgcn_readfirstlane(lds0 + AT_K(j) + (8 + wid) * 1024)); \
        glds16(vsrc + row_ * 1024, (unsigned)__builtin_amdgcn_readfirstlane(lds0 + AT_V(j) + wid * 1024)); } while (0)
#define AT_STEP(n) do { if ((n) + 2 < NJ) { if (wid < 4) AT_BAR(6); else AT_BAR(4); } else if ((n) + 1 < NJ) { if (wid < 4) AT_BAR(3); else AT_BAR(2); } else AT_BAR(0); if ((n) + 3 < NJ) AT_DMA((n) + 3); } while (0)
    AT_BAR(0);
    AT_DMA(0); AT_DMA(1); AT_DMA(2);
    const int g16 = lane >> 4, qq = (lane & 15) >> 2, pp = lane & 3;
    const int vtr_off = (4 * hi + qq) * 64 + (16 * (g16 & 1) + 4 * pp) * 2;
    {
        AT_STEP(0);
        attn_q(lds, 0, s0, q, hi, qf, negm, p0, p1);
        attn_sp<false, true>(lds, 0, p0, p1, pb, o0, o1, negm, m_run, l_run);
    }
    const int jend = (s0 + 31) / 64 + 2 < NJ ? (s0 + 31) / 64 + 2 : NJ;
    for (int j = 1; j < jend; ++j) {
        AT_STEP(j);
        attn_q(lds, j, s0, q, hi, qf, negm, p0, p1);
        attn_sp<true, false>(lds, AT_V(j - 1) + vtr_off, p0, p1, pb, o0, o1, negm, m_run, l_run);
    }
    attn_pv(lds, AT_V(jend - 1) + vtr_off, pb, o0, o1);
    for (int j = jend; j < NJ; ++j) AT_STEP(j);
#undef AT_DMA
#undef AT_STEP
    const float inv = 1.f / (l_run + __shfl_xor(l_run, 32));
    bf16_t* orow = O + qrow * 1024 + h * 64;
#pragma unroll
    for (int g4 = 0; g4 < 4; ++g4) {
        u32x2 w0, w1; w0.x = pk2(o0[4 * g4] * inv, o0[4 * g4 + 1] * inv); w0.y = pk2(o0[4 * g4 + 2] * inv, o0[4 * g4 + 3] * inv);
        w1.x = pk2(o1[4 * g4] * inv, o1[4 * g4 + 1] * inv); w1.y = pk2(o1[4 * g4 + 2] * inv, o1[4 * g4 + 3] * inv);
        *(u32x2*)(orow + 8 * g4 + 4 * hi) = w0; *(u32x2*)(orow + 32 + 8 * g4 + 4 * hi) = w1;
    }
}
__device__ __forceinline__ void phase_attn(const Ctx& C) {
    unsigned char* ws = C.ws;
    const bf16_t* Q = (const bf16_t*)(ws + SLOT(0)); const bf16_t* KN = (const bf16_t*)(ws + SLOT(4)); const bf16_t* V = (const bf16_t*)(ws + SLOT(6)); const bf16_t* KR = (const bf16_t*)(ws + WS_KROPE);
    bf16_t* O = (bf16_t*)(ws + SLOT(3));
    const int G = C.G, c = blockIdx.x; const int vcu = (G % 8 == 0) ? (c % 8) * (G / 8) + c / 8 : c;
    for (int bh = vcu; bh < NB * 16; bh += G)
        for (int i = 0; i < 8; ++i) { const int qb = (i & 1) ? 7 - (i >> 1) : (i >> 1); attn_unit(C, bh >> 4, bh & 15, qb, Q, KN, KR, V, O); }
    __syncthreads();
}

__device__ __forceinline__ int tk_enc(float f) { const int x = __float_as_int(f); return x ^ ((x >> 31) & 0x7fffffff); }
__device__ __forceinline__ float tk_dec(int k) { return __int_as_float(k ^ ((k >> 31) & 0x7fffffff)); }
#define TK_CE(a, b) do { const int hi_ = max((a), (b)), lo_ = min((a), (b)); (a) = hi_; (b) = lo_; } while (0)
__device__ __forceinline__ void tk_sort16(int (&v)[16]) {
#pragma unroll
    for (int k = 2; k <= 16; k <<= 1)
#pragma unroll
        for (int j = k >> 1; j > 0; j >>= 1)
#pragma unroll
            for (int i = 0; i < 16; ++i) { const int l = i ^ j; if (l > i) { if ((i & k) == 0) TK_CE(v[i], v[l]); else TK_CE(v[l], v[i]); } }
}
__device__ __forceinline__ void tk_merge16(int (&a)[16], const int (&b)[16]) {
#pragma unroll
    for (int i = 0; i < 16; ++i) a[i] = max(a[i], b[15 - i]);
#pragma unroll
    for (int j = 8; j > 0; j >>= 1)
#pragma unroll
        for (int i = 0; i < 16; ++i) { const int l = i ^ j; if (l > i) TK_CE(a[i], a[l]); }
}
__host__ __device__ constexpr int tk_pos(int i) { int n = 0; for (int a = 0; a < i; ++a) n += 16 / (a + 1); return n; }
__host__ __device__ constexpr int tk_ci(int n) { int i = 0; while (i < 15 && tk_pos(i + 1) <= n) ++i; return i; }
__host__ __device__ constexpr int tk_cj(int n) { return n - tk_pos(tk_ci(n)); }
__device__ __forceinline__ int tk_lookup(const int (&w)[4], int i) {
    const unsigned long long lo = ((unsigned long long)(unsigned)w[1] << 32) | (unsigned long long)(unsigned)w[0], hi = ((unsigned long long)(unsigned)w[3] << 32) | (unsigned long long)(unsigned)w[2];
    const unsigned long long a = (i & 8) ? hi : lo;
    return (int)(a >> (8 * (i & 7))) & 127;
}
__device__ __forceinline__ void phase_topk(const Ctx& C) {
    unsigned char* ws = C.ws;
    const _Float16* SC = (const _Float16*)(ws + SLOT(0)); int* TIDX = (int*)(ws + SLOT(5)); float* TVAL = (float*)(ws + SLOT(5) + (size_t)M * 128 * 4);
    const int gt = blockIdx.x * NTHR + C.tid, NT = C.G * NTHR;
    for (int it = gt; it < M * 8 * 4; it += NT) {
        const int p = it >> 2, q = it & 3;
        f16x8 raw[8];
        { const unsigned char* blk = (const unsigned char*)(SC + (size_t)(p - (C.lane >> 2)) * 256);
          LAS unsigned char* tl = C.lds + C.wave * 9216;
          u32x4 cv[8];
#pragma unroll
          for (int c = 0; c < 8; ++c) cv[c] = *(const u32x4*)(blk + 1024 * c + 16 * C.lane);
#pragma unroll
          for (int c = 0; c < 8; ++c) *(LAS u32x4*)(tl + 144 * (8 * c + (C.lane >> 3)) + 16 * (C.lane & 7)) = cv[c];
#pragma unroll
          for (int c = 0; c < 8; ++c) raw[c] = *(LAS const f16x8*)(tl + 144 * C.lane + 16 * c); }
        const int ibase = 127 - 64 * (q & 1);
        int ch[4][16];
#pragma unroll
        for (int c = 0; c < 4; ++c)
#pragma unroll
            for (int e = 0; e < 16; ++e) ch[c][e] = (tk_enc((float)raw[2 * c + (e >> 3)][e & 7]) & ~127) | (ibase - (16 * c + e));
        tk_sort16(ch[0]); tk_sort16(ch[1]); tk_sort16(ch[2]); tk_sort16(ch[3]);
        tk_merge16(ch[0], ch[1]); tk_merge16(ch[2], ch[3]); tk_merge16(ch[0], ch[2]);
        int oth[16];
#pragma unroll
        for (int i = 0; i < 16; ++i) oth[i] = __builtin_amdgcn_mov_dpp(ch[0][i], 0xB1, 0xF, 0xF, true);
        tk_merge16(ch[0], oth);
#pragma unroll
        for (int i = 0; i < 16; ++i) oth[i] = __builtin_amdgcn_mov_dpp(ch[0][i], 0x4E, 0xF, 0xF, true);
        int t1[16], t2[16];
#pragma unroll
        for (int i = 0; i < 16; ++i) { t1[i] = (q < 2) ? ch[0][i] : oth[i]; t2[i] = (q < 2) ? oth[i] : ch[0][i]; }
        float f1[16], f2[16];
#pragma unroll
        for (int i = 0; i < 16; ++i) { f1[i] = tk_dec(t1[i]); f2[i] = tk_dec(t2[i]); }
        int cd[1][16];
#pragma unroll
        for (int sl = 0; sl < 16; ++sl) {
            float a[4], b[4]; int tg[4];
#pragma unroll
            for (int qq = 0; qq < 4; ++qq) { const int n = 16 * qq + sl, nn = n < 50 ? n : 49; a[qq] = f1[tk_ci(nn)]; b[qq] = f2[tk_cj(nn)]; tg[qq] = 255 - (16 * tk_ci(nn) + tk_cj(nn)); }
            const float av = q == 0 ? a[0] : q == 1 ? a[1] : q == 2 ? a[2] : a[3], bv = q == 0 ? b[0] : q == 1 ? b[1] : q == 2 ? b[2] : b[3];
            const int tv = q == 0 ? tg[0] : q == 1 ? tg[1] : q == 2 ? tg[2] : tg[3];
            const int key = (tk_enc(av + bv) & ~255) | tv;
            cd[0][sl] = (48 + sl >= 50 && q == 3) ? (int)0x80000000 : key;
        }
        tk_sort16(cd[0]);
#pragma unroll
        for (int i = 0; i < 16; ++i) oth[i] = __builtin_amdgcn_mov_dpp(cd[0][i], 0xB1, 0xF, 0xF, true);
        tk_merge16(cd[0], oth);
#pragma unroll
        for (int i = 0; i < 16; ++i) oth[i] = __builtin_amdgcn_mov_dpp(cd[0][i], 0x4E, 0xF, 0xF, true);
        tk_merge16(cd[0], oth);
        int w1[4], w2[4];
#pragma unroll
        for (int m = 0; m < 4; ++m) { w1[m] = (t1[4 * m] & 127) | ((t1[4 * m + 1] & 127) << 8) | ((t1[4 * m + 2] & 127) << 16) | ((t1[4 * m + 3] & 127) << 24);
                                      w2[m] = (t2[4 * m] & 127) | ((t2[4 * m + 1] & 127) << 8) | ((t2[4 * m + 2] & 127) << 16) | ((t2[4 * m + 3] & 127) << 24); }
        if (q == 0) {
            int id[16];
#pragma unroll
            for (int k = 0; k < 16; ++k) { const int c = 255 - (cd[0][k] & 255); id[k] = (127 - tk_lookup(w1, c >> 4)) * 128 + (127 - tk_lookup(w2, c & 15)); }
            int* oi = TIDX + (size_t)p * 16;
#pragma unroll
            for (int k = 0; k < 16; k += 4) *(int4*)(oi + k) = make_int4(id[k], id[k + 1], id[k + 2], id[k + 3]);
        } else if (q == 1) {
            float* ov = TVAL + (size_t)p * 16;
#pragma unroll
            for (int k = 0; k < 16; k += 4) *(f32x4*)(ov + k) = (f32x4){tk_dec(cd[0][k]), tk_dec(cd[0][k + 1]), tk_dec(cd[0][k + 2]), tk_dec(cd[0][k + 3])};
        }
    }
}

__device__ __forceinline__ void phase_x8(const Ctx& C) {
    unsigned char* ws = C.ws; const int lane = C.lane;
    const bf16_t* H1B = (const bf16_t*)(ws + SLOT(4)); unsigned char* X8 = ws + SLOT(2); float* XS = (float*)(ws + SLOT(2) + (size_t)M * 1024);
    int tok = C.gw; u32x4 na = {0u, 0u, 0u, 0u}, nb = {0u, 0u, 0u, 0u};
    if (tok < M) { na = *(const u32x4*)(H1B + (size_t)tok * 1024 + 16 * lane); nb = *(const u32x4*)(H1B + (size_t)tok * 1024 + 16 * lane + 8); }
    for (; tok < M; tok += C.NGW) {
        const u32x4 xa = na, xb = nb;
        { const int nt = tok + C.NGW; if (nt < M) { na = *(const u32x4*)(H1B + (size_t)nt * 1024 + 16 * lane); nb = *(const u32x4*)(H1B + (size_t)nt * 1024 + 16 * lane + 8); } }
        float hv[16]; { float t8[8]; unpack8(xa, t8);
#pragma unroll
            for (int i = 0; i < 8; ++i) hv[i] = t8[i];
            unpack8(xb, t8);
#pragma unroll
            for (int i = 0; i < 8; ++i) hv[8 + i] = t8[i]; }
        float am = 0.f;
#pragma unroll
        for (int i = 0; i < 16; ++i) am = fmaxf(am, fabsf(hv[i]));
#pragma unroll
        for (int o = 1; o < 64; o <<= 1) am = fmaxf(am, __shfl_xor(am, o));
        const float scale = am > 0.f ? am * (1.f / 127.f) : 1.f, inv = 1.f / scale;
        u32x4 w;
#pragma unroll
        for (int j = 0; j < 4; ++j) { const int q0 = (int)rintf(hv[4 * j] * inv), q1 = (int)rintf(hv[4 * j + 1] * inv), q2 = (int)rintf(hv[4 * j + 2] * inv), q3 = (int)rintf(hv[4 * j + 3] * inv);
            w[j] = (unsigned)(q0 & 255) | ((unsigned)(q1 & 255) << 8) | ((unsigned)(q2 & 255) << 16) | ((unsigned)q3 << 24); }
        *(u32x4*)(X8 + (size_t)tok * 1024 + 16 * lane) = w;
        if (lane == 0) XS[tok] = scale;
    }
}
__device__ __forceinline__ int idpp_ror8(int v) { return __builtin_amdgcn_update_dpp(0, v, 0x128, 0xF, 0xF, true); }
__device__ __forceinline__ int idpp_hmir(int v) { return __builtin_amdgcn_update_dpp(0, v, 0x141, 0xF, 0xF, true); }
__device__ __forceinline__ int idpp_x2(int v) { return __builtin_amdgcn_mov_dpp(v, 0x4E, 0xF, 0xF, true); }
__device__ __forceinline__ int idpp_x1(int v) { return __builtin_amdgcn_mov_dpp(v, 0xB1, 0xF, 0xF, true); }
__device__ __forceinline__ int idot16(const u32x4 w, const u32x4 x, int a) {
    a = __builtin_amdgcn_sdot4((int)w.x, (int)x.x, a, false); a = __builtin_amdgcn_sdot4((int)w.y, (int)x.y, a, false);
    a = __builtin_amdgcn_sdot4((int)w.z, (int)x.z, a, false); return __builtin_amdgcn_sdot4((int)w.w, (int)x.w, a, false);
}
__device__ __forceinline__ void u_process(unsigned c, unsigned co, int n, int tok, const u32x4 (&x)[4], float xscale, const unsigned char* PU, float* ACT, int lane, bool b3, bool b2) {
    const int rs = lane >> 4; const unsigned p16 = 16u * (unsigned)(lane & 15);
    for (int base = 0; base < n; base += 32) {
        u32x4 w[8][4];
#pragma unroll
        for (int m = 0; m < 8; ++m) if (base + 4 * m < n) {
            const unsigned off = (unsigned)__builtin_amdgcn_ds_bpermute(((base + 4 * m + rs) & 63) * 4, (int)co);
            const unsigned char* rp = PU + (off + p16);
#pragma unroll
            for (int i = 0; i < 4; ++i) w[m][i] = *(const u32x4*)(rp + 256 * i); }
        __builtin_amdgcn_sched_barrier(0);
#pragma unroll
        for (int G = 0; G < 2; ++G) if (base + 16 * G < n) {
            int p4[4];
#pragma unroll
            for (int mm = 0; mm < 4; ++mm) { int a = 0;
#pragma unroll
                for (int i = 0; i < 4; ++i) a = idot16(w[4 * G + mm][i], x[i], a);
                p4[mm] = a; }
            int t0, t1, u;
            { const int keep = b3 ? p4[1] : p4[0], send = b3 ? p4[0] : p4[1]; t0 = keep + idpp_ror8(send); }
            { const int keep = b3 ? p4[3] : p4[2], send = b3 ? p4[2] : p4[3]; t1 = keep + idpp_ror8(send); }
            { const int keep = b2 ? t1 : t0, send = b2 ? t0 : t1; u = keep + idpp_hmir(send); }
            u += idpp_x2(u); u += idpp_x1(u);
            const int slot = base + 16 * G + 4 * ((b2 ? 2 : 0) + (b3 ? 1 : 0)) + rs;
            const unsigned mine = (unsigned)__builtin_amdgcn_ds_bpermute((slot & 63) * 4, (int)c);
            if ((lane & 3) == 0 && slot < n) ACT[(size_t)tok * 128 + (mine >> 16)] = (float)u * xscale;
        }
    }
}
constexpr int UB = 8;
__device__ __forceinline__ float u_batch_request(const unsigned char* X8, const float* XS, const int* TIDX, int tb, int tstep, unsigned xs_addr, int lane) {
#pragma unroll
    for (int k = 0; k < UB; ++k) { const int tk = tb + k * tstep; if (tk < M) glds16(X8 + (size_t)tk * 1024 + 16 * lane, xs_addr + k * 1024); }
#pragma unroll
    for (int k = 0; k < UB; k += 2) { if (tb + k * tstep < M) { int tk = tb + (k + (lane >> 5)) * tstep; tk = tk < M ? tk : tb;
        glds16(TIDX + (size_t)tk * 128 + 4 * (lane & 31), xs_addr + UB * 1024 + k * 512); } }
    const int tl = tb + (lane & (UB - 1)) * tstep;
    return XS[tl < M ? tl : tb];
}
__device__ __forceinline__ void phase_upart(const Ctx& C, int xcc, int rank) {
    unsigned char* ws = C.ws; const int lane = C.lane;
    const unsigned char* X8 = ws + SLOT(2); const float* XS = (const float*)(ws + SLOT(2) + (size_t)M * 1024);
    const int* TIDX = (const int*)(ws + SLOT(5)); float* ACT = (float*)(ws + SLOT(0));
    const unsigned char* PU = ws + WS_PU;
    LAS unsigned char* xs = C.lds + C.wave * (UB * 1536);
    const unsigned xs_addr = (unsigned)__builtin_amdgcn_readfirstlane((int)(unsigned)(size_t)xs);
    int nloc, xi, nx;
    if ((C.G & 7) == 0) { nx = 8; xi = xcc; nloc = C.G >> 3; } else { nx = 1; xi = 0; nloc = C.G; rank = blockIdx.x; }
    const bool b3 = (lane & 8) != 0, b2 = (lane & 4) != 0; const int pos = lane & 15;
    const int tstep = nloc * NWAVES;
    for (int sub = xi; sub < 8; sub += nx) {
        const unsigned dummy = (unsigned)(sub << 11) * 1024u;
        int tb = rank * NWAVES + C.wave;
        float svn = 0.f;
        if (tb < M) svn = u_batch_request(X8, XS, TIDX, tb, tstep, xs_addr, lane);
        for (; tb < M; tb += UB * tstep) {
            asm volatile("s_waitcnt vmcnt(0)" ::: "memory");
            const float sv = svn;
#pragma unroll 1
            for (int k = 0; k < UB; ++k) {
                const int tok = tb + k * tstep; if (tok >= M) break;
                u32x4 x[4];
#pragma unroll
                for (int i = 0; i < 4; ++i) x[i] = *(LAS const u32x4*)(xs + k * 1024 + 256 * i + 16 * pos);
                const int ca = *(LAS const int*)(xs + UB * 1024 + k * 512 + 4 * lane), cb = *(LAS const int*)(xs + UB * 1024 + k * 512 + 256 + 4 * lane);
                const float xscale = __uint_as_float(__builtin_amdgcn_readlane(__float_as_uint(sv), k));
                const bool fa = (ca >> 11) == sub, fb = (cb >> 11) == sub;
                const unsigned long long ma = __ballot(fa), mb = __ballot(fb);
                const int npa = __builtin_popcountll(ma), npb = __builtin_popcountll(mb);
                const int ra_ = (int)__builtin_amdgcn_mbcnt_hi((unsigned)(ma >> 32), __builtin_amdgcn_mbcnt_lo((unsigned)ma, 0u));
                const int rb_ = (int)__builtin_amdgcn_mbcnt_hi((unsigned)(mb >> 32), __builtin_amdgcn_mbcnt_lo((unsigned)mb, 0u));
                const int da = fa ? ra_ : npa + (lane - ra_), db = fb ? rb_ : npb + (lane - rb_);
                const unsigned cA = (unsigned)__builtin_amdgcn_ds_permute(da * 4, ca | (lane << 16));
                const unsigned cB = (unsigned)__builtin_amdgcn_ds_permute(db * 4, cb | ((64 + lane) << 16));
                if (npa + npb <= 64) {
                    const unsigned pulled = (unsigned)__builtin_amdgcn_ds_bpermute(((lane - npa) & 63) * 4, (int)cB);
                    const unsigned cc = lane < npa ? cA : pulled; const int n = npa + npb;
                    u_process(cc, lane < n ? (cc & 0xffffu) * 1024u : dummy, n, tok, x, xscale, PU, ACT, lane, b3, b2);
                } else { u_process(cA, lane < npa ? (cA & 0xffffu) * 1024u : dummy, npa, tok, x, xscale, PU, ACT, lane, b3, b2);
                         u_process(cB, lane < npb ? (cB & 0xffffu) * 1024u : dummy, npb, tok, x, xscale, PU, ACT, lane, b3, b2); }
            }
            asm volatile("s_waitcnt lgkmcnt(0)" ::: "memory");
            if (tb + UB * tstep < M) svn = u_batch_request(X8, XS, TIDX, tb + UB * tstep, tstep, xs_addr, lane);
        }
    }
}
__device__ __forceinline__ void phase_gather(const Ctx& C, float* DST) {
    unsigned char* ws = C.ws; const int lane = C.lane;
    const bf16_t* H1B = (const bf16_t*)(ws + SLOT(4)); const int* TIDX = (const int*)(ws + SLOT(5)); const float* TVAL = (const float*)(ws + SLOT(5) + (size_t)M * 128 * 4);
    const float* ACT = (const float*)(ws + SLOT(0));
    const unsigned char* PV = ws + WS_PV; const float* SU = (const float*)(ws + WS_SU); const float* SV = (const float*)(ws + WS_SV);
    const float* fg = C.in[24];
    const int l4 = lane >> 2; const unsigned l8 = 8u * (unsigned)lane;
    int tok = C.gw;
    u32x4 ra = {0u, 0u, 0u, 0u}, rb = {0u, 0u, 0u, 0u};
    if (tok < M) { ra = *(const u32x4*)(H1B + (size_t)tok * 1024 + 16 * lane); rb = *(const u32x4*)(H1B + (size_t)tok * 1024 + 16 * lane + 8); }
    for (; tok < M; tok += C.NGW) {
        f32x4 e[4]; float ss = 0.f;
        { float hv[16]; { float t8[8]; unpack8(ra, t8);
#pragma unroll
            for (int i = 0; i < 8; ++i) hv[i] = t8[i];
            unpack8(rb, t8);
#pragma unroll
            for (int i = 0; i < 8; ++i) hv[8 + i] = t8[i]; }
#pragma unroll
          for (int j = 0; j < 4; ++j) { e[j] = (f32x4){hv[4 * j], hv[4 * j + 1], hv[4 * j + 2], hv[4 * j + 3]}; ss += (e[j][0] * e[j][0] + e[j][1] * e[j][1]) + (e[j][2] * e[j][2] + e[j][3] * e[j][3]); } }
        { const int nt = tok + C.NGW; if (nt < M) { ra = *(const u32x4*)(H1B + (size_t)nt * 1024 + 16 * lane); rb = *(const u32x4*)(H1B + (size_t)nt * 1024 + 16 * lane + 8); } }
        f32x4* dp = (f32x4*)(DST + (size_t)tok * 1024 + 16 * lane);
        const float rstd = 1.f / sqrtf(wave_sum(ss) * (1.f / 1024.f) + EPS);
        f32x2 acc[8];
#pragma unroll
        for (int i = 0; i < 8; ++i) acc[i] = (f32x2){0.f, 0.f};
        int idxn0 = TIDX[(size_t)tok * 128 + l4], idxn1 = TIDX[(size_t)tok * 128 + 16 + l4];
        float tsn0 = TVAL[(size_t)tok * 128 + l4], tsn1 = TVAL[(size_t)tok * 128 + 16 + l4], dtn0 = ACT[(size_t)tok * 128 + l4], dtn1 = ACT[(size_t)tok * 128 + 16 + l4];
        for (int hp = 0; hp < 8; hp += 2) {
            const int idx0 = idxn0, idx1 = idxn1; const float ts0 = tsn0 * rstd, ts1 = tsn1 * rstd, dot0 = dtn0, dot1 = dtn1;
            u32x2 pa[32];
#pragma unroll
            for (int m = 0; m < 32; ++m) { const unsigned id = (unsigned)__builtin_amdgcn_readlane(m < 16 ? idx0 : idx1, 4 * (m & 15)); pa[m] = *(const u32x2*)(PV + (id * 512u + l8)); }
            __builtin_amdgcn_sched_barrier(0);
            const float su0 = SU[idx0], sv0 = SV[idx0], su1 = SU[idx1], sv1 = SV[idx1];
            if (hp < 6) { const size_t nb = (size_t)tok * 128 + (hp + 2) * 16 + l4; idxn0 = TIDX[nb]; idxn1 = TIDX[nb + 16]; tsn0 = TVAL[nb]; tsn1 = TVAL[nb + 16]; dtn0 = ACT[nb]; dtn1 = ACT[nb + 16]; }
            __builtin_amdgcn_sched_barrier(0);
            float mx0 = ts0, mx1 = ts1;
#pragma unroll
            for (int o = 4; o < 64; o <<= 1) { mx0 = fmaxf(mx0, __shfl_xor(mx0, o)); mx1 = fmaxf(mx1, __shfl_xor(mx1, o)); }
            const float ee0 = ex2((ts0 - mx0) * LOG2E), ee1 = ex2((ts1 - mx1) * LOG2E); float sm0 = ee0, sm1 = ee1;
#pragma unroll
            for (int o = 4; o < 64; o <<= 1) { sm0 += __shfl_xor(sm0, o); sm1 += __shfl_xor(sm1, o); }
            const float coef0 = (ee0 / sm0) * gelu_t(dot0 * su0 * rstd) * sv0, coef1 = (ee1 / sm1) * gelu_t(dot1 * su1 * rstd) * sv1;
#pragma unroll
            for (int m = 0; m < 32; ++m) {
                const float ck = __uint_as_float(__builtin_amdgcn_readlane(__float_as_uint(m < 16 ? coef0 : coef1), 4 * (m & 15)));
#pragma unroll
                for (int d = 0; d < 2; ++d) {
                    acc[4 * d] = __builtin_elementwise_fma(__builtin_amdgcn_cvt_scalef32_pk_f32_fp4(pa[m][d], 1.0f, 0), (f32x2){ck, ck}, acc[4 * d]);
                    acc[4 * d + 1] = __builtin_elementwise_fma(__builtin_amdgcn_cvt_scalef32_pk_f32_fp4(pa[m][d], 1.0f, 1), (f32x2){ck, ck}, acc[4 * d + 1]);
                    acc[4 * d + 2] = __builtin_elementwise_fma(__builtin_amdgcn_cvt_scalef32_pk_f32_fp4(pa[m][d], 1.0f, 2), (f32x2){ck, ck}, acc[4 * d + 2]);
                    acc[4 * d + 3] = __builtin_elementwise_fma(__builtin_amdgcn_cvt_scalef32_pk_f32_fp4(pa[m][d], 1.0f, 3), (f32x2){ck, ck}, acc[4 * d + 3]); }
                __builtin_amdgcn_sched_barrier(0);
            }
        }
        float s2 = 0.f;
#pragma unroll
        for (int j = 0; j < 4; ++j) {
            e[j][0] += acc[2 * j].x; e[j][1] += acc[2 * j].y; e[j][2] += acc[2 * j + 1].x; e[j][3] += acc[2 * j + 1].y;
            s2 += (e[j][0] * e[j][0] + e[j][1] * e[j][1]) + (e[j][2] * e[j][2] + e[j][3] * e[j][3]); }
        const float r2 = 1.f / sqrtf(wave_sum(s2) * (1.f / 1024.f) + EPS);
        const f32x4* fp = (const f32x4*)(fg + 16 * lane);
#pragma unroll
        for (int j = 0; j < 4; ++j) dp[j] = e[j] * r2 * fp[j];
    }
}

constexpr int NPHASE = 16;
__global__ void __launch_bounds__(NTHR, 2) hybrid_fwd(Args args) {
    extern __shared__ __attribute__((aligned(16))) unsigned char lds_raw[];
    Ctx C;
    C.lds = (LAS unsigned char*)lds_raw; C.tid = threadIdx.x; C.lane = C.tid & 63; C.wave = __builtin_amdgcn_readfirstlane(C.tid >> 6);
    C.G = gridDim.x; C.gw = blockIdx.x * NWAVES + C.wave; C.NGW = C.G * NWAVES; C.ws = args.ws; C.out = args.out; C.in = args.in;
    unsigned char* ws = args.ws;
    volatile LAS unsigned* MISC = (volatile LAS unsigned*)(C.lds + MISC_OFF);
    for (int u = C.tid; u < (LDS_BYTES - RING_BYTES) / 4; u += NTHR) ((LAS unsigned*)(C.lds + RING_BYTES))[u] = 0u;
    __syncthreads();
    XcdBarrier bar; bar.bar = (unsigned*)(ws + WS_CTL) + 1024; bar.x = 0; bar.st = nullptr;
    if (ONE_LAUNCH) bar = xcd_barrier_post((unsigned*)(ws + WS_CTL) + 1024, MISC + 8);
    const int lo = args.ph_lo, hi = args.ph_hi;
#ifndef PHMASK
#define PHMASK 0xffff
#endif
#define IN(k) (((PHMASK >> (k)) & 1) && lo <= (k) && (k) < hi)
#ifndef PROBE_PHASE
#define PROBE_PHASE -1
#endif
#define REPS(k) for (int rep_ = 0; rep_ < ((k) == PROBE_PHASE ? 2 : 1); ++rep_)
#define SEAM(k) do { if (IN(k) && IN((k) + 1)) xcd_barrier(bar); } while (0)
    const int G = C.G, cb = blockIdx.x;
    LAS unsigned char* ring = C.lds;

    if (IN(0)) REPS(0) { phase_prologue(C); }
    SEAM(0);
    if (IN(1)) REPS(1) {
        pg8::Gemm g{(const bf16_t*)(ws + SLOT(0)), (const bf16_t*)(ws + WS_WIN), 1024, 1024, 1024, 0, 256 * 1024};
        pg8::Sched S; S.init(256, 19, G, cb, 256, 6, 4);
        pg8::Epi8<FInproj> E{{(bf16_t*)(ws + SLOT(1)), (bf16_t*)(ws + SLOT(2)), (bf16_t*)(ws + SLOT(3)), (bf16_t*)(ws + SLOT(4)), (bf16_t*)(ws + SLOT(5))}};
        pg8::gemm_phase(ring, g, S, E);
    }
    SEAM(1);
    if (IN(2)) REPS(2) { phase_thin(C); }
    SEAM(2);
    if (IN(3)) REPS(3) {
        pg8::Gemm g{(const bf16_t*)(ws + SLOT(0)), (const bf16_t*)(ws + WS_WGATE), 1024, 128, 128, 128, 256 * 128};
        pg8::Sched S; S.init(256, 8, G, cb, 256, 8, 0);
        pg8::EpiPair<FGate> E{{(const bf16_t*)(ws + SLOT(0)), args.in[7], args.in[9], (const float*)(ws + WS_CLAM), (bf16_t*)(ws + SLOT(1)), (bf16_t*)(ws + SLOT(6))}};
        pg8::gemm_phase(ring, g, S, E);
    }
    SEAM(3);
    if (IN(4)) REPS(4) { phase_scan1(C); }
    SEAM(4);
    if (IN(5)) REPS(5) { phase_scan2(C); }
    SEAM(5);
    if (IN(6)) REPS(6) {
        pg8::Gemm g{(const bf16_t*)(ws + SLOT(0)), (const bf16_t*)(ws + WS_WRNN), 1024, 1024, 1024, 0, 256 * 1024};
        pg8::Sched S; S.init(256, 4, G, cb, 0, 0, 0);
        pg8::Epi8<FMul<false>> E{{(const bf16_t*)(ws + SLOT(4)), nullptr, (bf16_t*)(ws + SLOT(2))}};
        pg8::gemm_phase(ring, g, S, E);
    }
    SEAM(6);
    if (IN(7)) REPS(7) {
        { pg8::Gemm g{(const bf16_t*)(ws + SLOT(3)) + CQ_OFF, (const bf16_t*)(ws + WS_WUQ), CQKV_LD, 384, 384, 0, 256 * 384};
          pg8::Sched S; S.init(256, 6, G, cb, 0, 0, 0);
          pg8::Epi8<FQ> E{{(const float*)(ws + WS_RSQ), (bf16_t*)(ws + SLOT(0))}};
          pg8::gemm_phase(ring, g, S, E); }
        { pg8::Gemm g{(const bf16_t*)(ws + SLOT(3)), (const bf16_t*)(ws + WS_WUKV), CQKV_LD, 256, 256, 0, 256 * 256};
          pg8::Sched S; S.init(256, 8, G, cb, 256, 8, 0);
          pg8::Epi8<FKV> E{{(const float*)(ws + WS_RSKV), (bf16_t*)(ws + SLOT(4)), (bf16_t*)(ws + SLOT(6))}};
          pg8::gemm_phase(ring, g, S, E); }
    }
    SEAM(7);
    if (IN(8)) REPS(8) { phase_attn(C); }
    SEAM(8);
    if (IN(9)) REPS(9) {
        pg8::Gemm g{(const bf16_t*)(ws + SLOT(3)), (const bf16_t*)(ws + WS_WATT), 1024, 1024, 1024, 0, 256 * 1024};
        pg8::Sched S; S.init(256, 4, G, cb, 0, 0, 0);
        pg8::Epi8<FMul<true>> E{{(const bf16_t*)(ws + SLOT(5)), (const bf16_t*)(ws + SLOT(2)), (bf16_t*)(ws + SLOT(0))}};
        pg8::gemm_phase(ring, g, S, E);
    }
    SEAM(9);
    if (IN(10)) REPS(10) {
        pg8::Gemm g{(const bf16_t*)(ws + SLOT(0)), (const bf16_t*)(ws + WS_WOUT), 1024, 1024, 1024, 0, 256 * 1024};
        pg8::Sched S; S.init(256, 4, G, cb, 0, 0, 0);
        pg8::Epi8<FRes> E{{args.in[0], (bf16_t*)(ws + SLOT(4))}};
        pg8::gemm_phase(ring, g, S, E);
    }
    SEAM(10);
    if (IN(11)) REPS(11) {
        pg8::Gemm g{(const bf16_t*)(ws + SLOT(4)), (const bf16_t*)(ws + WS_WPQ), 1024, 1024, 1024, 0, 256 * 1024};
        pg8::Sched S; S.init(256, 8, G, cb, 0, 0, 0);
        pg8::Epi8<FF16> E{{(_Float16*)(ws + SLOT(0)), 2048}};
        pg8::gemm_phase(ring, g, S, E);
    }
    SEAM(11);
    if (IN(13)) REPS(13) { phase_x8(C); phase_topk(C); }
    SEAM(13);
    if (IN(14)) REPS(14) { phase_upart(C, (int)(blockIdx.x & 7), (int)(blockIdx.x >> 3)); }
    SEAM(14);
    if (IN(15)) REPS(15) { phase_gather(C, C.out); }
#undef IN
#undef SEAM
}

extern "C" void kernel_launch(void* const* d_in, const int* in_sizes, int n_in, void* d_out, int out_size, void* d_ws, size_t ws_size, hipStream_t stream) {
    static int grid = 0;
    if (grid == 0) {
        if (n_in != 25 || in_sizes[0] != M * DM || out_size != M * DM || ws_size < WS_END) { fprintf(stderr, "kernel_launch: unexpected shapes (n_in %d in0 %d out %d ws %zu need %zu); nothing launched\n", n_in, n_in > 0 ? in_sizes[0] : -1, out_size, ws_size, (size_t)WS_END); grid = -1; return; }
        int dev = 0, cus = 0, per_cu = 0;
        if (hipGetDevice(&dev) != hipSuccess || hipDeviceGetAttribute(&cus, hipDeviceAttributeMultiprocessorCount, dev) != hipSuccess) { grid = -1; return; }
        if (hipFuncSetAttribute((const void*)hybrid_fwd, hipFuncAttributeMaxDynamicSharedMemorySize, LDS_BYTES) != hipSuccess) { fprintf(stderr, "kernel_launch: hipFuncSetAttribute failed\n"); grid = -1; return; }
        if (hipOccupancyMaxActiveBlocksPerMultiprocessor(&per_cu, (const void*)hybrid_fwd, NTHR, LDS_BYTES) != hipSuccess || per_cu < 1) fprintf(stderr, "kernel_launch: occupancy query reports %d\n", per_cu);
        (void)hipGetLastError();
        grid = cus;
    }
    if (grid < 0) return;
    if (hipMemsetAsync((char*)d_ws + WS_CTL, 0, CTL_ZERO_BYTES, stream) != hipSuccess) return;
    Args a{};
    for (int i = 0; i < 25; ++i) a.in[i] = (const float*)d_in[i];
    a.out = (float*)d_out; a.ws = (unsigned char*)d_ws;
#if ONE_LAUNCH
    a.ph_lo = 0; a.ph_hi = NPHASE;
    hipLaunchKernelGGL(hybrid_fwd, dim3(grid), dim3(NTHR), LDS_BYTES, stream, a);
#else
    for (int p = 0; p < NPHASE; ++p) { a.ph_lo = p; a.ph_hi = p + 1; hipLaunchKernelGGL(hybrid_fwd, dim3(grid), dim3(NTHR), LDS_BYTES, stream, a); }
#endif
}
```

```cpp
#include <hip/hip_runtime.h>
#include <cstdio>
#include <cstdint>

#ifndef ONE_LAUNCH
#define ONE_LAUNCH 1
#endif

#define LAS __attribute__((address_space(3)))
#define GAS __attribute__((address_space(1)))
typedef unsigned short bf16_t;
typedef short bf16x8 __attribute__((ext_vector_type(8)));
typedef float f32x4 __attribute__((ext_vector_type(4)));
typedef float f32x2 __attribute__((ext_vector_type(2)));
typedef float f32x16 __attribute__((ext_vector_type(16)));
typedef unsigned u32x4 __attribute__((ext_vector_type(4)));
typedef unsigned u32x2 __attribute__((ext_vector_type(2)));
typedef __bf16 bf16x2_t __attribute__((ext_vector_type(2)));
typedef short v4i16_t __attribute__((ext_vector_type(4)));

constexpr int DM = 1024, NB = 32, SEQ = 2048, NMETA = 16;
constexpr int M = NB * SEQ;
constexpr int METAROW = M;
constexpr int MTOT = M + 256;
constexpr int NPOS = SEQ + NMETA;
constexpr int DIN_P = 4864;
constexpr int CQKV_LD = 768, CQ_OFF = 384, KR_OFF = 256;
constexpr int QLD = 1536;
constexpr int NEXP = 16384;
constexpr float EPS = 1e-6f;
constexpr float LOG2E = 1.4426950408889634f;
constexpr float QSCALE = 0.10206207261596577f * 1.4426950408889634f;

constexpr size_t A1 = (size_t)MTOT * 1024 * 2;
constexpr size_t WS_CTL = 0, CTL_ZERO_BYTES = 65536;
constexpr size_t WS_WIN = 1u << 20;
constexpr size_t WS_WGATE = WS_WIN + (size_t)DIN_P * 1024 * 2;
constexpr size_t WS_WUQ = WS_WGATE + 2048 * 128 * 2;
constexpr size_t WS_WUKV = WS_WUQ + 1536 * 384 * 2;
constexpr size_t WS_WRNN = WS_WUKV + 2048 * 256 * 2;
constexpr size_t WS_WATT = WS_WRNN + 1024 * 1024 * 2;
constexpr size_t WS_WOUT = WS_WATT + 1024 * 1024 * 2;
constexpr size_t WS_WPQ = WS_WOUT + 1024 * 1024 * 2;
constexpr size_t WS_KEYS = WS_WPQ + 2048 * 1024 * 2;
constexpr size_t WS_PU = WS_KEYS + 256 * 256 * 2;
constexpr size_t WS_PV = WS_PU + (size_t)NEXP * 1024;
constexpr size_t WS_SU = WS_PV + (size_t)NEXP * 1024;
constexpr size_t WS_SV = WS_SU + (size_t)NEXP * 4;
constexpr size_t WS_CTAB = WS_SV + (size_t)NEXP * 4;
constexpr size_t WS_STAB = WS_CTAB + NPOS * 16 * 4;
constexpr size_t WS_CLAM = WS_STAB + NPOS * 16 * 4;
constexpr size_t WS_RSQ = WS_CLAM + 4096;
constexpr size_t WS_RSKV = WS_RSQ + (size_t)MTOT * 4;
constexpr size_t WS_KROPE = WS_RSKV + (size_t)MTOT * 4;
constexpr size_t WS_SCP = WS_KROPE + (size_t)MTOT * 32 * 2;
constexpr size_t WS_SCH = WS_SCP + 512 * 1024 * 4;
constexpr size_t WS_CARRY0 = WS_SCH + 512 * 1024 * 4;
constexpr size_t WS_SLOTS = ((WS_CARRY0 + 4096 + 4095) / 4096) * 4096;
constexpr size_t WS_END = WS_SLOTS + 7 * A1;
#define SLOT(i) (WS_SLOTS + (size_t)(i) * A1)

#define LDS_WAIT() asm volatile("s_waitcnt lgkmcnt(0)" ::: "memory")
#define VM_WAIT() asm volatile("s_waitcnt vmcnt(0)" ::: "memory")
__device__ __forceinline__ unsigned pk2(float lo, float hi) { f32x2 v = {lo, hi}; bf16x2_t b = __builtin_convertvector(v, bf16x2_t); return __builtin_bit_cast(unsigned, b); }
__device__ __forceinline__ float bf_lo(unsigned w) { return __uint_as_float(w << 16); }
__device__ __forceinline__ float bf_hi(unsigned w) { return __uint_as_float(w & 0xffff0000u); }
__device__ __forceinline__ float bf2f(bf16_t h) { return __uint_as_float((unsigned)h << 16); }
__device__ __forceinline__ float ex2(float x) { return __builtin_amdgcn_exp2f(x); }
__device__ __forceinline__ float rcpf_(float x) { return __builtin_amdgcn_rcpf(x); }
__device__ __forceinline__ float sigm(float v) { return rcpf_(1.f + ex2(-LOG2E * v)); }
__device__ __forceinline__ float gelu_t(float v) { const float y = v * (1.f + 0.044715f * v * v); return v * rcpf_(1.f + ex2(-2.302208198f * y)); }
__device__ __forceinline__ float wave_sum(float v) {
#pragma unroll
    for (int o = 1; o < 64; o <<= 1) v += __shfl_xor(v, o);
    return v;
}
__device__ __forceinline__ void unpack8(u32x4 w, float (&o)[8]) { o[0] = bf_lo(w.x); o[1] = bf_hi(w.x); o[2] = bf_lo(w.y); o[3] = bf_hi(w.y); o[4] = bf_lo(w.z); o[5] = bf_hi(w.z); o[6] = bf_lo(w.w); o[7] = bf_hi(w.w); }
__device__ __forceinline__ u32x4 pack8(const float (&o)[8]) { u32x4 w; w.x = pk2(o[0], o[1]); w.y = pk2(o[2], o[3]); w.z = pk2(o[4], o[5]); w.w = pk2(o[6], o[7]); return w; }
__device__ __forceinline__ float dot2bf(unsigned a, unsigned b, float acc) { return __builtin_amdgcn_fdot2_f32_bf16(__builtin_bit_cast(bf16x2_t, a), __builtin_bit_cast(bf16x2_t, b), acc, false); }

namespace pg8 {
constexpr int BM = 256, BK = 64, HALF = 128, HTB = HALF * BK * 2, STAGE_BYTES = 8 * HTB, NXCD = 8, WGM = 8;
__host__ __device__ __forceinline__ int lds_byte(int r, int c) { const int st = (r >> 4) * 2 + (c >> 5), rr = r & 15, cc = c & 31, ob = rr * 64 + cc * 2; return st * 1024 + (ob ^ (((ob >> 9) & 1) << 5)); }
__host__ __device__ __forceinline__ void stage_rc(int b, int& R, int& C) { const int st = b / 1024, sb = b % 1024, swz = sb ^ (((sb >> 9) & 1) << 5); R = (st >> 1) * 16 + swz / 64; C = (st & 1) * 32 + (swz % 64) / 2; }
__host__ __device__ __forceinline__ int perm32(int rho) { const int n = rho >> 4, i = rho & 15; return 8 * (i >> 2) + 4 * n + (i & 3); }

struct Unit { int pm, pn; };
struct Gemm { const bf16_t* A; const bf16_t* Bt; int lda, ldb, K, a_pn_off, b_pn_stride; };

struct Sched {
    int nM, nN, nwg, G, c, xpm, xn, xskip;
    __device__ __forceinline__ void init(int nM_, int nN_, int G_, int c_, int xpm_, int xn_, int xskip_) { nM = nM_; nN = nN_; nwg = nM_ * nN_; G = G_; c = c_; xpm = xpm_; xn = xn_; xskip = xskip_; }
    __device__ __forceinline__ bool next(int i, Unit& u) const {
        const int nmain = nwg > c ? (nwg - c - 1) / G + 1 : 0;
        if (i < nmain) {
            int wgid = i * G + c; { const int q = nwg / NXCD, r = nwg % NXCD, xcd = wgid % NXCD, off = wgid / NXCD; wgid = (xcd < r ? xcd * (q + 1) : r * (q + 1) + (xcd - r) * q) + off; }
            const int nig = WGM * nN, gid = wgid / nig, fm = gid * WGM, gsz = (nM - fm) < WGM ? (nM - fm) : WGM;
            u.pm = fm + ((wgid % nig) % gsz); u.pn = (wgid % nig) / gsz; return true;
        }
        const int e = G - 1 - c;
        if (i == nmain && e < xn) { u.pm = xpm; u.pn = e + (e >= 4 ? xskip : 0); return true; }
        return false;
    }
};

template <class F> struct Epi8 {
    static constexpr bool PERM = true;
    F f;
    __device__ __forceinline__ void operator()(const f32x4 (&acc)[2][2][4][2], const Unit& u, int wr, int wc, int fr, int fq) const {
        const int row0 = u.pm * BM + wr * 64 + fr, col0 = u.pn * BM + wc * 32 + 8 * fq;
#pragma unroll
        for (int ai = 0; ai < 2; ++ai) {
            typename F::Pre pre[4][2];
#pragma unroll
            for (int m = 0; m < 4; ++m)
#pragma unroll
                for (int bj = 0; bj < 2; ++bj) pre[m][bj] = f.load(u.pn, row0 + ai * HALF + m * 16, col0 + bj * HALF);
#pragma unroll
            for (int m = 0; m < 4; ++m)
#pragma unroll
                for (int bj = 0; bj < 2; ++bj) f.apply(pre[m][bj], u.pn, row0 + ai * HALF + m * 16, col0 + bj * HALF, acc[ai][bj][m][0], acc[ai][bj][m][1]);
        }
    }
};
template <class F> struct EpiPair {
    static constexpr bool PERM = true;
    F f;
    __device__ __forceinline__ void operator()(const f32x4 (&acc)[2][2][4][2], const Unit& u, int wr, int wc, int fr, int fq) const {
        const int row0 = u.pm * BM + wr * 64 + fr, col0 = wc * 32 + 8 * fq;
#pragma unroll
        for (int ai = 0; ai < 2; ++ai) {
            typename F::Pre pre[4];
#pragma unroll
            for (int m = 0; m < 4; ++m) pre[m] = f.load(u.pn, row0 + ai * HALF + m * 16, col0);
#pragma unroll
            for (int m = 0; m < 4; ++m) f.apply(pre[m], u.pn, row0 + ai * HALF + m * 16, col0, acc[ai][0][m][0], acc[ai][0][m][1], acc[ai][1][m][0], acc[ai][1][m][1]);
        }
    }
};

template <class Epi>
__device__ __forceinline__ void gemm_phase(LAS unsigned char* lds, const Gemm g, const Sched& S, const Epi& E) {
    int tid_ = threadIdx.x; asm volatile("" : "+v"(tid_));
    const int tid = tid_, wid = __builtin_amdgcn_readfirstlane(tid >> 6), lane = tid & 63, wr = wid >> 2, wc = wid & 3, fr = lane & 15, fq = lane >> 4;
    int nt_ = g.K / BK; asm volatile("" : "+s"(nt_));
    const int nt = nt_;
    unsigned voffA[2], voffB[2];
#pragma unroll
    for (int i = 0; i < 2; ++i) { int R, C; stage_rc(tid * 16 + i * 8192, R, C); const int Rb = Epi::PERM ? ((R & ~31) + perm32(R & 31)) : R;
        voffA[i] = (unsigned)(R * g.lda + C) * 2u; voffB[i] = (unsigned)(Rb * g.ldb + C) * 2u; }
    const size_t kstep = (size_t)(BK * 2);
    const size_t hA = (size_t)HALF * g.lda * 2, hB = (size_t)HALF * g.ldb * 2;
    const unsigned ldsw = (unsigned)wid * 1024u;
    const int aoff = lds_byte(wr * 64 + fr, fq * 8), boff = lds_byte(wc * 32 + fr, fq * 8);
#define PG8_SA(b, h) (((b) * 2 + (h)) * HTB)
#define PG8_SB(b, h) ((4 + (b) * 2 + (h)) * HTB)
#define PG8_STAGE(bufoff, gbase, voff) do { _Pragma("unroll") for (int _i = 0; _i < 2; ++_i) \
        __builtin_amdgcn_global_load_lds((const unsigned*)((const char*)(gbase) + (voff)[_i]), (LAS unsigned*)(lds + (bufoff) + ldsw + _i * 8192), 16, 0, 0); } while (0)
#define PG8_LDA(dst, b, h) do { _Pragma("unroll") for (int m = 0; m < 4; ++m) _Pragma("unroll") for (int k = 0; k < 2; ++k) dst[m][k] = *(const LAS bf16x8*)(lds + PG8_SA(b, h) + aoff + m * 2048 + k * 1024); } while (0)
#define PG8_LDB(dst, b, h) do { _Pragma("unroll") for (int n = 0; n < 2; ++n) _Pragma("unroll") for (int k = 0; k < 2; ++k) dst[n][k] = *(const LAS bf16x8*)(lds + PG8_SB(b, h) + boff + n * 2048 + k * 1024); } while (0)
#define PG8_MMA(ai, bj, At, Bt) do { __builtin_amdgcn_s_setprio(1); _Pragma("unroll") for (int m = 0; m < 4; ++m) _Pragma("unroll") for (int n = 0; n < 2; ++n) _Pragma("unroll") for (int k = 0; k < 2; ++k) \
        acc[ai][bj][m][n] = __builtin_amdgcn_mfma_f32_16x16x32_bf16(Bt[n][k], At[m][k], acc[ai][bj][m][n], 0, 0, 0); __builtin_amdgcn_s_setprio(0); } while (0)
#define PG8_WAIT_V(n) asm volatile("s_waitcnt vmcnt(" #n ")" ::: "memory")
#define PG8_WAIT_L(n) asm volatile("s_waitcnt lgkmcnt(" #n ")" ::: "memory")
#define PG8_BAR __builtin_amdgcn_s_barrier()
#define PG8_SCHED __builtin_amdgcn_sched_barrier(0)
#define PG8_ABASE(u) ((const char*)g.A + ((size_t)(u).pm * BM * g.lda + (size_t)(u).pn * g.a_pn_off) * 2)
#define PG8_BBASE(u) ((const char*)g.Bt + (size_t)(u).pn * g.b_pn_stride * 2)
    Unit cur, nxt; int ui = 0;
    if (!S.next(0, cur)) return;
    f32x4 acc[2][2][4][2];
#pragma unroll
    for (int a = 0; a < 2; ++a)
#pragma unroll
        for (int b = 0; b < 2; ++b)
#pragma unroll
            for (int m = 0; m < 4; ++m)
#pragma unroll
                for (int n = 0; n < 2; ++n) acc[a][b][m][n] = (f32x4){0.f, 0.f, 0.f, 0.f};
    bf16x8 At[4][2], B0[2][2], B1[2][2];
    const char* cA = PG8_ABASE(cur); const char* cB = PG8_BBASE(cur);
    PG8_STAGE(PG8_SB(0, 0), cB, voffB); PG8_STAGE(PG8_SB(0, 1), cB + hB, voffB); PG8_STAGE(PG8_SA(0, 0), cA, voffA); PG8_STAGE(PG8_SA(0, 1), cA + hA, voffA);
    if (wr == 1) PG8_BAR;
    PG8_WAIT_V(2); PG8_BAR;
    PG8_STAGE(PG8_SB(1, 0), cB + kstep, voffB); PG8_STAGE(PG8_SA(1, 0), cA + kstep, voffA); PG8_STAGE(PG8_SB(1, 1), cB + hB + kstep, voffB);
    PG8_WAIT_V(6); PG8_BAR;
    for (;;) {
        const bool has_next = S.next(ui + 1, nxt);
        const char* nA = has_next ? PG8_ABASE(nxt) : cA; const char* nB = has_next ? PG8_BBASE(nxt) : cB;
        asm volatile("" : "+s"(cA), "+s"(cB), "+s"(nA), "+s"(nB));
#pragma unroll 1
        for (int t = 0; t < nt; t += 2) {
            const bool last = (t == nt - 2);
            const char* a1 = cA + (size_t)(t + 1) * kstep;
            const char* a2 = last ? nA : cA + (size_t)(t + 2) * kstep; const char* b2 = last ? nB : cB + (size_t)(t + 2) * kstep;
            const char* a3 = a2 + kstep; const char* b3 = b2 + kstep;
            PG8_LDB(B0, 0, 0); PG8_LDB(B1, 0, 1); PG8_SCHED; PG8_LDA(At, 0, 0); PG8_STAGE(PG8_SA(1, 1), a1 + hA, voffA);
            PG8_WAIT_V(8); PG8_WAIT_L(0); PG8_BAR; PG8_MMA(0, 0, At, B0); PG8_MMA(0, 1, At, B1); PG8_BAR; PG8_SCHED;
            PG8_LDA(At, 0, 1); PG8_STAGE(PG8_SB(0, 0), b2, voffB); PG8_STAGE(PG8_SB(0, 1), b2 + hB, voffB); PG8_STAGE(PG8_SA(0, 0), a2, voffA);
            PG8_WAIT_V(8); PG8_WAIT_L(0); PG8_BAR; PG8_MMA(1, 0, At, B0); PG8_MMA(1, 1, At, B1); PG8_BAR; PG8_SCHED;
            PG8_LDB(B0, 1, 0); PG8_LDB(B1, 1, 1); PG8_SCHED; PG8_LDA(At, 1, 0); PG8_STAGE(PG8_SA(0, 1), a2 + hA, voffA);
            PG8_WAIT_V(8); PG8_WAIT_L(0); PG8_BAR; PG8_MMA(0, 0, At, B0); PG8_MMA(0, 1, At, B1); PG8_BAR; PG8_SCHED;
            PG8_LDA(At, 1, 1); PG8_STAGE(PG8_SB(1, 0), b3, voffB); PG8_STAGE(PG8_SB(1, 1), b3 + hB, voffB); PG8_STAGE(PG8_SA(1, 0), a3, voffA);
            PG8_WAIT_V(8); PG8_WAIT_L(0); PG8_BAR; PG8_MMA(1, 0, At, B0); PG8_MMA(1, 1, At, B1); PG8_BAR; PG8_SCHED;
        }
        if (wr == 0) PG8_BAR;
        E(acc, cur, wr, wc, fr, fq);
        if (!has_next) break;
#pragma unroll
        for (int a = 0; a < 2; ++a)
#pragma unroll
            for (int b = 0; b < 2; ++b)
#pragma unroll
                for (int m = 0; m < 4; ++m)
#pragma unroll
                    for (int n = 0; n < 2; ++n) acc[a][b][m][n] = (f32x4){0.f, 0.f, 0.f, 0.f};
        cur = nxt; cA = nA; cB = nB; ++ui;
        if (wr == 1) PG8_BAR;
    }
    PG8_WAIT_V(0);
    PG8_BAR;
#undef PG8_SA
#undef PG8_SB
#undef PG8_STAGE
#undef PG8_LDA
#undef PG8_LDB
#undef PG8_MMA
#undef PG8_WAIT_V
#undef PG8_WAIT_L
#undef PG8_BAR
#undef PG8_SCHED
#undef PG8_ABASE
#undef PG8_BBASE
}
}

#define XB_TMO      128
#define XB_XCNT(j)  (256  + 64 * (j))
#define XB_XSUB(j)  (1280 + 64 * (j))
#define XB_XGEN(j)  (2304 + 64 * (j))
#define XB_TOP      3328
#define XB_TOPGEN   3392
#define XCD_BAR_WORDS 3456
#define XB_SPIN_CAP (1u << 18)
__device__ __forceinline__ unsigned xb_ld(unsigned* p)              { return __hip_atomic_load(p, __ATOMIC_RELAXED, __HIP_MEMORY_SCOPE_AGENT); }
__device__ __forceinline__ unsigned xb_add(unsigned* p, unsigned v) { return __hip_atomic_fetch_add(p, v, __ATOMIC_RELAXED, __HIP_MEMORY_SCOPE_AGENT); }
__device__ __forceinline__ unsigned xb_xcc_id() { return (unsigned)__builtin_amdgcn_s_getreg((3 << 11) | 20) & 0xFu; }
#define XB_SPIN(cond, bar) do { unsigned _sp = 0; while (cond) { __builtin_amdgcn_s_sleep(1); \
    if ((++_sp & 255u) == 0u) { if (xb_ld(&(bar)[XB_TMO])) break; if (_sp > XB_SPIN_CAP) { atomicAdd(&(bar)[XB_TMO], 1u); break; } } } } while (0)
struct XcdBarrier { unsigned* bar; unsigned x; volatile LAS unsigned* st; };
__device__ __forceinline__ XcdBarrier xcd_barrier_post(unsigned* bar, volatile LAS unsigned* st) {
    XcdBarrier b; b.bar = bar; b.x = xb_xcc_id(); b.st = st;
    if (threadIdx.x == 0) (void)xb_add(&bar[XB_XCNT(b.x)], 1u);
    return b;
}
__device__ __forceinline__ void xcd_barrier_complete(unsigned* bar, unsigned x, unsigned& nloc, unsigned& nx) {
    const unsigned G = gridDim.x * gridDim.y * gridDim.z;
    unsigned sum, cnt, mine, sp = 0u;
    for (;;) {
        sum = 0u; cnt = 0u; mine = 0u;
#pragma unroll
        for (unsigned j = 0; j < 16; ++j) { const unsigned c = xb_ld(&bar[XB_XCNT(j)]); sum += c; cnt += (c > 0u) ? 1u : 0u; mine = (j == x) ? c : mine; }
        if (sum == G) break;
        __builtin_amdgcn_s_sleep(1);
        if ((++sp & 255u) == 0u) { if (xb_ld(&bar[XB_TMO])) break; if (sp > XB_SPIN_CAP) { atomicAdd(&bar[XB_TMO], 1u); break; } }
    }
    nloc = mine > 0u ? mine : 1u; nx = cnt > 0u ? cnt : 1u;
}
__device__ __forceinline__ void xcd_barrier(const XcdBarrier& b) {
    asm volatile("s_waitcnt vmcnt(0)" ::: "memory");
    __syncthreads();
    if (threadIdx.x == 0) {
        unsigned* bar = b.bar;
        __builtin_amdgcn_s_waitcnt(0);
        unsigned nloc = b.st[0], nx = b.st[1];
        if (nloc == 0u) { xcd_barrier_complete(bar, b.x, nloc, nx); b.st[0] = nloc; b.st[1] = nx; }
        const unsigned old = xb_add(&bar[XB_XSUB(b.x)], 1u);
        const unsigned gen = old / nloc;
        if (old + 1u == (gen + 1u) * nloc) {
            __builtin_amdgcn_fence(__ATOMIC_RELEASE, "agent");
            asm volatile("s_waitcnt vmcnt(0)" ::: "memory");
            const unsigned og = xb_add(&bar[XB_TOP], 1u);
            const unsigned tg = og / nx;
            if (og + 1u == (tg + 1u) * nx) xb_add(&bar[XB_TOPGEN], 1u);
            else XB_SPIN(xb_ld(&bar[XB_TOPGEN]) == tg, bar);
            __builtin_amdgcn_fence(__ATOMIC_ACQUIRE, "agent");
            xb_add(&bar[XB_XGEN(b.x)], 1u);
            asm volatile("s_waitcnt vmcnt(0)" ::: "memory");
        } else {
            XB_SPIN(xb_ld(&bar[XB_XGEN(b.x)]) == gen, bar);
            __builtin_amdgcn_fence(__ATOMIC_ACQUIRE, "agent");
            asm volatile("s_waitcnt vmcnt(0)" ::: "memory");
        }
    }
    __syncthreads();
}

constexpr int NWAVES = 8, NTHR = 512;
constexpr int RING_BYTES = 131072, MISC_OFF = RING_BYTES + 320, LDS_BYTES = 147456;
struct Args { const float* in[25]; float* out; unsigned char* ws; int ph_lo, ph_hi; };
static_assert(sizeof(Args) == 25 * 8 + 8 + 8 + 8, "Args has no padding");

struct Ctx {
    LAS unsigned char* lds; int tid, lane, wave, G, gw, NGW;
    unsigned char* ws; float* out; const float* const* in;
};

__device__ __forceinline__ void store8(bf16_t* p, f32x4 a, f32x4 b) { u32x4 w; w.x = pk2(a[0], a[1]); w.y = pk2(a[2], a[3]); w.z = pk2(b[0], b[1]); w.w = pk2(b[2], b[3]); *(u32x4*)p = w; }
struct NoPre {};
struct FInproj {
    typedef NoPre Pre;
    bf16_t *XR, *GR, *CQKV, *GRNN, *GATT;
    __device__ __forceinline__ Pre load(int, int, int) const { return Pre(); }
    __device__ __forceinline__ void apply(const Pre&, int pn, int row, int col, f32x4 a, f32x4 b) const {
        if (pn < 4) { store8(XR + (size_t)row * 1024 + col, a, b); }
        else if (pn < 8) {
#pragma unroll
            for (int i = 0; i < 4; ++i) { a[i] = gelu_t(a[i]); b[i] = gelu_t(b[i]); }
            store8(GR + (size_t)row * 1024 + (col - 1024), a, b); }
        else if (pn < 11) { store8(CQKV + (size_t)row * CQKV_LD + (col - 2048), a, b); }
        else {
#pragma unroll
            for (int i = 0; i < 4; ++i) { a[i] = sigm(a[i]); b[i] = sigm(b[i]); }
            if (pn < 15) store8(GRNN + (size_t)row * 1024 + (col - 2816), a, b); else store8(GATT + (size_t)row * 1024 + (col - 3840), a, b); }
    }
};
struct FGate {
    struct Pre { u32x4 xc; };
    const bf16_t* XC; const float *ba, *bx, *clam; bf16_t *LA, *UU;
    __device__ __forceinline__ Pre load(int pn, int row, int cl) const { Pre p; p.xc = *(const u32x4*)(XC + (size_t)row * 1024 + pn * 128 + cl); return p; }
    __device__ __forceinline__ void apply(const Pre& pr, int pn, int row, int cl, f32x4 a0, f32x4 a1, f32x4 x0, f32x4 x1) const {
        const int ch = pn * 128 + cl; const size_t off = (size_t)row * 1024 + ch;
        float xc[8]; unpack8(pr.xc, xc);
        const f32x4 ba0 = *(const f32x4*)(ba + ch), ba1 = *(const f32x4*)(ba + ch + 4), bx0 = *(const f32x4*)(bx + ch), bx1 = *(const f32x4*)(bx + ch + 4), cl0 = *(const f32x4*)(clam + ch), cl1 = *(const f32x4*)(clam + ch + 4);
        float la[8], uu[8];
#pragma unroll
        for (int i = 0; i < 8; ++i) {
            const float ga = (i < 4 ? a0[i & 3] + ba0[i & 3] : a1[i & 3] + ba1[i & 3]), gx = (i < 4 ? x0[i & 3] + bx0[i & 3] : x1[i & 3] + bx1[i & 3]), cc = (i < 4 ? cl0[i & 3] : cl1[i & 3]);
            const float r = sigm(ga), ig = sigm(gx), l = r * cc;
            la[i] = l; uu[i] = sqrtf(fmaxf(1.f - ex2(2.f * LOG2E * l), 0.f)) * (ig * xc[i]);
        }
        *(u32x4*)(LA + off) = pack8(la); *(u32x4*)(UU + off) = pack8(uu);
    }
};
struct FQ {
    struct Pre { float sc; };
    const float* rsq; bf16_t* Q;
    __device__ __forceinline__ Pre load(int, int row, int) const { Pre p; p.sc = rsq[row]; return p; }
    __device__ __forceinline__ void apply(const Pre& pr, int pn, int row, int col, f32x4 a, f32x4 b) const {
        const float sc = pr.sc * QSCALE; a = a * sc; b = b * sc;
        store8(Q + (size_t)row * QLD + col, a, b);
    }
};
struct FKV {
    struct Pre { float sc; };
    const float* rskv; bf16_t *KN, *V;
    __device__ __forceinline__ Pre load(int, int row, int) const { Pre p; p.sc = rskv[row]; return p; }
    __device__ __forceinline__ void apply(const Pre& pr, int pn, int row, int col, f32x4 a, f32x4 b) const {
        const float sc = pr.sc; a = a * sc; b = b * sc;
        if (pn < 4) store8(KN + (size_t)row * 1024 + col, a, b); else store8(V + (size_t)row * 1024 + (col - 1024), a, b);
    }
};
template <bool HAS_ADD> struct FMul {
    struct Pre { u32x4 g, ad; };
    const bf16_t* Gt; const bf16_t* ADD; bf16_t* O;
    __device__ __forceinline__ Pre load(int, int row, int col) const { const size_t off = (size_t)row * 1024 + col; Pre p; p.g = *(const u32x4*)(Gt + off); if (HAS_ADD) p.ad = *(const u32x4*)(ADD + off); else p.ad = (u32x4){0u, 0u, 0u, 0u}; return p; }
    __device__ __forceinline__ void apply(const Pre& pr, int pn, int row, int col, f32x4 a, f32x4 b) const {
        const size_t off = (size_t)row * 1024 + col; float gg[8]; unpack8(pr.g, gg);
        if (HAS_ADD) { float ad[8]; unpack8(pr.ad, ad);
#pragma unroll
            for (int i = 0; i < 4; ++i) { a[i] = ad[i] + gg[i] * a[i]; b[i] = ad[4 + i] + gg[4 + i] * b[i]; } }
        else {
#pragma unroll
            for (int i = 0; i < 4; ++i) { a[i] = gg[i] * a[i]; b[i] = gg[4 + i] * b[i]; } }
        store8(O + off, a, b);
    }
};
struct FRes {
    struct Pre { f32x4 x0, x1; };
    const float* X; bf16_t* H1B;
    __device__ __forceinline__ Pre load(int, int row, int col) const { const size_t off = (size_t)row * 1024 + col; Pre p; p.x0 = *(const f32x4*)(X + off); p.x1 = *(const f32x4*)(X + off + 4); return p; }
    __device__ __forceinline__ void apply(const Pre& pr, int pn, int row, int col, f32x4 a, f32x4 b) const {
        store8(H1B + (size_t)row * 1024 + col, a + pr.x0, b + pr.x1);
    }
};
typedef _Float16 f16x8 __attribute__((ext_vector_type(8)));
struct FF16 { typedef NoPre Pre; _Float16* O; int ldc;
    __device__ __forceinline__ Pre load(int, int, int) const { return Pre(); }
    __device__ __forceinline__ void apply(const Pre&, int pn, int row, int col, f32x4 a, f32x4 b) const {
        f16x8 h = {(_Float16)a[0], (_Float16)a[1], (_Float16)a[2], (_Float16)a[3], (_Float16)b[0], (_Float16)b[1], (_Float16)b[2], (_Float16)b[3]};
        *(f16x8*)(O + (size_t)row * ldc + col) = h; } };
struct FF32 { typedef NoPre Pre; float* O; int ldc;
    __device__ __forceinline__ Pre load(int, int, int) const { return Pre(); }
    __device__ __forceinline__ void apply(const Pre&, int pn, int row, int col, f32x4 a, f32x4 b) const { float* p = O + (size_t)row * ldc + col; *(f32x4*)p = a; *(f32x4*)(p + 4) = b; } };

struct MapId { __device__ __forceinline__ int operator()(int n) const { return n; } };
struct MapWin { __device__ __forceinline__ int operator()(int n) const {
    if (n < 2048) return n;
    if (n < 2816) { const int c = n - 2048; if (c < 256) return 2432 + c; if (c < 288) return 2688 + (c - 256); if (c < 384) return -1; return 2048 + (c - 384); }
    if (n < 3840) return 2720 + (n - 2816);
    return 3744 + (n - 3840); } };
struct MapUq { __device__ __forceinline__ int operator()(int n) const { const int h = n / 96, w = n % 96; if (w < 64) return n; const int t = w - 64; return h * 96 + 64 + (t >> 1) + 16 * (t & 1); } };
struct MapUkv { __device__ __forceinline__ int operator()(int n) const { if (n < 1024) return (n >> 6) * 128 + (n & 63); const int m = n - 1024; return (m >> 6) * 128 + 64 + (m & 63); } };

template <class Map> __device__ __forceinline__ void transpose_item(const float* W, int ldw, int Ndst, bf16_t* WT, int ldt, const float* kscale, LAS float* scr, int item, int lane, Map map) {
    const int nblk = Ndst / 32, kb = item / nblk, nb = item % nblk, k0 = 64 * kb, n0 = 32 * nb;
    const int src = map(n0 + (lane & 31));
#pragma unroll 8
    for (int i = 0; i < 32; ++i) { const int kk = 2 * i + (lane >> 5); float v = 0.f; if (src >= 0) { v = W[(size_t)(k0 + kk) * ldw + src]; if (kscale) v *= kscale[k0 + kk]; } scr[kk * 33 + (lane & 31)] = v; }
    LDS_WAIT(); asm volatile("" ::: "memory");
    const int c = lane & 7;
#pragma unroll
    for (int j = 0; j < 4; ++j) { const int n = (lane >> 3) + 8 * j; const LAS float* s = scr + (8 * c) * 33 + n;
        u32x4 o; o.x = pk2(s[0 * 33], s[1 * 33]); o.y = pk2(s[2 * 33], s[3 * 33]); o.z = pk2(s[4 * 33], s[5 * 33]); o.w = pk2(s[6 * 33], s[7 * 33]);
        *(u32x4*)(WT + (size_t)(n0 + n) * ldt + k0 + 8 * c) = o; }
    LDS_WAIT(); asm volatile("" ::: "memory");
}
__device__ __forceinline__ void rms_row_bf16(const float* xrow, const float* g, bf16_t* orow, int lane) {
    const f32x4* xr = (const f32x4*)xrow + lane; f32x4 v[4]; float s = 0.f;
#pragma unroll
    for (int j = 0; j < 4; ++j) { v[j] = xr[64 * j]; s += (v[j][0] * v[j][0] + v[j][1] * v[j][1]) + (v[j][2] * v[j][2] + v[j][3] * v[j][3]); }
    const float rstd = 1.f / sqrtf(wave_sum(s) * (1.f / 1024.f) + EPS);
    u32x2* o8 = (u32x2*)orow + lane;
#pragma unroll
    for (int j = 0; j < 4; ++j) { const f32x4 gg = ((const f32x4*)g)[lane + 64 * j]; u32x2 w; w.x = pk2(v[j][0] * rstd * gg[0], v[j][1] * rstd * gg[1]); w.y = pk2(v[j][2] * rstd * gg[2], v[j][3] * rstd * gg[3]); o8[64 * j] = w; }
}
__device__ __forceinline__ void rms_row_f32(const float* xrow, const float* g, float* orow, int lane) {
    const f32x4* xr = (const f32x4*)xrow + lane; f32x4 v[4]; float s = 0.f;
#pragma unroll
    for (int j = 0; j < 4; ++j) { v[j] = xr[64 * j]; s += (v[j][0] * v[j][0] + v[j][1] * v[j][1]) + (v[j][2] * v[j][2] + v[j][3] * v[j][3]); }
    const float rstd = 1.f / sqrtf(wave_sum(s) * (1.f / 1024.f) + EPS);
#pragma unroll
    for (int j = 0; j < 4; ++j) { const f32x4 gg = ((const f32x4*)g)[lane + 64 * j]; ((f32x4*)orow)[lane + 64 * j] = v[j] * rstd * gg; }
}

__device__ __forceinline__ void phase_prologue(const Ctx& C) {
    unsigned char* ws = C.ws; const float* const* in = C.in;
    LAS float* scr = (LAS float*)(C.lds + C.wave * 16384);
    const int gw = C.gw, NGW = C.NGW, lane = C.lane;
    constexpr int I_WIN = 16 * (DIN_P / 32), I_UQ = 6 * (1536 / 32), I_UKV = 4 * (2048 / 32), I_SQ = 16 * 32, I_G = 2 * 4;
    constexpr int NITEMS = I_WIN + I_UQ + I_UKV + 3 * I_SQ + 16 * I_G;
    for (int it = gw; it < NITEMS; it += NGW) {
        int r = it;
        if (r < I_WIN) { transpose_item(in[3], 4768, DIN_P, (bf16_t*)(ws + WS_WIN), 1024, nullptr, scr, r, lane, MapWin()); continue; } r -= I_WIN;
        if (r < I_UQ) { transpose_item(in[13], 1536, 1536, (bf16_t*)(ws + WS_WUQ), 384, in[12], scr, r, lane, MapUq()); continue; } r -= I_UQ;
        if (r < I_UKV) { transpose_item(in[15], 2048, 2048, (bf16_t*)(ws + WS_WUKV), 256, in[14], scr, r, lane, MapUkv()); continue; } r -= I_UKV;
        if (r < I_SQ) { transpose_item(in[11], 1024, 1024, (bf16_t*)(ws + WS_WRNN), 1024, nullptr, scr, r, lane, MapId()); continue; } r -= I_SQ;
        if (r < I_SQ) { transpose_item(in[16], 1024, 1024, (bf16_t*)(ws + WS_WATT), 1024, nullptr, scr, r, lane, MapId()); continue; } r -= I_SQ;
        if (r < I_SQ) { transpose_item(in[17], 1024, 1024, (bf16_t*)(ws + WS_WOUT), 1024, nullptr, scr, r, lane, MapId()); continue; } r -= I_SQ;
        { const int mat = r / I_G, sub = r % I_G, blk = mat >> 1, which = mat & 1;
          transpose_item((which ? in[8] : in[6]) + (size_t)blk * 16384, 128, 128, (bf16_t*)(ws + WS_WGATE) + (size_t)(blk * 256 + which * 128) * 128, 128, nullptr, scr, sub, lane, MapId()); }
    }
    const int gt = blockIdx.x * NTHR + C.tid, NT = C.G * NTHR;
    for (int it = blockIdx.x; it < 256; it += C.G) {
        const int hh = it >> 4, kc = it & 15, half = hh & 1, k = kc * 64 + lane, c0 = 16 * C.wave;
        const f32x4* keys = (const f32x4*)((half ? in[21] : in[20]) + (size_t)c0 * 128);
        LAS f32x4* ks = (LAS f32x4*)scr;
#pragma unroll
        for (int j = 0; j < 8; ++j) ks[j * 64 + lane] = keys[j * 64 + lane];
        const f32x4* wq = (const f32x4*)(in[19] + (size_t)k * 2048 + hh * 128); const float g2k = in[18][k];
        f32x4 a[32];
#pragma unroll
        for (int d4 = 0; d4 < 32; ++d4) a[d4] = wq[d4];
        LDS_WAIT(); asm volatile("" ::: "memory");
        bf16_t* o = (bf16_t*)(ws + WS_WPQ) + (size_t)(hh * 128 + c0) * 1024 + k;
#pragma unroll 4
        for (int c = 0; c < 16; ++c) { float s0 = 0.f, s1 = 0.f;
#pragma unroll
            for (int d4 = 0; d4 < 32; d4 += 2) { const f32x4 k0 = ks[c * 32 + d4], k1 = ks[c * 32 + d4 + 1]; s0 += (a[d4][0] * k0[0] + a[d4][1] * k0[1]) + (a[d4][2] * k0[2] + a[d4][3] * k0[3]); s1 += (a[d4 + 1][0] * k1[0] + a[d4 + 1][1] * k1[1]) + (a[d4 + 1][2] * k1[2] + a[d4 + 1][3] * k1[3]); }
            o[(size_t)c * 1024] = (bf16_t)(pk2((s0 + s1) * g2k, 0.f) & 0xffffu); }
        LDS_WAIT(); asm volatile("" ::: "memory");
    }
    for (int i = gt; i < NPOS * 16; i += NT) { const int pos = i >> 4, j = i & 15; const float inv = exp2f(-(float)j * (13.287712379549449f / 16.f)); const float ang = (float)pos * inv;
        float t = ang * 0.15915494309189535f; t = t - floorf(t);
        ((float*)(ws + WS_CTAB))[i] = __builtin_amdgcn_cosf(t); ((float*)(ws + WS_STAB))[i] = __builtin_amdgcn_sinf(t); }
    for (int i = gt; i < 1024; i += NT) { const float lam = in[10][i]; ((float*)(ws + WS_CLAM))[i] = -8.f * log1pf(expf(-lam)); }
    {
        f32x4 g2n[4];
#pragma unroll
        for (int j = 0; j < 4; ++j) g2n[j] = ((const f32x4*)(in[18] + 16 * lane))[j];
        for (int e = gw; e < NEXP; e += NGW) {
            f32x4 v[4]; float am = 0.f;
#pragma unroll
            for (int j = 0; j < 4; ++j) { v[j] = ((const f32x4*)(in[22] + (size_t)e * 1024 + 16 * lane))[j] * g2n[j]; am = fmaxf(am, fmaxf(fmaxf(fabsf(v[j][0]), fabsf(v[j][1])), fmaxf(fabsf(v[j][2]), fabsf(v[j][3])))); }
#pragma unroll
            for (int o = 1; o < 64; o <<= 1) am = fmaxf(am, __shfl_xor(am, o));
            const float scale = am > 0.f ? am * (1.f / 127.f) : 1.f, inv = 1.f / scale;
            u32x4 w;
#pragma unroll
            for (int j = 0; j < 4; ++j) { const int q0 = (int)rintf(v[j][0] * inv), q1 = (int)rintf(v[j][1] * inv), q2 = (int)rintf(v[j][2] * inv), q3 = (int)rintf(v[j][3] * inv);
                w[j] = (unsigned)(q0 & 255) | ((unsigned)(q1 & 255) << 8) | ((unsigned)(q2 & 255) << 16) | ((unsigned)q3 << 24); }
            *(u32x4*)(ws + WS_PU + (size_t)e * 1024 + 16 * lane) = w;
            if (lane == 0) ((float*)(ws + WS_SU))[e] = scale;
        }
    }
    for (int e = gw; e < NEXP; e += NGW) {
        f32x4 v[4]; float am = 0.f;
#pragma unroll
        for (int j = 0; j < 4; ++j) { v[j] = ((const f32x4*)(in[23] + (size_t)e * 1024 + 16 * lane))[j]; am = fmaxf(am, fmaxf(fmaxf(fabsf(v[j][0]), fabsf(v[j][1])), fmaxf(fabsf(v[j][2]), fabsf(v[j][3])))); }
#pragma unroll
        for (int o = 1; o < 64; o <<= 1) am = fmaxf(am, __shfl_xor(am, o));
        const float scale = am > 0.f ? am * (1.f / 6.f) : 1.f, inv = 1.f / scale;
        u32x2 w;
#pragma unroll
        for (int d = 0; d < 2; ++d) { unsigned p = 0u;
            p = __builtin_amdgcn_cvt_scalef32_pk_fp4_f32(p, v[2 * d][0] * inv, v[2 * d][1] * inv, 1.0f, 0); p = __builtin_amdgcn_cvt_scalef32_pk_fp4_f32(p, v[2 * d][2] * inv, v[2 * d][3] * inv, 1.0f, 1);
            p = __builtin_amdgcn_cvt_scalef32_pk_fp4_f32(p, v[2 * d + 1][0] * inv, v[2 * d + 1][1] * inv, 1.0f, 2); p = __builtin_amdgcn_cvt_scalef32_pk_fp4_f32(p, v[2 * d + 1][2] * inv, v[2 * d + 1][3] * inv, 1.0f, 3);
            w[d] = p; }
        *(u32x2*)(ws + WS_PV + (size_t)e * 512 + 8 * lane) = w;
        if (lane == 0) ((float*)(ws + WS_SV))[e] = scale;
    }
    bf16_t* N1 = (bf16_t*)(ws + SLOT(0));
    {
        f32x4 gg[4];
#pragma unroll
        for (int j = 0; j < 4; ++j) gg[j] = ((const f32x4*)in[2])[lane + 64 * j];
        int m = gw; f32x4 nv[4];
        if (m < M) {
#pragma unroll
            for (int j = 0; j < 4; ++j) nv[j] = ((const f32x4*)(in[0] + (size_t)m * 1024))[lane + 64 * j]; }
        for (; m < M; m += NGW) {
            f32x4 v[4]; float sq = 0.f;
#pragma unroll
            for (int j = 0; j < 4; ++j) { v[j] = nv[j]; sq += (v[j][0] * v[j][0] + v[j][1] * v[j][1]) + (v[j][2] * v[j][2] + v[j][3] * v[j][3]); }
            if (m + NGW < M) {
#pragma unroll
                for (int j = 0; j < 4; ++j) nv[j] = ((const f32x4*)(in[0] + (size_t)(m + NGW) * 1024))[lane + 64 * j]; }
            const float rstd = 1.f / sqrtf(wave_sum(sq) * (1.f / 1024.f) + EPS);
            u32x2* o8 = (u32x2*)(N1 + (size_t)m * 1024) + lane;
#pragma unroll
            for (int j = 0; j < 4; ++j) { u32x2 w; w.x = pk2(v[j][0] * rstd * gg[j][0], v[j][1] * rstd * gg[j][1]); w.y = pk2(v[j][2] * rstd * gg[j][2], v[j][3] * rstd * gg[j][3]); o8[64 * j] = w; }
        }
    }
    for (int m = gw; m < 256; m += NGW) {
        if (m < NMETA) rms_row_bf16(in[1] + (size_t)m * 1024, in[2], N1 + (size_t)(METAROW + m) * 1024, lane);
        else { u32x4* o = (u32x4*)(N1 + (size_t)(METAROW + m) * 1024); o[lane] = (u32x4){0u, 0u, 0u, 0u}; o[64 + lane] = (u32x4){0u, 0u, 0u, 0u}; }
    }
}

__device__ __forceinline__ int prev_row(int r, int j) {
    if (r < M) { const int s = r & (SEQ - 1); return s >= j ? r - j : METAROW + NMETA + (s - j); }
    const int p = r - METAROW; return p >= j ? r - j : -1;
}
struct ThinRow { u32x4 xa, xb, cq, ckv; unsigned k1, k2; };
__device__ __forceinline__ ThinRow thin_load(const bf16_t* XR, const bf16_t* CQKV, int r, int lane) {
    ThinRow d; const bf16_t* z = CQKV + (size_t)r * CQKV_LD;
    d.xa = *(const u32x4*)(XR + (size_t)r * 1024 + lane * 8); d.xb = *(const u32x4*)(XR + (size_t)r * 1024 + 512 + lane * 8);
    d.cq = *(const u32x4*)(z + CQ_OFF + (lane < 48 ? lane : 0) * 8); d.ckv = *(const u32x4*)(z + (lane & 31) * 8);
    d.k1 = z[KR_OFF + (lane & 15)]; d.k2 = z[KR_OFF + 16 + (lane & 15)];
    return d;
}
__device__ __forceinline__ void thin_row_stats(unsigned char* ws, const ThinRow& d, int r, int lane) {
    float* RSQ = (float*)(ws + WS_RSQ); float* RSKV = (float*)(ws + WS_RSKV); bf16_t* KROPE = (bf16_t*)(ws + WS_KROPE);
    float sq = 0.f, skv = 0.f;
    { float v[8]; unpack8(d.cq, v); float a = 0.f;
#pragma unroll
      for (int i = 0; i < 8; ++i) a += v[i] * v[i];
      sq = lane < 48 ? a : 0.f; }
    { float v[8]; unpack8(d.ckv, v); float a = 0.f;
#pragma unroll
      for (int i = 0; i < 8; ++i) a += v[i] * v[i];
      skv = lane < 32 ? a : 0.f; }
    sq = wave_sum(sq); skv = wave_sum(skv);
    if (lane == 0) { RSQ[r] = 1.f / sqrtf(sq * (1.f / 384.f) + EPS); RSKV[r] = 1.f / sqrtf(skv * (1.f / 256.f) + EPS); }
    if (lane < 16) { const int pos = r < M ? NMETA + (r & (SEQ - 1)) : r - METAROW; const float x1 = bf2f((bf16_t)d.k1), x2 = bf2f((bf16_t)d.k2);
        const float c = ((const float*)(ws + WS_CTAB))[pos * 16 + lane], s = ((const float*)(ws + WS_STAB))[pos * 16 + lane];
        ((unsigned*)(KROPE + (size_t)r * 32))[lane] = pk2(x1 * c - x2 * s, x1 * s + x2 * c); }
}
__device__ __forceinline__ void phase_thin(const Ctx& C) {
    unsigned char* ws = C.ws; const float* const* in = C.in; const int lane = C.lane;
    const bf16_t* XR = (const bf16_t*)(ws + SLOT(1)); const bf16_t* CQKV = (const bf16_t*)(ws + SLOT(3)); bf16_t* XC = (bf16_t*)(ws + SLOT(0));
    const float* cw = in[4]; const float* cb = in[5];
    float w[4][16], bias[16];
#pragma unroll
    for (int hh = 0; hh < 2; ++hh)
#pragma unroll
        for (int i = 0; i < 8; ++i) { const int ch = hh * 512 + lane * 8 + i; bias[hh * 8 + i] = cb[ch];
#pragma unroll
            for (int t = 0; t < 4; ++t) w[t][hh * 8 + i] = cw[t * 1024 + ch]; }
    for (int st = C.gw; st < M / 32 + 1; st += C.NGW) {
        const bool meta = st == M / 32; const int r0 = meta ? METAROW : st * 32, nrow = meta ? NMETA : 32;
        float x1[16], x2[16], x3[16];
        const bool first = meta || (r0 & (SEQ - 1)) == 0;
        ThinRow nx = thin_load(XR, CQKV, r0, lane);
#pragma unroll
        for (int j = 1; j <= 3; ++j) { const int pr = first ? (meta ? -1 : METAROW + NMETA - j) : r0 - j;
#pragma unroll
            for (int hh = 0; hh < 2; ++hh) { float v[8];
                if (pr >= 0) unpack8(*(const u32x4*)(XR + (size_t)pr * 1024 + hh * 512 + lane * 8), v); else {
#pragma unroll
                    for (int i = 0; i < 8; ++i) v[i] = 0.f; }
#pragma unroll
                for (int i = 0; i < 8; ++i) { if (j == 1) x1[hh * 8 + i] = v[i]; else if (j == 2) x2[hh * 8 + i] = v[i]; else x3[hh * 8 + i] = v[i]; } } }
        for (int t = 0; t < nrow; ++t) { const int r = r0 + t; float x0[16];
            const ThinRow d = nx;
            if (t + 1 < nrow) nx = thin_load(XR, CQKV, r + 1, lane);
            { float v[8]; unpack8(d.xa, v);
#pragma unroll
              for (int i = 0; i < 8; ++i) x0[i] = v[i];
              unpack8(d.xb, v);
#pragma unroll
              for (int i = 0; i < 8; ++i) x0[8 + i] = v[i]; }
#pragma unroll
            for (int hh = 0; hh < 2; ++hh) { float y[8];
#pragma unroll
                for (int i = 0; i < 8; ++i) { const int q = hh * 8 + i; y[i] = bias[q] + w[3][q] * x0[q] + w[2][q] * x1[q] + w[1][q] * x2[q] + w[0][q] * x3[q]; }
                *(u32x4*)(XC + (size_t)r * 1024 + hh * 512 + lane * 8) = pack8(y); }
#pragma unroll
            for (int q = 0; q < 16; ++q) { x3[q] = x2[q]; x2[q] = x1[q]; x1[q] = x0[q]; }
            thin_row_stats(ws, d, r, lane);
        }
    }
    float* RSQ = (float*)(ws + WS_RSQ); float* RSKV = (float*)(ws + WS_RSKV); bf16_t* KROPE = (bf16_t*)(ws + WS_KROPE);
    for (int r = M + NMETA + C.gw; r < MTOT; r += C.NGW) {
        u32x4* o = (u32x4*)(XC + (size_t)r * 1024); o[lane] = (u32x4){0u, 0u, 0u, 0u}; o[64 + lane] = (u32x4){0u, 0u, 0u, 0u};
        if (lane == 0) { RSQ[r] = 0.f; RSKV[r] = 0.f; }
        if (lane < 16) ((unsigned*)(KROPE + (size_t)r * 32))[lane] = 0u;
    }
}

__device__ __forceinline__ void phase_scan1(const Ctx& C) {
    unsigned char* ws = C.ws; const int lane = C.lane;
    const bf16_t* LA = (const bf16_t*)(ws + SLOT(1)); const bf16_t* UU = (const bf16_t*)(ws + SLOT(6));
    float* SCP = (float*)(ws + WS_SCP); float* SCH = (float*)(ws + WS_SCH); float* CARRY0 = (float*)(ws + WS_CARRY0);
    for (int it = C.gw; it < 2048 + 4; it += C.NGW) {
        const bool meta = it >= 2048; const int q = it & 3, bc = it >> 2, ch = q * 256 + lane * 4;
        const int row0 = meta ? METAROW : bc * 128, nrow = meta ? NMETA : 128;
        float P[4] = {1.f, 1.f, 1.f, 1.f}, H[4] = {0.f, 0.f, 0.f, 0.f};
#pragma unroll 8
        for (int t = 0; t < nrow; ++t) { const u32x2 l2 = *(const u32x2*)(LA + (size_t)(row0 + t) * 1024 + ch), u2 = *(const u32x2*)(UU + (size_t)(row0 + t) * 1024 + ch);
            const float a0 = ex2(LOG2E * bf_lo(l2.x)), a1 = ex2(LOG2E * bf_hi(l2.x)), a2 = ex2(LOG2E * bf_lo(l2.y)), a3 = ex2(LOG2E * bf_hi(l2.y));
            P[0] *= a0; P[1] *= a1; P[2] *= a2; P[3] *= a3;
            H[0] = a0 * H[0] + bf_lo(u2.x); H[1] = a1 * H[1] + bf_hi(u2.x); H[2] = a2 * H[2] + bf_lo(u2.y); H[3] = a3 * H[3] + bf_hi(u2.y); }
        if (meta) *(f32x4*)(CARRY0 + ch) = (f32x4){H[0], H[1], H[2], H[3]};
        else { *(f32x4*)(SCP + (size_t)bc * 1024 + ch) = (f32x4){P[0], P[1], P[2], P[3]}; *(f32x4*)(SCH + (size_t)bc * 1024 + ch) = (f32x4){H[0], H[1], H[2], H[3]}; }
    }
}
__device__ __forceinline__ void phase_scan2(const Ctx& C) {
    unsigned char* ws = C.ws; const int lane = C.lane;
    const bf16_t* LA = (const bf16_t*)(ws + SLOT(1)); const bf16_t* UU = (const bf16_t*)(ws + SLOT(6)); const bf16_t* GR = (const bf16_t*)(ws + SLOT(2)); bf16_t* HRG = (bf16_t*)(ws + SLOT(0));
    const float* SCP = (const float*)(ws + WS_SCP); const float* SCH = (const float*)(ws + WS_SCH); const float* CARRY0 = (const float*)(ws + WS_CARRY0);
    for (int it = C.gw; it < 2048; it += C.NGW) {
        const int q = it & 3, bc = it >> 2, b = bc >> 4, c = bc & 15, ch = q * 256 + lane * 4;
        f32x4 h = *(const f32x4*)(CARRY0 + ch);
        for (int cc = 0; cc < c; ++cc) { const f32x4 p = *(const f32x4*)(SCP + (size_t)(b * 16 + cc) * 1024 + ch), e = *(const f32x4*)(SCH + (size_t)(b * 16 + cc) * 1024 + ch); h = p * h + e; }
        float H[4] = {h[0], h[1], h[2], h[3]};
        const int row0 = bc * 128;
#pragma unroll 8
        for (int t = 0; t < 128; ++t) { const size_t off = (size_t)(row0 + t) * 1024 + ch; const u32x2 l2 = *(const u32x2*)(LA + off), u2 = *(const u32x2*)(UU + off), g2 = *(const u32x2*)(GR + off);
            H[0] = ex2(LOG2E * bf_lo(l2.x)) * H[0] + bf_lo(u2.x); H[1] = ex2(LOG2E * bf_hi(l2.x)) * H[1] + bf_hi(u2.x); H[2] = ex2(LOG2E * bf_lo(l2.y)) * H[2] + bf_lo(u2.y); H[3] = ex2(LOG2E * bf_hi(l2.y)) * H[3] + bf_hi(u2.y);
            u32x2 o; o.x = pk2(H[0] * bf_lo(g2.x), H[1] * bf_hi(g2.x)); o.y = pk2(H[2] * bf_lo(g2.y), H[3] * bf_hi(g2.y)); *(u32x2*)(HRG + off) = o; }
    }
}

constexpr int AT_KSLOT = 12 * 1024, AT_VSLOT = 8192;
#define AT_K(j) (((j) & 3) * AT_KSLOT)
#define AT_V(j) (4 * AT_KSLOT + ((j) & 7) * AT_VSLOT)
static_assert(4 * AT_KSLOT + 8 * AT_VSLOT <= 131072, "attention rings fit the phase scratch");
__device__ __forceinline__ void glds16(const void* gsrc, unsigned lds_dst) { unsigned keep;
    asm volatile("s_mov_b32 %0, m0\n\ts_mov_b32 m0, %2\n\ts_nop 0\n\tglobal_load_lds_dwordx4 %1, off\n\ts_mov_b32 m0, %0" : "=&s"(keep) : "v"(gsrc), "s"(lds_dst) : "memory"); }
#define AT_BAR(N) asm volatile("s_waitcnt vmcnt(" #N ") lgkmcnt(0)\n\ts_barrier" ::: "memory")
__device__ __forceinline__ int crow(int r, int hi) { return (r & 3) + 8 * (r >> 2) + 4 * hi; }
__device__ __forceinline__ void attn_q(LAS unsigned char* lds, int j, int s0, int q, int hi, const bf16x8 (&qf)[6], const f32x16& negm, f32x16& p0, f32x16& p1) {
    const int kb = AT_K(j);
    __builtin_amdgcn_s_setprio(1);
#pragma unroll
    for (int ks = 0; ks < 6; ++ks) {
        const bf16x8 a0 = *(const LAS bf16x8*)(lds + kb + (2 * ks + hi) * 1024 + q * 16);
        const bf16x8 a1 = *(const LAS bf16x8*)(lds + kb + (2 * ks + hi) * 1024 + (32 + q) * 16);
        if (ks == 0) { p0 = __builtin_amdgcn_mfma_f32_32x32x16_bf16(a0, qf[0], negm, 0, 0, 0); p1 = __builtin_amdgcn_mfma_f32_32x32x16_bf16(a1, qf[0], negm, 0, 0, 0); }
        else { p0 = __builtin_amdgcn_mfma_f32_32x32x16_bf16(a0, qf[ks], p0, 0, 0, 0); p1 = __builtin_amdgcn_mfma_f32_32x32x16_bf16(a1, qf[ks], p1, 0, 0, 0); }
    }
    __builtin_amdgcn_s_setprio(0);
    if (j == 0) {
#pragma unroll
        for (int r = 0; r < 16; ++r) { if (crow(r, hi) >= NMETA) p0[r] = -INFINITY; p1[r] = -INFINITY; }
    } else if ((j - 1) * 64 + 63 > s0) {
        const int qs = s0 + q, k0 = (j - 1) * 64;
#pragma unroll
        for (int r = 0; r < 16; ++r) { const int kk = k0 + crow(r, hi); if (kk > qs) p0[r] = -INFINITY; if (kk + 32 > qs) p1[r] = -INFINITY; }
    }
}
__device__ __forceinline__ void attn_pv(LAS unsigned char* lds, int vbase, const bf16x8 (&pb)[4], f32x16& o0, f32x16& o1) {
#pragma unroll
    for (int s = 0; s < 4; ++s)
#pragma unroll
        for (int db = 0; db < 2; ++db) {
            const v4i16_t lo = __builtin_amdgcn_ds_read_tr16_b64_v4i16((LAS v4i16_t*)(lds + vbase + db * 4096 + s * 1024));
            const v4i16_t hh = __builtin_amdgcn_ds_read_tr16_b64_v4i16((LAS v4i16_t*)(lds + vbase + db * 4096 + s * 1024 + 512));
            const bf16x8 va = {lo[0], lo[1], lo[2], lo[3], hh[0], hh[1], hh[2], hh[3]};
            if (db == 0) o0 = __builtin_amdgcn_mfma_f32_32x32x16_bf16(va, pb[s], o0, 0, 0, 0); else o1 = __builtin_amdgcn_mfma_f32_32x32x16_bf16(va, pb[s], o1, 0, 0, 0);
        }
}
#ifndef ATT_THR
#define ATT_THR 8.0f
#endif
template <bool DOPV, bool FIRST> __device__ __forceinline__ void attn_sp(LAS unsigned char* lds, int vbase, f32x16& p0, f32x16& p1, bf16x8 (&pb)[4], f32x16& o0, f32x16& o1, f32x16& negm, float& m_run, float& l_run) {
    float mx = fmaxf(p0[0], p1[0]);
#pragma unroll
    for (int r = 1; r < 16; ++r) mx = fmaxf(fmaxf(mx, p0[r]), p1[r]);
    mx = fmaxf(mx, __shfl_xor(mx, 32));
    if (DOPV) attn_pv(lds, vbase, pb, o0, o1);
    float rs = 0.f;
#pragma unroll
    for (int r = 0; r < 16; ++r) { p0[r] = ex2(p0[r]); p1[r] = ex2(p1[r]); rs += p0[r] + p1[r]; }
    if (FIRST || !__all(mx <= ATT_THR)) {
        const float d = FIRST ? mx : fmaxf(mx, 0.f), alpha = ex2(-d);
#pragma unroll
        for (int r = 0; r < 16; ++r) { p0[r] *= alpha; p1[r] *= alpha; o0[r] *= alpha; o1[r] *= alpha; }
        rs *= alpha; l_run *= alpha; m_run += d;
#pragma unroll
        for (int r = 0; r < 16; ++r) negm[r] = -m_run;
    }
    l_run += rs;
#pragma unroll
    for (int s = 0; s < 4; ++s) { unsigned w[4];
#pragma unroll
        for (int jj = 0; jj < 4; ++jj) w[jj] = (s < 2) ? pk2(p0[8 * (s & 1) + 2 * jj], p0[8 * (s & 1) + 2 * jj + 1]) : pk2(p1[8 * (s & 1) + 2 * jj], p1[8 * (s & 1) + 2 * jj + 1]);
        u32x4 ww = {w[0], w[1], w[2], w[3]}; pb[s] = __builtin_bit_cast(bf16x8, ww); }
}
__device__ __forceinline__ void attn_unit(const Ctx& C, int b, int h, int qb, const bf16_t* Q, const bf16_t* KN, const bf16_t* KR, const bf16_t* V, bf16_t* O) {
    const int tid = C.tid, lane = C.lane, wid = C.wave, q = lane & 31, hi = lane >> 5;
    LAS unsigned char* lds = C.lds;
    const int s0 = qb * 256 + wid * 32;
    const size_t qrow = (size_t)b * SEQ + s0 + q;
    bf16x8 qf[6];
#pragma unroll
    for (int ks = 0; ks < 6; ++ks) qf[ks] = *(const bf16x8*)(Q + qrow * QLD + h * 96 + ks * 16 + hi * 8);
    {
        const float* ctab = (const float*)(C.ws + WS_CTAB) + (NMETA + s0 + q) * 16; const float* stab = (const float*)(C.ws + WS_STAB) + (NMETA + s0 + q) * 16;
#pragma unroll
        for (int ks = 4; ks < 6; ++ks) { const f32x4 cc = *(const f32x4*)(ctab + 8 * (ks - 4) + 4 * hi), sn = *(const f32x4*)(stab + 8 * (ks - 4) + 4 * hi);
            const u32x4 w = __builtin_bit_cast(u32x4, qf[ks]); u32x4 r;
            { const float x1 = bf_lo(w.x), x2 = bf_hi(w.x); r.x = pk2(x1 * cc[0] - x2 * sn[0], x1 * sn[0] + x2 * cc[0]); }
            { const float x1 = bf_lo(w.y), x2 = bf_hi(w.y); r.y = pk2(x1 * cc[1] - x2 * sn[1], x1 * sn[1] + x2 * cc[1]); }
            { const float x1 = bf_lo(w.z), x2 = bf_hi(w.z); r.z = pk2(x1 * cc[2] - x2 * sn[2], x1 * sn[2] + x2 * cc[2]); }
            { const float x1 = bf_lo(w.w), x2 = bf_hi(w.w); r.w = pk2(x1 * cc[3] - x2 * sn[3], x1 * sn[3] + x2 * cc[3]); }
            qf[ks] = __builtin_bit_cast(bf16x8, r); }
    }
    f32x16 o0 = {}, o1 = {}, p0 = {}, p1 = {};
    bf16x8 pb[4] = {};
    float m_run = 0.f, l_run = 0.f; f32x16 negm = {};
    const int NJ = 4 * qb + 5;
    const unsigned lds0 = (unsigned)(size_t)lds;
    const bf16_t* ksrc = KN + (size_t)lane * 1024 + h * 64 + wid * 8;
    const bf16_t* rsrc = KR + (size_t)lane * 32 + (wid & 3) * 8;
    const bf16_t* vsrc = V + (size_t)(16 * (wid & 3) + (lane >> 2)) * 1024 + h * 64 + (wid >> 2) * 32 + (lane & 3) * 8;
#define AT_DMA(j) do { const size_t row_ = (j) == 0 ? (size_t)METAROW : (size_t)b * SEQ + (size_t)((j) - 1) * 64; \
        glds16(ksrc + row_ * 1024, (unsigned)__builtin_amdgcn_readfirstlane(lds0 + AT_K(j) + wid * 1024)); \
        if (wid < 4) glds16(rsrc + row_ * 32, (unsigned)__builtin_amdgcn_readfirstlane(lds0 + AT_K(j) + (8 + wid) * 1024)); \
        glds16(vsrc + row_ * 1024, (unsigned)__builtin_amdgcn_readfirstlane(lds0 + AT_V(j) + wid * 1024)); } while (0)
#define AT_STEP(n) do { if ((n) + 2 < NJ) { if (wid < 4) AT_BAR(6); else AT_BAR(4); } else if ((n) + 1 < NJ) { if (wid < 4) AT_BAR(3); else AT_BAR(2); } else AT_BAR(0); if ((n) + 3 < NJ) AT_DMA((n) + 3); } while (0)
    AT_BAR(0);
    AT_DMA(0); AT_DMA(1); AT_DMA(2);
    const int g16 = lane >> 4, qq = (lane & 15) >> 2, pp = lane & 3;
    const int vtr_off = (4 * hi + qq) * 64 + (16 * (g16 & 1) + 4 * pp) * 2;
    {
        AT_STEP(0);
        attn_q(lds, 0, s0, q, hi, qf, negm, p0, p1);
        attn_sp<false, true>(lds, 0, p0, p1, pb, o0, o1, negm, m_run, l_run);
    }
    const int jend = (s0 + 31) / 64 + 2 < NJ ? (s0 + 31) / 64 + 2 : NJ;
    for (int j = 1; j < jend; ++j) {
        AT_STEP(j);
        attn_q(lds, j, s0, q, hi, qf, negm, p0, p1);
        attn_sp<true, false>(lds, AT_V(j - 1) + vtr_off, p0, p1, pb, o0, o1, negm, m_run, l_run);
    }
    attn_pv(lds, AT_V(jend - 1) + vtr_off, pb, o0, o1);
    for (int j = jend; j < NJ; ++j) AT_STEP(j);
#undef AT_DMA
#undef AT_STEP
    const float inv = 1.f / (l_run + __shfl_xor(l_run, 32));
    bf16_t* orow = O + qrow * 1024 + h * 64;
#pragma unroll
    for (int g4 = 0; g4 < 4; ++g4) {
        u32x2 w0, w1; w0.x = pk2(o0[4 * g4] * inv, o0[4 * g4 + 1] * inv); w0.y = pk2(o0[4 * g4 + 2] * inv, o0[4 * g4 + 3] * inv);
        w1.x = pk2(o1[4 * g4] * inv, o1[4 * g4 + 1] * inv); w1.y = pk2(o1[4 * g4 + 2] * inv, o1[4 * g4 + 3] * inv);
        *(u32x2*)(orow + 8 * g4 + 4 * hi) = w0; *(u32x2*)(orow + 32 + 8 * g4 + 4 * hi) = w1;
    }
}
__device__ __forceinline__ void phase_attn(const Ctx& C) {
    unsigned char* ws = C.ws;
    const bf16_t* Q = (const bf16_t*)(ws + SLOT(0)); const bf16_t* KN = (const bf16_t*)(ws + SLOT(4)); const bf16_t* V = (const bf16_t*)(ws + SLOT(6)); const bf16_t* KR = (const bf16_t*)(ws + WS_KROPE);
    bf16_t* O = (bf16_t*)(ws + SLOT(3));
    const int G = C.G, c = blockIdx.x; const int vcu = (G % 8 == 0) ? (c % 8) * (G / 8) + c / 8 : c;
    for (int bh = vcu; bh < NB * 16; bh += G)
        for (int i = 0; i < 8; ++i) { const int qb = (i & 1) ? 7 - (i >> 1) : (i >> 1); attn_unit(C, bh >> 4, bh & 15, qb, Q, KN, KR, V, O); }
    __syncthreads();
}

__device__ __forceinline__ int tk_enc(float f) { const int x = __float_as_int(f); return x ^ ((x >> 31) & 0x7fffffff); }
__device__ __forceinline__ float tk_dec(int k) { return __int_as_float(k ^ ((k >> 31) & 0x7fffffff)); }
#define TK_CE(a, b) do { const int hi_ = max((a), (b)), lo_ = min((a), (b)); (a) = hi_; (b) = lo_; } while (0)
__device__ __forceinline__ void tk_sort16(int (&v)[16]) {
#define TK_S(a, b) TK_CE(v[a], v[b]);
    TK_S(0,13) TK_S(1,12) TK_S(2,15) TK_S(3,14) TK_S(4,8) TK_S(5,6) TK_S(7,11) TK_S(9,10)
    TK_S(0,5) TK_S(1,7) TK_S(2,9) TK_S(3,4) TK_S(6,13) TK_S(8,14) TK_S(10,15) TK_S(11,12)
    TK_S(0,1) TK_S(2,3) TK_S(4,5) TK_S(6,8) TK_S(7,9) TK_S(10,11) TK_S(12,13) TK_S(14,15)
    TK_S(0,2) TK_S(1,3) TK_S(4,10) TK_S(5,11) TK_S(6,7) TK_S(8,9) TK_S(12,14) TK_S(13,15)
    TK_S(1,2) TK_S(3,12) TK_S(4,6) TK_S(5,7) TK_S(8,10) TK_S(9,11) TK_S(13,14)
    TK_S(1,4) TK_S(2,6) TK_S(5,8) TK_S(7,10) TK_S(9,13) TK_S(11,14)
    TK_S(2,4) TK_S(3,6) TK_S(9,12) TK_S(11,13)
    TK_S(3,5) TK_S(6,8) TK_S(7,9) TK_S(10,12)
    TK_S(3,4) TK_S(5,6) TK_S(7,8) TK_S(9,10) TK_S(11,12)
    TK_S(6,7) TK_S(8,9)
#undef TK_S
}
__device__ __forceinline__ void tk_merge16(int (&a)[16], const int (&b)[16]) {
#pragma unroll
    for (int i = 0; i < 16; ++i) a[i] = max(a[i], b[15 - i]);
#pragma unroll
    for (int j = 8; j > 0; j >>= 1)
#pragma unroll
        for (int i = 0; i < 16; ++i) { const int l = i ^ j; if (l > i) TK_CE(a[i], a[l]); }
}
__host__ __device__ constexpr int tk_pos(int i) { int n = 0; for (int a = 0; a < i; ++a) n += 16 / (a + 1); return n; }
__host__ __device__ constexpr int tk_ci(int n) { int i = 0; while (i < 15 && tk_pos(i + 1) <= n) ++i; return i; }
__host__ __device__ constexpr int tk_cj(int n) { return n - tk_pos(tk_ci(n)); }
__device__ __forceinline__ int tk_lookup(const int (&w)[4], int i) {
    const unsigned long long lo = ((unsigned long long)(unsigned)w[1] << 32) | (unsigned long long)(unsigned)w[0], hi = ((unsigned long long)(unsigned)w[3] << 32) | (unsigned long long)(unsigned)w[2];
    const unsigned long long a = (i & 8) ? hi : lo;
    return (int)(a >> (8 * (i & 7))) & 127;
}
__device__ __forceinline__ void phase_topk(const Ctx& C) {
    unsigned char* ws = C.ws;
    const _Float16* SC = (const _Float16*)(ws + SLOT(0)); int* TIDX = (int*)(ws + SLOT(5)); float* TVAL = (float*)(ws + SLOT(5) + (size_t)M * 128 * 4);
    const int gt = blockIdx.x * NTHR + C.tid, NT = C.G * NTHR;
    for (int it = gt; it < M * 8 * 4; it += NT) {
        const int p = it >> 2, q = it & 3;
        f16x8 raw[8];
        { const unsigned char* blk = (const unsigned char*)(SC + (size_t)(p - (C.lane >> 2)) * 256);
          LAS unsigned char* tl = C.lds + C.wave * 9216;
          u32x4 cv[8];
#pragma unroll
          for (int c = 0; c < 8; ++c) cv[c] = *(const u32x4*)(blk + 1024 * c + 16 * C.lane);
#pragma unroll
          for (int c = 0; c < 8; ++c) *(LAS u32x4*)(tl + 144 * (8 * c + (C.lane >> 3)) + 16 * (C.lane & 7)) = cv[c];
#pragma unroll
          for (int c = 0; c < 8; ++c) raw[c] = *(LAS const f16x8*)(tl + 144 * C.lane + 16 * c); }
        const int ibase = 127 - 64 * (q & 1);
        int ch[4][16];
#pragma unroll
        for (int c = 0; c < 4; ++c)
#pragma unroll
            for (int e = 0; e < 16; ++e) ch[c][e] = (tk_enc((float)raw[2 * c + (e >> 3)][e & 7]) & ~127) | (ibase - (16 * c + e));
        tk_sort16(ch[0]); tk_sort16(ch[1]); tk_sort16(ch[2]); tk_sort16(ch[3]);
        tk_merge16(ch[0], ch[1]); tk_merge16(ch[2], ch[3]); tk_merge16(ch[0], ch[2]);
        int oth[16];
#pragma unroll
        for (int i = 0; i < 16; ++i) oth[i] = __builtin_amdgcn_mov_dpp(ch[0][i], 0xB1, 0xF, 0xF, true);
        tk_merge16(ch[0], oth);
#pragma unroll
        for (int i = 0; i < 16; ++i) oth[i] = __builtin_amdgcn_mov_dpp(ch[0][i], 0x4E, 0xF, 0xF, true);
        int t1[16], t2[16];
#pragma unroll
        for (int i = 0; i < 16; ++i) { t1[i] = (q < 2) ? ch[0][i] : oth[i]; t2[i] = (q < 2) ? oth[i] : ch[0][i]; }
        float f1[16], f2[16];
#pragma unroll
        for (int i = 0; i < 16; ++i) { f1[i] = tk_dec(t1[i]); f2[i] = tk_dec(t2[i]); }
        int cd[1][16];
#pragma unroll
        for (int sl = 0; sl < 16; ++sl) {
            float a[4], b[4]; int tg[4];
#pragma unroll
            for (int qq = 0; qq < 4; ++qq) { const int n = 16 * qq + sl, nn = n < 50 ? n : 49; a[qq] = f1[tk_ci(nn)]; b[qq] = f2[tk_cj(nn)]; tg[qq] = 255 - (16 * tk_ci(nn) + tk_cj(nn)); }
            const float av = q == 0 ? a[0] : q == 1 ? a[1] : q == 2 ? a[2] : a[3], bv = q == 0 ? b[0] : q == 1 ? b[1] : q == 2 ? b[2] : b[3];
            const int tv = q == 0 ? tg[0] : q == 1 ? tg[1] : q == 2 ? tg[2] : tg[3];
            const int key = (tk_enc(av + bv) & ~255) | tv;
            cd[0][sl] = (48 + sl >= 50 && q == 3) ? (int)0x80000000 : key;
        }
        tk_sort16(cd[0]);
#pragma unroll
        for (int i = 0; i < 16; ++i) oth[i] = __builtin_amdgcn_mov_dpp(cd[0][i], 0xB1, 0xF, 0xF, true);
        tk_merge16(cd[0], oth);
#pragma unroll
        for (int i = 0; i < 16; ++i) oth[i] = __builtin_amdgcn_mov_dpp(cd[0][i], 0x4E, 0xF, 0xF, true);
        tk_merge16(cd[0], oth);
        int w1[4], w2[4];
#pragma unroll
        for (int m = 0; m < 4; ++m) { w1[m] = (t1[4 * m] & 127) | ((t1[4 * m + 1] & 127) << 8) | ((t1[4 * m + 2] & 127) << 16) | ((t1[4 * m + 3] & 127) << 24);
                                      w2[m] = (t2[4 * m] & 127) | ((t2[4 * m + 1] & 127) << 8) | ((t2[4 * m + 2] & 127) << 16) | ((t2[4 * m + 3] & 127) << 24); }
        if (q == 0) {
            int id[16];
#pragma unroll
            for (int k = 0; k < 16; ++k) { const int c = 255 - (cd[0][k] & 255); id[k] = (127 - tk_lookup(w1, c >> 4)) * 128 + (127 - tk_lookup(w2, c & 15)); }
            int* oi = TIDX + (size_t)p * 16;
#pragma unroll
            for (int k = 0; k < 16; k += 4) *(int4*)(oi + k) = make_int4(id[k], id[k + 1], id[k + 2], id[k + 3]);
        } else if (q == 1) {
            float* ov = TVAL + (size_t)p * 16;
#pragma unroll
            for (int k = 0; k < 16; k += 4) *(f32x4*)(ov + k) = (f32x4){tk_dec(cd[0][k]), tk_dec(cd[0][k + 1]), tk_dec(cd[0][k + 2]), tk_dec(cd[0][k + 3])};
        }
    }
}

__device__ __forceinline__ void phase_x8(const Ctx& C) {
    unsigned char* ws = C.ws; const int lane = C.lane;
    const bf16_t* H1B = (const bf16_t*)(ws + SLOT(4)); unsigned char* X8 = ws + SLOT(2); float* XS = (float*)(ws + SLOT(2) + (size_t)M * 1024);
    int tok = C.gw; u32x4 na = {0u, 0u, 0u, 0u}, nb = {0u, 0u, 0u, 0u};
    if (tok < M) { na = *(const u32x4*)(H1B + (size_t)tok * 1024 + 16 * lane); nb = *(const u32x4*)(H1B + (size_t)tok * 1024 + 16 * lane + 8); }
    for (; tok < M; tok += C.NGW) {
        const u32x4 xa = na, xb = nb;
        { const int nt = tok + C.NGW; if (nt < M) { na = *(const u32x4*)(H1B + (size_t)nt * 1024 + 16 * lane); nb = *(const u32x4*)(H1B + (size_t)nt * 1024 + 16 * lane + 8); } }
        float hv[16]; { float t8[8]; unpack8(xa, t8);
#pragma unroll
            for (int i = 0; i < 8; ++i) hv[i] = t8[i];
            unpack8(xb, t8);
#pragma unroll
            for (int i = 0; i < 8; ++i) hv[8 + i] = t8[i]; }
        float am = 0.f;
#pragma unroll
        for (int i = 0; i < 16; ++i) am = fmaxf(am, fabsf(hv[i]));
#pragma unroll
        for (int o = 1; o < 64; o <<= 1) am = fmaxf(am, __shfl_xor(am, o));
        const float scale = am > 0.f ? am * (1.f / 127.f) : 1.f, inv = 1.f / scale;
        u32x4 w;
#pragma unroll
        for (int j = 0; j < 4; ++j) { const int q0 = (int)rintf(hv[4 * j] * inv), q1 = (int)rintf(hv[4 * j + 1] * inv), q2 = (int)rintf(hv[4 * j + 2] * inv), q3 = (int)rintf(hv[4 * j + 3] * inv);
            w[j] = (unsigned)(q0 & 255) | ((unsigned)(q1 & 255) << 8) | ((unsigned)(q2 & 255) << 16) | ((unsigned)q3 << 24); }
        *(u32x4*)(X8 + (size_t)tok * 1024 + 16 * lane) = w;
        if (lane == 0) XS[tok] = scale;
    }
}
__device__ __forceinline__ int idpp_ror8(int v) { return __builtin_amdgcn_update_dpp(0, v, 0x128, 0xF, 0xF, true); }
__device__ __forceinline__ int idpp_hmir(int v) { return __builtin_amdgcn_update_dpp(0, v, 0x141, 0xF, 0xF, true); }
__device__ __forceinline__ int idpp_x2(int v) { return __builtin_amdgcn_mov_dpp(v, 0x4E, 0xF, 0xF, true); }
__device__ __forceinline__ int idpp_x1(int v) { return __builtin_amdgcn_mov_dpp(v, 0xB1, 0xF, 0xF, true); }
__device__ __forceinline__ int idot16(const u32x4 w, const u32x4 x, int a) {
    a = __builtin_amdgcn_sdot4((int)w.x, (int)x.x, a, false); a = __builtin_amdgcn_sdot4((int)w.y, (int)x.y, a, false);
    a = __builtin_amdgcn_sdot4((int)w.z, (int)x.z, a, false); return __builtin_amdgcn_sdot4((int)w.w, (int)x.w, a, false);
}
__device__ __forceinline__ void u_process(unsigned c, unsigned co, int n, int tok, const u32x4 (&x)[4], float xscale, const unsigned char* PU, float* ACT, int lane, bool b3, bool b2) {
    const int rs = lane >> 4; const unsigned p16 = 16u * (unsigned)(lane & 15);
    for (int base = 0; base < n; base += 32) {
        u32x4 w[8][4];
#pragma unroll
        for (int m = 0; m < 8; ++m) if (base + 4 * m < n) {
            const unsigned off = (unsigned)__builtin_amdgcn_ds_bpermute(((base + 4 * m + rs) & 63) * 4, (int)co);
            const unsigned char* rp = PU + (off + p16);
#pragma unroll
            for (int i = 0; i < 4; ++i) w[m][i] = *(const u32x4*)(rp + 256 * i); }
        __builtin_amdgcn_sched_barrier(0);
#pragma unroll
        for (int G = 0; G < 2; ++G) if (base + 16 * G < n) {
            int p4[4];
#pragma unroll
            for (int mm = 0; mm < 4; ++mm) { int a = 0;
#pragma unroll
                for (int i = 0; i < 4; ++i) a = idot16(w[4 * G + mm][i], x[i], a);
                p4[mm] = a; }
            int t0, t1, u;
            { const int keep = b3 ? p4[1] : p4[0], send = b3 ? p4[0] : p4[1]; t0 = keep + idpp_ror8(send); }
            { const int keep = b3 ? p4[3] : p4[2], send = b3 ? p4[2] : p4[3]; t1 = keep + idpp_ror8(send); }
            { const int keep = b2 ? t1 : t0, send = b2 ? t0 : t1; u = keep + idpp_hmir(send); }
            u += idpp_x2(u); u += idpp_x1(u);
            const int slot = base + 16 * G + 4 * ((b2 ? 2 : 0) + (b3 ? 1 : 0)) + rs;
            const unsigned mine = (unsigned)__builtin_amdgcn_ds_bpermute((slot & 63) * 4, (int)c);
            if ((lane & 3) == 0 && slot < n) ACT[(size_t)tok * 128 + (mine >> 16)] = (float)u * xscale;
        }
    }
}
constexpr int UB = 8;
__device__ __forceinline__ float u_batch_request(const unsigned char* X8, const float* XS, const int* TIDX, int tb, int tstep, unsigned xs_addr, int lane) {
#pragma unroll
    for (int k = 0; k < UB; ++k) { const int tk = tb + k * tstep; if (tk < M) glds16(X8 + (size_t)tk * 1024 + 16 * lane, xs_addr + k * 1024); }
#pragma unroll
    for (int k = 0; k < UB; k += 2) { if (tb + k * tstep < M) { int tk = tb + (k + (lane >> 5)) * tstep; tk = tk < M ? tk : tb;
        glds16(TIDX + (size_t)tk * 128 + 4 * (lane & 31), xs_addr + UB * 1024 + k * 512); } }
    const int tl = tb + (lane & (UB - 1)) * tstep;
    return XS[tl < M ? tl : tb];
}
__device__ __forceinline__ void phase_upart(const Ctx& C, int xcc, int rank) {
    unsigned char* ws = C.ws; const int lane = C.lane;
    const unsigned char* X8 = ws + SLOT(2); const float* XS = (const float*)(ws + SLOT(2) + (size_t)M * 1024);
    const int* TIDX = (const int*)(ws + SLOT(5)); float* ACT = (float*)(ws + SLOT(0));
    const unsigned char* PU = ws + WS_PU;
    LAS unsigned char* xs = C.lds + C.wave * (UB * 1536);
    const unsigned xs_addr = (unsigned)__builtin_amdgcn_readfirstlane((int)(unsigned)(size_t)xs);
    int nloc, xi, nx;
    if ((C.G & 7) == 0) { nx = 8; xi = xcc; nloc = C.G >> 3; } else { nx = 1; xi = 0; nloc = C.G; rank = blockIdx.x; }
    const bool b3 = (lane & 8) != 0, b2 = (lane & 4) != 0; const int pos = lane & 15;
    const int tstep = nloc * NWAVES;
    for (int sub = xi; sub < 8; sub += nx) {
        const unsigned dummy = (unsigned)(sub << 11) * 1024u;
        int tb = rank * NWAVES + C.wave;
        float svn = 0.f;
        if (tb < M) svn = u_batch_request(X8, XS, TIDX, tb, tstep, xs_addr, lane);
        for (; tb < M; tb += UB * tstep) {
            asm volatile("s_waitcnt vmcnt(0)" ::: "memory");
            const float sv = svn;
#pragma unroll 1
            for (int k = 0; k < UB; ++k) {
                const int tok = tb + k * tstep; if (tok >= M) break;
                u32x4 x[4];
#pragma unroll
                for (int i = 0; i < 4; ++i) x[i] = *(LAS const u32x4*)(xs + k * 1024 + 256 * i + 16 * pos);
                const int ca = *(LAS const int*)(xs + UB * 1024 + k * 512 + 4 * lane), cb = *(LAS const int*)(xs + UB * 1024 + k * 512 + 256 + 4 * lane);
                const float xscale = __uint_as_float(__builtin_amdgcn_readlane(__float_as_uint(sv), k));
                const bool fa = (ca >> 11) == sub, fb = (cb >> 11) == sub;
                const unsigned long long ma = __ballot(fa), mb = __ballot(fb);
                const int npa = __builtin_popcountll(ma), npb = __builtin_popcountll(mb);
                const int ra_ = (int)__builtin_amdgcn_mbcnt_hi((unsigned)(ma >> 32), __builtin_amdgcn_mbcnt_lo((unsigned)ma, 0u));
                const int rb_ = (int)__builtin_amdgcn_mbcnt_hi((unsigned)(mb >> 32), __builtin_amdgcn_mbcnt_lo((unsigned)mb, 0u));
                const int da = fa ? ra_ : npa + (lane - ra_), db = fb ? rb_ : npb + (lane - rb_);
                const unsigned cA = (unsigned)__builtin_amdgcn_ds_permute(da * 4, ca | (lane << 16));
                const unsigned cB = (unsigned)__builtin_amdgcn_ds_permute(db * 4, cb | ((64 + lane) << 16));
                if (npa + npb <= 64) {
                    const unsigned pulled = (unsigned)__builtin_amdgcn_ds_bpermute(((lane - npa) & 63) * 4, (int)cB);
                    const unsigned cc = lane < npa ? cA : pulled; const int n = npa + npb;
                    u_process(cc, lane < n ? (cc & 0xffffu) * 1024u : dummy, n, tok, x, xscale, PU, ACT, lane, b3, b2);
                } else { u_process(cA, lane < npa ? (cA & 0xffffu) * 1024u : dummy, npa, tok, x, xscale, PU, ACT, lane, b3, b2);
                         u_process(cB, lane < npb ? (cB & 0xffffu) * 1024u : dummy, npb, tok, x, xscale, PU, ACT, lane, b3, b2); }
            }
            asm volatile("s_waitcnt lgkmcnt(0)" ::: "memory");
            if (tb + UB * tstep < M) svn = u_batch_request(X8, XS, TIDX, tb + UB * tstep, tstep, xs_addr, lane);
        }
    }
}
__device__ __forceinline__ void phase_gather(const Ctx& C, float* DST) {
    unsigned char* ws = C.ws; const int lane = C.lane;
    const bf16_t* H1B = (const bf16_t*)(ws + SLOT(4)); const int* TIDX = (const int*)(ws + SLOT(5)); const float* TVAL = (const float*)(ws + SLOT(5) + (size_t)M * 128 * 4);
    const float* ACT = (const float*)(ws + SLOT(0));
    const unsigned char* PV = ws + WS_PV; const float* SU = (const float*)(ws + WS_SU); const float* SV = (const float*)(ws + WS_SV);
    const float* fg = C.in[24];
    const int l4 = lane >> 2; const unsigned l8 = 8u * (unsigned)lane;
    int tok = C.gw;
    u32x4 ra = {0u, 0u, 0u, 0u}, rb = {0u, 0u, 0u, 0u};
    if (tok < M) { ra = *(const u32x4*)(H1B + (size_t)tok * 1024 + 16 * lane); rb = *(const u32x4*)(H1B + (size_t)tok * 1024 + 16 * lane + 8); }
    for (; tok < M; tok += C.NGW) {
        f32x4 e[4]; float ss = 0.f;
        { float hv[16]; { float t8[8]; unpack8(ra, t8);
#pragma unroll
            for (int i = 0; i < 8; ++i) hv[i] = t8[i];
            unpack8(rb, t8);
#pragma unroll
            for (int i = 0; i < 8; ++i) hv[8 + i] = t8[i]; }
#pragma unroll
          for (int j = 0; j < 4; ++j) { e[j] = (f32x4){hv[4 * j], hv[4 * j + 1], hv[4 * j + 2], hv[4 * j + 3]}; ss += (e[j][0] * e[j][0] + e[j][1] * e[j][1]) + (e[j][2] * e[j][2] + e[j][3] * e[j][3]); } }
        { const int nt = tok + C.NGW; if (nt < M) { ra = *(const u32x4*)(H1B + (size_t)nt * 1024 + 16 * lane); rb = *(const u32x4*)(H1B + (size_t)nt * 1024 + 16 * lane + 8); } }
        f32x4* dp = (f32x4*)(DST + (size_t)tok * 1024 + 16 * lane);
        const float rstd = 1.f / sqrtf(wave_sum(ss) * (1.f / 1024.f) + EPS);
        f32x2 acc[8];
#pragma unroll
        for (int i = 0; i < 8; ++i) acc[i] = (f32x2){0.f, 0.f};
        int idxn0 = TIDX[(size_t)tok * 128 + l4], idxn1 = TIDX[(size_t)tok * 128 + 16 + l4];
        float tsn0 = TVAL[(size_t)tok * 128 + l4], tsn1 = TVAL[(size_t)tok * 128 + 16 + l4], dtn0 = ACT[(size_t)tok * 128 + l4], dtn1 = ACT[(size_t)tok * 128 + 16 + l4];
        for (int hp = 0; hp < 8; hp += 2) {
            const int idx0 = idxn0, idx1 = idxn1; const float ts0 = tsn0 * rstd, ts1 = tsn1 * rstd, dot0 = dtn0, dot1 = dtn1;
            u32x2 pa[32];
#pragma unroll
            for (int m = 0; m < 32; ++m) { const unsigned id = (unsigned)__builtin_amdgcn_readlane(m < 16 ? idx0 : idx1, 4 * (m & 15)); pa[m] = *(const u32x2*)(PV + (id * 512u + l8)); }
            __builtin_amdgcn_sched_barrier(0);
            const float su0 = SU[idx0], sv0 = SV[idx0], su1 = SU[idx1], sv1 = SV[idx1];
            if (hp < 6) { const size_t nb = (size_t)tok * 128 + (hp + 2) * 16 + l4; idxn0 = TIDX[nb]; idxn1 = TIDX[nb + 16]; tsn0 = TVAL[nb]; tsn1 = TVAL[nb + 16]; dtn0 = ACT[nb]; dtn1 = ACT[nb + 16]; }
            __builtin_amdgcn_sched_barrier(0);
            float mx0 = ts0, mx1 = ts1;
#pragma unroll
            for (int o = 4; o < 64; o <<= 1) { mx0 = fmaxf(mx0, __shfl_xor(mx0, o)); mx1 = fmaxf(mx1, __shfl_xor(mx1, o)); }
            const float ee0 = ex2((ts0 - mx0) * LOG2E), ee1 = ex2((ts1 - mx1) * LOG2E); float sm0 = ee0, sm1 = ee1;
#pragma unroll
            for (int o = 4; o < 64; o <<= 1) { sm0 += __shfl_xor(sm0, o); sm1 += __shfl_xor(sm1, o); }
            const float coef0 = (ee0 / sm0) * gelu_t(dot0 * su0 * rstd) * sv0, coef1 = (ee1 / sm1) * gelu_t(dot1 * su1 * rstd) * sv1;
#pragma unroll
            for (int m = 0; m < 32; ++m) {
                const float ck = __uint_as_float(__builtin_amdgcn_readlane(__float_as_uint(m < 16 ? coef0 : coef1), 4 * (m & 15)));
#pragma unroll
                for (int d = 0; d < 2; ++d) {
                    acc[4 * d] = __builtin_elementwise_fma(__builtin_amdgcn_cvt_scalef32_pk_f32_fp4(pa[m][d], 1.0f, 0), (f32x2){ck, ck}, acc[4 * d]);
                    acc[4 * d + 1] = __builtin_elementwise_fma(__builtin_amdgcn_cvt_scalef32_pk_f32_fp4(pa[m][d], 1.0f, 1), (f32x2){ck, ck}, acc[4 * d + 1]);
                    acc[4 * d + 2] = __builtin_elementwise_fma(__builtin_amdgcn_cvt_scalef32_pk_f32_fp4(pa[m][d], 1.0f, 2), (f32x2){ck, ck}, acc[4 * d + 2]);
                    acc[4 * d + 3] = __builtin_elementwise_fma(__builtin_amdgcn_cvt_scalef32_pk_f32_fp4(pa[m][d], 1.0f, 3), (f32x2){ck, ck}, acc[4 * d + 3]); }
                __builtin_amdgcn_sched_barrier(0);
            }
        }
        float s2 = 0.f;
#pragma unroll
        for (int j = 0; j < 4; ++j) {
            e[j][0] += acc[2 * j].x; e[j][1] += acc[2 * j].y; e[j][2] += acc[2 * j + 1].x; e[j][3] += acc[2 * j + 1].y;
            s2 += (e[j][0] * e[j][0] + e[j][1] * e[j][1]) + (e[j][2] * e[j][2] + e[j][3] * e[j][3]); }
        const float r2 = 1.f / sqrtf(wave_sum(s2) * (1.f / 1024.f) + EPS);
        const f32x4* fp = (const f32x4*)(fg + 16 * lane);
#pragma unroll
        for (int j = 0; j < 4; ++j) dp[j] = e[j] * r2 * fp[j];
    }
}

constexpr int NPHASE = 16;
__global__ void __launch_bounds__(NTHR, 2) hybrid_fwd(Args args) {
    extern __shared__ __attribute__((aligned(16))) unsigned char lds_raw[];
    Ctx C;
    C.lds = (LAS unsigned char*)lds_raw; C.tid = threadIdx.x; C.lane = C.tid & 63; C.wave = __builtin_amdgcn_readfirstlane(C.tid >> 6);
    C.G = gridDim.x; C.gw = blockIdx.x * NWAVES + C.wave; C.NGW = C.G * NWAVES; C.ws = args.ws; C.out = args.out; C.in = args.in;
    unsigned char* ws = args.ws;
    volatile LAS unsigned* MISC = (volatile LAS unsigned*)(C.lds + MISC_OFF);
    for (int u = C.tid; u < (LDS_BYTES - RING_BYTES) / 4; u += NTHR) ((LAS unsigned*)(C.lds + RING_BYTES))[u] = 0u;
    __syncthreads();
    XcdBarrier bar; bar.bar = (unsigned*)(ws + WS_CTL) + 1024; bar.x = 0; bar.st = nullptr;
    if (ONE_LAUNCH) bar = xcd_barrier_post((unsigned*)(ws + WS_CTL) + 1024, MISC + 8);
    const int lo = args.ph_lo, hi = args.ph_hi;
#ifndef PHMASK
#define PHMASK 0xffff
#endif
#define IN(k) (((PHMASK >> (k)) & 1) && lo <= (k) && (k) < hi)
#ifndef PROBE_PHASE
#define PROBE_PHASE -1
#endif
#define REPS(k) for (int rep_ = 0; rep_ < ((k) == PROBE_PHASE ? 2 : 1); ++rep_)
#define SEAM(k) do { if (IN(k) && IN((k) + 1)) xcd_barrier(bar); } while (0)
    const int G = C.G, cb = blockIdx.x;
    LAS unsigned char* ring = C.lds;

    if (IN(0)) REPS(0) { phase_prologue(C); }
    SEAM(0);
    if (IN(1)) REPS(1) {
        pg8::Gemm g{(const bf16_t*)(ws + SLOT(0)), (const bf16_t*)(ws + WS_WIN), 1024, 1024, 1024, 0, 256 * 1024};
        pg8::Sched S; S.init(256, 19, G, cb, 256, 6, 4);
        pg8::Epi8<FInproj> E{{(bf16_t*)(ws + SLOT(1)), (bf16_t*)(ws + SLOT(2)), (bf16_t*)(ws + SLOT(3)), (bf16_t*)(ws + SLOT(4)), (bf16_t*)(ws + SLOT(5))}};
        pg8::gemm_phase(ring, g, S, E);
    }
    SEAM(1);
    if (IN(2)) REPS(2) { phase_thin(C); }
    SEAM(2);
    if (IN(3)) REPS(3) {
        pg8::Gemm g{(const bf16_t*)(ws + SLOT(0)), (const bf16_t*)(ws + WS_WGATE), 1024, 128, 128, 128, 256 * 128};
        pg8::Sched S; S.init(256, 8, G, cb, 256, 8, 0);
        pg8::EpiPair<FGate> E{{(const bf16_t*)(ws + SLOT(0)), args.in[7], args.in[9], (const float*)(ws + WS_CLAM), (bf16_t*)(ws + SLOT(1)), (bf16_t*)(ws + SLOT(6))}};
        pg8::gemm_phase(ring, g, S, E);
    }
    SEAM(3);
    if (IN(4)) REPS(4) { phase_scan1(C); }
    SEAM(4);
    if (IN(5)) REPS(5) { phase_scan2(C); }
    SEAM(5);
    if (IN(6)) REPS(6) {
        pg8::Gemm g{(const bf16_t*)(ws + SLOT(0)), (const bf16_t*)(ws + WS_WRNN), 1024, 1024, 1024, 0, 256 * 1024};
        pg8::Sched S; S.init(256, 4, G, cb, 0, 0, 0);
        pg8::Epi8<FMul<false>> E{{(const bf16_t*)(ws + SLOT(4)), nullptr, (bf16_t*)(ws + SLOT(2))}};
        pg8::gemm_phase(ring, g, S, E);
    }
    SEAM(6);
    if (IN(7)) REPS(7) {
        { pg8::Gemm g{(const bf16_t*)(ws + SLOT(3)) + CQ_OFF, (const bf16_t*)(ws + WS_WUQ), CQKV_LD, 384, 384, 0, 256 * 384};
          pg8::Sched S; S.init(256, 6, G, cb, 0, 0, 0);
          pg8::Epi8<FQ> E{{(const float*)(ws + WS_RSQ), (bf16_t*)(ws + SLOT(0))}};
          pg8::gemm_phase(ring, g, S, E); }
        { pg8::Gemm g{(const bf16_t*)(ws + SLOT(3)), (const bf16_t*)(ws + WS_WUKV), CQKV_LD, 256, 256, 0, 256 * 256};
          pg8::Sched S; S.init(256, 8, G, cb, 256, 8, 0);
          pg8::Epi8<FKV> E{{(const float*)(ws + WS_RSKV), (bf16_t*)(ws + SLOT(4)), (bf16_t*)(ws + SLOT(6))}};
          pg8::gemm_phase(ring, g, S, E); }
    }
    SEAM(7);
    if (IN(8)) REPS(8) { phase_attn(C); }
    SEAM(8);
    if (IN(9)) REPS(9) {
        pg8::Gemm g{(const bf16_t*)(ws + SLOT(3)), (const bf16_t*)(ws + WS_WATT), 1024, 1024, 1024, 0, 256 * 1024};
        pg8::Sched S; S.init(256, 4, G, cb, 0, 0, 0);
        pg8::Epi8<FMul<true>> E{{(const bf16_t*)(ws + SLOT(5)), (const bf16_t*)(ws + SLOT(2)), (bf16_t*)(ws + SLOT(0))}};
        pg8::gemm_phase(ring, g, S, E);
    }
    SEAM(9);
    if (IN(10)) REPS(10) {
        pg8::Gemm g{(const bf16_t*)(ws + SLOT(0)), (const bf16_t*)(ws + WS_WOUT), 1024, 1024, 1024, 0, 256 * 1024};
        pg8::Sched S; S.init(256, 4, G, cb, 0, 0, 0);
        pg8::Epi8<FRes> E{{args.in[0], (bf16_t*)(ws + SLOT(4))}};
        pg8::gemm_phase(ring, g, S, E);
    }
    SEAM(10);
    if (IN(11)) REPS(11) {
        pg8::Gemm g{(const bf16_t*)(ws + SLOT(4)), (const bf16_t*)(ws + WS_WPQ), 1024, 1024, 1024, 0, 256 * 1024};
        pg8::Sched S; S.init(256, 8, G, cb, 0, 0, 0);
        pg8::Epi8<FF16> E{{(_Float16*)(ws + SLOT(0)), 2048}};
        pg8::gemm_phase(ring, g, S, E);
    }
    SEAM(11);
    if (IN(13)) REPS(13) { phase_x8(C); phase_topk(C); }
    SEAM(13);
    if (IN(14)) REPS(14) { phase_upart(C, (int)(blockIdx.x & 7), (int)(blockIdx.x >> 3)); }
    SEAM(14);
    if (IN(15)) REPS(15) { phase_gather(C, C.out); }
#undef IN
#undef SEAM
}

extern "C" void kernel_launch(void* const* d_in, const int* in_sizes, int n_in, void* d_out, int out_size, void* d_ws, size_t ws_size, hipStream_t stream) {
    static int grid = 0;
    if (grid == 0) {
        if (n_in != 25 || in_sizes[0] != M * DM || out_size != M * DM || ws_size < WS_END) { fprintf(stderr, "kernel_launch: unexpected shapes (n_in %d in0 %d out %d ws %zu need %zu); nothing launched\n", n_in, n_in > 0 ? in_sizes[0] : -1, out_size, ws_size, (size_t)WS_END); grid = -1; return; }
        int dev = 0, cus = 0, per_cu = 0;
        if (hipGetDevice(&dev) != hipSuccess || hipDeviceGetAttribute(&cus, hipDeviceAttributeMultiprocessorCount, dev) != hipSuccess) { grid = -1; return; }
        if (hipFuncSetAttribute((const void*)hybrid_fwd, hipFuncAttributeMaxDynamicSharedMemorySize, LDS_BYTES) != hipSuccess) { fprintf(stderr, "kernel_launch: hipFuncSetAttribute failed\n"); grid = -1; return; }
        if (hipOccupancyMaxActiveBlocksPerMultiprocessor(&per_cu, (const void*)hybrid_fwd, NTHR, LDS_BYTES) != hipSuccess || per_cu < 1) fprintf(stderr, "kernel_launch: occupancy query reports %d\n", per_cu);
        (void)hipGetLastError();
        grid = cus;
    }
    if (grid < 0) return;
    if (hipMemsetAsync((char*)d_ws + WS_CTL, 0, CTL_ZERO_BYTES, stream) != hipSuccess) return;
    Args a{};
    for (int i = 0; i < 25; ++i) a.in[i] = (const float*)d_in[i];
    a.out = (float*)d_out; a.ws = (unsigned char*)d_ws;
#if ONE_LAUNCH
    a.ph_lo = 0; a.ph_hi = NPHASE;
    hipLaunchKernelGGL(hybrid_fwd, dim3(grid), dim3(NTHR), LDS_BYTES, stream, a);
#else
    for (int p = 0; p < NPHASE; ++p) { a.ph_lo = p; a.ph_hi = p + 1; hipLaunchKernelGGL(hybrid_fwd, dim3(grid), dim3(NTHR), LDS_BYTES, stream, a); }
#endif
}
```

```cpp
#include <hip/hip_runtime.h>
#include <cstdio>
#include <cstdint>

#ifndef ONE_LAUNCH
#define ONE_LAUNCH 1
#endif

#define LAS __attribute__((address_space(3)))
#define GAS __attribute__((address_space(1)))
typedef unsigned short bf16_t;
typedef short bf16x8 __attribute__((ext_vector_type(8)));
typedef float f32x4 __attribute__((ext_vector_type(4)));
typedef float f32x2 __attribute__((ext_vector_type(2)));
typedef float f32x16 __attribute__((ext_vector_type(16)));
typedef unsigned u32x4 __attribute__((ext_vector_type(4)));
typedef unsigned u32x2 __attribute__((ext_vector_type(2)));
typedef __bf16 bf16x2_t __attribute__((ext_vector_type(2)));
typedef short v4i16_t __attribute__((ext_vector_type(4)));

constexpr int DM = 1024, NB = 32, SEQ = 2048, NMETA = 16;
constexpr int M = NB * SEQ;
constexpr int METAROW = M;
constexpr int MTOT = M + 256;
constexpr int NPOS = SEQ + NMETA;
constexpr int DIN_P = 4864;
constexpr int CQKV_LD = 768, CQ_OFF = 384, KR_OFF = 256;
constexpr int QLD = 1536;
constexpr int NEXP = 16384;
constexpr float EPS = 1e-6f;
constexpr float LOG2E = 1.4426950408889634f;
constexpr float QSCALE = 0.10206207261596577f * 1.4426950408889634f;

constexpr size_t A1 = (size_t)MTOT * 1024 * 2;
constexpr size_t WS_CTL = 0, CTL_ZERO_BYTES = 65536;
constexpr size_t WS_WIN = 1u << 20;
constexpr size_t WS_WGATE = WS_WIN + (size_t)DIN_P * 1024 * 2;
constexpr size_t WS_WUQ = WS_WGATE + 2048 * 128 * 2;
constexpr size_t WS_WUKV = WS_WUQ + 1536 * 384 * 2;
constexpr size_t WS_WRNN = WS_WUKV + 2048 * 256 * 2;
constexpr size_t WS_WATT = WS_WRNN + 1024 * 1024 * 2;
constexpr size_t WS_WOUT = WS_WATT + 1024 * 1024 * 2;
constexpr size_t WS_WPQ = WS_WOUT + 1024 * 1024 * 2;
constexpr size_t WS_KEYS = WS_WPQ + 2048 * 1024 * 2;
constexpr size_t WS_PU = WS_KEYS + 256 * 256 * 2;
constexpr size_t WS_PV = WS_PU + (size_t)NEXP * 1024;
constexpr size_t WS_SU = WS_PV + (size_t)NEXP * 1024;
constexpr size_t WS_SV = WS_SU + (size_t)NEXP * 4;
constexpr size_t WS_CTAB = WS_SV + (size_t)NEXP * 4;
constexpr size_t WS_STAB = WS_CTAB + NPOS * 16 * 4;
constexpr size_t WS_CLAM = WS_STAB + NPOS * 16 * 4;
constexpr size_t WS_RSQ = WS_CLAM + 4096;
constexpr size_t WS_RSKV = WS_RSQ + (size_t)MTOT * 4;
constexpr size_t WS_KROPE = WS_RSKV + (size_t)MTOT * 4;
constexpr size_t WS_SCP = WS_KROPE + (size_t)MTOT * 32 * 2;
constexpr size_t WS_SCH = WS_SCP + 512 * 1024 * 4;
constexpr size_t WS_CARRY0 = WS_SCH + 512 * 1024 * 4;
constexpr size_t WS_SLOTS = ((WS_CARRY0 + 4096 + 4095) / 4096) * 4096;
constexpr size_t WS_END = WS_SLOTS + 7 * A1;
#define SLOT(i) (WS_SLOTS + (size_t)(i) * A1)

__device__ __forceinline__ int hw_lane() { int l_; asm volatile("v_mbcnt_lo_u32_b32 %0, -1, 0\n\tv_mbcnt_hi_u32_b32 %0, -1, %0" : "=v"(l_)); return l_; }
#define LDS_WAIT() asm volatile("s_waitcnt lgkmcnt(0)" ::: "memory")
#define VM_WAIT() asm volatile("s_waitcnt vmcnt(0)" ::: "memory")
__device__ __forceinline__ unsigned pk2(float lo, float hi) { f32x2 v = {lo, hi}; bf16x2_t b = __builtin_convertvector(v, bf16x2_t); return __builtin_bit_cast(unsigned, b); }
__device__ __forceinline__ float bf_lo(unsigned w) { return __uint_as_float(w << 16); }
__device__ __forceinline__ float bf_hi(unsigned w) { return __uint_as_float(w & 0xffff0000u); }
__device__ __forceinline__ float bf2f(bf16_t h) { return __uint_as_float((unsigned)h << 16); }
__device__ __forceinline__ float ex2(float x) { return __builtin_amdgcn_exp2f(x); }
__device__ __forceinline__ float rcpf_(float x) { return __builtin_amdgcn_rcpf(x); }
__device__ __forceinline__ float sigm(float v) { return rcpf_(1.f + ex2(-LOG2E * v)); }
__device__ __forceinline__ float gelu_t(float v) { const float y = v * (1.f + 0.044715f * v * v); return v * rcpf_(1.f + ex2(-2.302208198f * y)); }
__device__ __forceinline__ float wave_sum(float v) {
#pragma unroll
    for (int o = 1; o < 64; o <<= 1) v += __shfl_xor(v, o);
    return v;
}
__device__ __forceinline__ void unpack8(u32x4 w, float (&o)[8]) { o[0] = bf_lo(w.x); o[1] = bf_hi(w.x); o[2] = bf_lo(w.y); o[3] = bf_hi(w.y); o[4] = bf_lo(w.z); o[5] = bf_hi(w.z); o[6] = bf_lo(w.w); o[7] = bf_hi(w.w); }
__device__ __forceinline__ u32x4 pack8(const float (&o)[8]) { u32x4 w; w.x = pk2(o[0], o[1]); w.y = pk2(o[2], o[3]); w.z = pk2(o[4], o[5]); w.w = pk2(o[6], o[7]); return w; }
__device__ __forceinline__ float dot2bf(unsigned a, unsigned b, float acc) { return __builtin_amdgcn_fdot2_f32_bf16(__builtin_bit_cast(bf16x2_t, a), __builtin_bit_cast(bf16x2_t, b), acc, false); }

__device__ __forceinline__ void glds16s(const void* sbase, unsigned voff, unsigned lds_dst) { unsigned keep;
    asm volatile("s_mov_b32 %0, m0\n\ts_mov_b32 m0, %3\n\ts_nop 0\n\tglobal_load_lds_dwordx4 %1, %2\n\ts_mov_b32 m0, %0" : "=&s"(keep) : "v"(voff), "s"(sbase), "s"(lds_dst) : "memory"); }
namespace pg8 {
constexpr int BM = 256, BK = 64, HALF = 128, HTB = HALF * BK * 2, STAGE_BYTES = 8 * HTB, NXCD = 8, WGM = 4;
__host__ __device__ __forceinline__ int lds_byte(int r, int c) { const int st = (r >> 4) * 2 + (c >> 5), rr = r & 15, cc = c & 31, ob = rr * 64 + cc * 2; return st * 1024 + (ob ^ (((ob >> 9) & 1) << 5)); }
__host__ __device__ __forceinline__ void stage_rc(int b, int& R, int& C) { const int st = b / 1024, sb = b % 1024, swz = sb ^ (((sb >> 9) & 1) << 5); R = (st >> 1) * 16 + swz / 64; C = (st & 1) * 32 + (swz % 64) / 2; }
__host__ __device__ __forceinline__ int perm32(int rho) { const int n = rho >> 4, i = rho & 15; return 8 * (i >> 2) + 4 * n + (i & 3); }

struct Unit { int pm, pn; };
struct Gemm { const bf16_t* A; const bf16_t* Bt; int lda, ldb, K, a_pn_off, b_pn_stride; };

struct Sched {
    int nM, nN, nwg, G, c, xpm, xn, xskip;
    __device__ __forceinline__ void init(int nM_, int nN_, int G_, int c_, int xpm_, int xn_, int xskip_) { nM = nM_; nN = nN_; nwg = nM_ * nN_; G = G_; c = c_; xpm = xpm_; xn = xn_; xskip = xskip_; }
    __device__ __forceinline__ bool next(int i, Unit& u) const {
        const int nmain = nwg > c ? (nwg - c - 1) / G + 1 : 0;
        if (i < nmain) {
            int wgid = i * G + c; { const int q = nwg / NXCD, r = nwg % NXCD, xcd = wgid % NXCD, off = wgid / NXCD; wgid = (xcd < r ? xcd * (q + 1) : r * (q + 1) + (xcd - r) * q) + off; }
            const int nig = WGM * nN, gid = wgid / nig, fm = gid * WGM, gsz = (nM - fm) < WGM ? (nM - fm) : WGM;
            u.pm = fm + ((wgid % nig) % gsz); u.pn = (wgid % nig) / gsz; return true;
        }
        const int e = G - 1 - c;
        if (i == nmain && e < xn) { u.pm = xpm; u.pn = e + (e >= 4 ? xskip : 0); return true; }
        return false;
    }
};

template <class F> struct Epi8 {
    static constexpr bool PERM = true;
    F f;
    __device__ __forceinline__ void operator()(const f32x4 (&acc)[2][2][4][2], const Unit& u, int wr, int wc, int fr, int fq) const {
        const int row0 = u.pm * BM + wr * 64 + fr, col0 = u.pn * BM + wc * 32 + 8 * fq;
        if constexpr (sizeof(typename F::Pre) == 4) {
            typename F::Pre pre[2][4][2];
#pragma unroll
            for (int ai = 0; ai < 2; ++ai)
#pragma unroll
                for (int m = 0; m < 4; ++m)
#pragma unroll
                    for (int bj = 0; bj < 2; ++bj) pre[ai][m][bj] = f.load(u.pn, row0 + ai * HALF + m * 16, col0 + bj * HALF);
#pragma unroll
            for (int ai = 0; ai < 2; ++ai)
#pragma unroll
                for (int m = 0; m < 4; ++m)
#pragma unroll
                    for (int bj = 0; bj < 2; ++bj) f.apply(pre[ai][m][bj], u.pn, row0 + ai * HALF + m * 16, col0 + bj * HALF, acc[ai][bj][m][0], acc[ai][bj][m][1]);
            return;
        }
#pragma unroll
        for (int ai = 0; ai < 2; ++ai) {
            typename F::Pre pre[4][2];
#pragma unroll
            for (int m = 0; m < 4; ++m)
#pragma unroll
                for (int bj = 0; bj < 2; ++bj) pre[m][bj] = f.load(u.pn, row0 + ai * HALF + m * 16, col0 + bj * HALF);
#pragma unroll
            for (int m = 0; m < 4; ++m)
#pragma unroll
                for (int bj = 0; bj < 2; ++bj) f.apply(pre[m][bj], u.pn, row0 + ai * HALF + m * 16, col0 + bj * HALF, acc[ai][bj][m][0], acc[ai][bj][m][1]);
        }
    }
};
template <class F> struct EpiPair {
    static constexpr bool PERM = true;
    F f;
    __device__ __forceinline__ void operator()(const f32x4 (&acc)[2][2][4][2], const Unit& u, int wr, int wc, int fr, int fq) const {
        const int row0 = u.pm * BM + wr * 64 + fr, col0 = wc * 32 + 8 * fq;
        const typename F::Chan cn = f.chan(u.pn, col0);
#pragma unroll
        for (int ai = 0; ai < 2; ++ai) {
            typename F::Pre pre[4];
#pragma unroll
            for (int m = 0; m < 4; ++m) pre[m] = f.load(u.pn, row0 + ai * HALF + m * 16, col0);
#pragma unroll
            for (int m = 0; m < 4; ++m) f.apply(pre[m], cn, u.pn, row0 + ai * HALF + m * 16, col0, acc[ai][0][m][0], acc[ai][0][m][1], acc[ai][1][m][0], acc[ai][1][m][1]);
        }
    }
};

typedef int i32x8g __attribute__((ext_vector_type(8)));
__device__ __forceinline__ i32x8g pg8_cat(bf16x8 a, bf16x8 b) { const u32x4 x = __builtin_bit_cast(u32x4, a), y = __builtin_bit_cast(u32x4, b); return (i32x8g){(int)x.x, (int)x.y, (int)x.z, (int)x.w, (int)y.x, (int)y.y, (int)y.z, (int)y.w}; }
template <class Epi, bool F8 = false>
__device__ __forceinline__ void gemm_phase(LAS unsigned char* lds, const Gemm g, const Sched& S, const Epi& E, int wave) {
    int tid_ = wave * 64 + hw_lane(); asm volatile("" : "+v"(tid_));
    const int tid = tid_, wid = __builtin_amdgcn_readfirstlane(tid >> 6), lane = tid & 63, wr = wid >> 2, wc = wid & 3, fr = lane & 15, fq = lane >> 4;
    int nt_ = g.K / BK; asm volatile("" : "+s"(nt_));
    const int nt = nt_;
    unsigned voffA[2], voffB[2];
#pragma unroll
    for (int i = 0; i < 2; ++i) { int R, C; stage_rc(tid * 16 + i * 8192, R, C); const int Rb = Epi::PERM ? ((R & ~31) + perm32(R & 31)) : R;
        voffA[i] = (unsigned)(R * g.lda + C) * 2u; voffB[i] = (unsigned)(Rb * g.ldb + C) * 2u; }
    const size_t kstep = (size_t)(BK * 2);
    const size_t hA = (size_t)HALF * g.lda * 2, hB = (size_t)HALF * g.ldb * 2;
    const unsigned ldsw = (unsigned)wid * 1024u, lds0 = (unsigned)(size_t)lds;
    const int aoff = lds_byte(wr * 64 + fr, fq * 8), boff = lds_byte(wc * 32 + fr, fq * 8);
#define PG8_SA(b, h) (((b) * 2 + (h)) * HTB)
#define PG8_SB(b, h) ((4 + (b) * 2 + (h)) * HTB)
#define PG8_STAGE(bufoff, gbase, voff) do { _Pragma("unroll") for (int _i = 0; _i < 2; ++_i) { \
        if (F8) glds16s((gbase), (voff)[_i], lds0 + (unsigned)(bufoff) + ldsw + _i * 8192);   \
        else __builtin_amdgcn_global_load_lds((const unsigned*)((const char*)(gbase) + (voff)[_i]), (LAS unsigned*)(lds + (bufoff) + ldsw + _i * 8192), 16, 0, 0); } } while (0)
#define PG8_LDA(dst, b, h) do { _Pragma("unroll") for (int m = 0; m < 4; ++m) _Pragma("unroll") for (int k = 0; k < 2; ++k) dst[m].f[k] = *(const LAS bf16x8*)(lds + PG8_SA(b, h) + aoff + m * 2048 + k * 1024); } while (0)
#define PG8_LDB(dst, b, h) do { _Pragma("unroll") for (int n = 0; n < 2; ++n) _Pragma("unroll") for (int k = 0; k < 2; ++k) dst[n].f[k] = *(const LAS bf16x8*)(lds + PG8_SB(b, h) + boff + n * 2048 + k * 1024); } while (0)
#define PG8_MMA(ai, bj, At, Bt) do { __builtin_amdgcn_s_setprio(1); _Pragma("unroll") for (int m = 0; m < 4; ++m) _Pragma("unroll") for (int n = 0; n < 2; ++n) { \
        if (F8) acc[ai][bj][m][n] = __builtin_amdgcn_mfma_scale_f32_16x16x128_f8f6f4(Bt[n].v, At[m].v, acc[ai][bj][m][n], 0, 0, 0, 0, 0, 0); \
        else { _Pragma("unroll") for (int k = 0; k < 2; ++k) acc[ai][bj][m][n] = __builtin_amdgcn_mfma_f32_16x16x32_bf16(Bt[n].f[k], At[m].f[k], acc[ai][bj][m][n], 0, 0, 0); } } __builtin_amdgcn_s_setprio(0); } while (0)
#define PG8_WAIT_V(n) asm volatile("s_waitcnt vmcnt(" #n ")" ::: "memory")
#define PG8_WAIT_L(n) asm volatile("s_waitcnt lgkmcnt(" #n ")" ::: "memory")
#define PG8_BAR __builtin_amdgcn_s_barrier()
#define PG8_SCHED __builtin_amdgcn_sched_barrier(0)
#define PG8_ABASE(u) ((const char*)g.A + ((size_t)(u).pm * BM * g.lda + (size_t)(u).pn * g.a_pn_off) * 2)
#define PG8_BBASE(u) ((const char*)g.Bt + (size_t)(u).pn * g.b_pn_stride * 2)
    Unit cur, nxt; int ui = 0;
    if (!S.next(0, cur)) return;
    f32x4 acc[2][2][4][2];
#pragma unroll
    for (int a = 0; a < 2; ++a)
#pragma unroll
        for (int b = 0; b < 2; ++b)
#pragma unroll
            for (int m = 0; m < 4; ++m)
#pragma unroll
                for (int n = 0; n < 2; ++n) acc[a][b][m][n] = (f32x4){0.f, 0.f, 0.f, 0.f};
    typedef union { bf16x8 f[2]; i32x8g v; } Frag;
    Frag At[4], B0[2], B1[2];
    const char* cA = PG8_ABASE(cur); const char* cB = PG8_BBASE(cur);
    PG8_STAGE(PG8_SB(0, 0), cB, voffB); PG8_STAGE(PG8_SB(0, 1), cB + hB, voffB); PG8_STAGE(PG8_SA(0, 0), cA, voffA); PG8_STAGE(PG8_SA(0, 1), cA + hA, voffA);
    if (wr == 1) PG8_BAR;
    PG8_WAIT_V(2); PG8_BAR;
    PG8_STAGE(PG8_SB(1, 0), cB + kstep, voffB); PG8_STAGE(PG8_SA(1, 0), cA + kstep, voffA); PG8_STAGE(PG8_SB(1, 1), cB + hB + kstep, voffB);
    PG8_WAIT_V(6); PG8_BAR;
    for (;;) {
        const bool has_next = S.next(ui + 1, nxt);
        const char* nA = has_next ? PG8_ABASE(nxt) : cA; const char* nB = has_next ? PG8_BBASE(nxt) : cB;
        asm volatile("" : "+s"(cA), "+s"(cB), "+s"(nA), "+s"(nB));
#pragma unroll 1
        for (int t = 0; t < nt; t += 2) {
            const bool last = (t == nt - 2);
            const char* a1 = cA + (size_t)(t + 1) * kstep;
            const char* a2 = last ? nA : cA + (size_t)(t + 2) * kstep; const char* b2 = last ? nB : cB + (size_t)(t + 2) * kstep;
            const char* a3 = a2 + kstep; const char* b3 = b2 + kstep;
            PG8_LDB(B0, 0, 0); PG8_LDB(B1, 0, 1); PG8_SCHED; PG8_LDA(At, 0, 0); PG8_STAGE(PG8_SA(1, 1), a1 + hA, voffA);
            PG8_WAIT_V(8); PG8_WAIT_L(0); PG8_BAR; PG8_MMA(0, 0, At, B0); PG8_MMA(0, 1, At, B1); PG8_BAR; PG8_SCHED;
            PG8_LDA(At, 0, 1); PG8_STAGE(PG8_SB(0, 0), b2, voffB); PG8_STAGE(PG8_SB(0, 1), b2 + hB, voffB); PG8_STAGE(PG8_SA(0, 0), a2, voffA);
            PG8_WAIT_V(8); PG8_WAIT_L(0); PG8_BAR; PG8_MMA(1, 0, At, B0); PG8_MMA(1, 1, At, B1); PG8_BAR; PG8_SCHED;
            PG8_LDB(B0, 1, 0); PG8_LDB(B1, 1, 1); PG8_SCHED; PG8_LDA(At, 1, 0); PG8_STAGE(PG8_SA(0, 1), a2 + hA, voffA);
            PG8_WAIT_V(8); PG8_WAIT_L(0); PG8_BAR; PG8_MMA(0, 0, At, B0); PG8_MMA(0, 1, At, B1); PG8_BAR; PG8_SCHED;
            PG8_LDA(At, 1, 1); PG8_STAGE(PG8_SB(1, 0), b3, voffB); PG8_STAGE(PG8_SB(1, 1), b3 + hB, voffB); PG8_STAGE(PG8_SA(1, 0), a3, voffA);
            PG8_WAIT_V(8); PG8_WAIT_L(0); PG8_BAR; PG8_MMA(1, 0, At, B0); PG8_MMA(1, 1, At, B1); PG8_BAR; PG8_SCHED;
        }
        if (wr == 0) PG8_BAR;
        { int l2_ = hw_lane(); asm volatile("" : "+v"(l2_)); E(acc, cur, wr, wc, l2_ & 15, l2_ >> 4); }
        if (!has_next) break;
#pragma unroll
        for (int a = 0; a < 2; ++a)
#pragma unroll
            for (int b = 0; b < 2; ++b)
#pragma unroll
                for (int m = 0; m < 4; ++m)
#pragma unroll
                    for (int n = 0; n < 2; ++n) acc[a][b][m][n] = (f32x4){0.f, 0.f, 0.f, 0.f};
        cur = nxt; cA = nA; cB = nB; ++ui;
        if (wr == 1) PG8_BAR;
    }
    PG8_WAIT_V(0);
    PG8_BAR;
#undef PG8_SA
#undef PG8_SB
#undef PG8_STAGE
#undef PG8_LDA
#undef PG8_LDB
#undef PG8_MMA
#undef PG8_WAIT_V
#undef PG8_WAIT_L
#undef PG8_BAR
#undef PG8_SCHED
#undef PG8_ABASE
#undef PG8_BBASE
}
}

#define XB_TMO      128
#define XB_XCNT(j)  (256  + 64 * (j))
#define XB_XSUB(j)  (1280 + 64 * (j))
#define XB_XGEN(j)  (2304 + 64 * (j))
#define XB_TOP      3328
#define XB_TOPGEN   3392
#define XCD_BAR_WORDS 3456
#define XB_SPIN_CAP (1u << 18)
__device__ __forceinline__ unsigned xb_ld(unsigned* p)              { return __hip_atomic_load(p, __ATOMIC_RELAXED, __HIP_MEMORY_SCOPE_AGENT); }
__device__ __forceinline__ unsigned xb_add(unsigned* p, unsigned v) { return __hip_atomic_fetch_add(p, v, __ATOMIC_RELAXED, __HIP_MEMORY_SCOPE_AGENT); }
__device__ __forceinline__ unsigned xb_xcc_id() { return (unsigned)__builtin_amdgcn_s_getreg((3 << 11) | 20) & 0xFu; }
#define XB_SPIN(cond, bar) do { unsigned _sp = 0; while (cond) { __builtin_amdgcn_s_sleep(1); \
    if ((++_sp & 255u) == 0u) { if (xb_ld(&(bar)[XB_TMO])) break; if (_sp > XB_SPIN_CAP) { atomicAdd(&(bar)[XB_TMO], 1u); break; } } } } while (0)
struct XcdBarrier { unsigned* bar; unsigned x; volatile LAS unsigned* st; bool w0; };
__device__ __forceinline__ XcdBarrier xcd_barrier_post(unsigned* bar, volatile LAS unsigned* st, bool w0) {
    XcdBarrier b; b.bar = bar; b.x = xb_xcc_id(); b.st = st; b.w0 = w0;
    if (w0 && hw_lane() == 0) (void)xb_add(&bar[XB_XCNT(b.x)], 1u);
    return b;
}
__device__ __forceinline__ void xcd_barrier_complete(unsigned* bar, unsigned x, unsigned& nloc, unsigned& nx) {
    const unsigned G = gridDim.x * gridDim.y * gridDim.z;
    unsigned sum, cnt, mine, sp = 0u;
    for (;;) {
        sum = 0u; cnt = 0u; mine = 0u;
#pragma unroll
        for (unsigned j = 0; j < 16; ++j) { const unsigned c = xb_ld(&bar[XB_XCNT(j)]); sum += c; cnt += (c > 0u) ? 1u : 0u; mine = (j == x) ? c : mine; }
        if (sum == G) break;
        __builtin_amdgcn_s_sleep(1);
        if ((++sp & 255u) == 0u) { if (xb_ld(&bar[XB_TMO])) break; if (sp > XB_SPIN_CAP) { atomicAdd(&bar[XB_TMO], 1u); break; } }
    }
    nloc = mine > 0u ? mine : 1u; nx = cnt > 0u ? cnt : 1u;
}
__device__ __forceinline__ void xcd_barrier(const XcdBarrier& b) {
    asm volatile("s_waitcnt vmcnt(0)" ::: "memory");
    __syncthreads();
    if (b.w0 && hw_lane() == 0) {
        unsigned* bar = b.bar;
        __builtin_amdgcn_s_waitcnt(0);
        unsigned nloc = b.st[0], nx = b.st[1];
        if (nloc == 0u) { xcd_barrier_complete(bar, b.x, nloc, nx); b.st[0] = nloc; b.st[1] = nx; }
        const unsigned old = xb_add(&bar[XB_XSUB(b.x)], 1u);
        const unsigned gen = old / nloc;
        if (old + 1u == (gen + 1u) * nloc) {
            __builtin_amdgcn_fence(__ATOMIC_RELEASE, "agent");
            asm volatile("s_waitcnt vmcnt(0)" ::: "memory");
            const unsigned og = xb_add(&bar[XB_TOP], 1u);
            const unsigned tg = og / nx;
            if (og + 1u == (tg + 1u) * nx) xb_add(&bar[XB_TOPGEN], 1u);
            else XB_SPIN(xb_ld(&bar[XB_TOPGEN]) == tg, bar);
            __builtin_amdgcn_fence(__ATOMIC_ACQUIRE, "agent");
            xb_add(&bar[XB_XGEN(b.x)], 1u);
            asm volatile("s_waitcnt vmcnt(0)" ::: "memory");
        } else {
            XB_SPIN(xb_ld(&bar[XB_XGEN(b.x)]) == gen, bar);
            __builtin_amdgcn_fence(__ATOMIC_ACQUIRE, "agent");
            asm volatile("s_waitcnt vmcnt(0)" ::: "memory");
        }
    }
    __syncthreads();
}

constexpr int NWAVES = 8, NTHR = 512;
constexpr int RING_BYTES = 131072, MISC_OFF = RING_BYTES + 320, LDS_BYTES = 147456;
struct Args { const float* in[25]; float* out; unsigned char* ws; int ph_lo, ph_hi; };
static_assert(sizeof(Args) == 25 * 8 + 8 + 8 + 8, "Args has no padding");

struct Ctx {
    LAS unsigned char* lds; int tid, lane, wave, G, gw, NGW;
    unsigned char* ws; float* out; const float* const* in;
};

__device__ __forceinline__ void store8(bf16_t* p, f32x4 a, f32x4 b) { u32x4 w; w.x = pk2(a[0], a[1]); w.y = pk2(a[2], a[3]); w.z = pk2(b[0], b[1]); w.w = pk2(b[2], b[3]); *(u32x4*)p = w; }
struct NoPre {};
__device__ __forceinline__ unsigned pk4f8(float a, float b, float c, float d);
constexpr float F8_ACT_SCALE = 16.f;
__device__ __forceinline__ size_t blk8(int row, int col) { return ((size_t)((row >> 4) * 32 + (col >> 5)) * 64 + (size_t)((row & 15) * 4 + ((col >> 3) & 3))) * 8; }
__device__ __forceinline__ unsigned pk4u8(f32x4 v) { unsigned w = 0; w = __builtin_amdgcn_cvt_pk_u8_f32(v[0], 0, w); w = __builtin_amdgcn_cvt_pk_u8_f32(v[1], 1, w); w = __builtin_amdgcn_cvt_pk_u8_f32(v[2], 2, w); return __builtin_amdgcn_cvt_pk_u8_f32(v[3], 3, w); }
struct FInproj {
    typedef NoPre Pre;
    bf16_t *XR, *GR, *CQKV, *GRNN, *GATT;
    __device__ __forceinline__ Pre load(int, int, int) const { return Pre(); }
    __device__ __forceinline__ void apply(const Pre&, int pn, int row, int col, f32x4 a, f32x4 b) const {
        a = a * (1.f / 16.f); b = b * (1.f / 16.f);
        if (pn < 4) { store8(XR + (size_t)row * 1024 + col, a, b); }
        else if (pn < 8) { store8(GR + (size_t)row * 1024 + (col - 1024), a, b); }
        else if (pn < 11) { u32x2 w; w.x = pk4f8(a[0] * F8_ACT_SCALE, a[1] * F8_ACT_SCALE, a[2] * F8_ACT_SCALE, a[3] * F8_ACT_SCALE); w.y = pk4f8(b[0] * F8_ACT_SCALE, b[1] * F8_ACT_SCALE, b[2] * F8_ACT_SCALE, b[3] * F8_ACT_SCALE);
            *(u32x2*)((unsigned char*)CQKV + (size_t)row * CQKV_LD + (col - 2048)) = w; }
        else {
#pragma unroll
            for (int i = 0; i < 4; ++i) { a[i] = __builtin_rintf(sigm(a[i]) * 255.f); b[i] = __builtin_rintf(sigm(b[i]) * 255.f); }
            u32x2 w; w.x = pk4u8(a); w.y = pk4u8(b);
            if (pn < 15) *(u32x2*)((unsigned char*)GRNN + blk8(row, col - 2816)) = w; else *(u32x2*)((unsigned char*)GATT + blk8(row, col - 3840)) = w; }
    }
};
struct FGate {
    struct Pre { u32x4 xc; };
    const bf16_t* XC; const float *ba, *bx, *clam; bf16_t *LA, *UU;
    __device__ __forceinline__ Pre load(int pn, int row, int cl) const { Pre p; p.xc = *(const u32x4*)(XC + (size_t)row * 1024 + pn * 128 + cl); return p; }
    struct Chan { f32x4 ba0, ba1, bx0, bx1, cl0, cl1; };
    __device__ __forceinline__ Chan chan(int pn, int cl) const { const int ch = pn * 128 + cl; Chan c; c.ba0 = *(const f32x4*)(ba + ch); c.ba1 = *(const f32x4*)(ba + ch + 4); c.bx0 = *(const f32x4*)(bx + ch); c.bx1 = *(const f32x4*)(bx + ch + 4); c.cl0 = *(const f32x4*)(clam + ch); c.cl1 = *(const f32x4*)(clam + ch + 4); return c; }
    __device__ __forceinline__ void apply(const Pre& pr, const Chan& cn, int pn, int row, int cl, f32x4 a0, f32x4 a1, f32x4 x0, f32x4 x1) const {
        const int ch = pn * 128 + cl; const size_t off = (size_t)row * 1024 + ch;
        float xc[8]; unpack8(pr.xc, xc);
        const f32x4 ba0 = cn.ba0, ba1 = cn.ba1, bx0 = cn.bx0, bx1 = cn.bx1, cl0 = cn.cl0, cl1 = cn.cl1;
        float la[8], uu[8];
#pragma unroll
        for (int i = 0; i < 8; ++i) {
            const float ga = (i < 4 ? a0[i & 3] + ba0[i & 3] : a1[i & 3] + ba1[i & 3]), gx = (i < 4 ? x0[i & 3] + bx0[i & 3] : x1[i & 3] + bx1[i & 3]), cc = (i < 4 ? cl0[i & 3] : cl1[i & 3]);
            const float r = sigm(ga), ig = sigm(gx), l = r * cc;
            la[i] = l; uu[i] = __builtin_amdgcn_sqrtf(fmaxf(1.f - ex2(2.f * LOG2E * l), 0.f)) * (ig * xc[i]);
        }
        *(u32x4*)(LA + off) = pack8(la); *(u32x4*)(UU + off) = pack8(uu);
    }
};
struct FQ {
    struct Pre { float sc; };
    const float* rsq; bf16_t* Q;
    __device__ __forceinline__ Pre load(int, int row, int) const { Pre p; p.sc = rsq[row]; return p; }
    __device__ __forceinline__ void apply(const Pre& pr, int pn, int row, int col, f32x4 a, f32x4 b) const {
        const float sc = pr.sc * (QSCALE / 256.f); a = a * sc; b = b * sc;
        store8(Q + (size_t)row * QLD + col, a, b);
    }
};
__device__ __forceinline__ size_t kv_off(int row, int c, bool isv) {
    const int h = c >> 6, d = c & 63; size_t tb; int kk;
    if (row < M) { const int b = row >> 11, sq = row & (SEQ - 1); tb = (size_t)((b * 16 + h) * 32 + (sq >> 6)) * 4096; kk = sq & 63; }
    else { const int m = row - M; if (m >= 64) return (size_t)M * 1024 + 65536 + (size_t)(m - 64) * 1024 + c; tb = (size_t)M * 1024 + (size_t)h * 4096; kk = m; }
    return tb + (isv ? (size_t)((d >> 5) * 2048 + kk * 32 + (d & 31)) : (size_t)((d >> 3) * 512 + kk * 8));
}
struct FKV {
    struct Pre { float sc; };
    const float* rskv; bf16_t *KN, *V;
    __device__ __forceinline__ Pre load(int, int row, int) const { Pre p; p.sc = rskv[row]; return p; }
    __device__ __forceinline__ void apply(const Pre& pr, int pn, int row, int col, f32x4 a, f32x4 b) const {
        const float sc = pr.sc * (1.f / 256.f); a = a * sc; b = b * sc;
        if (pn < 4) store8(KN + kv_off(row, col, false), a, b); else store8(V + kv_off(row, col - 1024, true), a, b);
    }
};
template <bool HAS_ADD> struct FMul {
    struct Pre { u32x2 g; u32x4 ad; };
    const unsigned char* Gt; const bf16_t* ADD; bf16_t* O; float osc;
    __device__ __forceinline__ Pre load(int, int row, int col) const { const size_t off = blk8(row, col); Pre p; p.g = *(const u32x2*)(Gt + off); if (HAS_ADD) p.ad = *(const u32x4*)(ADD + off); else p.ad = (u32x4){0u, 0u, 0u, 0u}; return p; }
    __device__ __forceinline__ void apply(const Pre& pr, int pn, int row, int col, f32x4 a, f32x4 b) const {
        const size_t off = HAS_ADD ? (size_t)row * 1024 + col : blk8(row, col); float gg[8];
#pragma unroll
        for (int i = 0; i < 4; ++i) { gg[i] = (float)((pr.g.x >> (8 * i)) & 255u) * osc; gg[4 + i] = (float)((pr.g.y >> (8 * i)) & 255u) * osc; }
        if (HAS_ADD) { float ad[8]; unpack8(pr.ad, ad);
#pragma unroll
            for (int i = 0; i < 4; ++i) { a[i] = (ad[i] + gg[i] * a[i]) * F8_ACT_SCALE; b[i] = (ad[4 + i] + gg[4 + i] * b[i]) * F8_ACT_SCALE; }
            u32x2 w; w.x = pk4f8(a[0], a[1], a[2], a[3]); w.y = pk4f8(b[0], b[1], b[2], b[3]);
            *(u32x2*)((unsigned char*)O + (size_t)row * 1024 + col) = w; return; }
        else {
#pragma unroll
            for (int i = 0; i < 4; ++i) { a[i] = gg[i] * a[i]; b[i] = gg[4 + i] * b[i]; } }
        store8(O + off, a, b);
    }
};
struct FRes {
    struct Pre { f32x4 x0, x1; };
    const float* X; bf16_t* H1B;
    __device__ __forceinline__ Pre load(int, int row, int col) const { const size_t off = (size_t)row * 1024 + col; Pre p; p.x0 = *(const f32x4*)(X + off); p.x1 = *(const f32x4*)(X + off + 4); return p; }
    __device__ __forceinline__ void apply(const Pre& pr, int pn, int row, int col, f32x4 a, f32x4 b) const {
        store8(H1B + (size_t)row * 1024 + col, a * (1.f / 256.f) + pr.x0, b * (1.f / 256.f) + pr.x1);
    }
};
typedef _Float16 f16x8 __attribute__((ext_vector_type(8)));
struct FF16 { typedef NoPre Pre; _Float16* O; int ldc;
    __device__ __forceinline__ Pre load(int, int, int) const { return Pre(); }
    __device__ __forceinline__ void apply(const Pre&, int pn, int row, int col, f32x4 a, f32x4 b) const {
        f16x8 h = {(_Float16)a[0], (_Float16)a[1], (_Float16)a[2], (_Float16)a[3], (_Float16)b[0], (_Float16)b[1], (_Float16)b[2], (_Float16)b[3]};
        *(f16x8*)(O + (size_t)row * ldc + col) = h; } };
struct FF32 { typedef NoPre Pre; float* O; int ldc;
    __device__ __forceinline__ Pre load(int, int, int) const { return Pre(); }
    __device__ __forceinline__ void apply(const Pre&, int pn, int row, int col, f32x4 a, f32x4 b) const { float* p = O + (size_t)row * ldc + col; *(f32x4*)p = a; *(f32x4*)(p + 4) = b; } };

struct MapId { __device__ __forceinline__ int operator()(int n) const { return n; } };
struct MapWin { __device__ __forceinline__ int operator()(int n) const {
    if (n < 2048) return n;
    if (n < 2816) { const int c = n - 2048; if (c < 256) return 2432 + c; if (c < 288) return 2688 + (c - 256); if (c < 384) return -1; return 2048 + (c - 384); }
    if (n < 3840) return 2720 + (n - 2816);
    return 3744 + (n - 3840); } };
struct MapUq { __device__ __forceinline__ int operator()(int n) const { const int h = n / 96, w = n % 96; if (w < 64) return n; const int t = w - 64; return h * 96 + 64 + (t >> 1) + 16 * (t & 1); } };
struct MapUkv { __device__ __forceinline__ int operator()(int n) const { if (n < 1024) return (n >> 6) * 128 + (n & 63); const int m = n - 1024; return (m >> 6) * 128 + 64 + (m & 63); } };

__device__ __forceinline__ float f8clamp(float v) { return __builtin_amdgcn_fmed3f(v, -448.f, 448.f); }
__device__ __forceinline__ unsigned pk4f8(float a, float b, float c, float d) { int p = __builtin_amdgcn_cvt_pk_fp8_f32(f8clamp(a), f8clamp(b), 0, false); p = __builtin_amdgcn_cvt_pk_fp8_f32(f8clamp(c), f8clamp(d), p, true); return (unsigned)p; }
constexpr float WIN_F8_SCALE = 16.f;
template <class Map, bool F8 = false> __device__ __forceinline__ void transpose_item(const float* W, int ldw, int Ndst, bf16_t* WT, int ldt, const float* kscale, LAS float* scr, int item, int lane, Map map) {
    const int nblk = Ndst / 32, kb = item / nblk, nb = item % nblk, k0 = 64 * kb, n0 = 32 * nb;
    const int src = map(n0 + (lane & 31));
#pragma unroll 8
    for (int i = 0; i < 32; ++i) { const int kk = 2 * i + (lane >> 5); float v = 0.f; if (src >= 0) { v = W[(size_t)(k0 + kk) * ldw + src]; if (kscale) v *= kscale[k0 + kk]; } scr[kk * 33 + (lane & 31)] = v; }
    LDS_WAIT(); asm volatile("" ::: "memory");
    const int c = lane & 7;
#pragma unroll
    for (int j = 0; j < 4; ++j) { const int n = (lane >> 3) + 8 * j; const LAS float* s = scr + (8 * c) * 33 + n;
        if (F8) { u32x2 o; o.x = pk4f8(s[0 * 33] * WIN_F8_SCALE, s[1 * 33] * WIN_F8_SCALE, s[2 * 33] * WIN_F8_SCALE, s[3 * 33] * WIN_F8_SCALE); o.y = pk4f8(s[4 * 33] * WIN_F8_SCALE, s[5 * 33] * WIN_F8_SCALE, s[6 * 33] * WIN_F8_SCALE, s[7 * 33] * WIN_F8_SCALE);
            *(u32x2*)((unsigned char*)WT + (size_t)(n0 + n) * ldt + k0 + 8 * c) = o; }
        else { u32x4 o; o.x = pk2(s[0 * 33], s[1 * 33]); o.y = pk2(s[2 * 33], s[3 * 33]); o.z = pk2(s[4 * 33], s[5 * 33]); o.w = pk2(s[6 * 33], s[7 * 33]);
        *(u32x4*)(WT + (size_t)(n0 + n) * ldt + k0 + 8 * c) = o; } }
    LDS_WAIT(); asm volatile("" ::: "memory");
}
__device__ __forceinline__ void rms_row_bf16(const float* xrow, const float* g, bf16_t* orow, int lane) {
    const f32x4* xr = (const f32x4*)xrow + lane; f32x4 v[4]; float s = 0.f;
#pragma unroll
    for (int j = 0; j < 4; ++j) { v[j] = xr[64 * j]; s += (v[j][0] * v[j][0] + v[j][1] * v[j][1]) + (v[j][2] * v[j][2] + v[j][3] * v[j][3]); }
    const float rstd = 1.f / sqrtf(wave_sum(s) * (1.f / 1024.f) + EPS);
    u32x2* o8 = (u32x2*)orow + lane;
#pragma unroll
    for (int j = 0; j < 4; ++j) { const f32x4 gg = ((const f32x4*)g)[lane + 64 * j]; u32x2 w; w.x = pk2(v[j][0] * rstd * gg[0], v[j][1] * rstd * gg[1]); w.y = pk2(v[j][2] * rstd * gg[2], v[j][3] * rstd * gg[3]); o8[64 * j] = w; }
}
__device__ __forceinline__ void rms_row_f32(const float* xrow, const float* g, float* orow, int lane) {
    const f32x4* xr = (const f32x4*)xrow + lane; f32x4 v[4]; float s = 0.f;
#pragma unroll
    for (int j = 0; j < 4; ++j) { v[j] = xr[64 * j]; s += (v[j][0] * v[j][0] + v[j][1] * v[j][1]) + (v[j][2] * v[j][2] + v[j][3] * v[j][3]); }
    const float rstd = 1.f / sqrtf(wave_sum(s) * (1.f / 1024.f) + EPS);
#pragma unroll
    for (int j = 0; j < 4; ++j) { const f32x4 gg = ((const f32x4*)g)[lane + 64 * j]; ((f32x4*)orow)[lane + 64 * j] = v[j] * rstd * gg; }
}

__device__ __forceinline__ void phase_tables(const Ctx& C, int gw, int NGW) {
    unsigned char* ws = C.ws; const float* const* in = C.in; const int lane = C.lane;
    {
        f32x4 g2n[4];
#pragma unroll
        for (int j = 0; j < 4; ++j) g2n[j] = ((const f32x4*)(in[18] + 16 * lane))[j];
        for (int e = gw; e < NEXP; e += NGW) {
            f32x4 v[4]; float am = 0.f;
#pragma unroll
            for (int j = 0; j < 4; ++j) { v[j] = ((const f32x4*)(in[22] + (size_t)e * 1024 + 16 * lane))[j] * g2n[j]; am = fmaxf(am, fmaxf(fmaxf(fabsf(v[j][0]), fabsf(v[j][1])), fmaxf(fabsf(v[j][2]), fabsf(v[j][3])))); }
#pragma unroll
            for (int o = 1; o < 64; o <<= 1) am = fmaxf(am, __shfl_xor(am, o));
            const float scale = am > 0.f ? am * (1.f / 127.f) : 1.f, inv = 1.f / scale;
            u32x4 w;
#pragma unroll
            for (int j = 0; j < 4; ++j) { const int q0 = (int)rintf(v[j][0] * inv), q1 = (int)rintf(v[j][1] * inv), q2 = (int)rintf(v[j][2] * inv), q3 = (int)rintf(v[j][3] * inv);
                w[j] = (unsigned)(q0 & 255) | ((unsigned)(q1 & 255) << 8) | ((unsigned)(q2 & 255) << 16) | ((unsigned)q3 << 24); }
            *(u32x4*)(ws + WS_PU + (size_t)e * 1024 + 16 * lane) = w;
            if (lane == 0) ((float*)(ws + WS_SU))[e] = scale;
        }
    }
    for (int e = gw; e < NEXP; e += NGW) {
        f32x4 v[4]; float am = 0.f;
#pragma unroll
        for (int j = 0; j < 4; ++j) { v[j] = ((const f32x4*)(in[23] + (size_t)e * 1024 + 16 * lane))[j]; am = fmaxf(am, fmaxf(fmaxf(fabsf(v[j][0]), fabsf(v[j][1])), fmaxf(fabsf(v[j][2]), fabsf(v[j][3])))); }
#pragma unroll
        for (int o = 1; o < 64; o <<= 1) am = fmaxf(am, __shfl_xor(am, o));
        const float scale = am > 0.f ? am * (1.f / 6.f) : 1.f, inv = 1.f / scale;
        u32x2 w;
#pragma unroll
        for (int d = 0; d < 2; ++d) { unsigned p = 0u;
            p = __builtin_amdgcn_cvt_scalef32_pk_fp4_f32(p, v[2 * d][0] * inv, v[2 * d][1] * inv, 1.0f, 0); p = __builtin_amdgcn_cvt_scalef32_pk_fp4_f32(p, v[2 * d][2] * inv, v[2 * d][3] * inv, 1.0f, 1);
            p = __builtin_amdgcn_cvt_scalef32_pk_fp4_f32(p, v[2 * d + 1][0] * inv, v[2 * d + 1][1] * inv, 1.0f, 2); p = __builtin_amdgcn_cvt_scalef32_pk_fp4_f32(p, v[2 * d + 1][2] * inv, v[2 * d + 1][3] * inv, 1.0f, 3);
            w[d] = p; }
        *(u32x2*)(ws + WS_PV + (size_t)e * 512 + 8 * lane) = w;
        if (lane == 0) ((float*)(ws + WS_SV))[e] = scale;
    }
}
__device__ __forceinline__ void phase_prologue(const Ctx& C) {
    unsigned char* ws = C.ws; const float* const* in = C.in;
    LAS float* scr = (LAS float*)(C.lds + C.wave * 16384);
    const int gw = C.gw, NGW = C.NGW, lane = C.lane;
    constexpr int I_WIN = 16 * (DIN_P / 32), I_UQ = 6 * (1536 / 32), I_UKV = 4 * (2048 / 32), I_SQ = 16 * 32, I_G = 2 * 4;
    constexpr int NITEMS = I_WIN + I_UQ + I_UKV + 3 * I_SQ + 16 * I_G;
    for (int it = gw; it < NITEMS; it += NGW) {
        int r = it;
        if (r < I_WIN) { transpose_item<MapWin, true>(in[3], 4768, DIN_P, (bf16_t*)(ws + WS_WIN), 1024, nullptr, scr, r, lane, MapWin()); continue; } r -= I_WIN;
        if (r < I_UQ) { transpose_item<MapUq, true>(in[13], 1536, 1536, (bf16_t*)(ws + WS_WUQ + 128), 512, in[12], scr, r, lane, MapUq()); continue; } r -= I_UQ;
        if (r < I_UKV) { transpose_item<MapUkv, true>(in[15], 2048, 2048, (bf16_t*)(ws + WS_WUKV), 256, in[14], scr, r, lane, MapUkv()); continue; } r -= I_UKV;
        if (r < I_SQ) { transpose_item<MapId, true>(in[11], 1024, 1024, (bf16_t*)(ws + WS_WRNN), 1024, nullptr, scr, r, lane, MapId()); continue; } r -= I_SQ;
        if (r < I_SQ) { transpose_item<MapId, true>(in[16], 1024, 1024, (bf16_t*)(ws + WS_WATT), 1024, nullptr, scr, r, lane, MapId()); continue; } r -= I_SQ;
        if (r < I_SQ) { transpose_item<MapId, true>(in[17], 1024, 1024, (bf16_t*)(ws + WS_WOUT), 1024, nullptr, scr, r, lane, MapId()); continue; } r -= I_SQ;
        { const int mat = r / I_G, sub = r % I_G, blk = mat >> 1, which = mat & 1;
          transpose_item((which ? in[8] : in[6]) + (size_t)blk * 16384, 128, 128, (bf16_t*)(ws + WS_WGATE) + (size_t)(blk * 256 + which * 128) * 128, 128, nullptr, scr, sub, lane, MapId()); }
    }
    const int gt = blockIdx.x * NTHR + C.tid, NT = C.G * NTHR;
    for (int it = blockIdx.x; it < 256; it += C.G) {
        const int hh = it >> 4, kc = it & 15, half = hh & 1, k = kc * 64 + lane, c0 = 16 * C.wave;
        const f32x4* keys = (const f32x4*)((half ? in[21] : in[20]) + (size_t)c0 * 128);
        LAS f32x4* ks = (LAS f32x4*)scr;
#pragma unroll
        for (int j = 0; j < 8; ++j) ks[j * 64 + lane] = keys[j * 64 + lane];
        const f32x4* wq = (const f32x4*)(in[19] + (size_t)k * 2048 + hh * 128); const float g2k = in[18][k];
        f32x4 a[32];
#pragma unroll
        for (int d4 = 0; d4 < 32; ++d4) a[d4] = wq[d4];
        LDS_WAIT(); asm volatile("" ::: "memory");
        bf16_t* o = (bf16_t*)(ws + WS_WPQ) + (size_t)(hh * 128 + c0) * 1024 + k;
#pragma unroll 4
        for (int c = 0; c < 16; ++c) { float s0 = 0.f, s1 = 0.f;
#pragma unroll
            for (int d4 = 0; d4 < 32; d4 += 2) { const f32x4 k0 = ks[c * 32 + d4], k1 = ks[c * 32 + d4 + 1]; s0 += (a[d4][0] * k0[0] + a[d4][1] * k0[1]) + (a[d4][2] * k0[2] + a[d4][3] * k0[3]); s1 += (a[d4 + 1][0] * k1[0] + a[d4 + 1][1] * k1[1]) + (a[d4 + 1][2] * k1[2] + a[d4 + 1][3] * k1[3]); }
            o[(size_t)c * 1024] = (bf16_t)(pk2((s0 + s1) * g2k, 0.f) & 0xffffu); }
        LDS_WAIT(); asm volatile("" ::: "memory");
    }
    for (int i = gt; i < 1536 * 8; i += NT) *(u32x4*)(ws + WS_WUQ + (size_t)(i >> 3) * 512 + (i & 7) * 16) = (u32x4){0u, 0u, 0u, 0u};
    for (int i = gt; i < NPOS * 16; i += NT) { const int pos = i >> 4, j = i & 15; const float inv = exp2f(-(float)j * (13.287712379549449f / 16.f)); const float ang = (float)pos * inv;
        float t = ang * 0.15915494309189535f; t = t - floorf(t);
        ((float*)(ws + WS_CTAB))[i] = __builtin_amdgcn_cosf(t); ((float*)(ws + WS_STAB))[i] = __builtin_amdgcn_sinf(t); }
    for (int i = gt; i < 1024; i += NT) { const float lam = in[10][i]; ((float*)(ws + WS_CLAM))[i] = -8.f * log1pf(expf(-lam)); }
    unsigned char* N1 = ws + SLOT(0);
    {
        f32x4 gg[4];
#pragma unroll
        for (int j = 0; j < 4; ++j) gg[j] = ((const f32x4*)in[2])[lane + 64 * j];
        int m = gw; f32x4 nv[4];
        if (m < M) {
#pragma unroll
            for (int j = 0; j < 4; ++j) nv[j] = ((const f32x4*)(in[0] + (size_t)m * 1024))[lane + 64 * j]; }
        for (; m < M; m += NGW) {
            f32x4 v[4]; float sq = 0.f;
#pragma unroll
            for (int j = 0; j < 4; ++j) { v[j] = nv[j]; sq += (v[j][0] * v[j][0] + v[j][1] * v[j][1]) + (v[j][2] * v[j][2] + v[j][3] * v[j][3]); }
            if (m + NGW < M) {
#pragma unroll
                for (int j = 0; j < 4; ++j) nv[j] = ((const f32x4*)(in[0] + (size_t)(m + NGW) * 1024))[lane + 64 * j]; }
            const float rstd = 1.f / sqrtf(wave_sum(sq) * (1.f / 1024.f) + EPS);
            unsigned* o4 = (unsigned*)(N1 + (size_t)m * 1024) + lane;
#pragma unroll
            for (int j = 0; j < 4; ++j) o4[64 * j] = pk4f8(v[j][0] * rstd * gg[j][0], v[j][1] * rstd * gg[j][1], v[j][2] * rstd * gg[j][2], v[j][3] * rstd * gg[j][3]);
        }
    }
    for (int m = gw; m < 256; m += NGW) {
        if (m < NMETA) { const f32x4* xr = (const f32x4*)(in[1] + (size_t)m * 1024) + lane; f32x4 v[4]; float sq = 0.f;
#pragma unroll
            for (int j = 0; j < 4; ++j) { v[j] = xr[64 * j]; sq += (v[j][0] * v[j][0] + v[j][1] * v[j][1]) + (v[j][2] * v[j][2] + v[j][3] * v[j][3]); }
            const float rstd = 1.f / sqrtf(wave_sum(sq) * (1.f / 1024.f) + EPS);
            unsigned* o4 = (unsigned*)(N1 + (size_t)(METAROW + m) * 1024) + lane;
#pragma unroll
            for (int j = 0; j < 4; ++j) { const f32x4 gg = ((const f32x4*)in[2])[lane + 64 * j]; o4[64 * j] = pk4f8(v[j][0] * rstd * gg[0], v[j][1] * rstd * gg[1], v[j][2] * rstd * gg[2], v[j][3] * rstd * gg[3]); } }
        else { u32x4* o = (u32x4*)(N1 + (size_t)(METAROW + m) * 1024); o[lane] = (u32x4){0u, 0u, 0u, 0u}; }
    }
}

__device__ __forceinline__ int prev_row(int r, int j) {
    if (r < M) { const int s = r & (SEQ - 1); return s >= j ? r - j : METAROW + NMETA + (s - j); }
    const int p = r - METAROW; return p >= j ? r - j : -1;
}
struct ThinRow { u32x4 xa, xb; u32x2 cq, ckv; unsigned k1, k2; };
__device__ __forceinline__ ThinRow thin_load(const bf16_t* XR, const bf16_t* CQKV, int r, int lane) {
    ThinRow d; const unsigned char* z = (const unsigned char*)CQKV + (size_t)r * CQKV_LD;
    d.xa = *(const u32x4*)(XR + (size_t)r * 1024 + lane * 8); d.xb = *(const u32x4*)(XR + (size_t)r * 1024 + 512 + lane * 8);
    d.cq = *(const u32x2*)(z + CQ_OFF + (lane < 48 ? lane : 0) * 8); d.ckv = *(const u32x2*)(z + (lane & 31) * 8);
    d.k1 = z[KR_OFF + (lane & 15)]; d.k2 = z[KR_OFF + 16 + (lane & 15)];
    return d;
}
__device__ __forceinline__ float f8sq8(u32x2 w) {
    const f32x2 a = __builtin_amdgcn_cvt_pk_f32_fp8((int)w.x, false), b = __builtin_amdgcn_cvt_pk_f32_fp8((int)w.x, true), c = __builtin_amdgcn_cvt_pk_f32_fp8((int)w.y, false), d = __builtin_amdgcn_cvt_pk_f32_fp8((int)w.y, true);
    return ((a.x * a.x + a.y * a.y) + (b.x * b.x + b.y * b.y) + (c.x * c.x + c.y * c.y) + (d.x * d.x + d.y * d.y)) * (1.f / (F8_ACT_SCALE * F8_ACT_SCALE));
}
__device__ __forceinline__ void thin_row_stats(unsigned char* ws, const ThinRow& d, int r, int lane) {
    float* RSQ = (float*)(ws + WS_RSQ); float* RSKV = (float*)(ws + WS_RSKV); bf16_t* KROPE = (bf16_t*)(ws + WS_KROPE);
    float sq = 0.f, skv = 0.f;
    { float a = f8sq8(d.cq); sq = lane < 48 ? a : 0.f; }
    { float a = f8sq8(d.ckv); skv = lane < 32 ? a : 0.f; }
    sq = wave_sum(sq); skv = wave_sum(skv);
    if (lane == 0) { RSQ[r] = 1.f / sqrtf(sq * (1.f / 384.f) + EPS); RSKV[r] = 1.f / sqrtf(skv * (1.f / 256.f) + EPS); }
    if (lane < 16) { const int pos = r < M ? NMETA + (r & (SEQ - 1)) : r - METAROW; const float x1 = __builtin_amdgcn_cvt_f32_fp8((int)d.k1, 0) * (1.f / F8_ACT_SCALE), x2 = __builtin_amdgcn_cvt_f32_fp8((int)d.k2, 0) * (1.f / F8_ACT_SCALE);
        const float c = ((const float*)(ws + WS_CTAB))[pos * 16 + lane], s = ((const float*)(ws + WS_STAB))[pos * 16 + lane];
        ((unsigned*)(KROPE + (size_t)r * 32))[lane] = pk2(x1 * c - x2 * s, x1 * s + x2 * c); }
}
__device__ __forceinline__ void phase_thin(const Ctx& C) {
    unsigned char* ws = C.ws; const float* const* in = C.in; const int lane = C.lane;
    const bf16_t* XR = (const bf16_t*)(ws + SLOT(1)); const bf16_t* CQKV = (const bf16_t*)(ws + SLOT(3)); bf16_t* XC = (bf16_t*)(ws + SLOT(0));
    const float* cw = in[4]; const float* cb = in[5];
    float w[4][16], bias[16];
#pragma unroll
    for (int hh = 0; hh < 2; ++hh)
#pragma unroll
        for (int i = 0; i < 8; ++i) { const int ch = hh * 512 + lane * 8 + i; bias[hh * 8 + i] = cb[ch];
#pragma unroll
            for (int t = 0; t < 4; ++t) w[t][hh * 8 + i] = cw[t * 1024 + ch]; }
    for (int st = C.gw; st < M / 32 + 1; st += C.NGW) {
        const bool meta = st == M / 32; const int r0 = meta ? METAROW : st * 32, nrow = meta ? NMETA : 32;
        float x1[16], x2[16], x3[16];
        const bool first = meta || (r0 & (SEQ - 1)) == 0;
        ThinRow nx = thin_load(XR, CQKV, r0, lane);
#pragma unroll
        for (int j = 1; j <= 3; ++j) { const int pr = first ? (meta ? -1 : METAROW + NMETA - j) : r0 - j;
#pragma unroll
            for (int hh = 0; hh < 2; ++hh) { float v[8];
                if (pr >= 0) unpack8(*(const u32x4*)(XR + (size_t)pr * 1024 + hh * 512 + lane * 8), v); else {
#pragma unroll
                    for (int i = 0; i < 8; ++i) v[i] = 0.f; }
#pragma unroll
                for (int i = 0; i < 8; ++i) { if (j == 1) x1[hh * 8 + i] = v[i]; else if (j == 2) x2[hh * 8 + i] = v[i]; else x3[hh * 8 + i] = v[i]; } } }
        for (int t = 0; t < nrow; ++t) { const int r = r0 + t; float x0[16];
            const ThinRow d = nx;
            if (t + 1 < nrow) nx = thin_load(XR, CQKV, r + 1, lane);
            { float v[8]; unpack8(d.xa, v);
#pragma unroll
              for (int i = 0; i < 8; ++i) x0[i] = v[i];
              unpack8(d.xb, v);
#pragma unroll
              for (int i = 0; i < 8; ++i) x0[8 + i] = v[i]; }
#pragma unroll
            for (int hh = 0; hh < 2; ++hh) { float y[8];
#pragma unroll
                for (int i = 0; i < 8; ++i) { const int q = hh * 8 + i; y[i] = bias[q] + w[3][q] * x0[q] + w[2][q] * x1[q] + w[1][q] * x2[q] + w[0][q] * x3[q]; }
                *(u32x4*)(XC + (size_t)r * 1024 + hh * 512 + lane * 8) = pack8(y); }
#pragma unroll
            for (int q = 0; q < 16; ++q) { x3[q] = x2[q]; x2[q] = x1[q]; x1[q] = x0[q]; }
            thin_row_stats(ws, d, r, lane);
        }
    }
    float* RSQ = (float*)(ws + WS_RSQ); float* RSKV = (float*)(ws + WS_RSKV); bf16_t* KROPE = (bf16_t*)(ws + WS_KROPE);
    for (int r = M + NMETA + C.gw; r < MTOT; r += C.NGW) {
        u32x4* o = (u32x4*)(XC + (size_t)r * 1024); o[lane] = (u32x4){0u, 0u, 0u, 0u}; o[64 + lane] = (u32x4){0u, 0u, 0u, 0u};
        if (lane == 0) { RSQ[r] = 0.f; RSKV[r] = 0.f; }
        if (lane < 16) ((unsigned*)(KROPE + (size_t)r * 32))[lane] = 0u;
    }
}

__device__ __forceinline__ void phase_scan1(const Ctx& C) {
    unsigned char* ws = C.ws; const int lane = C.lane;
    const bf16_t* LA = (const bf16_t*)(ws + SLOT(1)); const bf16_t* UU = (const bf16_t*)(ws + SLOT(6));
    float* SCP = (float*)(ws + WS_SCP); float* SCH = (float*)(ws + WS_SCH); float* CARRY0 = (float*)(ws + WS_CARRY0);
    for (int it = C.gw; it < 2048 + 4; it += C.NGW) {
        const bool meta = it >= 2048; const int q = it & 3, bc = it >> 2, ch = q * 256 + lane * 4;
        const int row0 = meta ? METAROW : bc * 128, nrow = meta ? NMETA : 128;
        float P[4] = {1.f, 1.f, 1.f, 1.f}, H[4] = {0.f, 0.f, 0.f, 0.f};
#pragma unroll 8
        for (int t = 0; t < nrow; ++t) { const u32x2 l2 = *(const u32x2*)(LA + (size_t)(row0 + t) * 1024 + ch), u2 = *(const u32x2*)(UU + (size_t)(row0 + t) * 1024 + ch);
            const float a0 = ex2(LOG2E * bf_lo(l2.x)), a1 = ex2(LOG2E * bf_hi(l2.x)), a2 = ex2(LOG2E * bf_lo(l2.y)), a3 = ex2(LOG2E * bf_hi(l2.y));
            P[0] *= a0; P[1] *= a1; P[2] *= a2; P[3] *= a3;
            H[0] = a0 * H[0] + bf_lo(u2.x); H[1] = a1 * H[1] + bf_hi(u2.x); H[2] = a2 * H[2] + bf_lo(u2.y); H[3] = a3 * H[3] + bf_hi(u2.y); }
        if (meta) *(f32x4*)(CARRY0 + ch) = (f32x4){H[0], H[1], H[2], H[3]};
        else { *(f32x4*)(SCP + (size_t)bc * 1024 + ch) = (f32x4){P[0], P[1], P[2], P[3]}; *(f32x4*)(SCH + (size_t)bc * 1024 + ch) = (f32x4){H[0], H[1], H[2], H[3]}; }
    }
}
__device__ __forceinline__ void phase_scan2(const Ctx& C) {
    unsigned char* ws = C.ws; const int lane = C.lane;
    const bf16_t* LA = (const bf16_t*)(ws + SLOT(1)); const bf16_t* UU = (const bf16_t*)(ws + SLOT(6)); const bf16_t* GR = (const bf16_t*)(ws + SLOT(2)); unsigned char* HRG = ws + SLOT(0);
    const float* SCP = (const float*)(ws + WS_SCP); const float* SCH = (const float*)(ws + WS_SCH); const float* CARRY0 = (const float*)(ws + WS_CARRY0);
    for (int it = C.gw; it < 2048; it += C.NGW) {
        const int q = it & 3, bc = it >> 2, b = bc >> 4, c = bc & 15, ch = q * 256 + lane * 4;
        f32x4 h = *(const f32x4*)(CARRY0 + ch);
        for (int cc = 0; cc < c; ++cc) { const f32x4 p = *(const f32x4*)(SCP + (size_t)(b * 16 + cc) * 1024 + ch), e = *(const f32x4*)(SCH + (size_t)(b * 16 + cc) * 1024 + ch); h = p * h + e; }
        float H[4] = {h[0], h[1], h[2], h[3]};
        const int row0 = bc * 128;
#pragma unroll 8
        for (int t = 0; t < 128; ++t) { const size_t off = (size_t)(row0 + t) * 1024 + ch; const u32x2 l2 = *(const u32x2*)(LA + off), u2 = *(const u32x2*)(UU + off), g2 = *(const u32x2*)(GR + off);
            H[0] = ex2(LOG2E * bf_lo(l2.x)) * H[0] + bf_lo(u2.x); H[1] = ex2(LOG2E * bf_hi(l2.x)) * H[1] + bf_hi(u2.x); H[2] = ex2(LOG2E * bf_lo(l2.y)) * H[2] + bf_lo(u2.y); H[3] = ex2(LOG2E * bf_hi(l2.y)) * H[3] + bf_hi(u2.y);
            *(unsigned*)(HRG + off) = pk4f8(H[0] * gelu_t(bf_lo(g2.x)) * F8_ACT_SCALE, H[1] * gelu_t(bf_hi(g2.x)) * F8_ACT_SCALE, H[2] * gelu_t(bf_lo(g2.y)) * F8_ACT_SCALE, H[3] * gelu_t(bf_hi(g2.y)) * F8_ACT_SCALE); }
    }
}

constexpr int AT_KSLOT = 12 * 1024, AT_VSLOT = 8192;
#define AT_K(j) (((j) & 3) * AT_KSLOT)
#define AT_V(j) (4 * AT_KSLOT + ((j) & 7) * AT_VSLOT)
static_assert(4 * AT_KSLOT + 8 * AT_VSLOT <= 131072, "attention rings fit the phase scratch");
__device__ __forceinline__ void glds16(const void* gsrc, unsigned lds_dst) { unsigned keep;
    asm volatile("s_mov_b32 %0, m0\n\ts_mov_b32 m0, %2\n\ts_nop 0\n\tglobal_load_lds_dwordx4 %1, off\n\ts_mov_b32 m0, %0" : "=&s"(keep) : "v"(gsrc), "s"(lds_dst) : "memory"); }
#define AT_BAR(N) asm volatile("s_waitcnt vmcnt(" #N ") lgkmcnt(0)\n\ts_barrier" ::: "memory")
__device__ __forceinline__ int crow(int r, int hi) { return (r & 3) + 8 * (r >> 2) + 4 * hi; }
#ifndef ATT_THR
#define ATT_THR 8.0f
#endif
#ifndef ATT_LOW
#define ATT_LOW -32.0f
#endif
template <bool FIRST> __device__ __forceinline__ void attn_sm(f32x16& p0, f32x16& p1, bf16x8 (&pb)[4], f32x16& o0, f32x16& o1, float& m_run, float& l_run, bool& mz) {
    float mx = fmaxf(p0[0], p1[0]);
#pragma unroll
    for (int r = 1; r < 16; ++r) mx = fmaxf(fmaxf(mx, p0[r]), p1[r]);
    mx = fmaxf(mx, __shfl_xor(mx, 32));
    mx -= m_run;
    if (!__all(mx <= ATT_THR && (!FIRST || mx >= ATT_LOW))) {
        const float d = FIRST ? mx : fmaxf(mx, 0.f), alpha = ex2(-d);
#pragma unroll
        for (int r = 0; r < 16; ++r) { o0[r] *= alpha; o1[r] *= alpha; }
        l_run *= alpha; m_run += d; mz = false;
    }
    float rs = 0.f;
    if (mz) {
#pragma unroll
        for (int r = 0; r < 16; ++r) { p0[r] = ex2(p0[r]); p1[r] = ex2(p1[r]); rs += p0[r] + p1[r]; }
    } else {
#pragma unroll
        for (int r = 0; r < 16; ++r) { p0[r] = ex2(p0[r] - m_run); p1[r] = ex2(p1[r] - m_run); rs += p0[r] + p1[r]; }
    }
    l_run += rs;
#pragma unroll
    for (int s = 0; s < 4; ++s) { unsigned w[4];
#pragma unroll
        for (int jj = 0; jj < 4; ++jj) w[jj] = (s < 2) ? pk2(p0[8 * (s & 1) + 2 * jj], p0[8 * (s & 1) + 2 * jj + 1]) : pk2(p1[8 * (s & 1) + 2 * jj], p1[8 * (s & 1) + 2 * jj + 1]);
        u32x4 ww = {w[0], w[1], w[2], w[3]}; pb[s] = __builtin_bit_cast(bf16x8, ww); }
}
__device__ __forceinline__ void attn_load_q(const Ctx& C, const bf16_t* Q, unsigned qrow, int h, int hi, int pos, bf16x8 (&qf)[6]) {
#pragma unroll
    for (int ks = 0; ks < 6; ++ks) qf[ks] = *(const bf16x8*)(Q + (qrow * (unsigned)QLD + (unsigned)(h * 96 + ks * 16 + hi * 8)));
    const float* ctab = (const float*)(C.ws + WS_CTAB) + (NMETA + pos) * 16; const float* stab = (const float*)(C.ws + WS_STAB) + (NMETA + pos) * 16;
#pragma unroll
    for (int ks = 4; ks < 6; ++ks) { const f32x4 cc = *(const f32x4*)(ctab + 8 * (ks - 4) + 4 * hi), sn = *(const f32x4*)(stab + 8 * (ks - 4) + 4 * hi);
        const u32x4 w = __builtin_bit_cast(u32x4, qf[ks]); u32x4 r;
        { const float x1 = bf_lo(w.x), x2 = bf_hi(w.x); r.x = pk2(x1 * cc[0] - x2 * sn[0], x1 * sn[0] + x2 * cc[0]); }
        { const float x1 = bf_lo(w.y), x2 = bf_hi(w.y); r.y = pk2(x1 * cc[1] - x2 * sn[1], x1 * sn[1] + x2 * cc[1]); }
        { const float x1 = bf_lo(w.z), x2 = bf_hi(w.z); r.z = pk2(x1 * cc[2] - x2 * sn[2], x1 * sn[2] + x2 * cc[2]); }
        { const float x1 = bf_lo(w.w), x2 = bf_hi(w.w); r.w = pk2(x1 * cc[3] - x2 * sn[3], x1 * sn[3] + x2 * cc[3]); }
        qf[ks] = __builtin_bit_cast(bf16x8, r); }
}
__device__ __forceinline__ void attn_mask(int j, int s0, int q, int hi, f32x16& p0, f32x16& p1) {
    if (j == 0) {
#pragma unroll
        for (int r = 0; r < 16; ++r) { if (crow(r, hi) >= NMETA) p0[r] = -INFINITY; p1[r] = -INFINITY; }
    } else if ((j - 1) * 64 + 63 > s0) {
        const int qs = s0 + q, k0 = (j - 1) * 64;
#pragma unroll
        for (int r = 0; r < 16; ++r) { const int kk = k0 + crow(r, hi); if (kk > qs) p0[r] = -INFINITY; if (kk + 32 > qs) p1[r] = -INFINITY; }
    }
}
template <bool DOA> __device__ __forceinline__ void attn_q2(LAS unsigned char* lds, int j, int q, int hi, const bf16x8 (&qa)[6], const bf16x8 (&qb_)[6],
                                                          f32x16& a0, f32x16& a1, f32x16& b0, f32x16& b1) {
    const int kb = AT_K(j);
    __builtin_amdgcn_s_setprio(1);
#pragma unroll
    for (int ks = 0; ks < 6; ++ks) {
        const bf16x8 k0 = *(const LAS bf16x8*)(lds + kb + (2 * ks + hi) * 1024 + q * 16);
        const bf16x8 k1 = *(const LAS bf16x8*)(lds + kb + (2 * ks + hi) * 1024 + (32 + q) * 16);
        if (ks == 0) { const f32x16 z = {}; if (DOA) { a0 = __builtin_amdgcn_mfma_f32_32x32x16_bf16(k0, qa[0], z, 0, 0, 0); a1 = __builtin_amdgcn_mfma_f32_32x32x16_bf16(k1, qa[0], z, 0, 0, 0); }
                       b0 = __builtin_amdgcn_mfma_f32_32x32x16_bf16(k0, qb_[0], z, 0, 0, 0); b1 = __builtin_amdgcn_mfma_f32_32x32x16_bf16(k1, qb_[0], z, 0, 0, 0); }
        else { if (DOA) { a0 = __builtin_amdgcn_mfma_f32_32x32x16_bf16(k0, qa[ks], a0, 0, 0, 0); a1 = __builtin_amdgcn_mfma_f32_32x32x16_bf16(k1, qa[ks], a1, 0, 0, 0); }
               b0 = __builtin_amdgcn_mfma_f32_32x32x16_bf16(k0, qb_[ks], b0, 0, 0, 0); b1 = __builtin_amdgcn_mfma_f32_32x32x16_bf16(k1, qb_[ks], b1, 0, 0, 0); }
    }
    __builtin_amdgcn_s_setprio(0);
}
template <bool DOA> __device__ __forceinline__ void attn_pv2(LAS unsigned char* lds, int vbase, const bf16x8 (&pa)[4], const bf16x8 (&pbb)[4], f32x16& oa0, f32x16& oa1, f32x16& ob0, f32x16& ob1) {
#pragma unroll
    for (int s = 0; s < 4; ++s)
#pragma unroll
        for (int db = 0; db < 2; ++db) {
            const v4i16_t lo = __builtin_amdgcn_ds_read_tr16_b64_v4i16((LAS v4i16_t*)(lds + vbase + db * 4096 + s * 1024));
            const v4i16_t hh = __builtin_amdgcn_ds_read_tr16_b64_v4i16((LAS v4i16_t*)(lds + vbase + db * 4096 + s * 1024 + 512));
            const bf16x8 va = {lo[0], lo[1], lo[2], lo[3], hh[0], hh[1], hh[2], hh[3]};
            if (db == 0) { if (DOA) oa0 = __builtin_amdgcn_mfma_f32_32x32x16_bf16(va, pa[s], oa0, 0, 0, 0); ob0 = __builtin_amdgcn_mfma_f32_32x32x16_bf16(va, pbb[s], ob0, 0, 0, 0); }
            else { if (DOA) oa1 = __builtin_amdgcn_mfma_f32_32x32x16_bf16(va, pa[s], oa1, 0, 0, 0); ob1 = __builtin_amdgcn_mfma_f32_32x32x16_bf16(va, pbb[s], ob1, 0, 0, 0); }
        }
}
__device__ __forceinline__ void attn_store_o(bf16_t* O, unsigned qrow, int h, int hi, const f32x16& o0, const f32x16& o1, float l_run) {
    const float inv = 1.f / (l_run + __shfl_xor(l_run, 32));
    unsigned char* orow = (unsigned char*)O + (qrow * 1024u + (unsigned)(h * 64));
    const float sc = inv * F8_ACT_SCALE;
#pragma unroll
    for (int g4 = 0; g4 < 4; ++g4) {
        *(unsigned*)(orow + 8 * g4 + 4 * hi) = pk4f8(o0[4 * g4] * sc, o0[4 * g4 + 1] * sc, o0[4 * g4 + 2] * sc, o0[4 * g4 + 3] * sc);
        *(unsigned*)(orow + 32 + 8 * g4 + 4 * hi) = pk4f8(o1[4 * g4] * sc, o1[4 * g4 + 1] * sc, o1[4 * g4 + 2] * sc, o1[4 * g4 + 3] * sc);
    }
}
__device__ __forceinline__ void attn_unit2(const Ctx& C, int b, int h, int ip, const bf16_t* Q, const bf16_t* KN, const bf16_t* KR, const bf16_t* V, bf16_t* O) {
    const int lane = C.lane, wid = C.wave, q = lane & 31, hi = lane >> 5;
    LAS unsigned char* lds = C.lds;
    const int sA = ip * 512 + wid * 32, sB = sA + 256;
    const unsigned qrowA = (unsigned)(b * SEQ + sA + q), qrowB = qrowA + 256u;
    bf16x8 qa[6], qb_[6];
    attn_load_q(C, Q, qrowA, h, hi, sA + q, qa); attn_load_q(C, Q, qrowB, h, hi, sB + q, qb_);
    f32x16 oa0 = {}, oa1 = {}, ob0 = {}, ob1 = {}, a0 = {}, a1 = {}, b0 = {}, b1 = {};
    bf16x8 pa[4] = {}, pbb[4] = {};
    float mA = 0.f, lA = 0.f, mB = 0.f, lB = 0.f; bool zA = true, zB = true;
    const int NJ = 8 * ip + 9;
    const unsigned lds0 = (unsigned)(size_t)lds;
#define AT_DMA(j) do { const unsigned row_ = (j) == 0 ? (unsigned)METAROW : (unsigned)(b * SEQ + ((j) - 1) * 64); int l2_ = lane; asm volatile("" : "+v"(l2_)); \
        const unsigned poff = 2u * (unsigned)(wid * 512 + l2_ * 8), roff = 2u * (unsigned)(l2_ * 32 + (wid & 3) * 8); \
        const unsigned tb_ = 2u * ((j) == 0 ? (unsigned)(M * 1024 + h * 4096) : (unsigned)(((b * 16 + h) * 32 + ((j) - 1)) * 4096)); \
        glds16s(KN, poff + tb_, (unsigned)__builtin_amdgcn_readfirstlane(lds0 + AT_K(j) + wid * 1024)); \
        if (wid < 4) glds16s(KR, roff + row_ * 64u, (unsigned)__builtin_amdgcn_readfirstlane(lds0 + AT_K(j) + (8 + wid) * 1024)); \
        glds16s(V, poff + tb_, (unsigned)__builtin_amdgcn_readfirstlane(lds0 + AT_V(j) + wid * 1024)); } while (0)
#define AT_STEP(n) do { if ((n) + 2 < NJ) { if (wid < 4) AT_BAR(6); else AT_BAR(4); } else if ((n) + 1 < NJ) { if (wid < 4) AT_BAR(3); else AT_BAR(2); } else AT_BAR(0); if ((n) + 3 < NJ) AT_DMA((n) + 3); } while (0)
    AT_BAR(0);
    AT_DMA(0); AT_DMA(1); AT_DMA(2);
    const int g16 = lane >> 4, qq = (lane & 15) >> 2, pp = lane & 3;
    const int vtr_off = (4 * hi + qq) * 64 + (16 * (g16 & 1) + 4 * pp) * 2;
    const int jendA = (sA + 31) / 64 + 2, jendB = jendA + 4;
    {
        AT_STEP(0);
        attn_q2<true>(lds, 0, q, hi, qa, qb_, a0, a1, b0, b1);
        attn_mask(0, sA, q, hi, a0, a1); attn_mask(0, sB, q, hi, b0, b1);
        attn_sm<true>(a0, a1, pa, oa0, oa1, mA, lA, zA);
        attn_sm<true>(b0, b1, pbb, ob0, ob1, mB, lB, zB);
        attn_pv2<true>(lds, AT_V(0) + vtr_off, pa, pbb, oa0, oa1, ob0, ob1);
    }
    int j = 1;
    for (; j < jendA; ++j) {
        AT_STEP(j);
        attn_q2<true>(lds, j, q, hi, qa, qb_, a0, a1, b0, b1);
        attn_mask(j, sA, q, hi, a0, a1);
        attn_sm<false>(a0, a1, pa, oa0, oa1, mA, lA, zA);
        attn_sm<false>(b0, b1, pbb, ob0, ob1, mB, lB, zB);
        attn_pv2<true>(lds, AT_V(j) + vtr_off, pa, pbb, oa0, oa1, ob0, ob1);
    }
    for (; j < jendB; ++j) {
        AT_STEP(j);
        attn_q2<false>(lds, j, q, hi, qa, qb_, a0, a1, b0, b1);
        attn_mask(j, sB, q, hi, b0, b1);
        attn_sm<false>(b0, b1, pbb, ob0, ob1, mB, lB, zB);
        attn_pv2<false>(lds, AT_V(j) + vtr_off, pa, pbb, oa0, oa1, ob0, ob1);
    }
    for (; j < NJ; ++j) AT_STEP(j);
#undef AT_DMA
#undef AT_STEP
    attn_store_o(O, qrowA, h, hi, oa0, oa1, lA);
    attn_store_o(O, qrowB, h, hi, ob0, ob1, lB);
}
__device__ __forceinline__ void phase_attn(const Ctx& C) {
    unsigned char* ws = C.ws;
    const bf16_t* Q = (const bf16_t*)(ws + SLOT(0)); const bf16_t* KN = (const bf16_t*)(ws + SLOT(4)); const bf16_t* V = (const bf16_t*)(ws + SLOT(6)); const bf16_t* KR = (const bf16_t*)(ws + WS_KROPE);
    bf16_t* O = (bf16_t*)(ws + SLOT(3));
    const int G = C.G, c = blockIdx.x; const int vcu = (G % 8 == 0) ? (c % 8) * (G / 8) + c / 8 : c;
    for (int bh = vcu; bh < NB * 16; bh += G)
        for (int i = 0; i < 4; ++i) { const int ip = (i & 1) ? 3 - (i >> 1) : (i >> 1); attn_unit2(C, bh >> 4, bh & 15, ip, Q, KN, KR, V, O); }
    __syncthreads();
}

__device__ __forceinline__ int tk_enc(float f) { const int x = __float_as_int(f); return x ^ ((x >> 31) & 0x7fffffff); }
__device__ __forceinline__ float tk_dec(int k) { return __int_as_float(k ^ ((k >> 31) & 0x7fffffff)); }
#define TK_CE(a, b) do { const int hi_ = max((a), (b)), lo_ = min((a), (b)); (a) = hi_; (b) = lo_; } while (0)
__device__ __forceinline__ void tk_sort16(int (&v)[16]) {
#define TK_S(a, b) TK_CE(v[a], v[b]);
    TK_S(0,13) TK_S(1,12) TK_S(2,15) TK_S(3,14) TK_S(4,8) TK_S(5,6) TK_S(7,11) TK_S(9,10)
    TK_S(0,5) TK_S(1,7) TK_S(2,9) TK_S(3,4) TK_S(6,13) TK_S(8,14) TK_S(10,15) TK_S(11,12)
    TK_S(0,1) TK_S(2,3) TK_S(4,5) TK_S(6,8) TK_S(7,9) TK_S(10,11) TK_S(12,13) TK_S(14,15)
    TK_S(0,2) TK_S(1,3) TK_S(4,10) TK_S(5,11) TK_S(6,7) TK_S(8,9) TK_S(12,14) TK_S(13,15)
    TK_S(1,2) TK_S(3,12) TK_S(4,6) TK_S(5,7) TK_S(8,10) TK_S(9,11) TK_S(13,14)
    TK_S(1,4) TK_S(2,6) TK_S(5,8) TK_S(7,10) TK_S(9,13) TK_S(11,14)
    TK_S(2,4) TK_S(3,6) TK_S(9,12) TK_S(11,13)
    TK_S(3,5) TK_S(6,8) TK_S(7,9) TK_S(10,12)
    TK_S(3,4) TK_S(5,6) TK_S(7,8) TK_S(9,10) TK_S(11,12)
    TK_S(6,7) TK_S(8,9)
#undef TK_S
}
__device__ __forceinline__ void tk_merge16(int (&a)[16], const int (&b)[16]) {
#pragma unroll
    for (int i = 0; i < 16; ++i) a[i] = max(a[i], b[15 - i]);
#pragma unroll
    for (int j = 8; j > 0; j >>= 1)
#pragma unroll
        for (int i = 0; i < 16; ++i) { const int l = i ^ j; if (l > i) TK_CE(a[i], a[l]); }
}
__host__ __device__ constexpr int tk_pos(int i) { int n = 0; for (int a = 0; a < i; ++a) n += 16 / (a + 1); return n; }
__host__ __device__ constexpr int tk_ci(int n) { int i = 0; while (i < 15 && tk_pos(i + 1) <= n) ++i; return i; }
__host__ __device__ constexpr int tk_cj(int n) { return n - tk_pos(tk_ci(n)); }
__device__ __forceinline__ int tk_lookup(const int (&w)[4], int i) {
    const unsigned long long lo = ((unsigned long long)(unsigned)w[1] << 32) | (unsigned long long)(unsigned)w[0], hi = ((unsigned long long)(unsigned)w[3] << 32) | (unsigned long long)(unsigned)w[2];
    const unsigned long long a = (i & 8) ? hi : lo;
    return (int)(a >> (8 * (i & 7))) & 127;
}
__device__ __forceinline__ void phase_topk(const Ctx& C) {
    unsigned char* ws = C.ws;
    const _Float16* SC = (const _Float16*)(ws + SLOT(0)); int* TIDX = (int*)(ws + SLOT(5)); float* TVAL = (float*)(ws + SLOT(5) + (size_t)M * 128 * 4);
    const int gt = blockIdx.x * NTHR + C.tid, NT = C.G * NTHR;
    for (int it = gt; it < M * 8 * 4; it += NT) {
        const int p = it >> 2, q = it & 3;
        f16x8 raw[8];
        { const unsigned char* blk = (const unsigned char*)(SC + (size_t)(p - (C.lane >> 2)) * 256);
          LAS unsigned char* tl = C.lds + C.wave * 9216;
          u32x4 cv[8];
#pragma unroll
          for (int c = 0; c < 8; ++c) cv[c] = *(const u32x4*)(blk + 1024 * c + 16 * C.lane);
#pragma unroll
          for (int c = 0; c < 8; ++c) *(LAS u32x4*)(tl + 144 * (8 * c + (C.lane >> 3)) + 16 * (C.lane & 7)) = cv[c];
#pragma unroll
          for (int c = 0; c < 8; ++c) raw[c] = *(LAS const f16x8*)(tl + 144 * C.lane + 16 * c); }
        const int ibase = 127 - 64 * (q & 1);
        int ch[4][16];
#pragma unroll
        for (int c = 0; c < 4; ++c)
#pragma unroll
            for (int e = 0; e < 16; ++e) ch[c][e] = (tk_enc((float)raw[2 * c + (e >> 3)][e & 7]) & ~127) | (ibase - (16 * c + e));
        tk_sort16(ch[0]); tk_sort16(ch[1]); tk_sort16(ch[2]); tk_sort16(ch[3]);
        tk_merge16(ch[0], ch[1]); tk_merge16(ch[2], ch[3]); tk_merge16(ch[0], ch[2]);
        int oth[16];
#pragma unroll
        for (int i = 0; i < 16; ++i) oth[i] = __builtin_amdgcn_mov_dpp(ch[0][i], 0xB1, 0xF, 0xF, true);
        tk_merge16(ch[0], oth);
#pragma unroll
        for (int i = 0; i < 16; ++i) oth[i] = __builtin_amdgcn_mov_dpp(ch[0][i], 0x4E, 0xF, 0xF, true);
        int t1[16], t2[16];
#pragma unroll
        for (int i = 0; i < 16; ++i) { t1[i] = (q < 2) ? ch[0][i] : oth[i]; t2[i] = (q < 2) ? oth[i] : ch[0][i]; }
        float f1[16], f2[16];
#pragma unroll
        for (int i = 0; i < 16; ++i) { f1[i] = tk_dec(t1[i]); f2[i] = tk_dec(t2[i]); }
        int cd[1][16];
#pragma unroll
        for (int sl = 0; sl < 16; ++sl) {
            float a[4], b[4]; int tg[4];
#pragma unroll
            for (int qq = 0; qq < 4; ++qq) { const int n = 16 * qq + sl, nn = n < 50 ? n : 49; a[qq] = f1[tk_ci(nn)]; b[qq] = f2[tk_cj(nn)]; tg[qq] = 255 - (16 * tk_ci(nn) + tk_cj(nn)); }
            const float av = q == 0 ? a[0] : q == 1 ? a[1] : q == 2 ? a[2] : a[3], bv = q == 0 ? b[0] : q == 1 ? b[1] : q == 2 ? b[2] : b[3];
            const int tv = q == 0 ? tg[0] : q == 1 ? tg[1] : q == 2 ? tg[2] : tg[3];
            const int key = (tk_enc(av + bv) & ~255) | tv;
            cd[0][sl] = (48 + sl >= 50 && q == 3) ? (int)0x80000000 : key;
        }
        tk_sort16(cd[0]);
#pragma unroll
        for (int i = 0; i < 16; ++i) oth[i] = __builtin_amdgcn_mov_dpp(cd[0][i], 0xB1, 0xF, 0xF, true);
        tk_merge16(cd[0], oth);
#pragma unroll
        for (int i = 0; i < 16; ++i) oth[i] = __builtin_amdgcn_mov_dpp(cd[0][i], 0x4E, 0xF, 0xF, true);
        tk_merge16(cd[0], oth);
        int w1[4], w2[4];
#pragma unroll
        for (int m = 0; m < 4; ++m) { w1[m] = (t1[4 * m] & 127) | ((t1[4 * m + 1] & 127) << 8) | ((t1[4 * m + 2] & 127) << 16) | ((t1[4 * m + 3] & 127) << 24);
                                      w2[m] = (t2[4 * m] & 127) | ((t2[4 * m + 1] & 127) << 8) | ((t2[4 * m + 2] & 127) << 16) | ((t2[4 * m + 3] & 127) << 24); }
        if (q == 0) {
            int id[16];
#pragma unroll
            for (int k = 0; k < 16; ++k) { const int c = 255 - (cd[0][k] & 255); id[k] = (127 - tk_lookup(w1, c >> 4)) * 128 + (127 - tk_lookup(w2, c & 15)); }
            int* oi = TIDX + (size_t)p * 16;
#pragma unroll
            for (int k = 0; k < 16; k += 4) *(int4*)(oi + k) = make_int4(id[k], id[k + 1], id[k + 2], id[k + 3]);
        } else if (q == 1) {
            float* ov = TVAL + (size_t)p * 16;
#pragma unroll
            for (int k = 0; k < 16; k += 4) *(f32x4*)(ov + k) = (f32x4){tk_dec(cd[0][k]), tk_dec(cd[0][k + 1]), tk_dec(cd[0][k + 2]), tk_dec(cd[0][k + 3])};
        }
    }
}

__device__ __forceinline__ void phase_x8(const Ctx& C) {
    unsigned char* ws = C.ws; const int lane = C.lane;
    const bf16_t* H1B = (const bf16_t*)(ws + SLOT(4)); unsigned char* X8 = ws + SLOT(2); float* XS = (float*)(ws + SLOT(2) + (size_t)M * 1024);
    int tok = C.gw; u32x4 na = {0u, 0u, 0u, 0u}, nb = {0u, 0u, 0u, 0u};
    if (tok < M) { na = *(const u32x4*)(H1B + (size_t)tok * 1024 + 16 * lane); nb = *(const u32x4*)(H1B + (size_t)tok * 1024 + 16 * lane + 8); }
    for (; tok < M; tok += C.NGW) {
        const u32x4 xa = na, xb = nb;
        { const int nt = tok + C.NGW; if (nt < M) { na = *(const u32x4*)(H1B + (size_t)nt * 1024 + 16 * lane); nb = *(const u32x4*)(H1B + (size_t)nt * 1024 + 16 * lane + 8); } }
        float hv[16]; { float t8[8]; unpack8(xa, t8);
#pragma unroll
            for (int i = 0; i < 8; ++i) hv[i] = t8[i];
            unpack8(xb, t8);
#pragma unroll
            for (int i = 0; i < 8; ++i) hv[8 + i] = t8[i]; }
        float am = 0.f;
#pragma unroll
        for (int i = 0; i < 16; ++i) am = fmaxf(am, fabsf(hv[i]));
#pragma unroll
        for (int o = 1; o < 64; o <<= 1) am = fmaxf(am, __shfl_xor(am, o));
        const float scale = am > 0.f ? am * (1.f / 127.f) : 1.f, inv = 1.f / scale;
        u32x4 w;
#pragma unroll
        for (int j = 0; j < 4; ++j) { const int q0 = (int)rintf(hv[4 * j] * inv), q1 = (int)rintf(hv[4 * j + 1] * inv), q2 = (int)rintf(hv[4 * j + 2] * inv), q3 = (int)rintf(hv[4 * j + 3] * inv);
            w[j] = (unsigned)(q0 & 255) | ((unsigned)(q1 & 255) << 8) | ((unsigned)(q2 & 255) << 16) | ((unsigned)q3 << 24); }
        *(u32x4*)(X8 + (size_t)tok * 1024 + 16 * lane) = w;
        if (lane == 0) XS[tok] = scale;
    }
}
__device__ __forceinline__ int idpp_ror8(int v) { return __builtin_amdgcn_update_dpp(0, v, 0x128, 0xF, 0xF, true); }
__device__ __forceinline__ int idpp_hmir(int v) { return __builtin_amdgcn_update_dpp(0, v, 0x141, 0xF, 0xF, true); }
__device__ __forceinline__ int idpp_x2(int v) { return __builtin_amdgcn_mov_dpp(v, 0x4E, 0xF, 0xF, true); }
__device__ __forceinline__ int idpp_x1(int v) { return __builtin_amdgcn_mov_dpp(v, 0xB1, 0xF, 0xF, true); }
__device__ __forceinline__ int idot16(const u32x4 w, const u32x4 x, int a) {
    a = __builtin_amdgcn_sdot4((int)w.x, (int)x.x, a, false); a = __builtin_amdgcn_sdot4((int)w.y, (int)x.y, a, false);
    a = __builtin_amdgcn_sdot4((int)w.z, (int)x.z, a, false); return __builtin_amdgcn_sdot4((int)w.w, (int)x.w, a, false);
}
__device__ __forceinline__ void u_process(unsigned c, unsigned co, int n, int tok, const u32x4 (&x)[4], float xscale, const unsigned char* PU, float* ACT, int lane, bool b3, bool b2) {
    const int rs = lane >> 4; const unsigned p16 = 16u * (unsigned)(lane & 15);
    for (int base = 0; base < n; base += 32) {
        u32x4 w[8][4];
#pragma unroll
        for (int m = 0; m < 8; ++m) if (base + 4 * m < n) {
            const unsigned off = (unsigned)__builtin_amdgcn_ds_bpermute(((base + 4 * m + rs) & 63) * 4, (int)co);
            const unsigned char* rp = PU + (off + p16);
#pragma unroll
            for (int i = 0; i < 4; ++i) w[m][i] = *(const u32x4*)(rp + 256 * i); }
        __builtin_amdgcn_sched_barrier(0);
#pragma unroll
        for (int H = 0; H < 4; ++H) if (base + 8 * H < n) {
            int p2[2];
#pragma unroll
            for (int mm = 0; mm < 2; ++mm) { int a = 0;
#pragma unroll
                for (int i = 0; i < 4; ++i) a = idot16(w[2 * H + mm][i], x[i], a);
                p2[mm] = a; }
            int u; { const int keep = b3 ? p2[1] : p2[0], send = b3 ? p2[0] : p2[1]; u = keep + idpp_ror8(send); }
            u += idpp_hmir(u); u += idpp_x2(u); u += idpp_x1(u);
            const int slot = base + 8 * H + (b3 ? 4 : 0) + rs;
            const unsigned mine = (unsigned)__builtin_amdgcn_ds_bpermute((slot & 63) * 4, (int)c);
            if ((lane & 7) == 0 && slot < n) ACT[(size_t)tok * 128 + (mine >> 16)] = (float)u * xscale;
        }
    }
}
constexpr int UB = 8;
__device__ __forceinline__ float u_batch_request(const unsigned char* X8, const float* XS, const int* TIDX, int tb, int tstep, unsigned xs_addr, int lane) {
#pragma unroll
    for (int k = 0; k < UB; ++k) { const int tk = tb + k * tstep; if (tk < M) glds16(X8 + (size_t)tk * 1024 + 16 * lane, xs_addr + k * 1024); }
#pragma unroll
    for (int k = 0; k < UB; k += 2) { if (tb + k * tstep < M) { int tk = tb + (k + (lane >> 5)) * tstep; tk = tk < M ? tk : tb;
        glds16(TIDX + (size_t)tk * 128 + 4 * (lane & 31), xs_addr + UB * 1024 + k * 512); } }
    const int tl = tb + (lane & (UB - 1)) * tstep;
    return XS[tl < M ? tl : tb];
}
__device__ __forceinline__ void phase_upart(const Ctx& C, int xcc, int rank) {
    unsigned char* ws = C.ws; const int lane = C.lane;
    const unsigned char* X8 = ws + SLOT(2); const float* XS = (const float*)(ws + SLOT(2) + (size_t)M * 1024);
    const int* TIDX = (const int*)(ws + SLOT(5)); float* ACT = (float*)(ws + SLOT(0));
    const unsigned char* PU = ws + WS_PU;
    LAS unsigned char* xs = C.lds + C.wave * (UB * 1536);
    const unsigned xs_addr = (unsigned)__builtin_amdgcn_readfirstlane((int)(unsigned)(size_t)xs);
    int nloc, xi, nx;
    if ((C.G & 7) == 0) { nx = 8; xi = xcc; nloc = C.G >> 3; } else { nx = 1; xi = 0; nloc = C.G; rank = blockIdx.x; }
    const bool b3 = (lane & 8) != 0, b2 = (lane & 4) != 0; const int pos = lane & 15;
    const int tstep = nloc * NWAVES;
    for (int sub = xi; sub < 8; sub += nx) {
        const unsigned dummy = (unsigned)(sub << 11) * 1024u;
        int tb = rank * NWAVES + C.wave;
        float svn = 0.f;
        if (tb < M) svn = u_batch_request(X8, XS, TIDX, tb, tstep, xs_addr, lane);
        for (; tb < M; tb += UB * tstep) {
            asm volatile("s_waitcnt vmcnt(0)" ::: "memory");
            const float sv = svn;
#pragma unroll 1
            for (int k = 0; k < UB; ++k) {
                const int tok = tb + k * tstep; if (tok >= M) break;
                u32x4 x[4];
#pragma unroll
                for (int i = 0; i < 4; ++i) x[i] = *(LAS const u32x4*)(xs + k * 1024 + 256 * i + 16 * pos);
                const int ca = *(LAS const int*)(xs + UB * 1024 + k * 512 + 4 * lane), cb = *(LAS const int*)(xs + UB * 1024 + k * 512 + 256 + 4 * lane);
                const float xscale = __uint_as_float(__builtin_amdgcn_readlane(__float_as_uint(sv), k));
                const bool fa = (ca >> 11) == sub, fb = (cb >> 11) == sub;
                const unsigned long long ma = __ballot(fa), mb = __ballot(fb);
                const int npa = __builtin_popcountll(ma), npb = __builtin_popcountll(mb);
                const int ra_ = (int)__builtin_amdgcn_mbcnt_hi((unsigned)(ma >> 32), __builtin_amdgcn_mbcnt_lo((unsigned)ma, 0u));
                const int rb_ = (int)__builtin_amdgcn_mbcnt_hi((unsigned)(mb >> 32), __builtin_amdgcn_mbcnt_lo((unsigned)mb, 0u));
                const int da = fa ? ra_ : npa + (lane - ra_), db = fb ? rb_ : npb + (lane - rb_);
                const unsigned cA = (unsigned)__builtin_amdgcn_ds_permute(da * 4, ca | (lane << 16));
                const unsigned cB = (unsigned)__builtin_amdgcn_ds_permute(db * 4, cb | ((64 + lane) << 16));
                if (npa + npb <= 64) {
                    const unsigned pulled = (unsigned)__builtin_amdgcn_ds_bpermute(((lane - npa) & 63) * 4, (int)cB);
                    const unsigned cc = lane < npa ? cA : pulled; const int n = npa + npb;
                    u_process(cc, lane < n ? (cc & 0xffffu) * 1024u : dummy, n, tok, x, xscale, PU, ACT, lane, b3, b2);
                } else { u_process(cA, lane < npa ? (cA & 0xffffu) * 1024u : dummy, npa, tok, x, xscale, PU, ACT, lane, b3, b2);
                         u_process(cB, lane < npb ? (cB & 0xffffu) * 1024u : dummy, npb, tok, x, xscale, PU, ACT, lane, b3, b2); }
            }
            asm volatile("s_waitcnt lgkmcnt(0)" ::: "memory");
            if (tb + UB * tstep < M) svn = u_batch_request(X8, XS, TIDX, tb + UB * tstep, tstep, xs_addr, lane);
        }
    }
}
__device__ __forceinline__ void phase_gather(const Ctx& C, float* DST) {
    unsigned char* ws = C.ws; const int lane = C.lane;
    const bf16_t* H1B = (const bf16_t*)(ws + SLOT(4)); const int* TIDX = (const int*)(ws + SLOT(5)); const float* TVAL = (const float*)(ws + SLOT(5) + (size_t)M * 128 * 4);
    const float* ACT = (const float*)(ws + SLOT(0));
    const unsigned char* PV = ws + WS_PV; const float* SU = (const float*)(ws + WS_SU); const float* SV = (const float*)(ws + WS_SV);
    const float* fg = C.in[24];
    const int l4 = lane >> 2; const unsigned l8 = 8u * (unsigned)lane;
    int tok = C.gw;
    u32x4 ra = {0u, 0u, 0u, 0u}, rb = {0u, 0u, 0u, 0u};
    if (tok < M) { ra = *(const u32x4*)(H1B + (size_t)tok * 1024 + 16 * lane); rb = *(const u32x4*)(H1B + (size_t)tok * 1024 + 16 * lane + 8); }
    for (; tok < M; tok += C.NGW) {
        f32x4 e[4]; float ss = 0.f;
        { float hv[16]; { float t8[8]; unpack8(ra, t8);
#pragma unroll
            for (int i = 0; i < 8; ++i) hv[i] = t8[i];
            unpack8(rb, t8);
#pragma unroll
            for (int i = 0; i < 8; ++i) hv[8 + i] = t8[i]; }
#pragma unroll
          for (int j = 0; j < 4; ++j) { e[j] = (f32x4){hv[4 * j], hv[4 * j + 1], hv[4 * j + 2], hv[4 * j + 3]}; ss += (e[j][0] * e[j][0] + e[j][1] * e[j][1]) + (e[j][2] * e[j][2] + e[j][3] * e[j][3]); } }
        { const int nt = tok + C.NGW; if (nt < M) { ra = *(const u32x4*)(H1B + (size_t)nt * 1024 + 16 * lane); rb = *(const u32x4*)(H1B + (size_t)nt * 1024 + 16 * lane + 8); } }
        f32x4* dp = (f32x4*)(DST + (size_t)tok * 1024 + 16 * lane);
        const float rstd = 1.f / sqrtf(wave_sum(ss) * (1.f / 1024.f) + EPS);
        f32x2 acc[8];
#pragma unroll
        for (int i = 0; i < 8; ++i) acc[i] = (f32x2){0.f, 0.f};
        int idxn0 = TIDX[(size_t)tok * 128 + l4], idxn1 = TIDX[(size_t)tok * 128 + 16 + l4];
        float tsn0 = TVAL[(size_t)tok * 128 + l4], tsn1 = TVAL[(size_t)tok * 128 + 16 + l4], dtn0 = ACT[(size_t)tok * 128 + l4], dtn1 = ACT[(size_t)tok * 128 + 16 + l4];
        for (int hp = 0; hp < 8; hp += 2) {
            const int idx0 = idxn0, idx1 = idxn1; const float ts0 = tsn0 * rstd, ts1 = tsn1 * rstd, dot0 = dtn0, dot1 = dtn1;
            u32x2 pa[32];
#pragma unroll
            for (int m = 0; m < 32; ++m) { const unsigned id = (unsigned)__builtin_amdgcn_readlane(m < 16 ? idx0 : idx1, 4 * (m & 15)); pa[m] = *(const u32x2*)(PV + (id * 512u + l8)); }
            __builtin_amdgcn_sched_barrier(0);
            const float su0 = SU[idx0], sv0 = SV[idx0], su1 = SU[idx1], sv1 = SV[idx1];
            if (hp < 6) { const size_t nb = (size_t)tok * 128 + (hp + 2) * 16 + l4; idxn0 = TIDX[nb]; idxn1 = TIDX[nb + 16]; tsn0 = TVAL[nb]; tsn1 = TVAL[nb + 16]; dtn0 = ACT[nb]; dtn1 = ACT[nb + 16]; }
            __builtin_amdgcn_sched_barrier(0);
            float mx0 = ts0, mx1 = ts1;
#pragma unroll
            for (int o = 4; o < 64; o <<= 1) { mx0 = fmaxf(mx0, __shfl_xor(mx0, o)); mx1 = fmaxf(mx1, __shfl_xor(mx1, o)); }
            const float ee0 = ex2((ts0 - mx0) * LOG2E), ee1 = ex2((ts1 - mx1) * LOG2E); float sm0 = ee0, sm1 = ee1;
#pragma unroll
            for (int o = 4; o < 64; o <<= 1) { sm0 += __shfl_xor(sm0, o); sm1 += __shfl_xor(sm1, o); }
            const float coef0 = (ee0 * rcpf_(sm0)) * gelu_t(dot0 * su0 * rstd) * sv0, coef1 = (ee1 * rcpf_(sm1)) * gelu_t(dot1 * su1 * rstd) * sv1;
#pragma unroll
            for (int m = 0; m < 32; ++m) {
                const float ck = __uint_as_float(__builtin_amdgcn_readlane(__float_as_uint(m < 16 ? coef0 : coef1), 4 * (m & 15)));
#pragma unroll
                for (int d = 0; d < 2; ++d) {
                    acc[4 * d] = __builtin_elementwise_fma(__builtin_amdgcn_cvt_scalef32_pk_f32_fp4(pa[m][d], 1.0f, 0), (f32x2){ck, ck}, acc[4 * d]);
                    acc[4 * d + 1] = __builtin_elementwise_fma(__builtin_amdgcn_cvt_scalef32_pk_f32_fp4(pa[m][d], 1.0f, 1), (f32x2){ck, ck}, acc[4 * d + 1]);
                    acc[4 * d + 2] = __builtin_elementwise_fma(__builtin_amdgcn_cvt_scalef32_pk_f32_fp4(pa[m][d], 1.0f, 2), (f32x2){ck, ck}, acc[4 * d + 2]);
                    acc[4 * d + 3] = __builtin_elementwise_fma(__builtin_amdgcn_cvt_scalef32_pk_f32_fp4(pa[m][d], 1.0f, 3), (f32x2){ck, ck}, acc[4 * d + 3]); }
                __builtin_amdgcn_sched_barrier(0);
            }
        }
        float s2 = 0.f;
#pragma unroll
        for (int j = 0; j < 4; ++j) {
            e[j][0] += acc[2 * j].x; e[j][1] += acc[2 * j].y; e[j][2] += acc[2 * j + 1].x; e[j][3] += acc[2 * j + 1].y;
            s2 += (e[j][0] * e[j][0] + e[j][1] * e[j][1]) + (e[j][2] * e[j][2] + e[j][3] * e[j][3]); }
        const float r2 = 1.f / sqrtf(wave_sum(s2) * (1.f / 1024.f) + EPS);
        const f32x4* fp = (const f32x4*)(fg + 16 * lane);
#pragma unroll
        for (int j = 0; j < 4; ++j) dp[j] = e[j] * r2 * fp[j];
    }
}

constexpr int NPHASE = 16;
__device__ __forceinline__ int relane(Ctx& C) { int l_ = hw_lane(); asm volatile("" : "+v"(l_)); C.lane = l_; C.tid = C.wave * 64 + l_; return 0; }
__global__ void __launch_bounds__(NTHR, 2) hybrid_fwd(Args args) {
    extern __shared__ __attribute__((aligned(16))) unsigned char lds_raw[];
    Ctx C;
    C.lds = (LAS unsigned char*)lds_raw; C.wave = __builtin_amdgcn_readfirstlane((int)(threadIdx.x >> 6)); asm volatile("" : "+s"(C.wave));     C.lane = hw_lane(); C.tid = C.wave * 64 + C.lane;
    C.G = gridDim.x; C.gw = blockIdx.x * NWAVES + C.wave; C.NGW = C.G * NWAVES; C.ws = args.ws; C.out = args.out; C.in = args.in;
    unsigned char* ws = args.ws;
    volatile LAS unsigned* MISC = (volatile LAS unsigned*)(C.lds + MISC_OFF);
    for (int u = C.tid; u < (LDS_BYTES - RING_BYTES) / 4; u += NTHR) ((LAS unsigned*)(C.lds + RING_BYTES))[u] = 0u;
    __syncthreads();
    XcdBarrier bar; bar.bar = (unsigned*)(ws + WS_CTL) + 1024; bar.x = 0; bar.st = nullptr; bar.w0 = C.wave == 0;
    if (ONE_LAUNCH) bar = xcd_barrier_post((unsigned*)(ws + WS_CTL) + 1024, MISC + 8, C.wave == 0);
    const int lo = args.ph_lo, hi = args.ph_hi;
#ifndef PHMASK
#define PHMASK 0xffff
#endif
#define IN(k) (((PHMASK >> (k)) & 1) && lo <= (k) && (k) < hi)
#ifndef PROBE_PHASE
#define PROBE_PHASE -1
#endif
#define REPS(k) for (int rep_ = relane(C); rep_ < ((k) == PROBE_PHASE ? 2 : 1); ++rep_)
#define SEAM(k) do { if (IN(k) && IN((k) + 1)) xcd_barrier(bar); } while (0)
    const int G = C.G, cb = blockIdx.x;
    LAS unsigned char* ring = C.lds;

    if (IN(0)) REPS(0) { phase_prologue(C); }
    SEAM(0);
    if (IN(1)) REPS(1) {
        pg8::Gemm g{(const bf16_t*)(ws + SLOT(0)), (const bf16_t*)(ws + WS_WIN), 512, 512, 512, 0, 256 * 512};
        pg8::Sched S; S.init(256, 19, G, cb, 256, 6, 4);
        pg8::Epi8<FInproj> E{{(bf16_t*)(ws + SLOT(1)), (bf16_t*)(ws + SLOT(2)), (bf16_t*)(ws + SLOT(3)), (bf16_t*)(ws + SLOT(4)), (bf16_t*)(ws + SLOT(5))}};
        pg8::gemm_phase<pg8::Epi8<FInproj>, true>(ring, g, S, E, C.wave);
        { const int nx = G > 12 ? 6 : 0;
          if (cb < G - nx) phase_tables(C, cb * NWAVES + C.wave, (G - nx) * NWAVES); }
    }
    SEAM(1);
    if (IN(2)) REPS(2) { phase_thin(C); }
    SEAM(2);
    if (IN(3)) REPS(3) {
        pg8::Gemm g{(const bf16_t*)(ws + SLOT(0)), (const bf16_t*)(ws + WS_WGATE), 1024, 128, 128, 128, 256 * 128};
        pg8::Sched S; S.init(256, 8, G, cb, 256, 8, 0);
        pg8::EpiPair<FGate> E{{(const bf16_t*)(ws + SLOT(0)), args.in[7], args.in[9], (const float*)(ws + WS_CLAM), (bf16_t*)(ws + SLOT(1)), (bf16_t*)(ws + SLOT(6))}};
        pg8::gemm_phase(ring, g, S, E, C.wave);
    }
    SEAM(3);
    if (IN(4)) REPS(4) { phase_scan1(C); }
    SEAM(4);
    if (IN(5)) REPS(5) { phase_scan2(C); }
    SEAM(5);
    if (IN(6)) REPS(6) {
        pg8::Gemm g{(const bf16_t*)(ws + SLOT(0)), (const bf16_t*)(ws + WS_WRNN), 512, 512, 512, 0, 256 * 512};
        pg8::Sched S; S.init(256, 4, G, cb, 0, 0, 0);
        pg8::Epi8<FMul<false>> E{{(const unsigned char*)(ws + SLOT(4)), nullptr, (bf16_t*)(ws + SLOT(2)), 1.f / (255.f * 256.f)}};
        pg8::gemm_phase<pg8::Epi8<FMul<false>>, true>(ring, g, S, E, C.wave);
    }
    SEAM(6);
    if (IN(7)) REPS(7) {
        { pg8::Gemm g{(const bf16_t*)(ws + SLOT(3) + KR_OFF), (const bf16_t*)(ws + WS_WUQ), CQKV_LD / 2, 256, 256, 0, 256 * 256};
          pg8::Sched S; S.init(256, 6, G, cb, 0, 0, 0);
          pg8::Epi8<FQ> E{{(const float*)(ws + WS_RSQ), (bf16_t*)(ws + SLOT(0))}};
          pg8::gemm_phase<pg8::Epi8<FQ>, true>(ring, g, S, E, C.wave); }
        { pg8::Gemm g{(const bf16_t*)(ws + SLOT(3)), (const bf16_t*)(ws + WS_WUKV), CQKV_LD / 2, 128, 128, 0, 256 * 128};
          pg8::Sched S; S.init(256, 8, G, cb, 256, 8, 0);
          pg8::Epi8<FKV> E{{(const float*)(ws + WS_RSKV), (bf16_t*)(ws + SLOT(4)), (bf16_t*)(ws + SLOT(6))}};
          pg8::gemm_phase<pg8::Epi8<FKV>, true>(ring, g, S, E, C.wave); }
    }
    SEAM(7);
    if (IN(8)) REPS(8) { phase_attn(C); }
    SEAM(8);
    if (IN(9)) REPS(9) {
        pg8::Gemm g{(const bf16_t*)(ws + SLOT(3)), (const bf16_t*)(ws + WS_WATT), 512, 512, 512, 0, 256 * 512};
        pg8::Sched S; S.init(256, 4, G, cb, 0, 0, 0);
        pg8::Epi8<FMul<true>> E{{(const unsigned char*)(ws + SLOT(5)), (const bf16_t*)(ws + SLOT(2)), (bf16_t*)(ws + SLOT(0)), 1.f / (255.f * 256.f)}};
        pg8::gemm_phase<pg8::Epi8<FMul<true>>, true>(ring, g, S, E, C.wave);
    }
    SEAM(9);
    if (IN(10)) REPS(10) {
        pg8::Gemm g{(const bf16_t*)(ws + SLOT(0)), (const bf16_t*)(ws + WS_WOUT), 512, 512, 512, 0, 256 * 512};
        pg8::Sched S; S.init(256, 4, G, cb, 0, 0, 0);
        pg8::Epi8<FRes> E{{args.in[0], (bf16_t*)(ws + SLOT(4))}};
        pg8::gemm_phase<pg8::Epi8<FRes>, true>(ring, g, S, E, C.wave);
    }
    SEAM(10);
    if (IN(11)) REPS(11) {
        pg8::Gemm g{(const bf16_t*)(ws + SLOT(4)), (const bf16_t*)(ws + WS_WPQ), 1024, 1024, 1024, 0, 256 * 1024};
        pg8::Sched S; S.init(256, 8, G, cb, 0, 0, 0);
        pg8::Epi8<FF16> E{{(_Float16*)(ws + SLOT(0)), 2048}};
        pg8::gemm_phase(ring, g, S, E, C.wave);
    }
    SEAM(11);
    if (IN(13)) REPS(13) { phase_x8(C); phase_topk(C); }
    SEAM(13);
    if (IN(14)) REPS(14) { phase_upart(C, (int)(blockIdx.x & 7), (int)(blockIdx.x >> 3)); }
    SEAM(14);
    if (IN(15)) REPS(15) { phase_gather(C, C.out); }
#undef IN
#undef SEAM
}

extern "C" void kernel_launch(void* const* d_in, const int* in_sizes, int n_in, void* d_out, int out_size, void* d_ws, size_t ws_size, hipStream_t stream) {
    static int grid = 0;
    if (grid == 0) {
        if (n_in != 25 || in_sizes[0] != M * DM || out_size != M * DM || ws_size < WS_END) { fprintf(stderr, "kernel_launch: unexpected shapes (n_in %d in0 %d out %d ws %zu need %zu); nothing launched\n", n_in, n_in > 0 ? in_sizes[0] : -1, out_size, ws_size, (size_t)WS_END); grid = -1; return; }
        int dev = 0, cus = 0, per_cu = 0;
        if (hipGetDevice(&dev) != hipSuccess || hipDeviceGetAttribute(&cus, hipDeviceAttributeMultiprocessorCount, dev) != hipSuccess) { grid = -1; return; }
        if (hipFuncSetAttribute((const void*)hybrid_fwd, hipFuncAttributeMaxDynamicSharedMemorySize, LDS_BYTES) != hipSuccess) { fprintf(stderr, "kernel_launch: hipFuncSetAttribute failed\n"); grid = -1; return; }
        if (hipOccupancyMaxActiveBlocksPerMultiprocessor(&per_cu, (const void*)hybrid_fwd, NTHR, LDS_BYTES) != hipSuccess || per_cu < 1) fprintf(stderr, "kernel_launch: occupancy query reports %d\n", per_cu);
        (void)hipGetLastError();
        grid = cus;
    }
    if (grid < 0) return;
    if (hipMemsetAsync((char*)d_ws + WS_CTL, 0, CTL_ZERO_BYTES, stream) != hipSuccess) return;
    Args a{};
    for (int i = 0; i < 25; ++i) a.in[i] = (const float*)d_in[i];
    a.out = (float*)d_out; a.ws = (unsigned char*)d_ws;
#if ONE_LAUNCH
    a.ph_lo = 0; a.ph_hi = NPHASE;
    hipLaunchKernelGGL(hybrid_fwd, dim3(grid), dim3(NTHR), LDS_BYTES, stream, a);
#else
    for (int p = 0; p < NPHASE; ++p) { a.ph_lo = p; a.ph_hi = p + 1; hipLaunchKernelGGL(hybrid_fwd, dim3(grid), dim3(NTHR), LDS_BYTES, stream, a); }
#endif
}
```
